# Optimizing an MI355X kernel written in HIP

```python
import math
import jax, jax.numpy as jnp
from jax import lax
import numpy as np

D_MODEL = 4096
BATCH = 2
SEQ = 8192
DEPTH = 1

NSA_HEADS = 16
NSA_KV_GROUPS = 4
HEAD_DIM = 128
CMP_BLOCK = 32
CMP_STRIDE = 16
CMP_HIDDEN = 256
SLC_BLOCK = 64
SLC_TOPK = 16
WINDOW = 512
Q_BLOCK = 128
NSA_WIDTH = NSA_HEADS * HEAD_DIM
KV_WIDTH = NSA_KV_GROUPS * HEAD_DIM
SGU_GROUPS = 16
SGU_GROUP_DIM = 128
SGU_CHUNK = 128
SGU_WIDTH = SGU_GROUPS * SGU_GROUP_DIM
REL_BUCKETS = 32
REL_MAX_DIST = 128
D_FF = 11008
CONV_WIDTH = 3
EPS = 1e-6
NEG = -1e30
FORCE = 1e6
IN_SPLITS = (NSA_WIDTH, KV_WIDTH, KV_WIDTH, KV_WIDTH, KV_WIDTH, KV_WIDTH, KV_WIDTH,
             NSA_HEADS * 3, 2 * SGU_WIDTH, D_MODEL, D_MODEL)
IN_WIDTH = sum(IN_SPLITS)

kernel_name = "hybrid_nsa_sgu_convffn_block"


def rms_norm(x, g):
    xf = x.astype(jnp.float32)
    y = xf * lax.rsqrt(jnp.mean(xf * xf, axis=-1, keepdims=True) + EPS)
    return (y * g.astype(jnp.float32)).astype(x.dtype)


def layer_norm(x, g, b):
    xf = x.astype(jnp.float32)
    mu = jnp.mean(xf, axis=-1, keepdims=True)
    var = jnp.mean(jnp.square(xf - mu), axis=-1, keepdims=True)
    y = (xf - mu) * lax.rsqrt(var + EPS) * g.astype(jnp.float32) + b.astype(jnp.float32)
    return y.astype(x.dtype)


def modulate(h, shift, scale):
    return h * (1 + scale[:, None, :]) + shift[:, None, :]


def rel_bucket(dist):
    n = jnp.maximum(dist, 0)
    max_exact = REL_BUCKETS // 2
    nf = jnp.maximum(n, 1).astype(jnp.float32)
    large = max_exact + (jnp.log(nf / max_exact) / math.log(REL_MAX_DIST / max_exact)
                         * (REL_BUCKETS - max_exact)).astype(jnp.int32)
    large = jnp.minimum(large, REL_BUCKETS - 1)
    return jnp.where(n < max_exact, n, large)


def selection_matrix(n_cmp, n_slc):
    ratio = SLC_BLOCK // CMP_STRIDE
    span = CMP_BLOCK // CMP_STRIDE
    d = jnp.arange(n_cmp)[:, None] - ratio * jnp.arange(n_slc)[None, :]
    b = jnp.arange(span)
    a = d[..., None] + b
    return jnp.sum((a >= 0) & (a < ratio), axis=-1).astype(jnp.float32)


def compress_blocks(kv, pos, w1, b1, w2, b2):
    B, T, G, dk = kv.shape
    n_cmp = (T - CMP_BLOCK) // CMP_STRIDE + 1
    idx = jnp.arange(n_cmp)[:, None] * CMP_STRIDE + jnp.arange(CMP_BLOCK)[None, :]
    blocks = kv[:, idx] + pos[:, None, :]
    blocks = blocks.transpose(0, 3, 1, 2, 4).reshape(B, G, n_cmp, CMP_BLOCK * dk)
    hid = jax.nn.gelu(blocks @ w1 + b1)
    return hid @ w2 + b2


def nsa_attention(q, kc, vc, ks, vs, kw, vw, gates, rel_table):
    B, T, H, dk = q.shape
    G = kc.shape[1]
    R = H // G
    n_cmp = kc.shape[2]
    n_slc = T // SLC_BLOCK
    top_k = min(SLC_TOPK, n_slc)
    n_sel = top_k * SLC_BLOCK
    qg = q.reshape(B, T, G, R, dk).transpose(0, 2, 3, 1, 4) * (HEAD_DIM ** -0.5)
    gg = gates.reshape(B, T, G, R, 3).transpose(0, 2, 3, 1, 4)
    ks_b = ks.transpose(0, 2, 1, 3).reshape(B, G, n_slc, SLC_BLOCK, dk)
    vs_b = vs.transpose(0, 2, 1, 3).reshape(B, G, n_slc, SLC_BLOCK, dk)
    pad = ((0, 0), (0, 0), (WINDOW, 0), (0, 0))
    kw_p = jnp.pad(kw.transpose(0, 2, 1, 3), pad)
    vw_p = jnp.pad(vw.transpose(0, 2, 1, 3), pad)
    sel_map = selection_matrix(n_cmp, n_slc)
    cmp_end = jnp.arange(n_cmp) * CMP_STRIDE + CMP_BLOCK - 1
    slc_start = jnp.arange(n_slc) * SLC_BLOCK
    tbl_grp = rel_table.reshape(REL_BUCKETS, G, R).transpose(1, 0, 2)
    b_idx = jnp.arange(B)[:, None, None, None]
    g_idx = jnp.arange(G)[None, :, None, None]
    q_idx = jnp.arange(Q_BLOCK)[None, None, :, None]

    def heads_bias(dist):
        bias = rel_table[rel_bucket(dist)]
        return bias.transpose(2, 0, 1).reshape(G, R, dist.shape[0], dist.shape[1])

    def block(qb):
        t0 = qb * Q_BLOCK
        tq = t0 + jnp.arange(Q_BLOCK)
        qq = lax.dynamic_slice_in_dim(qg, t0, Q_BLOCK, axis=3)
        gq = lax.dynamic_slice_in_dim(gg, t0, Q_BLOCK, axis=3)
        dist_c = tq[:, None] - cmp_end[None, :]
        vis_c = dist_c >= 0
        s_c = jnp.einsum('bgrqd,bgnd->bgrqn', qq, kc).astype(jnp.float32) + heads_bias(dist_c)
        s_c = jnp.where(vis_c, s_c, NEG)
        p_c = jnp.where(jnp.any(vis_c, axis=-1)[:, None], jax.nn.softmax(s_c, axis=-1), 0.0)
        o_c = jnp.einsum('bgrqn,bgnd->bgrqd', p_c.astype(vc.dtype), vc)
        imp = jnp.einsum('bgrqn,nj->bgqj', p_c, sel_map)
        cur = tq // SLC_BLOCK
        vis_s = slc_start[None, :] <= tq[:, None]
        j = jnp.arange(n_slc)[None, :]
        forced = (j == 0) | (j == cur[:, None]) | (j == cur[:, None] - 1)
        score = jnp.where(vis_s & forced, FORCE, jnp.where(vis_s, imp, -1.0))
        _, sel = lax.top_k(score, top_k)
        sel_ok = vis_s[q_idx, sel]
        kg = ks_b[b_idx, g_idx, sel]
        vg = vs_b[b_idx, g_idx, sel]
        tok = sel[..., None] * SLC_BLOCK + jnp.arange(SLC_BLOCK)
        dist_s = tq[:, None, None] - tok
        ok_s = sel_ok[..., None] & (dist_s >= 0)
        bias_s = tbl_grp[g_idx[..., None], rel_bucket(dist_s)].transpose(0, 1, 5, 2, 3, 4)
        s_s = jnp.einsum('bgrqd,bgqkld->bgrqkl', qq, kg).astype(jnp.float32) + bias_s
        s_s = jnp.where(ok_s[:, :, None], s_s, NEG).reshape(B, G, R, Q_BLOCK, n_sel)
        p_s = jax.nn.softmax(s_s, axis=-1)
        o_s = jnp.einsum('bgrqm,bgqmd->bgrqd', p_s.astype(vg.dtype), vg.reshape(B, G, Q_BLOCK, n_sel, dk))
        kwb = lax.dynamic_slice_in_dim(kw_p, t0, Q_BLOCK + WINDOW, axis=2)
        vwb = lax.dynamic_slice_in_dim(vw_p, t0, Q_BLOCK + WINDOW, axis=2)
        kpos = t0 - WINDOW + jnp.arange(Q_BLOCK + WINDOW)
        dist_w = tq[:, None] - kpos[None, :]
        ok_w = (dist_w >= 0) & (dist_w < WINDOW) & (kpos[None, :] >= 0)
        s_w = jnp.einsum('bgrqd,bgkd->bgrqk', qq, kwb).astype(jnp.float32) + heads_bias(dist_w)
        p_w = jax.nn.softmax(jnp.where(ok_w, s_w, NEG), axis=-1)
        o_w = jnp.einsum('bgrqk,bgkd->bgrqd', p_w.astype(vwb.dtype), vwb)
        o = gq[..., 0:1] * o_c + gq[..., 1:2] * o_s + gq[..., 2:3] * o_w
        return o.transpose(0, 3, 1, 2, 4).reshape(B, Q_BLOCK, H * dk)

    out = lax.map(block, jnp.arange(T // Q_BLOCK))
    return out.transpose(1, 0, 2, 3).reshape(B, T, H * dk)


def spatial_gating(z, ln_g, ln_b, w_s, b_s):
    B, T, _ = z.shape
    u, v = jnp.split(jax.nn.gelu(z), 2, axis=-1)
    v = layer_norm(v, ln_g, ln_b)
    v = v.reshape(B, T // SGU_CHUNK, SGU_CHUNK, SGU_GROUPS, SGU_GROUP_DIM)
    w = w_s * jnp.tril(jnp.ones((SGU_CHUNK, SGU_CHUNK), w_s.dtype))
    mixed = jnp.einsum('hts,bcshd->bcthd', w, v) + b_s.T[:, :, None]
    return u * mixed.reshape(B, T, SGU_WIDTH)


def token_mixer(h, w_in, cmp_pos, cmp_w1, cmp_b1, cmp_w2, cmp_b2, rel_table,
                sgu_ln_g, sgu_ln_b, sgu_w, sgu_b, w_proj_nsa, w_proj_sgu, w_out):
    B, T, _ = h.shape
    proj = h @ w_in
    (q, k_c, v_c, k_s, v_s, k_w, v_w, g_nsa, z_sgu, g_a, g_b) = jnp.split(
        proj, list(np.cumsum(IN_SPLITS)[:-1]), axis=-1)
    kvshape = (B, T, NSA_KV_GROUPS, HEAD_DIM)
    kc = compress_blocks(k_c.reshape(kvshape), cmp_pos[0], cmp_w1[0], cmp_b1[0], cmp_w2[0], cmp_b2[0])
    vc = compress_blocks(v_c.reshape(kvshape), cmp_pos[1], cmp_w1[1], cmp_b1[1], cmp_w2[1], cmp_b2[1])
    gates = jax.nn.sigmoid(g_nsa).reshape(B, T, NSA_HEADS, 3)
    y_a = nsa_attention(q.reshape(B, T, NSA_HEADS, HEAD_DIM), kc, vc,
                        k_s.reshape(kvshape), v_s.reshape(kvshape),
                        k_w.reshape(kvshape), v_w.reshape(kvshape), gates, rel_table)
    y_b = spatial_gating(z_sgu, sgu_ln_g, sgu_ln_b, sgu_w, sgu_b)
    merged = jax.nn.sigmoid(g_a) * (y_a @ w_proj_nsa) + jax.nn.sigmoid(g_b) * (y_b @ w_proj_sgu)
    return merged @ w_out


def conv_ffn(h, w_up, conv_w, conv_b, w_down):
    a = h @ w_up
    T = a.shape[1]
    ap = jnp.pad(a, ((0, 0), (CONV_WIDTH - 1, 0), (0, 0)))
    conv = conv_b
    for k in range(CONV_WIDTH):
        conv = conv + ap[:, k:k + T] * conv_w[k]
    gate, up = jnp.split(conv, 2, axis=-1)
    return (jax.nn.silu(gate) * up) @ w_down


def setup_inputs(seed: int = 0) -> dict:
    key = jax.random.key(seed)
    ks = jax.random.split(key, 24)
    L = DEPTH
    f32 = jnp.float32

    def nrm(k, shape, scale):
        return jax.random.normal(k, shape, f32) * scale

    return {
        "x": nrm(ks[0], (BATCH, SEQ, D_MODEL), 1.0),
        "c": nrm(ks[1], (BATCH, D_MODEL), 1.0),
        "w_mod": nrm(ks[2], (L, D_MODEL, 6 * D_MODEL), D_MODEL ** -0.5),
        "b_mod": nrm(ks[3], (L, 6 * D_MODEL), 0.01),
        "g_norms": 1.0 + nrm(ks[4], (L, 4, D_MODEL), 0.01),
        "w_in": nrm(ks[5], (L, D_MODEL, IN_WIDTH), D_MODEL ** -0.5),
        "cmp_pos": nrm(ks[6], (L, 2, CMP_BLOCK, HEAD_DIM), 0.02),
        "cmp_w1": nrm(ks[7], (L, 2, CMP_BLOCK * HEAD_DIM, CMP_HIDDEN), (CMP_BLOCK * HEAD_DIM) ** -0.5),
        "cmp_b1": nrm(ks[8], (L, 2, CMP_HIDDEN), 0.01),
        "cmp_w2": nrm(ks[9], (L, 2, CMP_HIDDEN, HEAD_DIM), CMP_HIDDEN ** -0.5),
        "cmp_b2": nrm(ks[10], (L, 2, HEAD_DIM), 0.01),
        "rel_table": nrm(ks[11], (REL_BUCKETS, NSA_HEADS), 0.5),
        "sgu_ln_g": 1.0 + nrm(ks[12], (L, SGU_WIDTH), 0.01),
        "sgu_ln_b": nrm(ks[13], (L, SGU_WIDTH), 0.01),
        "sgu_w": nrm(ks[14], (L, SGU_GROUPS, SGU_CHUNK, SGU_CHUNK), SGU_CHUNK ** -0.5),
        "sgu_b": 1.0 + nrm(ks[15], (L, SGU_GROUPS, SGU_CHUNK), 0.01),
        "w_proj_nsa": nrm(ks[16], (L, NSA_WIDTH, D_MODEL), NSA_WIDTH ** -0.5),
        "w_proj_sgu": nrm(ks[17], (L, SGU_WIDTH, D_MODEL), SGU_WIDTH ** -0.5),
        "w_out": nrm(ks[18], (L, D_MODEL, D_MODEL), D_MODEL ** -0.5),
        "w_ffn_up": nrm(ks[19], (L, D_MODEL, 2 * D_FF), D_MODEL ** -0.5),
        "ffn_conv_w": nrm(ks[20], (L, CONV_WIDTH, 2 * D_FF), CONV_WIDTH ** -0.5),
        "ffn_conv_b": nrm(ks[21], (L, 2 * D_FF), 0.01),
        "w_ffn_down": nrm(ks[22], (L, D_FF, D_MODEL), D_FF ** -0.5),
    }


def reference(x, c, w_mod, b_mod, g_norms, w_in, cmp_pos, cmp_w1, cmp_b1, cmp_w2, cmp_b2,
              rel_table, sgu_ln_g, sgu_ln_b, sgu_w, sgu_b, w_proj_nsa, w_proj_sgu, w_out,
              w_ffn_up, ffn_conv_w, ffn_conv_b, w_ffn_down):
    c_act = jax.nn.silu(c)
    for l in range(DEPTH):
        mod = c_act @ w_mod[l] + b_mod[l]
        sh1, sc1, gt1, sh2, sc2, gt2 = jnp.split(mod, 6, axis=-1)
        h = modulate(rms_norm(x, g_norms[l, 0]), sh1, sc1)
        y = token_mixer(h, w_in[l], cmp_pos[l], cmp_w1[l], cmp_b1[l], cmp_w2[l], cmp_b2[l], rel_table,
                        sgu_ln_g[l], sgu_ln_b[l], sgu_w[l], sgu_b[l], w_proj_nsa[l], w_proj_sgu[l], w_out[l])
        x = x + gt1[:, None, :] * rms_norm(y, g_norms[l, 1])
        h = modulate(rms_norm(x, g_norms[l, 2]), sh2, sc2)
        y = conv_ffn(h, w_ffn_up[l], ffn_conv_w[l], ffn_conv_b[l], w_ffn_down[l])
        x = x + gt2[:, None, :] * rms_norm(y, g_norms[l, 3])
    return x
```

```cpp
#include <hip/hip_runtime.h>
#include <cstdio>
#include <cstdint>

#ifndef MK_N_LAUNCHES
#define MK_N_LAUNCHES 1
#endif

#ifndef PROBE_DUP
#define PROBE_DUP 0
#endif
#define GAS __attribute__((address_space(1)))
#define LAS __attribute__((address_space(3)))
typedef _Float16 f16;
typedef _Float16 hx8 __attribute__((ext_vector_type(8)));
typedef _Float16 hx4 __attribute__((ext_vector_type(4)));
typedef _Float16 hx2 __attribute__((ext_vector_type(2)));
typedef float f32x4 __attribute__((ext_vector_type(4)));
typedef float f32x2 __attribute__((ext_vector_type(2)));
typedef unsigned u32x4 __attribute__((ext_vector_type(4)));
typedef unsigned u32x2 __attribute__((ext_vector_type(2)));

constexpr int NB = 2, T = 8192, D = 4096, M = NB * T;
constexpr int NG = 4, HD = 128;
constexpr int DFF = 11008, NUP = 2 * DFF;
constexpr int IN_W = 17456, NPROJ = 16384, NMOD = 6 * D;
constexpr float EPS = 1e-6f;
constexpr float LOG2E = 1.4426950408889634f;
constexpr float SC2 = 0.08838834764831845f * 1.4426950408889634f;

constexpr size_t MiB = 1ull << 20;
constexpr size_t WS_CTL = 0, CTL_BYTES = 1 * MiB;
constexpr size_t WS_MOD = 1 * MiB;
constexpr size_t WS_POSW1 = 1 * MiB + 256 * 1024;
constexpr size_t WS_W2T = 1 * MiB + 384 * 1024;
constexpr size_t WS_SGUW = 2 * MiB;
constexpr size_t WS_WG = 2 * MiB + 512 * 1024;
constexpr size_t WS_KC = 3 * MiB;
constexpr size_t WS_VCT = 4 * MiB;
constexpr size_t WS_GATES = 5 * MiB;
constexpr size_t WS_W1T = 8 * MiB;
constexpr size_t WS_WUP = 16 * MiB;
constexpr size_t WS_WDN = 188 * MiB;
constexpr size_t WS_WIN = 274 * MiB;
constexpr size_t WS_WVT = 402 * MiB;
constexpr size_t WS_WM = 410 * MiB;
constexpr size_t WS_WO = 442 * MiB;
constexpr size_t WS_H = 474 * MiB;
constexpr size_t WS_Q = 602 * MiB;
constexpr size_t WS_KV = 666 * MiB;
constexpr size_t WS_VT = 730 * MiB;
constexpr size_t WS_Z = 762 * MiB;
constexpr size_t WS_GA = 890 * MiB;
constexpr size_t WS_GB = 1018 * MiB;
constexpr size_t WS_YAB = 1146 * MiB;
constexpr size_t WS_H2 = 274 * MiB;
constexpr size_t WS_AH = 406 * MiB;
constexpr size_t WS_AT = 418 * MiB;
constexpr size_t WS_ACT = 1090 * MiB;
constexpr size_t WS_Y2 = 432 * MiB;
constexpr size_t WS_X1H = 602 * MiB;
constexpr size_t WS_YSC = 1274 * MiB;
constexpr size_t WS_END = 1434 * MiB;

constexpr int CW_BAR = 4096;

constexpr int LDS_BYTES = 147456;
constexpr int MISC_OFF = LDS_BYTES - 512;
constexpr int NWAVES = 8, NTHREADS = 512;

#define LDS_WAIT() asm volatile("s_waitcnt lgkmcnt(0)" ::: "memory")
#define VM_WAIT() asm volatile("s_waitcnt vmcnt(0)" ::: "memory")
__device__ __forceinline__ unsigned pkh(float lo, float hi) { hx2 p; p.x = (f16)lo; p.y = (f16)hi; return __builtin_bit_cast(unsigned, p); }
__device__ __forceinline__ unsigned pkb(float lo, float hi) { unsigned r; asm volatile("v_cvt_pk_bf16_f32 %0, %1, %2" : "=v"(r) : "v"(lo), "v"(hi)); return r; }
#ifndef FFN_BF16
#define FFN_BF16 1
#endif
__device__ __forceinline__ unsigned pk_ffn(float lo, float hi) { return FFN_BF16 ? pkb(lo, hi) : pkh(lo, hi); }
#ifndef MIX_BF16
#define MIX_BF16 1
#endif
__device__ __forceinline__ unsigned pk_mix(float lo, float hi) { return MIX_BF16 ? pkb(lo, hi) : pkh(lo, hi); }
__device__ __forceinline__ float wave_sum(float v) {
#pragma unroll
    for (int o = 1; o < 64; o <<= 1) v += __shfl_xor(v, o);
    return v;
}
__device__ __forceinline__ float fsigmoid(float x) { return __builtin_amdgcn_rcpf(1.0f + __builtin_amdgcn_exp2f(-LOG2E * x)); }
__device__ __forceinline__ float fsilu(float x) { return x * fsigmoid(x); }
__device__ __forceinline__ float fgelu(float x) { const float u = x * (1.0f + 0.044715f * x * x); return x * __builtin_amdgcn_rcpf(1.0f + __builtin_amdgcn_exp2f(-2.302208198f * u)); }
template <int CTRL> __device__ __forceinline__ float dpp_f(float v) { return __builtin_bit_cast(float, __builtin_amdgcn_update_dpp(0, __builtin_bit_cast(int, v), CTRL, 0xF, 0xF, true)); }

namespace pg8 {
constexpr int BM = 256, BK = 64, HALF = 128, HTB = HALF * BK * 2, STAGE_BYTES = 8 * HTB, NXCD = 8, WGM = 8;
__host__ __device__ __forceinline__ int lds_byte(int r, int c) { const int st = (r >> 4) * 2 + (c >> 5), rr = r & 15, cc = c & 31, ob = rr * 64 + cc * 2; return st * 1024 + (ob ^ (((ob >> 9) & 1) << 5)); }
__host__ __device__ __forceinline__ void stage_rc(int b, int& R, int& C) { const int st = b / 1024, sb = b % 1024, swz = sb ^ (((sb >> 9) & 1) << 5); R = (st >> 1) * 16 + swz / 64; C = (st & 1) * 32 + (swz % 64) / 2; }
__host__ __device__ __forceinline__ int perm32(int rho) { const int n = rho >> 4, i = rho & 15; return 8 * (i >> 2) + 4 * n + (i & 3); }

struct Unit { int pm, pn; };
struct Gemm { const f16* A; const f16* Bt; int M, N, K; };

struct StaticOrder {
    int nM, nN, nwg, G, c;
    __host__ __device__ void init(int M_, int N_, int G_, int c_) { nM = M_ / BM; nN = N_ / BM; nwg = nM * nN; G = G_; c = c_; }
    __host__ __device__ bool next(int i, Unit& u) const {
        const long L = (long)i * G + c; if (L >= nwg) return false;
        int wgid = (int)L; { const int q = nwg / NXCD, r = nwg % NXCD, xcd = wgid % NXCD, off = wgid / NXCD; wgid = (xcd < r ? xcd * (q + 1) : r * (q + 1) + (xcd - r) * q) + off; }
        const int nig = WGM * nN, gid = wgid / nig, fm = gid * WGM, gsz = (nM - fm) < WGM ? (nM - fm) : WGM;
        u.pm = fm + ((wgid % nig) % gsz); u.pn = (wgid % nig) / gsz; return true;
    }
    __device__ __forceinline__ void a_ready(const Unit&) const {}
    __device__ __forceinline__ void done(const Unit&) const {}
};

__device__ __forceinline__ u32x4 pack8(const f32x4 v0, const f32x4 v1) { u32x4 w; w.x = pkh(v0[0], v0[1]); w.y = pkh(v0[2], v0[3]); w.z = pkh(v1[0], v1[1]); w.w = pkh(v1[2], v1[3]); return w; }

__device__ __forceinline__ unsigned opaque(unsigned v) { asm volatile("" : "+v"(v)); return v; }
struct EpiF32 {
    static constexpr bool PERM = false, AFTER_DRAIN = false, HAS_MID = false;
    float* C; int ldc;
    __device__ __forceinline__ void mid(f32x4 (&)[2][2][4][2], const Unit&, int, int, int, int) const {}
    __device__ __forceinline__ void operator()(const f32x4 (&acc)[2][2][4][2], const Unit& u, int wr, int wc, int fr, int fq) const {
        const unsigned off = opaque((unsigned)((u.pm * BM + wr * 64 + fr) * ldc + u.pn * BM + wc * 32 + 4 * fq) * 4u);
        char* base = (char*)C;
#pragma unroll
        for (int ai = 0; ai < 2; ++ai)
#pragma unroll
            for (int m = 0; m < 4; ++m) { const unsigned ro = off + (unsigned)((ai * HALF + m * 16) * ldc) * 4u;
#pragma unroll
                for (int bj = 0; bj < 2; ++bj)
#pragma unroll
                    for (int n = 0; n < 2; ++n) *(f32x4*)(base + ro + (bj * HALF + n * 16) * 4) = acc[ai][bj][m][n]; }
    }
};
struct EpiH16 {
    static constexpr bool PERM = true, AFTER_DRAIN = false, HAS_MID = false;
    f16* O; int ldc;
    __device__ __forceinline__ void mid(f32x4 (&)[2][2][4][2], const Unit&, int, int, int, int) const {}
    __device__ __forceinline__ void operator()(const f32x4 (&acc)[2][2][4][2], const Unit& u, int wr, int wc, int fr, int fq) const {
        const unsigned off = opaque((unsigned)((u.pm * BM + wr * 64 + fr) * ldc + u.pn * BM + wc * 32 + 8 * fq) * 2u);
        char* base = (char*)O;
#pragma unroll
        for (int ai = 0; ai < 2; ++ai)
#pragma unroll
            for (int m = 0; m < 4; ++m) { const unsigned ro = off + (unsigned)((ai * HALF + m * 16) * ldc) * 2u;
#pragma unroll
                for (int bj = 0; bj < 2; ++bj) *(u32x4*)(base + ro + bj * HALF * 2) = pack8(acc[ai][bj][m][0], acc[ai][bj][m][1]); }
    }
};
struct EpiProj {
    static constexpr bool PERM = true, AFTER_DRAIN = false, HAS_MID = false;
    f16 *Q, *KV, *Z, *GA, *GB;
    __device__ __forceinline__ void mid(f32x4 (&)[2][2][4][2], const Unit&, int, int, int, int) const {}
    __device__ __forceinline__ void operator()(const f32x4 (&acc)[2][2][4][2], const Unit& u, int wr, int wc, int fr, int fq) const {
        const int pn = u.pn; char* base; int ldc, colt, act;
        if (pn < 8) { base = (char*)Q; ldc = 2048; colt = pn * 256; act = 0; }
        else if (pn < 16) { base = (char*)KV; ldc = 2048; colt = (pn - 8) * 256; act = 0; }
        else if (pn < 32) { base = (char*)Z; ldc = 4096; colt = (pn - 16) * 256; act = 1; }
        else if (pn < 48) { base = (char*)GA; ldc = 4096; colt = (pn - 32) * 256; act = 2; }
        else { base = (char*)GB; ldc = 4096; colt = (pn - 48) * 256; act = 2; }
        const unsigned off = opaque((unsigned)((u.pm * BM + wr * 64 + fr) * ldc + colt + wc * 32 + 8 * fq) * 2u);
#pragma unroll
        for (int ai = 0; ai < 2; ++ai)
#pragma unroll
            for (int m = 0; m < 4; ++m) { const unsigned ro = off + (unsigned)((ai * HALF + m * 16) * ldc) * 2u;
#pragma unroll
                for (int bj = 0; bj < 2; ++bj) { f32x4 v0 = acc[ai][bj][m][0], v1 = acc[ai][bj][m][1];
                    if (act == 1) {
#pragma unroll
                        for (int j = 0; j < 4; ++j) { v0[j] = fgelu(v0[j]); v1[j] = fgelu(v1[j]); } }
                    else if (act == 2) {
#pragma unroll
                        for (int j = 0; j < 4; ++j) { v0[j] = fsigmoid(v0[j]); v1[j] = fsigmoid(v1[j]); } }
                    *(u32x4*)(base + ro + bj * HALF * 2) = pack8(v0, v1); } }
    }
};
struct EpiMerge {
    static constexpr bool PERM = true, AFTER_DRAIN = false, HAS_MID = true;
    const f16 *GA, *GB; f16* O;
    __device__ __forceinline__ void mid(f32x4 (&acc)[2][2][4][2], const Unit& u, int wr, int wc, int fr, int fq) const {
        const unsigned off = opaque((unsigned)((u.pm * BM + wr * 64 + fr) * D + u.pn * BM + wc * 32 + 8 * fq) * 2u);
        const char* ga = (const char*)GA; const char* gb = (const char*)GB;
#pragma unroll
        for (int ai = 0; ai < 2; ++ai)
#pragma unroll
            for (int m = 0; m < 4; ++m) { const unsigned ro = off + (unsigned)((ai * HALF + m * 16) * D) * 2u;
#pragma unroll
                for (int bj = 0; bj < 2; ++bj) { const hx8 a = *(const hx8*)(ga + ro + bj * HALF * 2), b = *(const hx8*)(gb + ro + bj * HALF * 2);
#pragma unroll
                    for (int j = 0; j < 4; ++j) { acc[ai][bj][m][0][j] *= (float)a[j] * __builtin_amdgcn_rcpf((float)b[j]); acc[ai][bj][m][1][j] *= (float)a[4 + j] * __builtin_amdgcn_rcpf((float)b[4 + j]); } } }
    }
    __device__ __forceinline__ void operator()(const f32x4 (&acc)[2][2][4][2], const Unit& u, int wr, int wc, int fr, int fq) const {
        const unsigned off = opaque((unsigned)((u.pm * BM + wr * 64 + fr) * D + u.pn * BM + wc * 32 + 8 * fq) * 2u);
        const char* gb = (const char*)GB; char* ob = (char*)O;
#pragma unroll
        for (int ai = 0; ai < 2; ++ai)
#pragma unroll
            for (int m = 0; m < 4; ++m) { const unsigned ro = off + (unsigned)((ai * HALF + m * 16) * D) * 2u;
#pragma unroll
                for (int bj = 0; bj < 2; ++bj) { const hx8 b = *(const hx8*)(gb + ro + bj * HALF * 2); f32x4 v0 = acc[ai][bj][m][0], v1 = acc[ai][bj][m][1];
#pragma unroll
                    for (int j = 0; j < 4; ++j) { v0[j] *= (float)b[j]; v1[j] *= (float)b[4 + j]; }
                    u32x4 w; w.x = pk_mix(v0[0], v0[1]); w.y = pk_mix(v0[2], v0[3]); w.z = pk_mix(v1[0], v1[1]); w.w = pk_mix(v1[2], v1[3]);
                    *(u32x4*)(ob + ro + bj * HALF * 2) = w; } }
    }
};

typedef short sx8 __attribute__((ext_vector_type(8)));
template <int CTRL> __device__ __forceinline__ float dpp_mov(float old, float v) { return __builtin_bit_cast(float, __builtin_amdgcn_update_dpp(__builtin_bit_cast(int, old), __builtin_bit_cast(int, v), CTRL, 0xF, 0xF, false)); }
struct EpiConv {
    static constexpr bool PERM = true, AFTER_DRAIN = false, HAS_MID = false;
    f16* ACT; float* AH; float* AT; const float* cw; const float* cb; LAS float* X; int bf16out;
    __device__ __forceinline__ void mid(f32x4 (&)[2][2][4][2], const Unit&, int, int, int, int) const {}
    __device__ __forceinline__ void operator()(const f32x4 (&acc)[2][2][4][2], const Unit& u, int wr, int wc, int fr, int fq) const {
        const int chl = wc * 32 + 8 * fq;
        if (fr >= 14) {
#pragma unroll
            for (int ai = 0; ai < 2; ++ai)
#pragma unroll
                for (int bj = 0; bj < 2; ++bj)
#pragma unroll
                    for (int n = 0; n < 2; ++n) *(LAS f32x4*)(X + ((((2 * ai + wr) * 2 + (fr - 14)) * 2 + bj) * 128 + chl + 4 * n)) = acc[ai][bj][3][n];
        }
        asm volatile("s_waitcnt lgkmcnt(0)" ::: "memory"); __builtin_amdgcn_s_barrier(); asm volatile("" ::: "memory");
        const unsigned ch0 = opaque((unsigned)(u.pn * 128 + chl));
        if (u.pm == 64) {
#pragma unroll
            for (int m = 0; m < 4; ++m)
#pragma unroll
                for (int bj = 0; bj < 2; ++bj)
#pragma unroll
                    for (int n = 0; n < 2; ++n) *(f32x4*)(AH + (size_t)((wr * 64 + 16 * m + fr) * 2 + bj) * DFF + ch0 + 4 * n) = acc[0][bj][m][n];
            return;
        }
        if (wr == 0 && fr < 2) {
#pragma unroll
            for (int bj = 0; bj < 2; ++bj)
#pragma unroll
                for (int n = 0; n < 2; ++n) *(f32x4*)(AT + (size_t)((u.pm * 2 + fr) * 2 + bj) * DFF + ch0 + 4 * n) = acc[0][bj][0][n];
        }
        const unsigned orow = opaque((unsigned)(u.pm * BM + wr * 64 + fr));
#pragma unroll
        for (int n = 0; n < 2; ++n) {
            f32x4 wv[3][2], bv[2];
#pragma unroll
            for (int bj = 0; bj < 2; ++bj) { bv[bj] = *(const f32x4*)(cb + bj * DFF + ch0 + 4 * n);
#pragma unroll
                for (int k = 0; k < 3; ++k) wv[k][bj] = *(const f32x4*)(cw + k * NUP + bj * DFF + ch0 + 4 * n); }
#pragma unroll
            for (int ai = 0; ai < 2; ++ai) {
                f32x4 E[2];
                const int blk = 2 * ai + wr - 1;
#pragma unroll
                for (int bj = 0; bj < 2; ++bj) { E[bj] = (f32x4){0.f, 0.f, 0.f, 0.f};
                    if (blk >= 0 && fr >= 14) E[bj] = *(const LAS f32x4*)(X + (((blk * 2 + (fr - 14)) * 2 + bj) * 128 + chl + 4 * n)); }
#pragma unroll
                for (int m = 0; m < 4; ++m) {
                    f32x4 cv[2];
#pragma unroll
                    for (int bj = 0; bj < 2; ++bj) { const f32x4 cur = acc[ai][bj][m][n]; const f32x4 prv = (m == 0) ? E[bj] : acc[ai][bj][m == 0 ? 0 : m - 1][n];
#pragma unroll
                        for (int i = 0; i < 4; ++i) { const float p1 = dpp_mov<0x111>(dpp_mov<0x121>(0.f, prv[i]), cur[i]), p2 = dpp_mov<0x112>(dpp_mov<0x122>(0.f, prv[i]), cur[i]);
                            cv[bj][i] = bv[bj][i] + wv[0][bj][i] * p2 + wv[1][bj][i] * p1 + wv[2][bj][i] * cur[i]; } }
                    float res[4];
#pragma unroll
                    for (int e = 0; e < 4; ++e) res[e] = fsilu(cv[0][e]) * cv[1][e];
                    u32x2 ov;
                    if (bf16out) { ov.x = pkb(res[0], res[1]); ov.y = pkb(res[2], res[3]); }
                    else { ov.x = pkh(res[0], res[1]); ov.y = pkh(res[2], res[3]); }
                    *(u32x2*)(ACT + (size_t)(orow + ai * HALF + m * 16) * DFF + ch0 + 4 * n) = ov;
                }
            }
        }
    }
};

template <class Epi, class Sched, bool ALIGN_EPI = true, bool BF16 = false>
__device__ __forceinline__ void gemm_phase(LAS unsigned char* lds, const Gemm g, const Sched& S, const Epi& E) {
    const int tid = threadIdx.x, wid = __builtin_amdgcn_readfirstlane(tid >> 6), lane = tid & 63, wr = wid >> 2, wc = wid & 3, fr = lane & 15, fq = lane >> 4;
    const int K = g.K, nt = K / BK;
    unsigned voffA[2], voffB[2];
#pragma unroll
    for (int i = 0; i < 2; ++i) { int R, C; stage_rc(tid * 16 + i * 8192, R, C); const int Rb = Epi::PERM ? ((R & ~31) + perm32(R & 31)) : R;
        voffA[i] = (unsigned)(R * K + C) * 2u; voffB[i] = (unsigned)(Rb * K + C) * 2u; }
    const size_t kstep = (size_t)(BK * 2);
    const size_t hstep = (size_t)HALF * K * 2;
    const size_t tstep = 2 * hstep;
    const unsigned ldsw = (unsigned)wid * 1024u;
    const int aoff = lds_byte(wr * 64 + fr, fq * 8), boff = lds_byte(wc * 32 + fr, fq * 8);
#define PG8_SA(b, h) (((b) * 2 + (h)) * HTB)
#define PG8_SB(b, h) ((4 + (b) * 2 + (h)) * HTB)
#define PG8_STAGE(bufoff, gbase, voff) do { _Pragma("unroll") for (int _i = 0; _i < 2; ++_i) \
        __builtin_amdgcn_global_load_lds((const unsigned*)((const char*)(gbase) + (voff)[_i]), (LAS unsigned*)(lds + (bufoff) + ldsw + _i * 8192), 16, 0, 0); } while (0)
#define PG8_LDA(dst, b, h) do { _Pragma("unroll") for (int m = 0; m < 4; ++m) _Pragma("unroll") for (int k = 0; k < 2; ++k) dst[m][k] = *(const LAS hx8*)(lds + PG8_SA(b, h) + aoff + m * 2048 + k * 1024); } while (0)
#define PG8_LDB(dst, b, h) do { _Pragma("unroll") for (int n = 0; n < 2; ++n) _Pragma("unroll") for (int k = 0; k < 2; ++k) dst[n][k] = *(const LAS hx8*)(lds + PG8_SB(b, h) + boff + n * 2048 + k * 1024); } while (0)
#define PG8_MMA(ai, bj, At, Bt) do { __builtin_amdgcn_s_setprio(1); _Pragma("unroll") for (int m = 0; m < 4; ++m) _Pragma("unroll") for (int n = 0; n < 2; ++n) _Pragma("unroll") for (int k = 0; k < 2; ++k) \
        { if constexpr (BF16) acc[ai][bj][m][n] = __builtin_amdgcn_mfma_f32_16x16x32_bf16(__builtin_bit_cast(sx8, Bt[n][k]), __builtin_bit_cast(sx8, At[m][k]), acc[ai][bj][m][n], 0, 0, 0); \
          else acc[ai][bj][m][n] = __builtin_amdgcn_mfma_f32_16x16x32_f16(Bt[n][k], At[m][k], acc[ai][bj][m][n], 0, 0, 0); } __builtin_amdgcn_s_setprio(0); } while (0)
#define PG8_WAIT_V(n) asm volatile("s_waitcnt vmcnt(" #n ")" ::: "memory")
#define PG8_WAIT_L(n) asm volatile("s_waitcnt lgkmcnt(" #n ")" ::: "memory")
#define PG8_BAR __builtin_amdgcn_s_barrier()
#define PG8_SCHED __builtin_amdgcn_sched_barrier(0)
    Unit cur, nxt; int ui = 0;
    if (!S.next(0, cur)) return;
    f32x4 acc[2][2][4][2];
#pragma unroll
    for (int a = 0; a < 2; ++a)
#pragma unroll
        for (int b = 0; b < 2; ++b)
#pragma unroll
            for (int m = 0; m < 4; ++m)
#pragma unroll
                for (int n = 0; n < 2; ++n) acc[a][b][m][n] = (f32x4){0.f, 0.f, 0.f, 0.f};
    hx8 At[4][2], B0[2][2], B1[2][2];
    const char* cA = (const char*)g.A + (size_t)cur.pm * tstep; const char* cB = (const char*)g.Bt + (size_t)cur.pn * tstep;
    S.a_ready(cur);
    PG8_STAGE(PG8_SB(0, 0), cB, voffB); PG8_STAGE(PG8_SB(0, 1), cB + hstep, voffB); PG8_STAGE(PG8_SA(0, 0), cA, voffA); PG8_STAGE(PG8_SA(0, 1), cA + hstep, voffA);
    if (wr == 1) PG8_BAR;
    PG8_WAIT_V(2); PG8_BAR;
    PG8_STAGE(PG8_SB(1, 0), cB + kstep, voffB); PG8_STAGE(PG8_SA(1, 0), cA + kstep, voffA); PG8_STAGE(PG8_SB(1, 1), cB + hstep + kstep, voffB);
    PG8_WAIT_V(6); PG8_BAR;
    for (;;) {
        const bool has_next = S.next(ui + 1, nxt);
        const char* nA = has_next ? (const char*)g.A + (size_t)nxt.pm * tstep : cA; const char* nB = has_next ? (const char*)g.Bt + (size_t)nxt.pn * tstep : cB;
        for (int t = 0; t < nt; t += 2) {
            const bool last = (t == nt - 2);
            const char* a1 = cA + (size_t)(t + 1) * kstep;
            const char* a2 = last ? nA : cA + (size_t)(t + 2) * kstep; const char* b2 = last ? nB : cB + (size_t)(t + 2) * kstep;
            const char* a3 = a2 + kstep; const char* b3 = b2 + kstep;
            if (last && has_next) S.a_ready(nxt);
            if constexpr (Epi::HAS_MID) { if (t == (nt >> 1)) E.mid(acc, cur, wr, wc, fr, fq); }
            PG8_LDB(B0, 0, 0); PG8_LDB(B1, 0, 1); PG8_SCHED; PG8_LDA(At, 0, 0); PG8_STAGE(PG8_SA(1, 1), a1 + hstep, voffA);
            PG8_WAIT_V(8); PG8_WAIT_L(0); PG8_BAR; PG8_MMA(0, 0, At, B0); PG8_MMA(0, 1, At, B1); PG8_BAR; PG8_SCHED;
            PG8_LDA(At, 0, 1); PG8_STAGE(PG8_SB(0, 0), b2, voffB); PG8_STAGE(PG8_SB(0, 1), b2 + hstep, voffB); PG8_STAGE(PG8_SA(0, 0), a2, voffA);
            PG8_WAIT_V(8); PG8_WAIT_L(0); PG8_BAR; PG8_MMA(1, 0, At, B0); PG8_MMA(1, 1, At, B1); PG8_BAR; PG8_SCHED;
            PG8_LDB(B0, 1, 0); PG8_LDB(B1, 1, 1); PG8_SCHED; PG8_LDA(At, 1, 0); PG8_STAGE(PG8_SA(0, 1), a2 + hstep, voffA);
            PG8_WAIT_V(8); PG8_WAIT_L(0); PG8_BAR; PG8_MMA(0, 0, At, B0); PG8_MMA(0, 1, At, B1); PG8_BAR; PG8_SCHED;
            PG8_LDA(At, 1, 1); PG8_STAGE(PG8_SB(1, 0), b3, voffB); PG8_STAGE(PG8_SB(1, 1), b3 + hstep, voffB); PG8_STAGE(PG8_SA(1, 0), a3, voffA);
            PG8_WAIT_V(8); PG8_WAIT_L(0); PG8_BAR; PG8_MMA(1, 0, At, B0); PG8_MMA(1, 1, At, B1); PG8_BAR; PG8_SCHED;
        }
        if constexpr (ALIGN_EPI) { if (wr == 0) PG8_BAR; }
        E(acc, cur, wr, wc, fr, fq); S.done(cur);
        if (!has_next) break;
#pragma unroll
        for (int a = 0; a < 2; ++a)
#pragma unroll
            for (int b = 0; b < 2; ++b)
#pragma unroll
                for (int m = 0; m < 4; ++m)
#pragma unroll
                    for (int n = 0; n < 2; ++n) acc[a][b][m][n] = (f32x4){0.f, 0.f, 0.f, 0.f};
        cur = nxt; cA = nA; cB = nB; ++ui;
        if constexpr (ALIGN_EPI) { if (wr == 1) PG8_BAR; }
    }
    PG8_WAIT_V(0);
    if constexpr (!ALIGN_EPI) { if (wr == 0) PG8_BAR; }
    PG8_BAR;
#undef PG8_SA
#undef PG8_SB
#undef PG8_STAGE
#undef PG8_LDA
#undef PG8_LDB
#undef PG8_MMA
#undef PG8_WAIT_V
#undef PG8_WAIT_L
#undef PG8_BAR
#undef PG8_SCHED
}
}

#define XB_TMO      128
#define XB_XCNT(j)  (256  + 64 * (j))
#define XB_XSUB(j)  (1280 + 64 * (j))
#define XB_XGEN(j)  (2304 + 64 * (j))
#define XB_TOP      3328
#define XB_TOPGEN   3392
#define XCD_BAR_WORDS 3456
#define XB_SPIN_CAP (1u << 18)
__device__ __forceinline__ unsigned xb_ld(unsigned* p)              { return __hip_atomic_load(p, __ATOMIC_RELAXED, __HIP_MEMORY_SCOPE_AGENT); }
__device__ __forceinline__ unsigned xb_add(unsigned* p, unsigned v) { return __hip_atomic_fetch_add(p, v, __ATOMIC_RELAXED, __HIP_MEMORY_SCOPE_AGENT); }
__device__ __forceinline__ unsigned xb_xcc_id() { return (unsigned)__builtin_amdgcn_s_getreg((3 << 11) | 20) & 0xFu; }
#define XB_SPIN(cond, bar) do { unsigned _sp = 0; while (cond) { __builtin_amdgcn_s_sleep(1); \
    if ((++_sp & 255u) == 0u) { if (xb_ld(&(bar)[XB_TMO])) break; if (_sp > XB_SPIN_CAP) { atomicAdd(&(bar)[XB_TMO], 1u); break; } } } } while (0)
struct XcdBarrier { unsigned* bar; unsigned x; volatile LAS unsigned* st; };
__device__ __forceinline__ XcdBarrier xcd_barrier_post(unsigned* bar, volatile LAS unsigned* st) {
    XcdBarrier b; b.bar = bar; b.x = xb_xcc_id(); b.st = st;
    if (threadIdx.x == 0) (void)xb_add(&bar[XB_XCNT(b.x)], 1u);
    return b;
}
__device__ __forceinline__ void xcd_barrier_complete(unsigned* bar, unsigned x, unsigned& nloc, unsigned& nx) {
    const unsigned G = gridDim.x * gridDim.y * gridDim.z;
    unsigned sum, cnt, mine, sp = 0u;
    for (;;) {
        sum = 0u; cnt = 0u; mine = 0u;
#pragma unroll
        for (unsigned j = 0; j < 16; ++j) { const unsigned c = xb_ld(&bar[XB_XCNT(j)]); sum += c; cnt += (c > 0u) ? 1u : 0u; mine = (j == x) ? c : mine; }
        if (sum == G) break;
        __builtin_amdgcn_s_sleep(1);
        if ((++sp & 255u) == 0u) { if (xb_ld(&bar[XB_TMO])) break; if (sp > XB_SPIN_CAP) { atomicAdd(&bar[XB_TMO], 1u); break; } }
    }
    nloc = mine > 0u ? mine : 1u; nx = cnt > 0u ? cnt : 1u;
}
__device__ __forceinline__ void xcd_barrier(const XcdBarrier& b) {
    asm volatile("s_waitcnt vmcnt(0)" ::: "memory");
    __syncthreads();
    if (threadIdx.x == 0) {
        unsigned* bar = b.bar;
        __builtin_amdgcn_s_waitcnt(0);
        unsigned nloc = b.st[0], nx = b.st[1];
        if (nloc == 0u) { xcd_barrier_complete(bar, b.x, nloc, nx); b.st[0] = nloc; b.st[1] = nx; }
        const unsigned old = xb_add(&bar[XB_XSUB(b.x)], 1u);
        const unsigned gen = old / nloc;
        if (old + 1u == (gen + 1u) * nloc) {
            __builtin_amdgcn_fence(__ATOMIC_RELEASE, "agent");
            asm volatile("s_waitcnt vmcnt(0)" ::: "memory");
            const unsigned og = xb_add(&bar[XB_TOP], 1u);
            const unsigned tg = og / nx;
            if (og + 1u == (tg + 1u) * nx) xb_add(&bar[XB_TOPGEN], 1u);
            else XB_SPIN(xb_ld(&bar[XB_TOPGEN]) == tg, bar);
            __builtin_amdgcn_fence(__ATOMIC_ACQUIRE, "agent");
            xb_add(&bar[XB_XGEN(b.x)], 1u);
            asm volatile("s_waitcnt vmcnt(0)" ::: "memory");
        } else {
            XB_SPIN(xb_ld(&bar[XB_XGEN(b.x)]) == gen, bar);
            __builtin_amdgcn_fence(__ATOMIC_ACQUIRE, "agent");
            asm volatile("s_waitcnt vmcnt(0)" ::: "memory");
        }
    }
    __syncthreads();
}

struct Args { const float* in[23]; float* out; unsigned char* ws; int ph_lo, ph_hi; };
struct Ctx {
    LAS unsigned char* lds;
    int tid, lane, wave, G, bid;
    const float *x, *c, *w_mod, *b_mod, *g_norms, *w_in, *cmp_pos, *cmp_w1, *cmp_b1, *cmp_w2, *cmp_b2, *rel_table, *ln_g, *ln_b, *sgu_w, *sgu_b,
                *w_pn, *w_ps, *w_out, *w_up, *conv_w, *conv_b, *w_dn;
    float* out; unsigned char* ws;
    float *mod, *posw1, *gates, *ysc, *AH, *AT; f16 *Y1, *Y2, *X1H, *W2T, *SGUW, *WG, *KC, *VCT, *W1T, *WUP, *WDN, *WIN, *WVT, *WM, *WO, *H, *Q, *KV, *VT, *Z, *GA, *GB, *YAB, *H2, *ACT;
};

__device__ __forceinline__ void p0_mod_item(Ctx& C, int item) {
    LAS float* sc = (LAS float*)C.lds;
    LAS float* red = (LAS float*)(C.lds + 32768);
    for (int i = C.tid; i < 2 * D; i += NTHREADS) sc[i] = fsilu(C.c[i]);
    __syncthreads();
    const int cq = C.tid & 31, kg = C.tid >> 5, n0 = item * 128 + 4 * cq;
    f32x4 a0 = {0.f, 0.f, 0.f, 0.f}, a1 = {0.f, 0.f, 0.f, 0.f};
    const float* wp = C.w_mod + (size_t)(kg * 256) * NMOD + n0;
#pragma unroll 8
    for (int i = 0; i < 256; ++i) { const f32x4 w = *(const f32x4*)(wp + (size_t)i * NMOD); const float s0 = sc[kg * 256 + i], s1 = sc[D + kg * 256 + i]; a0 += w * s0; a1 += w * s1; }
    *(LAS f32x4*)(red + (kg * 2 + 0) * 128 + 4 * cq) = a0; *(LAS f32x4*)(red + (kg * 2 + 1) * 128 + 4 * cq) = a1;
    __syncthreads();
    if (C.tid < 256) { const int b = C.tid >> 7, col = C.tid & 127; float s = 0.f;
#pragma unroll
        for (int k = 0; k < 16; ++k) s += red[(k * 2 + b) * 128 + col];
        C.mod[b * NMOD + item * 128 + col] = s + C.b_mod[item * 128 + col]; }
    __syncthreads();
}
__device__ __forceinline__ void p0_posw1_item(Ctx& C, int item) {
    LAS float* red = (LAS float*)C.lds;
    const int kk = item >> 2, j = (item & 3) * 64 + C.lane; float s = 0.f;
    const float* w = C.cmp_w1 + (size_t)kk * 4096 * 256 + j; const float* pp = C.cmp_pos + kk * 4096;
    for (int k = C.wave * 512; k < C.wave * 512 + 512; ++k) s += pp[k] * w[(size_t)k * 256];
    red[C.wave * 64 + C.lane] = s;
    __syncthreads();
    if (C.wave == 0) { float t = 0.f;
#pragma unroll
        for (int k = 0; k < 8; ++k) t += red[k * 64 + C.lane];
        C.posw1[kk * 256 + j] = t + C.cmp_b1[kk * 256 + j]; }
    __syncthreads();
}
__device__ __forceinline__ f16* win_row(Ctx& C, int n) {
    if (n < 3584) return C.WIN + (size_t)n * D;
    if (n < 4096) return C.WVT + (size_t)(n - 3584) * D;
    if (n < 4608) return C.WIN + (size_t)(n - 512) * D;
    if (n < 5120) return C.WVT + (size_t)(n - 4608 + 512) * D;
    if (n < 5168) return C.WG + (size_t)(n - 5120) * D;
    return C.WIN + (size_t)(n - 5168 + 4096) * D;
}
__device__ __forceinline__ void p0_transpose_item(Ctx& C, int mat, const float* src, int N, int kb, int nb, LAS float* scr) {
    const int lane = C.lane, k0 = kb * 64, n0 = nb * 64, r4 = lane >> 4, c4 = (lane & 15) * 4; const bool ok = n0 + c4 < N;
    const float* sp = src + (size_t)(k0 + r4) * N + (ok ? n0 + c4 : 0);
#pragma unroll
    for (int i = 0; i < 16; ++i) { const f32x4 v = ok ? *(const f32x4*)(sp + (size_t)(4 * i) * N) : (f32x4){0.f, 0.f, 0.f, 0.f};
        LAS float* d = scr + (4 * i + r4) * 65 + c4; d[0] = v.x; d[1] = v.y; d[2] = v.z; d[3] = v.w; }
    LDS_WAIT();
    const int c = lane & 7;
#pragma unroll
    for (int j = 0; j < 8; ++j) { const int nn = (lane >> 3) + 8 * j, ng = n0 + nn;
        if (ng < N) { const LAS float* s = scr + (8 * c) * 65 + nn;
            u32x4 o;
            if ((FFN_BF16 && (mat == 4 || mat == 5)) || (MIX_BF16 && (mat == 1 || mat == 2 || mat == 3))) { o.x = pkb(s[0], s[65]); o.y = pkb(s[2 * 65], s[3 * 65]); o.z = pkb(s[4 * 65], s[5 * 65]); o.w = pkb(s[6 * 65], s[7 * 65]); }
            else { o.x = pkh(s[0], s[65]); o.y = pkh(s[2 * 65], s[3 * 65]); o.z = pkh(s[4 * 65], s[5 * 65]); o.w = pkh(s[6 * 65], s[7 * 65]); }
            f16* rowp;
            if (mat == 0) rowp = win_row(C, ng);
            else if (mat == 1) rowp = C.WM + (size_t)ng * D;
            else if (mat == 2) rowp = C.WM + (size_t)ng * D + 2048;
            else if (mat == 3) rowp = C.WO + (size_t)ng * D;
            else if (mat == 4) { const int isup = ng >= DFF ? 1 : 0, cc = ng - isup * DFF; rowp = C.WUP + (size_t)((cc >> 7) * 256 + isup * 128 + (cc & 127)) * D; }
            else if (mat == 5) rowp = C.WDN + (size_t)ng * DFF;
            else if (mat == 6) rowp = C.W1T + (size_t)ng * D;
            else rowp = C.W1T + (size_t)(256 + ng) * D;
            *(u32x4*)(rowp + k0 + 8 * c) = o; } }
    LDS_WAIT();
}
__device__ __forceinline__ void p0_prologue(Ctx& C) {
    for (int it = C.bid; it < 200; it += C.G) { if (it < 192) p0_mod_item(C, it); else p0_posw1_item(C, it - 192); }
    const int gw = C.bid * NWAVES + C.wave, NGW = C.G * NWAVES;
    LAS float* scr = (LAS float*)(C.lds + C.wave * 16640);
    constexpr int I0 = 64 * 273, I1 = 32 * 64, I3 = 64 * 64, I4 = 64 * 344, I5 = 172 * 64, I6 = 64 * 4;
    constexpr int NIT = I0 + 2 * I1 + I3 + I4 + I5 + 2 * I6;
    for (int it = gw; it < NIT; it += NGW) {
        int r = it;
        if (r < I0) { p0_transpose_item(C, 0, C.w_in, IN_W, r / 273, r % 273, scr); continue; } r -= I0;
        if (r < I1) { p0_transpose_item(C, 1, C.w_pn, D, r / 64, r % 64, scr); continue; } r -= I1;
        if (r < I1) { p0_transpose_item(C, 2, C.w_ps, D, r / 64, r % 64, scr); continue; } r -= I1;
        if (r < I3) { p0_transpose_item(C, 3, C.w_out, D, r / 64, r % 64, scr); continue; } r -= I3;
        if (r < I4) { p0_transpose_item(C, 4, C.w_up, NUP, r / 344, r % 344, scr); continue; } r -= I4;
        if (r < I5) { p0_transpose_item(C, 5, C.w_dn, D, r / 64, r % 64, scr); continue; } r -= I5;
        if (r < I6) { p0_transpose_item(C, 6, C.cmp_w1, 256, r / 4, r % 4, scr); continue; } r -= I6;
        p0_transpose_item(C, 7, C.cmp_w1 + (size_t)4096 * 256, 256, r / 4, r % 4, scr);
    }
    const int gt = C.bid * NTHREADS + C.tid, NGT = C.G * NTHREADS;
    for (int i = gt; i < 16 * 128 * 128; i += NGT) { const int s = i & 127, t = (i >> 7) & 127; C.SGUW[i] = (f16)(s <= t ? C.sgu_w[i] : 0.f); }
    for (int i = gt; i < 2 * 128 * 256; i += NGT) { const int j = i & 255, d = (i >> 8) & 127, kk = i >> 15; C.W2T[i] = (f16)C.cmp_w2[(size_t)kk * 256 * 128 + j * 128 + d]; }
    for (int i = gt; i < 16 * D; i += NGT) C.WG[48 * D + i] = (f16)0.f;
    __syncthreads();
}

__device__ __forceinline__ void p1_norm(Ctx& C) {
    const int gw = C.bid * NWAVES + C.wave, NGW = C.G * NWAVES, lane = C.lane;
    for (int row = gw; row < M; row += NGW) {
        const int b = row >> 13; const f32x4* xr = (const f32x4*)(C.x + (size_t)row * D);
        f32x4 v[16]; float ss = 0.f;
#pragma unroll
        for (int j = 0; j < 16; ++j) { v[j] = xr[lane + 64 * j]; ss += (v[j].x * v[j].x + v[j].y * v[j].y) + (v[j].z * v[j].z + v[j].w * v[j].w); }
        const float rs = 1.0f / sqrtf(wave_sum(ss) * (1.0f / D) + EPS);
        const f32x4* g4 = (const f32x4*)(C.g_norms); const f32x4* sh = (const f32x4*)(C.mod + b * NMOD); const f32x4* sc = (const f32x4*)(C.mod + b * NMOD + D);
        u32x2* o = (u32x2*)(C.H + (size_t)row * D);
#pragma unroll
        for (int j = 0; j < 16; ++j) { const int k = lane + 64 * j; const f32x4 h = v[j] * rs * g4[k] * (sc[k] + 1.0f) + sh[k]; u32x2 w; w.x = pkh(h.x, h.y); w.y = pkh(h.z, h.w); o[k] = w; }
    }
}
__device__ __forceinline__ void p7_norm(Ctx& C) {
    const int gw = C.bid * NWAVES + C.wave, NGW = C.G * NWAVES, lane = C.lane;
    for (int row = gw; row < M; row += NGW) {
        const int b = row >> 13; const hx8* yr = (const hx8*)(C.Y1 + (size_t)row * D); const f32x4* xr = (const f32x4*)(C.x + (size_t)row * D); u32x2* orow = (u32x2*)(C.X1H + (size_t)row * D);
        f32x4 v[16]; float ss = 0.f;
#pragma unroll
        for (int j = 0; j < 8; ++j) { const hx8 hv = yr[lane + 64 * j];
            v[2 * j] = (f32x4){(float)hv[0], (float)hv[1], (float)hv[2], (float)hv[3]}; v[2 * j + 1] = (f32x4){(float)hv[4], (float)hv[5], (float)hv[6], (float)hv[7]}; }
#pragma unroll
        for (int j = 0; j < 16; ++j) ss += (v[j].x * v[j].x + v[j].y * v[j].y) + (v[j].z * v[j].z + v[j].w * v[j].w);
        const float rs = 1.0f / sqrtf(wave_sum(ss) * (1.0f / D) + EPS);
        const f32x4* g1 = (const f32x4*)(C.g_norms + D); const f32x4* gt = (const f32x4*)(C.mod + b * NMOD + 2 * D);
        float s2 = 0.f;
#pragma unroll
        for (int j = 0; j < 16; ++j) { const int k = 2 * (lane + 64 * (j >> 1)) + (j & 1); v[j] = xr[k] + gt[k] * (v[j] * rs * g1[k]); { u32x2 xw; xw.x = pkh(v[j].x, v[j].y); xw.y = pkh(v[j].z, v[j].w); orow[k] = xw; } s2 += (v[j].x * v[j].x + v[j].y * v[j].y) + (v[j].z * v[j].z + v[j].w * v[j].w); }
        const float rs2 = 1.0f / sqrtf(wave_sum(s2) * (1.0f / D) + EPS);
        const f32x4* g2 = (const f32x4*)(C.g_norms + 2 * D); const f32x4* sh = (const f32x4*)(C.mod + b * NMOD + 3 * D); const f32x4* sc = (const f32x4*)(C.mod + b * NMOD + 4 * D);
        u32x4* o = (u32x4*)(C.H2 + (size_t)row * D);
#pragma unroll
        for (int j = 0; j < 8; ++j) { const int k = 2 * (lane + 64 * j); const f32x4 h0 = v[2 * j] * rs2 * g2[k] * (sc[k] + 1.0f) + sh[k], h1 = v[2 * j + 1] * rs2 * g2[k + 1] * (sc[k + 1] + 1.0f) + sh[k + 1];
            u32x4 w; w.x = pk_ffn(h0.x, h0.y); w.y = pk_ffn(h0.z, h0.w); w.z = pk_ffn(h1.x, h1.y); w.w = pk_ffn(h1.z, h1.w); o[lane + 64 * j] = w;
            if ((row & 255) >= 254) ((u32x4*)(C.H2 + (size_t)(M + 2 * (row >> 8) + (row & 1)) * D))[lane + 64 * j] = w; }
    }
}
__device__ __forceinline__ void p11_final(Ctx& C) {
    const int gw = C.bid * NWAVES + C.wave, NGW = C.G * NWAVES, lane = C.lane;
    for (int row = gw; row < M; row += NGW) {
        const int b = row >> 13; f32x4* orow = (f32x4*)(C.out + (size_t)row * D); const hx8* yr = (const hx8*)(C.Y2 + (size_t)row * D); const hx8* xr = (const hx8*)(C.X1H + (size_t)row * D);
        f32x4 v[16]; float ss = 0.f;
#pragma unroll
        for (int j = 0; j < 8; ++j) { const hx8 hv = yr[lane + 64 * j];
            v[2 * j] = (f32x4){(float)hv[0], (float)hv[1], (float)hv[2], (float)hv[3]}; v[2 * j + 1] = (f32x4){(float)hv[4], (float)hv[5], (float)hv[6], (float)hv[7]}; }
#pragma unroll
        for (int j = 0; j < 16; ++j) ss += (v[j].x * v[j].x + v[j].y * v[j].y) + (v[j].z * v[j].z + v[j].w * v[j].w);
        const float rs = 1.0f / sqrtf(wave_sum(ss) * (1.0f / D) + EPS);
        const f32x4* g3 = (const f32x4*)(C.g_norms + 3 * D); const f32x4* gt = (const f32x4*)(C.mod + b * NMOD + 5 * D);
#pragma unroll
        for (int j = 0; j < 8; ++j) { const hx8 xv = xr[lane + 64 * j]; const int k = 2 * (lane + 64 * j);
            const f32x4 x0 = {(float)xv[0], (float)xv[1], (float)xv[2], (float)xv[3]}, x1 = {(float)xv[4], (float)xv[5], (float)xv[6], (float)xv[7]};
            orow[k] = x0 + gt[k] * (v[2 * j] * rs * g3[k]); orow[k + 1] = x1 + gt[k + 1] * (v[2 * j + 1] * rs * g3[k + 1]); }
    }
}

__device__ __forceinline__ void p3_gates_item(Ctx& C, int item) {
    const int lane = C.lane, w = C.wave, qr = lane & 15, q = lane >> 4, mt = w & 3, kh = w >> 2;
    const f16* ap = C.H + (size_t)(item * 64 + mt * 16 + qr) * D + kh * 2048 + 8 * q;
    const f16* bp = C.WG + (size_t)qr * D + kh * 2048 + 8 * q;
    f32x4 acc[3] = {{0.f, 0.f, 0.f, 0.f}, {0.f, 0.f, 0.f, 0.f}, {0.f, 0.f, 0.f, 0.f}};
#pragma unroll 16
    for (int ks = 0; ks < 64; ++ks) { const hx8 a = *(const hx8*)(ap + 32 * ks);
#pragma unroll
        for (int nt = 0; nt < 3; ++nt) { const hx8 b = *(const hx8*)(bp + (size_t)nt * 16 * D + 32 * ks); acc[nt] = __builtin_amdgcn_mfma_f32_16x16x32_f16(a, b, acc[nt], 0, 0, 0); } }
    LAS f32x4* red = (LAS f32x4*)C.lds;
    if (kh == 1) {
#pragma unroll
        for (int nt = 0; nt < 3; ++nt) red[(mt * 3 + nt) * 64 + lane] = acc[nt]; }
    __syncthreads();
    if (kh == 0) {
#pragma unroll
        for (int nt = 0; nt < 3; ++nt) { const f32x4 s = acc[nt] + red[(mt * 3 + nt) * 64 + lane];
#pragma unroll
            for (int i = 0; i < 4; ++i) C.gates[(size_t)(item * 64 + mt * 16 + 4 * q + i) * 48 + nt * 16 + qr] = fsigmoid(s[i]); } }
    __syncthreads();
}
__device__ __forceinline__ void p3_compress_item(Ctx& C, int item) {
    const int lane = C.lane, w = C.wave, qr = lane & 15, q = lane >> 4, kk = item >> 7, R0 = (item & 127) * 32;
    LAS f16* hid = (LAS f16*)C.lds;
    LAS unsigned char* abuf = C.lds + 20480;
    const int srow = C.tid >> 4, sseg = C.tid & 15;
    const f16* sp;
    { const int R = R0 + srow, b = R >> 11, g = (R >> 9) & 3, n = R & 511, nc = n > 510 ? 510 : n; sp = C.KV + (size_t)(b * T + 16 * nc) * 2048 + kk * 512 + g * 128 + 8 * sseg; }
    const int sdst = (srow * 16 + (sseg ^ (srow & 15))) * 16;
    const f16* pb0 = C.W1T + (size_t)(kk * 256 + 32 * w + qr) * D + 8 * q; const f16* pb1 = pb0 + (size_t)16 * D;
    f32x4 acc[2][2] = {{{0.f, 0.f, 0.f, 0.f}, {0.f, 0.f, 0.f, 0.f}}, {{0.f, 0.f, 0.f, 0.f}, {0.f, 0.f, 0.f, 0.f}}};
    hx8 fb[2][8]; hx8 nxt = *(const hx8*)sp; sp += 2048;
#define CM_LOADB(buf) do { _Pragma("unroll") for (int k4 = 0; k4 < 4; ++k4) { fb[buf][2 * k4] = *(const hx8*)(pb0 + 32 * k4); fb[buf][2 * k4 + 1] = *(const hx8*)(pb1 + 32 * k4); } pb0 += 128; pb1 += 128; } while (0)
#define CM_STEP(c, buf) do { *(LAS hx8*)(abuf + ((c) & 1) * 8192 + sdst) = nxt; \
        if ((c) + 1 < 32) { nxt = *(const hx8*)sp; sp += 2048; CM_LOADB((buf) ^ 1); } \
        __syncthreads(); \
        hx8 af_[8]; _Pragma("unroll") for (int i_ = 0; i_ < 8; ++i_) { const int mt_ = i_ >> 2, k4_ = i_ & 3; af_[i_] = *(const LAS hx8*)(abuf + ((c) & 1) * 8192 + ((16 * mt_ + qr) * 16 + ((4 * k4_ + q) ^ qr)) * 16); } \
        _Pragma("unroll") for (int k4 = 0; k4 < 4; ++k4) { \
            acc[0][0] = __builtin_amdgcn_mfma_f32_16x16x32_f16(af_[k4], fb[buf][2 * k4], acc[0][0], 0, 0, 0); acc[0][1] = __builtin_amdgcn_mfma_f32_16x16x32_f16(af_[k4], fb[buf][2 * k4 + 1], acc[0][1], 0, 0, 0); \
            acc[1][0] = __builtin_amdgcn_mfma_f32_16x16x32_f16(af_[4 + k4], fb[buf][2 * k4], acc[1][0], 0, 0, 0); acc[1][1] = __builtin_amdgcn_mfma_f32_16x16x32_f16(af_[4 + k4], fb[buf][2 * k4 + 1], acc[1][1], 0, 0, 0); } } while (0)
    CM_LOADB(0);
#pragma unroll 1
    for (int c = 0; c < 32; c += 2) { CM_STEP(c, 0); CM_STEP(c + 1, 1); }
#undef CM_LOADB
#undef CM_STEP
    __syncthreads();
#pragma unroll
    for (int mt = 0; mt < 2; ++mt)
#pragma unroll
        for (int nt = 0; nt < 2; ++nt) { const int j = 32 * w + 16 * nt + qr; const float pb = C.posw1[kk * 256 + j];
#pragma unroll
            for (int i = 0; i < 4; ++i) hid[(16 * mt + 4 * q + i) * 264 + j] = (f16)fgelu(acc[mt][nt][i] + pb); }
    __syncthreads();
    const f16* wp = C.W2T + (size_t)(kk * 128 + 16 * w + qr) * 256 + 8 * q;
    f32x4 o2[2] = {{0.f, 0.f, 0.f, 0.f}, {0.f, 0.f, 0.f, 0.f}};
#pragma unroll
    for (int ks = 0; ks < 8; ++ks) { const hx8 wf = *(const hx8*)(wp + 32 * ks);
#pragma unroll
        for (int mt = 0; mt < 2; ++mt) { const hx8 hf = *(const LAS hx8*)(hid + (16 * mt + qr) * 264 + 32 * ks + 8 * q);
            if (kk == 0) o2[mt] = __builtin_amdgcn_mfma_f32_16x16x32_f16(wf, hf, o2[mt], 0, 0, 0);
            else o2[mt] = __builtin_amdgcn_mfma_f32_16x16x32_f16(hf, wf, o2[mt], 0, 0, 0); } }
    if (kk == 0) {
#pragma unroll
        for (int mt = 0; mt < 2; ++mt) { const int R = R0 + 16 * mt + qr, n = R & 511, d0 = 16 * w + 4 * q; const bool pad = n == 511;
            float v[4];
#pragma unroll
            for (int i = 0; i < 4; ++i) v[i] = pad ? 0.f : o2[mt][i] + C.cmp_b2[d0 + i];
            u32x2 o; o.x = pkh(v[0], v[1]); o.y = pkh(v[2], v[3]); *(u32x2*)(C.KC + (size_t)R * 128 + d0) = o; }
    } else {
#pragma unroll
        for (int mt = 0; mt < 2; ++mt) { const int Rb = R0 + 16 * mt + 4 * q, bg = Rb >> 9, n0 = Rb & 511, d = 16 * w + qr; const float bb = C.cmp_b2[128 + d];
            float v[4];
#pragma unroll
            for (int i = 0; i < 4; ++i) v[i] = (n0 + i == 511) ? 0.f : o2[mt][i] + bb;
            u32x2 o; o.x = pkh(v[0], v[1]); o.y = pkh(v[2], v[3]); *(u32x2*)(C.VCT + ((size_t)bg * 128 + d) * 512 + n0) = o; }
    }
    __syncthreads();
}
__device__ __forceinline__ void p3_sgu_item(Ctx& C, int item) {
    const int lane = C.lane, w = C.wave, tid = C.tid, qr = lane & 15, q = lane >> 4, r0 = (item >> 1) * 128, half = item & 1;
    LAS float* stats = (LAS float*)C.lds;
    LAS f16* vt = (LAS f16*)(C.lds + 1024);
#pragma unroll 4
    for (int tk = 0; tk < 16; ++tk) { const int s = 16 * w + tk; const f16* vp = C.Z + (size_t)(r0 + s) * D + 2048 + 8 * lane;
        float xv[32]; float sum = 0.f;
#pragma unroll
        for (int jj = 0; jj < 4; ++jj) { const hx8 h = *(const hx8*)(vp + 512 * jj);
#pragma unroll
            for (int e = 0; e < 8; ++e) { xv[8 * jj + e] = (float)h[e]; sum += xv[8 * jj + e]; } }
        const float mu = wave_sum(sum) * (1.0f / 2048.0f); float sq = 0.f;
#pragma unroll
        for (int e = 0; e < 32; ++e) { const float dv = xv[e] - mu; sq += dv * dv; }
        const float var = wave_sum(sq) * (1.0f / 2048.0f);
        if (lane == 0) { stats[2 * s] = mu; stats[2 * s + 1] = 1.0f / sqrtf(var + EPS); } }
    __syncthreads();
    for (int gi = 0; gi < 8; ++gi) { const int hh = half * 8 + gi;
        { const int s = tid >> 2, seg = tid & 3; const float mu = stats[2 * s], rstd = stats[2 * s + 1];
          const f16* vp = C.Z + (size_t)(r0 + s) * D + 2048 + hh * 128 + 32 * seg;
#pragma unroll
          for (int i = 0; i < 4; ++i) { const hx8 h = *(const hx8*)(vp + 8 * i);
#pragma unroll
              for (int e = 0; e < 8; ++e) { const int d = 32 * seg + 8 * i + e; const float y = ((float)h[e] - mu) * rstd * C.ln_g[hh * 128 + d] + C.ln_b[hh * 128 + d]; vt[d * 136 + s] = (f16)y; } } }
        __syncthreads();
        hx8 wf[4];
#pragma unroll
        for (int ks = 0; ks < 4; ++ks) wf[ks] = *(const hx8*)(C.SGUW + ((size_t)(hh * 128 + 16 * w + qr)) * 128 + 32 * ks + 8 * q);
        f32x4 acc[8];
#pragma unroll
        for (int dt = 0; dt < 8; ++dt) { acc[dt] = (f32x4){0.f, 0.f, 0.f, 0.f};
#pragma unroll
            for (int ks = 0; ks < 4; ++ks) { const hx8 af = *(const LAS hx8*)(vt + (16 * dt + qr) * 136 + 32 * ks + 8 * q); acc[dt] = __builtin_amdgcn_mfma_f32_16x16x32_f16(af, wf[ks], acc[dt], 0, 0, 0); } }
        { const int tl = 16 * w + qr; const float bs = C.sgu_b[hh * 128 + tl];
          const f16* up = C.Z + (size_t)(r0 + tl) * D + hh * 128 + 4 * q; f16* yp = C.YAB + (size_t)(r0 + tl) * D + 2048 + hh * 128 + 4 * q;
#pragma unroll
          for (int dt = 0; dt < 8; ++dt) { const hx4 u = *(const hx4*)(up + 16 * dt);
              u32x2 o; o.x = pk_mix((float)u[0] * (acc[dt][0] + bs), (float)u[1] * (acc[dt][1] + bs)); o.y = pk_mix((float)u[2] * (acc[dt][2] + bs), (float)u[3] * (acc[dt][3] + bs));
              *(u32x2*)(yp + 16 * dt) = o; } }
        __syncthreads();
    }
}

constexpr int ATT_LUT = 0, ATT_IMP = 8192, ATT_STG = 40960, STG_BYTES = 32768, STG_V = 16384;
static_assert(ATT_STG + 3 * STG_BYTES <= MISC_OFF, "attention LDS map");
__device__ __forceinline__ int rel_bucket_small(int n) {
    if (n < 16) return n;
    int b = 16;
    b += n >= 19; b += n >= 21; b += n >= 24; b += n >= 27; b += n >= 31; b += n >= 35; b += n >= 40; b += n >= 46; b += n >= 52; b += n >= 59; b += n >= 67; b += n >= 77; b += n >= 87; b += n >= 99; b += n >= 113;
    return b;
}
__device__ __forceinline__ void att_issue(Ctx& C, int s, int n_c, int n_s, int ks0g, int b, int g) {
    const int lane = (int)pg8::opaque((unsigned)C.lane), w = C.wave;
    const f16* kb; const f16* vb; int ldk, ldv, kb0;
    if (s < 2 * n_c) { kb0 = 64 * (s < n_c ? s : s - n_c); kb = C.KC + (size_t)(b * 4 + g) * 512 * 128; ldk = 128; vb = C.VCT + (size_t)(b * 4 + g) * 128 * 512; ldv = 512; }
    else if (s < 2 * n_c + n_s) { kb0 = 64 * (s - 2 * n_c); kb = C.KV + (size_t)b * T * 2048 + 1024 + g * 128; ldk = 2048; vb = C.VT + (size_t)(g * 128) * M + (size_t)b * T; ldv = M; }
    else { kb0 = ks0g + 64 * (s - 2 * n_c - n_s); kb = C.KV + (size_t)b * T * 2048 + 1536 + g * 128; ldk = 2048; vb = C.VT + (size_t)(512 + g * 128) * M + (size_t)b * T; ldv = M; }
    LAS unsigned char* buf = C.lds + ATT_STG + (s % 3) * STG_BYTES;
#pragma unroll
    for (int i = 0; i < 2; ++i) { const int R = 8 * w + 4 * i + (lane >> 4), m = R & 15, key = kb0 + 32 * (R >> 5) + (m >> 2) * 8 + (m & 3) + 4 * ((R >> 4) & 1), cidx = (lane & 15) ^ m;
        __builtin_amdgcn_global_load_lds((const unsigned*)(kb + (size_t)key * ldk + cidx * 8), (LAS unsigned*)(buf + (8 * w + 4 * i) * 256), 16, 0, 0); }
#pragma unroll
    for (int i = 0; i < 2; ++i) { const int dr = 16 * w + 8 * i + (lane >> 3), v = (lane & 7) ^ ((dr & 15) >> 1);
        __builtin_amdgcn_global_load_lds((const unsigned*)(vb + (size_t)dr * ldv + kb0 + 8 * v), (LAS unsigned*)(buf + STG_V + (16 * w + 8 * i) * 128), 16, 0, 0); }
}
#define SB() __builtin_amdgcn_sched_barrier(0)
#define ATT_QK2(TL) do { _Pragma("unroll") for (int scn_ = 0; scn_ < 2; ++scn_) { hx8 kf_[8]; \
        _Pragma("unroll") for (int i_ = 0; i_ < 8; ++i_) { const int kt_ = i_ >> 2, ks_ = i_ & 3; \
            kf_[i_] = *(const LAS hx8*)(bufp + scn_ * 8192 + kt_ * 4096 + qr * 256 + (((4 * ks_ + q) ^ qr) << 4)); } \
        __builtin_amdgcn_s_setprio(1); \
        _Pragma("unroll") for (int t_ = 0; t_ < 2; ++t_) { f32x4 a_ = {0.f, 0.f, 0.f, 0.f}; \
            _Pragma("unroll") for (int ks = 0; ks < 4; ++ks) a_ = __builtin_amdgcn_mfma_f32_16x16x32_f16(kf_[4 * t_ + ks], qf[TL][ks], a_, 0, 0, 0); sv[2 * scn_ + t_] = a_; } \
        __builtin_amdgcn_s_setprio(0); } } while (0)
#define SVJ(tl, j) (sv[(j) >> 2][(j) & 3])
#define ATT_PV2() do { SB(); \
    _Pragma("unroll") for (int sn_ = 0; sn_ < 2; ++sn_) { hx8 vf_[8]; \
        _Pragma("unroll") for (int dt_ = 0; dt_ < 8; ++dt_) vf_[dt_] = *(const LAS hx8*)(bufp + STG_V + qr * 128 + (((4 * sn_ + q) ^ (qr >> 1)) << 4) + dt_ * 2048); \
        _Pragma("unroll") for (int tl_ = 0; tl_ < 2; ++tl_) { if (act[tl_]) { _Pragma("unroll") for (int dt = 0; dt < 8; ++dt) o[tl_][dt] = __builtin_amdgcn_mfma_f32_16x16x32_f16(vf_[dt], pf[tl_][sn_], o[tl_][dt], 0, 0, 0); } } } \
    SB(); } while (0)
#define ATT_MAXUPD(TL, RESCALE_O) do { if (__any(cm_ > m[TL] + 8.0f)) { cm_ = fmaxf(cm_, __shfl_xor(cm_, 16)); cm_ = fmaxf(cm_, __shfl_xor(cm_, 32)); \
    const float mn_ = fmaxf(m[TL], cm_); const float al_ = __builtin_amdgcn_exp2f(m[TL] - mn_); m[TL] = mn_; l[TL] *= al_; \
    if (RESCALE_O) { _Pragma("unroll") for (int dt = 0; dt < 8; ++dt) o[TL][dt] *= al_; } } } while (0)
#define ATT_PACKP(TL) do { _Pragma("unroll") for (int j = 0; j < 8; ++j) { pf[TL][0][j] = (f16)p[j]; pf[TL][1][j] = (f16)p[8 + j]; } } while (0)
#define ATT_SOFTMAX_FAR(TL, cb_, RESCALE_O) do { float mx_ = SVJ(TL, 0); _Pragma("unroll") for (int j = 1; j < 16; ++j) mx_ = fmaxf(mx_, SVJ(TL, j)); \
    float cm_ = mx_ * SC2 + (cb_); ATT_MAXUPD(TL, RESCALE_O); const float off_ = (cb_) - m[TL]; float ps_ = 0.f; \
    _Pragma("unroll") for (int j = 0; j < 16; ++j) { const float e_ = __builtin_amdgcn_exp2f(SVJ(TL, j) * SC2 + off_); ps_ += e_; pf[TL][j >> 3][j & 7] = (f16)e_; } l[TL] += ps_; } while (0)
#define ATT_SOFTMAX_NEAR(TL, RESCALE_O) do { float cm_ = sc[0]; _Pragma("unroll") for (int j = 1; j < 16; ++j) cm_ = fmaxf(cm_, sc[j]); \
    ATT_MAXUPD(TL, RESCALE_O); float ps_ = 0.f; \
    _Pragma("unroll") for (int j = 0; j < 16; ++j) { const float e_ = __builtin_amdgcn_exp2f(sc[j] - m[TL]); ps_ += e_; pf[TL][j >> 3][j & 7] = (f16)e_; } l[TL] += ps_; } while (0)
#define ATT_STAGE_BEGIN() do { if (s + 1 < S) asm volatile("s_waitcnt vmcnt(4)" ::: "memory"); else asm volatile("s_waitcnt vmcnt(0)" ::: "memory"); \
    __builtin_amdgcn_s_barrier(); asm volatile("" ::: "memory"); \
    if (s + 2 < S) att_issue(C, s + 2, n_c, n_s, ks0g, b, g); \
    bufp = C.lds + ATT_STG + (s % 3) * STG_BYTES; } while (0)
constexpr float NEGBIG = -3.0e38f;

__device__ __forceinline__ void p4_attn_unit(Ctx& C, int u) {
    const int lane = C.lane, w = C.wave, qr = lane & 15, q = lane >> 4, tok = qr >> 2, r = qr & 3;
    const int bg = u & 7, b = bg >> 2, g = bg & 3, tj = u >> 3, t0g = tj * 64, t0 = t0g + w * 8, h = g * 4 + r;
    const LAS float* lut = (const LAS float*)(C.lds + ATT_LUT) + h * 128;
    LAS float* imp = (LAS float*)(C.lds + ATT_IMP) + w * 1024;
    const LAS unsigned char* bufp = C.lds + ATT_STG;
    const int n_c = (tj >> 4) + 1, n_s = tj + 1, ks0g = (t0g - 511 < 0 ? 0 : t0g - 511) & ~63, n_w = ((t0g + 63 - ks0g) >> 6) + 1, S = 2 * n_c + n_s + n_w;
    hx8 qf[2][4];
#pragma unroll
    for (int tl = 0; tl < 2; ++tl) { const int t = t0 + 4 * tl + tok; const f16* qp = C.Q + (size_t)(b * T + t) * 2048 + h * 128 + 8 * q;
#pragma unroll
        for (int ks = 0; ks < 4; ++ks) qf[tl][ks] = *(const hx8*)(qp + 32 * ks); }
#define GATE(tl, i) (C.gates[(size_t)(b * T + t0 + 4 * (tl) + tok) * 48 + h * 3 + (i)])
#define YSP(tl) ((f32x4*)(C.ysc + (size_t)(b * T + t0 + 4 * (tl) + tok) * 2048 + h * 128 + 4 * q))
    const float b127 = lut[127];
    f32x4 o[2][8], sv[4]; hx8 pf[2][2]; float sc[16], p[16], m[2], l[2]; bool act[2];
#pragma unroll
    for (int tl = 0; tl < 2; ++tl)
#pragma unroll
        for (int dt = 0; dt < 8; ++dt) o[tl][dt] = (f32x4){0.f, 0.f, 0.f, 0.f};
    for (int i = lane; i < 1024; i += 64) imp[i] = 0.f;
    asm volatile("s_waitcnt vmcnt(0) lgkmcnt(0)" ::: "memory");
    __syncthreads();
    int s = 0;
    att_issue(C, 0, n_c, n_s, ks0g, b, g); att_issue(C, 1, n_c, n_s, ks0g, b, g);

    m[0] = m[1] = -1e30f; l[0] = l[1] = 0.f;
    for (int c = 0; c < n_c; ++c, ++s) {
        ATT_STAGE_BEGIN();
        const int kb0 = 64 * c;
        act[0] = kb0 <= ((t0 + 3 - 31) >> 4); act[1] = kb0 <= ((t0 + 7 - 31) >> 4);
        if (!act[1]) continue;
#pragma unroll
        for (int tl = 0; tl < 2; ++tl) { if (act[tl]) { const int tb = t0 + 4 * tl, t = tb + tok, nmax_t = (t - 31) >> 4;
            ATT_QK2(tl);
            if (kb0 + 63 <= ((tb - 31) >> 4) && tb - 16 * (kb0 + 63) - 31 >= 127) { ATT_SOFTMAX_FAR(tl, b127, false); }
            else {
#pragma unroll
                for (int j = 0; j < 16; ++j) { const int n = kb0 + 32 * (j >> 3) + 8 * q + (j & 7), dist = t - 16 * n - 31;
                    const int di = dist < 0 ? 0 : (dist > 127 ? 127 : dist); const float lv = lut[di]; const float sx = SVJ(tl, j) * SC2 + lv; sc[j] = n <= nmax_t ? sx : NEGBIG; }
                ATT_SOFTMAX_NEAR(tl, false); } } }
    }
    float il[2];
#pragma unroll
    for (int tl = 0; tl < 2; ++tl) { l[tl] += __shfl_xor(l[tl], 16); l[tl] += __shfl_xor(l[tl], 32); il[tl] = l[tl] > 0.f ? 1.0f / l[tl] : 0.f; }
    float carry[2] = {0.f, 0.f};
    for (int c = 0; c < n_c; ++c, ++s) {
        ATT_STAGE_BEGIN();
        const int kb0 = 64 * c;
        act[0] = kb0 <= ((t0 + 3 - 31) >> 4); act[1] = kb0 <= ((t0 + 7 - 31) >> 4);
        if (!act[1]) continue;
#pragma unroll
        for (int tl = 0; tl < 2; ++tl) { if (act[tl]) { const int t = t0 + 4 * tl + tok, nmax_t = (t - 31) >> 4;
            ATT_QK2(tl);
#pragma unroll
            for (int j = 0; j < 16; ++j) { const int n = kb0 + 32 * (j >> 3) + 8 * q + (j & 7), dist = t - 16 * n - 31;
                const int di = dist < 0 ? 0 : (dist > 127 ? 127 : dist); const float lv = lut[di]; const float px = __builtin_amdgcn_exp2f(SVJ(tl, j) * SC2 + lv - m[tl]) * il[tl]; p[j] = n <= nmax_t ? px : 0.f; }
            ATT_PACKP(tl);
#pragma unroll
            for (int scn = 0; scn < 2; ++scn) { float ph[8];
#pragma unroll
                for (int j = 0; j < 8; ++j) { float v = p[8 * scn + j]; v += dpp_f<0xB1>(v); v += dpp_f<0x4E>(v); ph[j] = v; }
                const float t7 = __shfl(ph[7], (lane + 48) & 63);
                const float left = q == 0 ? carry[tl] : t7; carry[tl] = t7;
                if (r == 0) { f32x2 iv; iv.x = left + 2.0f * (ph[0] + ph[1] + ph[2]) + ph[3]; iv.y = ph[3] + 2.0f * (ph[4] + ph[5] + ph[6]) + ph[7];
                    *(LAS f32x2*)(imp + (4 * tl + tok) * 128 + ((kb0 + 32 * scn) >> 2) + 2 * q) = iv; } } } }
        ATT_PV2();
    }
#pragma unroll
    for (int tl = 0; tl < 2; ++tl) { f32x4* ysp = YSP(tl); const float gc = GATE(tl, 0);
#pragma unroll
        for (int dt = 0; dt < 8; ++dt) { ysp[4 * dt] = o[tl][dt] * gc; o[tl][dt] = (f32x4){0.f, 0.f, 0.f, 0.f}; } }
    LDS_WAIT();
    unsigned long long my_lo[2] = {0ull, 0ull}, my_hi[2] = {0ull, 0ull}, U_lo[2] = {0ull, 0ull}, U_hi[2] = {0ull, 0ull};
#pragma unroll
    for (int tk = 0; tk < 8; ++tk) { const int tt = t0 + tk, cur = tt >> 6; unsigned long long lo, hi;
        if (cur < 16) { lo = (1ull << (cur + 1)) - 1ull; hi = 0ull; }
        else {
            LAS float* P = imp + tk * 128;
            const int j0 = lane, j1 = lane + 64;
            const bool c0 = j0 >= 1 && j0 <= cur - 2, c1 = j1 <= cur - 2;
            const float i0 = c0 ? P[j0] : -1.0f, i1 = c1 ? P[j1] : -1.0f;
            LDS_WAIT();
            P[j0] = i0; P[j1] = i1;
            LDS_WAIT();
            int r0 = 0, r1 = 0;
            for (int jp = 0; jp <= cur - 2; jp += 4) { const f32x4 v = *(const LAS f32x4*)(P + jp);
#pragma unroll
                for (int e = 0; e < 4; ++e) { r0 += (v[e] > i0 || (v[e] == i0 && jp + e < j0)) ? 1 : 0; r1 += (v[e] > i1 || (v[e] == i1 && jp + e < j1)) ? 1 : 0; } }
            const bool sel0 = (c0 && r0 < 13) || j0 == 0 || j0 == cur || j0 == cur - 1, sel1 = (c1 && r1 < 13) || j1 == cur || j1 == cur - 1;
            lo = __ballot(sel0); hi = __ballot(sel1);
        }
        U_lo[tk >> 2] |= lo; U_hi[tk >> 2] |= hi; if (tok == (tk & 3)) { my_lo[tk >> 2] = lo; my_hi[tk >> 2] = hi; } }
    m[0] = m[1] = -1e30f; l[0] = l[1] = 0.f;
    for (int jb = 0; jb < n_s; ++jb, ++s) {
        ATT_STAGE_BEGIN();
        bool mine[2];
#pragma unroll
        for (int tl = 0; tl < 2; ++tl) { act[tl] = jb < 64 ? ((U_lo[tl] >> jb) & 1ull) : ((U_hi[tl] >> (jb - 64)) & 1ull); mine[tl] = jb < 64 ? ((my_lo[tl] >> jb) & 1ull) : ((my_hi[tl] >> (jb - 64)) & 1ull); }
        if (!act[0] && !act[1]) continue;
        const int kb0 = 64 * jb;
#pragma unroll
        for (int tl = 0; tl < 2; ++tl) { if (act[tl]) { const int tb = t0 + 4 * tl, t = tb + tok;
            ATT_QK2(tl);
            if (tb - (kb0 + 63) >= 127) { const float cb = mine[tl] ? b127 : NEGBIG; ATT_SOFTMAX_FAR(tl, cb, true); }
            else { const int bd = t - kb0 - 8 * q;
#pragma unroll
                for (int j = 0; j < 16; ++j) { const int dist = bd - 32 * (j >> 3) - (j & 7);
                    const int di = dist < 0 ? 0 : (dist > 127 ? 127 : dist); const float lv = lut[di]; const float sx = SVJ(tl, j) * SC2 + lv; sc[j] = (mine[tl] && dist >= 0) ? sx : NEGBIG; }
                ATT_SOFTMAX_NEAR(tl, true); } } }
        ATT_PV2();
    }
#pragma unroll
    for (int tl = 0; tl < 2; ++tl) { l[tl] += __shfl_xor(l[tl], 16); l[tl] += __shfl_xor(l[tl], 32); const float gl = l[tl] > 0.f ? GATE(tl, 1) / l[tl] : 0.f; f32x4* ysp = YSP(tl);
#pragma unroll
        for (int dt = 0; dt < 8; ++dt) { ysp[4 * dt] = ysp[4 * dt] + o[tl][dt] * gl; o[tl][dt] = (f32x4){0.f, 0.f, 0.f, 0.f}; } }
    m[0] = m[1] = -1e30f; l[0] = l[1] = 0.f;
    for (int k = 0; k < n_w; ++k, ++s) {
        ATT_STAGE_BEGIN();
        const int kb0 = ks0g + 64 * k;
#pragma unroll
        for (int tl = 0; tl < 2; ++tl) { const int tb = t0 + 4 * tl; act[tl] = !(kb0 > tb + 3 || kb0 + 63 < tb - 511); }
        if (!act[0] && !act[1]) continue;
#pragma unroll
        for (int tl = 0; tl < 2; ++tl) { if (act[tl]) { const int tb = t0 + 4 * tl, t = tb + tok;
            ATT_QK2(tl);
            if (tb - (kb0 + 63) >= 127 && tb + 3 - kb0 <= 511) { ATT_SOFTMAX_FAR(tl, b127, true); }
            else { const int bd = t - kb0 - 8 * q;
#pragma unroll
                for (int j = 0; j < 16; ++j) { const int dist = bd - 32 * (j >> 3) - (j & 7);
                    const int di = dist < 0 ? 0 : (dist > 127 ? 127 : dist); const float lv = lut[di]; const float sx = SVJ(tl, j) * SC2 + lv; sc[j] = (dist >= 0 && dist < 512) ? sx : NEGBIG; }
                ATT_SOFTMAX_NEAR(tl, true); } } }
        ATT_PV2();
    }
#pragma unroll
    for (int tl = 0; tl < 2; ++tl) { l[tl] += __shfl_xor(l[tl], 16); l[tl] += __shfl_xor(l[tl], 32); const float gl = l[tl] > 0.f ? GATE(tl, 2) / l[tl] : 0.f; const f32x4* ysp = YSP(tl);
        f16* yp = C.YAB + (size_t)(b * T + t0 + 4 * tl + tok) * D + h * 128 + 4 * q;
#pragma unroll
        for (int dt = 0; dt < 8; ++dt) { const f32x4 yv = ysp[4 * dt] + o[tl][dt] * gl; u32x2 ov; ov.x = pk_mix(yv[0], yv[1]); ov.y = pk_mix(yv[2], yv[3]); *(u32x2*)(yp + 16 * dt) = ov; } }
}
#undef GATE
#undef YSP
__device__ __forceinline__ void p4_attention(Ctx& C) {
    LAS float* lut = (LAS float*)(C.lds + ATT_LUT);
    for (int i = C.tid; i < 16 * 128; i += NTHREADS) { const int hh = i >> 7, n = i & 127; lut[i] = C.rel_table[rel_bucket_small(n) * 16 + hh] * LOG2E; }
    __syncthreads();
    for (int u = C.bid; u < 1024; u += C.G) p4_attn_unit(C, u);
    __syncthreads();
}

__device__ __forceinline__ void p9_fixup(Ctx& C) {
    const int gt = C.bid * NTHREADS + C.tid, NGT = C.G * NTHREADS;
    for (int it = gt; it < 64 * (DFF / 8); it += NGT) {
        const int pm = it / (DFF / 8), c0 = (it % (DFF / 8)) * 8; const bool first = ((pm * 256) & (T - 1)) == 0;
        float res[2][8];
#pragma unroll
        for (int h4 = 0; h4 < 2; ++h4) {
            f32x4 cvv[2][2];
#pragma unroll
            for (int bj = 0; bj < 2; ++bj) { const int cc = c0 + 4 * h4;
                const f32x4 w0 = *(const f32x4*)(C.conv_w + 0 * NUP + bj * DFF + cc), w1 = *(const f32x4*)(C.conv_w + 1 * NUP + bj * DFF + cc), w2 = *(const f32x4*)(C.conv_w + 2 * NUP + bj * DFF + cc), bb = *(const f32x4*)(C.conv_b + bj * DFF + cc);
                const f32x4 a0 = *(const f32x4*)(C.AT + (size_t)((pm * 2 + 0) * 2 + bj) * DFF + cc), a1 = *(const f32x4*)(C.AT + (size_t)((pm * 2 + 1) * 2 + bj) * DFF + cc);
                f32x4 hm2 = {0.f, 0.f, 0.f, 0.f}, hm1 = {0.f, 0.f, 0.f, 0.f};
                if (!first) { hm2 = *(const f32x4*)(C.AH + (size_t)((2 * (pm - 1) + 0) * 2 + bj) * DFF + cc); hm1 = *(const f32x4*)(C.AH + (size_t)((2 * (pm - 1) + 1) * 2 + bj) * DFF + cc); }
                cvv[0][bj] = bb + w0 * hm2 + w1 * hm1 + w2 * a0; cvv[1][bj] = bb + w0 * hm1 + w1 * a0 + w2 * a1; }
#pragma unroll
            for (int j = 0; j < 2; ++j)
#pragma unroll
                for (int i = 0; i < 4; ++i) res[j][4 * h4 + i] = fsilu(cvv[j][0][i]) * cvv[j][1][i]; }
#pragma unroll
        for (int j = 0; j < 2; ++j) { u32x4 ov; ov.x = pk_ffn(res[j][0], res[j][1]); ov.y = pk_ffn(res[j][2], res[j][3]); ov.z = pk_ffn(res[j][4], res[j][5]); ov.w = pk_ffn(res[j][6], res[j][7]);
            *(u32x4*)(C.ACT + (size_t)(pm * 256 + j) * DFF + c0) = ov; }
    }
}

__device__ __forceinline__ void ph2_proj(Ctx& C) {
    { pg8::Gemm g{C.H, C.WIN, M, NPROJ, D}; pg8::StaticOrder S; S.init(M, NPROJ, C.G, C.bid);
      pg8::EpiProj E{C.Q, C.KV, C.Z, C.GA, C.GB};
      pg8::gemm_phase<pg8::EpiProj, pg8::StaticOrder>(C.lds, g, S, E); }
    { pg8::Gemm g{C.WVT, C.H, 1024, M, D}; pg8::StaticOrder S; S.init(1024, M, C.G, C.bid);
      pg8::EpiH16 E{C.VT, M};
      pg8::gemm_phase<pg8::EpiH16, pg8::StaticOrder>(C.lds, g, S, E); }
}
__device__ __forceinline__ void ph3_mixers(Ctx& C) {
    for (int it = C.bid; it < 256; it += C.G) p3_gates_item(C, it);
    if constexpr (((PROBE_DUP) >> 12) & 1) { for (int it = C.bid; it < 256; it += C.G) p3_gates_item(C, it); }
    for (int it = C.bid; it < 256; it += C.G) p3_compress_item(C, it);
    if constexpr (((PROBE_DUP) >> 13) & 1) { for (int it = C.bid; it < 256; it += C.G) p3_compress_item(C, it); }
    for (int it = C.bid; it < 256; it += C.G) p3_sgu_item(C, it);
    if constexpr (((PROBE_DUP) >> 14) & 1) { for (int it = C.bid; it < 256; it += C.G) p3_sgu_item(C, it); }
}
__device__ __forceinline__ void ph5_merge(Ctx& C) {
    pg8::Gemm g{C.YAB, C.WM, M, D, D}; pg8::StaticOrder S; S.init(M, D, C.G, C.bid);
    pg8::EpiMerge E{C.GA, C.GB, C.H};
    pg8::gemm_phase<pg8::EpiMerge, pg8::StaticOrder, true, MIX_BF16 != 0>(C.lds, g, S, E);
}
__device__ __forceinline__ void ph6_out(Ctx& C) {
    pg8::Gemm g{C.H, C.WO, M, D, D}; pg8::StaticOrder S; S.init(M, D, C.G, C.bid);
    pg8::EpiH16 E{C.Y1, D};
    pg8::gemm_phase<pg8::EpiH16, pg8::StaticOrder, true, MIX_BF16 != 0>(C.lds, g, S, E);
}
__device__ __forceinline__ void ph8_up(Ctx& C) {
    pg8::Gemm g{C.H2, C.WUP, M + 256, NUP, D}; pg8::StaticOrder S; S.init(M + 256, NUP, C.G, C.bid);
    pg8::EpiConv E{C.ACT, C.AH, C.AT, C.conv_w, C.conv_b, (LAS float*)(C.lds + pg8::STAGE_BYTES), FFN_BF16};
    pg8::gemm_phase<pg8::EpiConv, pg8::StaticOrder, true, FFN_BF16 != 0>(C.lds, g, S, E);
}
__device__ __forceinline__ void ph9_conv(Ctx& C) { p9_fixup(C); }
__device__ __forceinline__ void ph10_down(Ctx& C) {
    pg8::Gemm g{C.ACT, C.WDN, M, D, DFF}; pg8::StaticOrder S; S.init(M, D, C.G, C.bid);
    pg8::EpiH16 E{C.Y2, D};
    pg8::gemm_phase<pg8::EpiH16, pg8::StaticOrder, true, FFN_BF16 != 0>(C.lds, g, S, E);
}

constexpr int NPHASE = 12;
__global__ void __launch_bounds__(NTHREADS, 2) fwd_kernel(Args args) {
    extern __shared__ __attribute__((aligned(16))) unsigned char lds_raw[];
    Ctx C;
    C.lds = (LAS unsigned char*)lds_raw;
    C.tid = threadIdx.x; C.lane = C.tid & 63; C.wave = __builtin_amdgcn_readfirstlane(C.tid >> 6); C.G = gridDim.x; C.bid = blockIdx.x;
    C.x = args.in[0]; C.c = args.in[1]; C.w_mod = args.in[2]; C.b_mod = args.in[3]; C.g_norms = args.in[4]; C.w_in = args.in[5]; C.cmp_pos = args.in[6]; C.cmp_w1 = args.in[7];
    C.cmp_b1 = args.in[8]; C.cmp_w2 = args.in[9]; C.cmp_b2 = args.in[10]; C.rel_table = args.in[11]; C.ln_g = args.in[12]; C.ln_b = args.in[13]; C.sgu_w = args.in[14]; C.sgu_b = args.in[15];
    C.w_pn = args.in[16]; C.w_ps = args.in[17]; C.w_out = args.in[18]; C.w_up = args.in[19]; C.conv_w = args.in[20]; C.conv_b = args.in[21]; C.w_dn = args.in[22];
    C.out = args.out; C.ws = args.ws; unsigned char* ws = args.ws;
    C.mod = (float*)(ws + WS_MOD); C.posw1 = (float*)(ws + WS_POSW1); C.gates = (float*)(ws + WS_GATES); C.ysc = (float*)(ws + WS_YSC); C.AH = (float*)(ws + WS_AH); C.AT = (float*)(ws + WS_AT); C.Y1 = (f16*)(ws + WS_Z); C.Y2 = (f16*)(ws + WS_Y2); C.X1H = (f16*)(ws + WS_X1H);
    C.W2T = (f16*)(ws + WS_W2T); C.SGUW = (f16*)(ws + WS_SGUW); C.WG = (f16*)(ws + WS_WG); C.KC = (f16*)(ws + WS_KC); C.VCT = (f16*)(ws + WS_VCT); C.W1T = (f16*)(ws + WS_W1T);
    C.WUP = (f16*)(ws + WS_WUP); C.WDN = (f16*)(ws + WS_WDN); C.WIN = (f16*)(ws + WS_WIN); C.WVT = (f16*)(ws + WS_WVT); C.WM = (f16*)(ws + WS_WM); C.WO = (f16*)(ws + WS_WO);
    C.H = (f16*)(ws + WS_H); C.Q = (f16*)(ws + WS_Q); C.KV = (f16*)(ws + WS_KV); C.VT = (f16*)(ws + WS_VT); C.Z = (f16*)(ws + WS_Z); C.GA = (f16*)(ws + WS_GA); C.GB = (f16*)(ws + WS_GB);
    C.YAB = (f16*)(ws + WS_YAB); C.H2 = (f16*)(ws + WS_H2); C.ACT = (f16*)(ws + WS_ACT);

    volatile LAS unsigned* MISC = (volatile LAS unsigned*)(C.lds + MISC_OFF);
    for (int u = C.tid; u < (LDS_BYTES - MISC_OFF) / 4; u += NTHREADS) MISC[u] = 0u;
    __syncthreads();
    unsigned* barw = (unsigned*)(ws + WS_CTL) + CW_BAR;
    XcdBarrier bar; bar.bar = barw; bar.x = 0; bar.st = nullptr;
    if (MK_N_LAUNCHES == 1) bar = xcd_barrier_post(barw, MISC + 8);
    const int lo = args.ph_lo, hi = args.ph_hi;
#define IN(k) (lo <= (k) && (k) < hi)
#define DUP(k) ((((PROBE_DUP) >> (k)) & 1) != 0)
#define SEAM(k) do { if (IN(k) && IN((k) + 1)) xcd_barrier(bar); } while (0)

    if (IN(0)) { p0_prologue(C); if constexpr (DUP(0)) p0_prologue(C); }
    SEAM(0);
    if (IN(1)) { p1_norm(C); if constexpr (DUP(1)) p1_norm(C); }
    SEAM(1);
    if (IN(2)) { ph2_proj(C); if constexpr (DUP(2)) ph2_proj(C); }
    SEAM(2);
    if (IN(3)) { ph3_mixers(C); if constexpr (DUP(3)) ph3_mixers(C); }
    SEAM(3);
    if (IN(4)) { p4_attention(C); if constexpr (DUP(4)) p4_attention(C); }
    SEAM(4);
    if (IN(5)) { ph5_merge(C); if constexpr (DUP(5)) ph5_merge(C); }
    SEAM(5);
    if (IN(6)) { ph6_out(C); if constexpr (DUP(6)) ph6_out(C); }
    SEAM(6);
    if (IN(7)) { p7_norm(C); }
    SEAM(7);
    if (IN(8)) { ph8_up(C); if constexpr (DUP(8)) ph8_up(C); }
    SEAM(8);
    if (IN(9)) { ph9_conv(C); if constexpr (DUP(9)) ph9_conv(C); }
    SEAM(9);
    if (IN(10)) { ph10_down(C); if constexpr (DUP(10)) ph10_down(C); }
    SEAM(10);
    if (IN(11)) { p11_final(C); }
#undef IN
#undef DUP
#undef SEAM
}

extern "C" void kernel_launch(void* const* d_in, const int* in_sizes, int n_in, void* d_out, int out_size, void* d_ws, size_t ws_size, hipStream_t stream) {
    static int grid = 0;
    if (grid == 0) {
        if (n_in != 23 || in_sizes[0] != M * D || out_size != M * D || ws_size < WS_END) { fprintf(stderr, "kernel_launch: unexpected shapes (n_in %d, in0 %d, out %d, ws %zu); nothing launched\n", n_in, n_in > 0 ? in_sizes[0] : -1, out_size, ws_size); grid = -1; return; }
        int dev = 0, cus = 0, per_cu = 0;
        if (hipGetDevice(&dev) != hipSuccess || hipDeviceGetAttribute(&cus, hipDeviceAttributeMultiprocessorCount, dev) != hipSuccess) { grid = -1; return; }
        if (hipFuncSetAttribute((const void*)fwd_kernel, hipFuncAttributeMaxDynamicSharedMemorySize, LDS_BYTES) != hipSuccess) { fprintf(stderr, "kernel_launch: hipFuncSetAttribute failed\n"); grid = -1; return; }
        if (hipOccupancyMaxActiveBlocksPerMultiprocessor(&per_cu, (const void*)fwd_kernel, NTHREADS, LDS_BYTES) != hipSuccess || per_cu < 1) { fprintf(stderr, "kernel_launch: occupancy query reports %d\n", per_cu); }
        (void)hipGetLastError();
        grid = cus;
        if (grid > 256) grid = 256;
    }
    if (grid < 0) return;
    (void)hipMemsetAsync((char*)d_ws + WS_CTL, 0, CTL_BYTES, stream);
    Args a{};
    for (int i = 0; i < 23; ++i) a.in[i] = (const float*)d_in[i];
    a.out = (float*)d_out; a.ws = (unsigned char*)d_ws;
    if (MK_N_LAUNCHES == 1) { a.ph_lo = 0; a.ph_hi = NPHASE; hipLaunchKernelGGL(fwd_kernel, dim3(grid), dim3(NTHREADS), LDS_BYTES, stream, a); }
    else { for (int li = 0; li < NPHASE; ++li) { a.ph_lo = li; a.ph_hi = li + 1; hipLaunchKernelGGL(fwd_kernel, dim3(grid), dim3(NTHREADS), LDS_BYTES, stream, a); } }
}
```

```cpp
#include <hip/hip_runtime.h>
#include <cstdio>
#include <cstdint>

#ifndef MK_N_LAUNCHES
#define MK_N_LAUNCHES 1
#endif

#ifndef PROBE_DUP
#define PROBE_DUP 0
#endif
#define GAS __attribute__((address_space(1)))
#define LAS __attribute__((address_space(3)))
typedef _Float16 f16;
typedef _Float16 hx8 __attribute__((ext_vector_type(8)));
typedef _Float16 hx4 __attribute__((ext_vector_type(4)));
typedef _Float16 hx2 __attribute__((ext_vector_type(2)));
typedef float f32x4 __attribute__((ext_vector_type(4)));
typedef float f32x2 __attribute__((ext_vector_type(2)));
typedef unsigned u32x4 __attribute__((ext_vector_type(4)));
typedef unsigned u32x2 __attribute__((ext_vector_type(2)));
typedef int ix4 __attribute__((ext_vector_type(4)));

constexpr int NB = 2, T = 8192, D = 4096, M = NB * T;
constexpr int NG = 4, HD = 128;
constexpr int DFF = 11008, NUP = 2 * DFF;
constexpr int IN_W = 17456, NPROJ = 16384, NMOD = 6 * D;
constexpr float EPS = 1e-6f;
constexpr float LOG2E = 1.4426950408889634f;
constexpr float SC2 = 0.08838834764831845f * 1.4426950408889634f;

constexpr size_t MiB = 1ull << 20;
constexpr size_t WS_CTL = 0, CTL_BYTES = 1 * MiB;
constexpr size_t WS_MOD = 1 * MiB;
constexpr size_t WS_POSW1 = 1 * MiB + 256 * 1024;
constexpr size_t WS_W2T = 1 * MiB + 384 * 1024;
constexpr size_t WS_SGUW = 2 * MiB;
constexpr size_t WS_WG = 2 * MiB + 512 * 1024;
constexpr size_t WS_KC = 3 * MiB;
constexpr size_t WS_VCT = 4 * MiB;
constexpr size_t WS_GATES = 5 * MiB;
constexpr size_t WS_W1T = 8 * MiB;
constexpr size_t WS_WUP = 16 * MiB;
constexpr size_t WS_WDN = 188 * MiB;
constexpr size_t WS_WIN = 274 * MiB;
constexpr size_t WS_WVT = 402 * MiB;
constexpr size_t WS_WM = 410 * MiB;
constexpr size_t WS_WO = 442 * MiB;
constexpr size_t WS_H = 474 * MiB;
constexpr size_t WS_Q = 602 * MiB;
constexpr size_t WS_KV = 666 * MiB;
constexpr size_t WS_VT = 730 * MiB;
constexpr size_t WS_Z = 762 * MiB;
constexpr size_t WS_GA = 890 * MiB;
constexpr size_t WS_GB = 1018 * MiB;
constexpr size_t WS_YAB = 1146 * MiB;
constexpr size_t WS_H2 = 274 * MiB;
constexpr size_t WS_AH = 406 * MiB;
constexpr size_t WS_AT = 418 * MiB;
constexpr size_t WS_ACT = 1090 * MiB;
constexpr size_t WS_Y2 = 432 * MiB;
constexpr size_t WS_X1H = 602 * MiB;
constexpr size_t WS_YSC = 1274 * MiB;
constexpr size_t WS_SA = 12 * MiB;
constexpr size_t WS_SW = 12 * MiB + 256 * 1024;
constexpr size_t WS_WUPQ = 1434 * MiB;
constexpr size_t WS_END = 1520 * MiB;

constexpr int CW_BAR = 4096;

constexpr int LDS_BYTES = 147456;
constexpr int MISC_OFF = LDS_BYTES - 512;
constexpr int NWAVES = 8, NTHREADS = 512;

#define LDS_WAIT() asm volatile("s_waitcnt lgkmcnt(0)" ::: "memory")
#define VM_WAIT() asm volatile("s_waitcnt vmcnt(0)" ::: "memory")
__device__ __forceinline__ unsigned pkh(float lo, float hi) { hx2 p; p.x = (f16)lo; p.y = (f16)hi; return __builtin_bit_cast(unsigned, p); }
__device__ __forceinline__ unsigned pkb(float lo, float hi) { unsigned r; asm volatile("v_cvt_pk_bf16_f32 %0, %1, %2" : "=v"(r) : "v"(lo), "v"(hi)); return r; }
#ifndef FFN_BF16
#define FFN_BF16 1
#endif
__device__ __forceinline__ unsigned pk_ffn(float lo, float hi) { return FFN_BF16 ? pkb(lo, hi) : pkh(lo, hi); }
#ifndef MIX_BF16
#define MIX_BF16 1
#endif
__device__ __forceinline__ unsigned pk_mix(float lo, float hi) { return MIX_BF16 ? pkb(lo, hi) : pkh(lo, hi); }
__device__ __forceinline__ float wave_max(float v) {
#pragma unroll
    for (int o = 1; o < 64; o <<= 1) v = fmaxf(v, __shfl_xor(v, o));
    return v;
}
__device__ __forceinline__ unsigned pk_i8(float a, float b, float c, float d) {
    const int ia = (int)__builtin_rintf(a), ib = (int)__builtin_rintf(b), ic = (int)__builtin_rintf(c), id = (int)__builtin_rintf(d);
    return (unsigned)(ia & 255) | ((unsigned)(ib & 255) << 8) | ((unsigned)(ic & 255) << 16) | ((unsigned)(id & 255) << 24);
}
__device__ __forceinline__ float wave_sum(float v) {
#pragma unroll
    for (int o = 1; o < 64; o <<= 1) v += __shfl_xor(v, o);
    return v;
}
__device__ __forceinline__ float fsigmoid(float x) { return __builtin_amdgcn_rcpf(1.0f + __builtin_amdgcn_exp2f(-LOG2E * x)); }
__device__ __forceinline__ float fsilu(float x) { return x * fsigmoid(x); }
__device__ __forceinline__ float fgelu(float x) { const float u = x * (1.0f + 0.044715f * x * x); return x * __builtin_amdgcn_rcpf(1.0f + __builtin_amdgcn_exp2f(-2.302208198f * u)); }
template <int CTRL> __device__ __forceinline__ float dpp_f(float v) { return __builtin_bit_cast(float, __builtin_amdgcn_update_dpp(0, __builtin_bit_cast(int, v), CTRL, 0xF, 0xF, true)); }

namespace pg8 {
constexpr int BM = 256, BK = 64, HALF = 128, HTB = HALF * BK * 2, STAGE_BYTES = 8 * HTB, NXCD = 8, WGM = 8;
__host__ __device__ __forceinline__ int lds_byte(int r, int c) { const int st = (r >> 4) * 2 + (c >> 5), rr = r & 15, cc = c & 31, ob = rr * 64 + cc * 2; return st * 1024 + (ob ^ (((ob >> 9) & 1) << 5)); }
__host__ __device__ __forceinline__ void stage_rc(int b, int& R, int& C) { const int st = b / 1024, sb = b % 1024, swz = sb ^ (((sb >> 9) & 1) << 5); R = (st >> 1) * 16 + swz / 64; C = (st & 1) * 32 + (swz % 64) / 2; }
__host__ __device__ __forceinline__ int perm32(int rho) { const int n = rho >> 4, i = rho & 15; return 8 * (i >> 2) + 4 * n + (i & 3); }

struct Unit { int pm, pn; };
struct Gemm { const f16* A; const f16* Bt; int M, N, K; };

struct StaticOrder {
    int nM, nN, nwg, G, c;
    __host__ __device__ void init(int M_, int N_, int G_, int c_) { nM = M_ / BM; nN = N_ / BM; nwg = nM * nN; G = G_; c = c_; }
    __host__ __device__ bool next(int i, Unit& u) const {
        const long L = (long)i * G + c; if (L >= nwg) return false;
        int wgid = (int)L; { const int q = nwg / NXCD, r = nwg % NXCD, xcd = wgid % NXCD, off = wgid / NXCD; wgid = (xcd < r ? xcd * (q + 1) : r * (q + 1) + (xcd - r) * q) + off; }
        const int nig = WGM * nN, gid = wgid / nig, fm = gid * WGM, gsz = (nM - fm) < WGM ? (nM - fm) : WGM;
        u.pm = fm + ((wgid % nig) % gsz); u.pn = (wgid % nig) / gsz; return true;
    }
    __device__ __forceinline__ void a_ready(const Unit&) const {}
    __device__ __forceinline__ void done(const Unit&) const {}
};

__device__ __forceinline__ u32x4 pack8(const f32x4 v0, const f32x4 v1) { u32x4 w; w.x = pkh(v0[0], v0[1]); w.y = pkh(v0[2], v0[3]); w.z = pkh(v1[0], v1[1]); w.w = pkh(v1[2], v1[3]); return w; }

__device__ __forceinline__ unsigned opaque(unsigned v) { asm volatile("" : "+v"(v)); return v; }
struct EpiF32 {
    static constexpr bool PERM = false, AFTER_DRAIN = false, HAS_MID = false;
    float* C; int ldc;
    __device__ __forceinline__ void mid(f32x4 (&)[2][2][4][2], const Unit&, int, int, int, int) const {}
    __device__ __forceinline__ void operator()(const f32x4 (&acc)[2][2][4][2], const Unit& u, int wr, int wc, int fr, int fq) const {
        const unsigned off = opaque((unsigned)((u.pm * BM + wr * 64 + fr) * ldc + u.pn * BM + wc * 32 + 4 * fq) * 4u);
        char* base = (char*)C;
#pragma unroll
        for (int ai = 0; ai < 2; ++ai)
#pragma unroll
            for (int m = 0; m < 4; ++m) { const unsigned ro = off + (unsigned)((ai * HALF + m * 16) * ldc) * 4u;
#pragma unroll
                for (int bj = 0; bj < 2; ++bj)
#pragma unroll
                    for (int n = 0; n < 2; ++n) *(f32x4*)(base + ro + (bj * HALF + n * 16) * 4) = acc[ai][bj][m][n]; }
    }
};
struct EpiH16 {
    static constexpr bool PERM = true, AFTER_DRAIN = false, HAS_MID = false;
    f16* O; int ldc;
    __device__ __forceinline__ void mid(f32x4 (&)[2][2][4][2], const Unit&, int, int, int, int) const {}
    __device__ __forceinline__ void operator()(const f32x4 (&acc)[2][2][4][2], const Unit& u, int wr, int wc, int fr, int fq) const {
        const unsigned off = opaque((unsigned)((u.pm * BM + wr * 64 + fr) * ldc + u.pn * BM + wc * 32 + 8 * fq) * 2u);
        char* base = (char*)O;
#pragma unroll
        for (int ai = 0; ai < 2; ++ai)
#pragma unroll
            for (int m = 0; m < 4; ++m) { const unsigned ro = off + (unsigned)((ai * HALF + m * 16) * ldc) * 2u;
#pragma unroll
                for (int bj = 0; bj < 2; ++bj) *(u32x4*)(base + ro + bj * HALF * 2) = pack8(acc[ai][bj][m][0], acc[ai][bj][m][1]); }
    }
};
struct EpiProj {
    static constexpr bool PERM = true, AFTER_DRAIN = false, HAS_MID = false;
    f16 *Q, *KV, *Z, *GA, *GB;
    __device__ __forceinline__ void mid(f32x4 (&)[2][2][4][2], const Unit&, int, int, int, int) const {}
    __device__ __forceinline__ void operator()(const f32x4 (&acc)[2][2][4][2], const Unit& u, int wr, int wc, int fr, int fq) const {
        const int pn = u.pn; char* base; int ldc, colt, act;
        if (pn < 8) { base = (char*)Q; ldc = 2048; colt = pn * 256; act = 0; }
        else if (pn < 16) { base = (char*)KV; ldc = 2048; colt = (pn - 8) * 256; act = 0; }
        else if (pn < 32) { base = (char*)Z; ldc = 4096; colt = (pn - 16) * 256; act = 1; }
        else if (pn < 48) { base = (char*)GA; ldc = 4096; colt = (pn - 32) * 256; act = 2; }
        else { base = (char*)GB; ldc = 4096; colt = (pn - 48) * 256; act = 2; }
        const unsigned off = opaque((unsigned)((u.pm * BM + wr * 64 + fr) * ldc + colt + wc * 32 + 8 * fq) * 2u);
#pragma unroll
        for (int ai = 0; ai < 2; ++ai)
#pragma unroll
            for (int m = 0; m < 4; ++m) { const unsigned ro = off + (unsigned)((ai * HALF + m * 16) * ldc) * 2u;
#pragma unroll
                for (int bj = 0; bj < 2; ++bj) { f32x4 v0 = acc[ai][bj][m][0], v1 = acc[ai][bj][m][1];
                    if (act == 1) {
#pragma unroll
                        for (int j = 0; j < 4; ++j) { v0[j] = fgelu(v0[j]); v1[j] = fgelu(v1[j]); } }
                    else if (act == 2) {
#pragma unroll
                        for (int j = 0; j < 4; ++j) { v0[j] = fsigmoid(v0[j]); v1[j] = fsigmoid(v1[j]); } }
                    *(u32x4*)(base + ro + bj * HALF * 2) = pack8(v0, v1); } }
    }
};
struct EpiMerge {
    static constexpr bool PERM = true, AFTER_DRAIN = false, HAS_MID = true;
    const f16 *GA, *GB; f16* O;
    __device__ __forceinline__ void mid(f32x4 (&acc)[2][2][4][2], const Unit& u, int wr, int wc, int fr, int fq) const {
        const unsigned off = opaque((unsigned)((u.pm * BM + wr * 64 + fr) * D + u.pn * BM + wc * 32 + 8 * fq) * 2u);
        const char* ga = (const char*)GA; const char* gb = (const char*)GB;
#pragma unroll
        for (int ai = 0; ai < 2; ++ai)
#pragma unroll
            for (int m = 0; m < 4; ++m) { const unsigned ro = off + (unsigned)((ai * HALF + m * 16) * D) * 2u;
#pragma unroll
                for (int bj = 0; bj < 2; ++bj) { const hx8 a = *(const hx8*)(ga + ro + bj * HALF * 2), b = *(const hx8*)(gb + ro + bj * HALF * 2);
#pragma unroll
                    for (int j = 0; j < 4; ++j) { acc[ai][bj][m][0][j] *= (float)a[j] * __builtin_amdgcn_rcpf((float)b[j]); acc[ai][bj][m][1][j] *= (float)a[4 + j] * __builtin_amdgcn_rcpf((float)b[4 + j]); } } }
    }
    __device__ __forceinline__ void operator()(const f32x4 (&acc)[2][2][4][2], const Unit& u, int wr, int wc, int fr, int fq) const {
        const unsigned off = opaque((unsigned)((u.pm * BM + wr * 64 + fr) * D + u.pn * BM + wc * 32 + 8 * fq) * 2u);
        const char* gb = (const char*)GB; char* ob = (char*)O;
#pragma unroll
        for (int ai = 0; ai < 2; ++ai)
#pragma unroll
            for (int m = 0; m < 4; ++m) { const unsigned ro = off + (unsigned)((ai * HALF + m * 16) * D) * 2u;
#pragma unroll
                for (int bj = 0; bj < 2; ++bj) { const hx8 b = *(const hx8*)(gb + ro + bj * HALF * 2); f32x4 v0 = acc[ai][bj][m][0], v1 = acc[ai][bj][m][1];
#pragma unroll
                    for (int j = 0; j < 4; ++j) { v0[j] *= (float)b[j]; v1[j] *= (float)b[4 + j]; }
                    u32x4 w; w.x = pk_mix(v0[0], v0[1]); w.y = pk_mix(v0[2], v0[3]); w.z = pk_mix(v1[0], v1[1]); w.w = pk_mix(v1[2], v1[3]);
                    *(u32x4*)(ob + ro + bj * HALF * 2) = w; } }
    }
};

typedef short sx8 __attribute__((ext_vector_type(8)));
template <int CTRL> __device__ __forceinline__ float dpp_mov(float old, float v) { return __builtin_bit_cast(float, __builtin_amdgcn_update_dpp(__builtin_bit_cast(int, old), __builtin_bit_cast(int, v), CTRL, 0xF, 0xF, false)); }
struct EpiConv {
    static constexpr bool PERM = true, AFTER_DRAIN = false, HAS_MID = false;
    unsigned char* ws; const float* cw; const float* cb; LAS float* X; int bf16out;
    __device__ __forceinline__ void mid(f32x4 (&)[2][2][4][2], const Unit&, int, int, int, int) const {}
    static __device__ __forceinline__ f32x4 deq(const f32x4 a, float s) { const ix4 iv = __builtin_bit_cast(ix4, a); return (f32x4){(float)iv[0] * s, (float)iv[1] * s, (float)iv[2] * s, (float)iv[3] * s}; }
    __device__ __forceinline__ void operator()(const f32x4 (&acc)[2][2][4][2], const Unit& u, int wr, int wc, int fr_, int fq_) const {
        const unsigned lane_o = opaque(threadIdx.x & 63u); const int fr = (int)(lane_o & 15u), fq = (int)(lane_o >> 4); (void)fr_; (void)fq_;
        f16* const ACT = (f16*)(ws + WS_ACT); float* const AH = (float*)(ws + WS_AH); float* const AT = (float*)(ws + WS_AT); const float* const SA = (const float*)(ws + WS_SA); const float* const SW = (const float*)(ws + WS_SW);
        const int chl = wc * 32 + 8 * fq;
        const unsigned ch0 = opaque((unsigned)(u.pn * 128 + chl)), wrow = opaque((unsigned)(u.pn * 256 + chl)), arow = opaque((unsigned)(u.pm * BM + wr * 64 + fr));
        float sa[2][4];
#pragma unroll
        for (int ai = 0; ai < 2; ++ai)
#pragma unroll
            for (int m = 0; m < 4; ++m) sa[ai][m] = SA[arow + ai * HALF + m * 16];
        if (fr >= 14) {
#pragma unroll
            for (int ai = 0; ai < 2; ++ai)
#pragma unroll
                for (int bj = 0; bj < 2; ++bj)
#pragma unroll
                    for (int n = 0; n < 2; ++n) *(LAS f32x4*)(X + ((((2 * ai + wr) * 2 + (fr - 14)) * 2 + bj) * 128 + chl + 4 * n)) = deq(acc[ai][bj][3][n], sa[ai][3]);
        }
        asm volatile("s_waitcnt lgkmcnt(0)" ::: "memory"); __builtin_amdgcn_s_barrier(); asm volatile("" ::: "memory");
        if (u.pm == 64) {
            const unsigned hro = opaque((unsigned)((wr * 64 + fr) * 2));
#pragma unroll
            for (int bj = 0; bj < 2; ++bj)
#pragma unroll
                for (int n = 0; n < 2; ++n) { const f32x4 swv = *(const f32x4*)(SW + wrow + bj * 128 + 4 * n);
#pragma unroll
                    for (int m = 0; m < 4; ++m) *(f32x4*)(AH + (size_t)(hro + 32 * m + bj) * DFF + ch0 + 4 * n) = deq(acc[0][bj][m][n], sa[0][m]) * swv; }
            return;
        }
        const unsigned orow = opaque((unsigned)(u.pm * BM + wr * 64 + fr));
#pragma unroll
        for (int n = 0; n < 2; ++n) {
            f32x4 wv[3][2], bv[2];
#pragma unroll
            for (int bj = 0; bj < 2; ++bj) { bv[bj] = *(const f32x4*)(cb + bj * DFF + ch0 + 4 * n); const f32x4 swv = *(const f32x4*)(SW + wrow + bj * 128 + 4 * n);
#pragma unroll
                for (int k = 0; k < 3; ++k) wv[k][bj] = *(const f32x4*)(cw + k * NUP + bj * DFF + ch0 + 4 * n) * swv;
                if (wr == 0 && fr < 2) *(f32x4*)(AT + (size_t)((u.pm * 2 + fr) * 2 + bj) * DFF + ch0 + 4 * n) = deq(acc[0][bj][0][n], sa[0][0]) * swv; }
#pragma unroll
            for (int ai = 0; ai < 2; ++ai) {
                f32x4 E[2];
                const int blk = 2 * ai + wr - 1;
#pragma unroll
                for (int bj = 0; bj < 2; ++bj) { E[bj] = (f32x4){0.f, 0.f, 0.f, 0.f};
                    if (blk >= 0 && fr >= 14) E[bj] = *(const LAS f32x4*)(X + (((blk * 2 + (fr - 14)) * 2 + bj) * 128 + chl + 4 * n)); }
#pragma unroll
                for (int m = 0; m < 4; ++m) {
                    f32x4 cv[2];
#pragma unroll
                    for (int bj = 0; bj < 2; ++bj) { const f32x4 cur = deq(acc[ai][bj][m][n], sa[ai][m]); const f32x4 prv = (m == 0) ? E[bj] : deq(acc[ai][bj][m == 0 ? 0 : m - 1][n], sa[ai][m == 0 ? 0 : m - 1]);
#pragma unroll
                        for (int i = 0; i < 4; ++i) { const float p1 = dpp_mov<0x111>(dpp_mov<0x121>(0.f, prv[i]), cur[i]), p2 = dpp_mov<0x112>(dpp_mov<0x122>(0.f, prv[i]), cur[i]);
                            cv[bj][i] = bv[bj][i] + wv[0][bj][i] * p2 + wv[1][bj][i] * p1 + wv[2][bj][i] * cur[i]; } }
                    float res[4];
#pragma unroll
                    for (int e = 0; e < 4; ++e) res[e] = fsilu(cv[0][e]) * cv[1][e];
                    u32x2 ov;
                    if (bf16out) { ov.x = pkb(res[0], res[1]); ov.y = pkb(res[2], res[3]); }
                    else { ov.x = pkh(res[0], res[1]); ov.y = pkh(res[2], res[3]); }
                    *(u32x2*)(ACT + (size_t)(orow + ai * HALF + m * 16) * DFF + ch0 + 4 * n) = ov;
                }
            }
        }
    }
};

template <class Epi, class Sched, bool ALIGN_EPI = true, int DT = 0  >
__device__ __forceinline__ void gemm_phase(LAS unsigned char* lds, const Gemm g, const Sched& S, const Epi& E) {
    const int tid = threadIdx.x, wid = __builtin_amdgcn_readfirstlane(tid >> 6), lane = tid & 63, wr = wid >> 2, wc = wid & 3, fr = lane & 15, fq = lane >> 4;
    const int K = g.K, nt = K / BK;
    unsigned voffA[2], voffB[2];
#pragma unroll
    for (int i = 0; i < 2; ++i) { int R, C; stage_rc(tid * 16 + i * 8192, R, C); const int Rb = Epi::PERM ? ((R & ~31) + perm32(R & 31)) : R;
        voffA[i] = (unsigned)(R * K + C) * 2u; voffB[i] = (unsigned)(Rb * K + C) * 2u; }
    const size_t kstep = (size_t)(BK * 2);
    const size_t hstep = (size_t)HALF * K * 2;
    const size_t tstep = 2 * hstep;
    const unsigned ldsw = (unsigned)wid * 1024u;
    const int aoff = lds_byte(wr * 64 + fr, fq * 8), boff = lds_byte(wc * 32 + fr, fq * 8);
#define PG8_SA(b, h) (((b) * 2 + (h)) * HTB)
#define PG8_SB(b, h) ((4 + (b) * 2 + (h)) * HTB)
#define PG8_STAGE(bufoff, gbase, voff) do { _Pragma("unroll") for (int _i = 0; _i < 2; ++_i) \
        __builtin_amdgcn_global_load_lds((const unsigned*)((const char*)(gbase) + (voff)[_i]), (LAS unsigned*)(lds + (bufoff) + ldsw + _i * 8192), 16, 0, 0); } while (0)
#define PG8_LDA(dst, b, h) do { _Pragma("unroll") for (int m = 0; m < 4; ++m) _Pragma("unroll") for (int k = 0; k < 2; ++k) dst[m][k] = *(const LAS hx8*)(lds + PG8_SA(b, h) + aoff + m * 2048 + k * 1024); } while (0)
#define PG8_LDB(dst, b, h) do { _Pragma("unroll") for (int n = 0; n < 2; ++n) _Pragma("unroll") for (int k = 0; k < 2; ++k) dst[n][k] = *(const LAS hx8*)(lds + PG8_SB(b, h) + boff + n * 2048 + k * 1024); } while (0)
#define PG8_MMA(ai, bj, At, Bt) do { __builtin_amdgcn_s_setprio(1); _Pragma("unroll") for (int m = 0; m < 4; ++m) _Pragma("unroll") for (int n = 0; n < 2; ++n) _Pragma("unroll") for (int k = 0; k < 2; ++k) \
        { if constexpr (DT == 2) acc[ai][bj][m][n] = __builtin_bit_cast(f32x4, __builtin_amdgcn_mfma_i32_16x16x64_i8(__builtin_bit_cast(ix4, Bt[n][k]), __builtin_bit_cast(ix4, At[m][k]), __builtin_bit_cast(ix4, acc[ai][bj][m][n]), 0, 0, 0)); \
          else if constexpr (DT == 1) acc[ai][bj][m][n] = __builtin_amdgcn_mfma_f32_16x16x32_bf16(__builtin_bit_cast(sx8, Bt[n][k]), __builtin_bit_cast(sx8, At[m][k]), acc[ai][bj][m][n], 0, 0, 0); \
          else acc[ai][bj][m][n] = __builtin_amdgcn_mfma_f32_16x16x32_f16(Bt[n][k], At[m][k], acc[ai][bj][m][n], 0, 0, 0); } __builtin_amdgcn_s_setprio(0); } while (0)
#define PG8_WAIT_V(n) asm volatile("s_waitcnt vmcnt(" #n ")" ::: "memory")
#define PG8_WAIT_L(n) asm volatile("s_waitcnt lgkmcnt(" #n ")" ::: "memory")
#define PG8_BAR __builtin_amdgcn_s_barrier()
#define PG8_SCHED __builtin_amdgcn_sched_barrier(0)
    Unit cur, nxt; int ui = 0;
    if (!S.next(0, cur)) return;
    f32x4 acc[2][2][4][2];
#pragma unroll
    for (int a = 0; a < 2; ++a)
#pragma unroll
        for (int b = 0; b < 2; ++b)
#pragma unroll
            for (int m = 0; m < 4; ++m)
#pragma unroll
                for (int n = 0; n < 2; ++n) acc[a][b][m][n] = (f32x4){0.f, 0.f, 0.f, 0.f};
    hx8 At[4][2], B0[2][2], B1[2][2];
    const char* cA = (const char*)g.A + (size_t)cur.pm * tstep; const char* cB = (const char*)g.Bt + (size_t)cur.pn * tstep;
    S.a_ready(cur);
    PG8_STAGE(PG8_SB(0, 0), cB, voffB); PG8_STAGE(PG8_SB(0, 1), cB + hstep, voffB); PG8_STAGE(PG8_SA(0, 0), cA, voffA); PG8_STAGE(PG8_SA(0, 1), cA + hstep, voffA);
    if (wr == 1) PG8_BAR;
    PG8_WAIT_V(2); PG8_BAR;
    PG8_STAGE(PG8_SB(1, 0), cB + kstep, voffB); PG8_STAGE(PG8_SA(1, 0), cA + kstep, voffA); PG8_STAGE(PG8_SB(1, 1), cB + hstep + kstep, voffB);
    PG8_WAIT_V(6); PG8_BAR;
    for (;;) {
        const bool has_next = S.next(ui + 1, nxt);
        const char* nA = has_next ? (const char*)g.A + (size_t)nxt.pm * tstep : cA; const char* nB = has_next ? (const char*)g.Bt + (size_t)nxt.pn * tstep : cB;
        for (int t = 0; t < nt; t += 2) {
            const bool last = (t == nt - 2);
            const char* a1 = cA + (size_t)(t + 1) * kstep;
            const char* a2 = last ? nA : cA + (size_t)(t + 2) * kstep; const char* b2 = last ? nB : cB + (size_t)(t + 2) * kstep;
            const char* a3 = a2 + kstep; const char* b3 = b2 + kstep;
            if (last && has_next) S.a_ready(nxt);
            if constexpr (Epi::HAS_MID) { if (t == (nt >> 1)) E.mid(acc, cur, wr, wc, fr, fq); }
            PG8_LDB(B0, 0, 0); PG8_LDB(B1, 0, 1); PG8_SCHED; PG8_LDA(At, 0, 0); PG8_STAGE(PG8_SA(1, 1), a1 + hstep, voffA);
            PG8_WAIT_V(8); PG8_WAIT_L(0); PG8_BAR; PG8_MMA(0, 0, At, B0); PG8_MMA(0, 1, At, B1); PG8_BAR; PG8_SCHED;
            PG8_LDA(At, 0, 1); PG8_STAGE(PG8_SB(0, 0), b2, voffB); PG8_STAGE(PG8_SB(0, 1), b2 + hstep, voffB); PG8_STAGE(PG8_SA(0, 0), a2, voffA);
            PG8_WAIT_V(8); PG8_WAIT_L(0); PG8_BAR; PG8_MMA(1, 0, At, B0); PG8_MMA(1, 1, At, B1); PG8_BAR; PG8_SCHED;
            PG8_LDB(B0, 1, 0); PG8_LDB(B1, 1, 1); PG8_SCHED; PG8_LDA(At, 1, 0); PG8_STAGE(PG8_SA(0, 1), a2 + hstep, voffA);
            PG8_WAIT_V(8); PG8_WAIT_L(0); PG8_BAR; PG8_MMA(0, 0, At, B0); PG8_MMA(0, 1, At, B1); PG8_BAR; PG8_SCHED;
            PG8_LDA(At, 1, 1); PG8_STAGE(PG8_SB(1, 0), b3, voffB); PG8_STAGE(PG8_SB(1, 1), b3 + hstep, voffB); PG8_STAGE(PG8_SA(1, 0), a3, voffA);
            PG8_WAIT_V(8); PG8_WAIT_L(0); PG8_BAR; PG8_MMA(1, 0, At, B0); PG8_MMA(1, 1, At, B1); PG8_BAR; PG8_SCHED;
        }
        if constexpr (ALIGN_EPI) { if (wr == 0) PG8_BAR; }
        E(acc, cur, wr, wc, fr, fq); S.done(cur);
        if (!has_next) break;
#pragma unroll
        for (int a = 0; a < 2; ++a)
#pragma unroll
            for (int b = 0; b < 2; ++b)
#pragma unroll
                for (int m = 0; m < 4; ++m)
#pragma unroll
                    for (int n = 0; n < 2; ++n) acc[a][b][m][n] = (f32x4){0.f, 0.f, 0.f, 0.f};
        cur = nxt; cA = nA; cB = nB; ++ui;
        if constexpr (ALIGN_EPI) { if (wr == 1) PG8_BAR; }
    }
    PG8_WAIT_V(0);
    if constexpr (!ALIGN_EPI) { if (wr == 0) PG8_BAR; }
    PG8_BAR;
#undef PG8_SA
#undef PG8_SB
#undef PG8_STAGE
#undef PG8_LDA
#undef PG8_LDB
#undef PG8_MMA
#undef PG8_WAIT_V
#undef PG8_WAIT_L
#undef PG8_BAR
#undef PG8_SCHED
}
}

#define XB_TMO      128
#define XB_XCNT(j)  (256  + 64 * (j))
#define XB_XSUB(j)  (1280 + 64 * (j))
#define XB_XGEN(j)  (2304 + 64 * (j))
#define XB_TOP      3328
#define XB_TOPGEN   3392
#define XCD_BAR_WORDS 3456
#define XB_SPIN_CAP (1u << 18)
__device__ __forceinline__ unsigned xb_ld(unsigned* p)              { return __hip_atomic_load(p, __ATOMIC_RELAXED, __HIP_MEMORY_SCOPE_AGENT); }
__device__ __forceinline__ unsigned xb_add(unsigned* p, unsigned v) { return __hip_atomic_fetch_add(p, v, __ATOMIC_RELAXED, __HIP_MEMORY_SCOPE_AGENT); }
__device__ __forceinline__ unsigned xb_xcc_id() { return (unsigned)__builtin_amdgcn_s_getreg((3 << 11) | 20) & 0xFu; }
#define XB_SPIN(cond, bar) do { unsigned _sp = 0; while (cond) { __builtin_amdgcn_s_sleep(1); \
    if ((++_sp & 255u) == 0u) { if (xb_ld(&(bar)[XB_TMO])) break; if (_sp > XB_SPIN_CAP) { atomicAdd(&(bar)[XB_TMO], 1u); break; } } } } while (0)
struct XcdBarrier { unsigned* bar; unsigned x; volatile LAS unsigned* st; };
__device__ __forceinline__ XcdBarrier xcd_barrier_post(unsigned* bar, volatile LAS unsigned* st) {
    XcdBarrier b; b.bar = bar; b.x = xb_xcc_id(); b.st = st;
    if (threadIdx.x == 0) (void)xb_add(&bar[XB_XCNT(b.x)], 1u);
    return b;
}
__device__ __forceinline__ void xcd_barrier_complete(unsigned* bar, unsigned x, unsigned& nloc, unsigned& nx) {
    const unsigned G = gridDim.x * gridDim.y * gridDim.z;
    unsigned sum, cnt, mine, sp = 0u;
    for (;;) {
        sum = 0u; cnt = 0u; mine = 0u;
#pragma unroll
        for (unsigned j = 0; j < 16; ++j) { const unsigned c = xb_ld(&bar[XB_XCNT(j)]); sum += c; cnt += (c > 0u) ? 1u : 0u; mine = (j == x) ? c : mine; }
        if (sum == G) break;
        __builtin_amdgcn_s_sleep(1);
        if ((++sp & 255u) == 0u) { if (xb_ld(&bar[XB_TMO])) break; if (sp > XB_SPIN_CAP) { atomicAdd(&bar[XB_TMO], 1u); break; } }
    }
    nloc = mine > 0u ? mine : 1u; nx = cnt > 0u ? cnt : 1u;
}
__device__ __forceinline__ void xcd_barrier(const XcdBarrier& b) {
    asm volatile("s_waitcnt vmcnt(0)" ::: "memory");
    __syncthreads();
    if (threadIdx.x == 0) {
        unsigned* bar = b.bar;
        __builtin_amdgcn_s_waitcnt(0);
        unsigned nloc = b.st[0], nx = b.st[1];
        if (nloc == 0u) { xcd_barrier_complete(bar, b.x, nloc, nx); b.st[0] = nloc; b.st[1] = nx; }
        const unsigned old = xb_add(&bar[XB_XSUB(b.x)], 1u);
        const unsigned gen = old / nloc;
        if (old + 1u == (gen + 1u) * nloc) {
            __builtin_amdgcn_fence(__ATOMIC_RELEASE, "agent");
            asm volatile("s_waitcnt vmcnt(0)" ::: "memory");
            const unsigned og = xb_add(&bar[XB_TOP], 1u);
            const unsigned tg = og / nx;
            if (og + 1u == (tg + 1u) * nx) xb_add(&bar[XB_TOPGEN], 1u);
            else XB_SPIN(xb_ld(&bar[XB_TOPGEN]) == tg, bar);
            __builtin_amdgcn_fence(__ATOMIC_ACQUIRE, "agent");
            xb_add(&bar[XB_XGEN(b.x)], 1u);
            asm volatile("s_waitcnt vmcnt(0)" ::: "memory");
        } else {
            XB_SPIN(xb_ld(&bar[XB_XGEN(b.x)]) == gen, bar);
            __builtin_amdgcn_fence(__ATOMIC_ACQUIRE, "agent");
            asm volatile("s_waitcnt vmcnt(0)" ::: "memory");
        }
    }
    __syncthreads();
}

struct Args { const float* in[23]; float* out; unsigned char* ws; int ph_lo, ph_hi; };
struct Ctx {
    LAS unsigned char* lds;
    int tid, lane, wave, G, bid;
    const float *x, *c, *w_mod, *b_mod, *g_norms, *w_in, *cmp_pos, *cmp_w1, *cmp_b1, *cmp_w2, *cmp_b2, *rel_table, *ln_g, *ln_b, *sgu_w, *sgu_b,
                *w_pn, *w_ps, *w_out, *w_up, *conv_w, *conv_b, *w_dn;
    float* out; unsigned char* ws;
    float *mod, *posw1, *gates, *ysc, *AH, *AT; f16 *Y1, *Y2, *X1H, *W2T, *SGUW, *WG, *KC, *VCT, *W1T, *WUP, *WDN, *WIN, *WVT, *WM, *WO, *H, *Q, *KV, *VT, *Z, *GA, *GB, *YAB, *H2, *ACT;
};

__device__ __forceinline__ void p0_mod_item(Ctx& C, int item) {
    LAS float* sc = (LAS float*)C.lds;
    LAS float* red = (LAS float*)(C.lds + 32768);
    for (int i = C.tid; i < 2 * D; i += NTHREADS) sc[i] = fsilu(C.c[i]);
    __syncthreads();
    const int cq = C.tid & 31, kg = C.tid >> 5, n0 = item * 128 + 4 * cq;
    f32x4 a0 = {0.f, 0.f, 0.f, 0.f}, a1 = {0.f, 0.f, 0.f, 0.f};
    const float* wp = C.w_mod + (size_t)(kg * 256) * NMOD + n0;
#pragma unroll 8
    for (int i = 0; i < 256; ++i) { const f32x4 w = *(const f32x4*)(wp + (size_t)i * NMOD); const float s0 = sc[kg * 256 + i], s1 = sc[D + kg * 256 + i]; a0 += w * s0; a1 += w * s1; }
    *(LAS f32x4*)(red + (kg * 2 + 0) * 128 + 4 * cq) = a0; *(LAS f32x4*)(red + (kg * 2 + 1) * 128 + 4 * cq) = a1;
    __syncthreads();
    if (C.tid < 256) { const int b = C.tid >> 7, col = C.tid & 127; float s = 0.f;
#pragma unroll
        for (int k = 0; k < 16; ++k) s += red[(k * 2 + b) * 128 + col];
        C.mod[b * NMOD + item * 128 + col] = s + C.b_mod[item * 128 + col]; }
    __syncthreads();
}
__device__ __forceinline__ void p0_posw1_item(Ctx& C, int item) {
    LAS float* red = (LAS float*)C.lds;
    const int kk = item >> 2, j = (item & 3) * 64 + C.lane; float s = 0.f;
    const float* w = C.cmp_w1 + (size_t)kk * 4096 * 256 + j; const float* pp = C.cmp_pos + kk * 4096;
    for (int k = C.wave * 512; k < C.wave * 512 + 512; ++k) s += pp[k] * w[(size_t)k * 256];
    red[C.wave * 64 + C.lane] = s;
    __syncthreads();
    if (C.wave == 0) { float t = 0.f;
#pragma unroll
        for (int k = 0; k < 8; ++k) t += red[k * 64 + C.lane];
        C.posw1[kk * 256 + j] = t + C.cmp_b1[kk * 256 + j]; }
    __syncthreads();
}
__device__ __forceinline__ f16* win_row(Ctx& C, int n) {
    if (n < 3584) return C.WIN + (size_t)n * D;
    if (n < 4096) return C.WVT + (size_t)(n - 3584) * D;
    if (n < 4608) return C.WIN + (size_t)(n - 512) * D;
    if (n < 5120) return C.WVT + (size_t)(n - 4608 + 512) * D;
    if (n < 5168) return C.WG + (size_t)(n - 5120) * D;
    return C.WIN + (size_t)(n - 5168 + 4096) * D;
}
__device__ __forceinline__ void p0_transpose_item(Ctx& C, int mat, const float* src, int N, int kb, int nb, LAS float* scr) {
    const int lane = C.lane, k0 = kb * 64, n0 = nb * 64, r4 = lane >> 4, c4 = (lane & 15) * 4; const bool ok = n0 + c4 < N;
    const float* sp = src + (size_t)(k0 + r4) * N + (ok ? n0 + c4 : 0);
#pragma unroll
    for (int i = 0; i < 16; ++i) { const f32x4 v = ok ? *(const f32x4*)(sp + (size_t)(4 * i) * N) : (f32x4){0.f, 0.f, 0.f, 0.f};
        LAS float* d = scr + (4 * i + r4) * 65 + c4; d[0] = v.x; d[1] = v.y; d[2] = v.z; d[3] = v.w; }
    LDS_WAIT();
    const int c = lane & 7;
#pragma unroll
    for (int j = 0; j < 8; ++j) { const int nn = (lane >> 3) + 8 * j, ng = n0 + nn;
        if (ng < N) { const LAS float* s = scr + (8 * c) * 65 + nn;
            u32x4 o;
            if ((FFN_BF16 && (mat == 4 || mat == 5)) || (MIX_BF16 && (mat == 1 || mat == 2 || mat == 3))) { o.x = pkb(s[0], s[65]); o.y = pkb(s[2 * 65], s[3 * 65]); o.z = pkb(s[4 * 65], s[5 * 65]); o.w = pkb(s[6 * 65], s[7 * 65]); }
            else { o.x = pkh(s[0], s[65]); o.y = pkh(s[2 * 65], s[3 * 65]); o.z = pkh(s[4 * 65], s[5 * 65]); o.w = pkh(s[6 * 65], s[7 * 65]); }
            f16* rowp;
            if (mat == 0) rowp = win_row(C, ng);
            else if (mat == 1) rowp = C.WM + (size_t)ng * D;
            else if (mat == 2) rowp = C.WM + (size_t)ng * D + 2048;
            else if (mat == 3) rowp = C.WO + (size_t)ng * D;
            else if (mat == 4) { const int isup = ng >= DFF ? 1 : 0, cc = ng - isup * DFF; rowp = C.WUP + (size_t)((cc >> 7) * 256 + isup * 128 + (cc & 127)) * D; }
            else if (mat == 5) rowp = C.WDN + (size_t)ng * DFF;
            else if (mat == 6) rowp = C.W1T + (size_t)ng * D;
            else rowp = C.W1T + (size_t)(256 + ng) * D;
            *(u32x4*)(rowp + k0 + 8 * c) = o; } }
    LDS_WAIT();
}
__device__ __forceinline__ void p0_prologue(Ctx& C) {
    for (int it = C.bid; it < 200; it += C.G) { if (it < 192) p0_mod_item(C, it); else p0_posw1_item(C, it - 192); }
    const int gw = C.bid * NWAVES + C.wave, NGW = C.G * NWAVES;
    LAS float* scr = (LAS float*)(C.lds + C.wave * 16640);
    constexpr int I0 = 64 * 273, I1 = 32 * 64, I3 = 64 * 64, I4 = 64 * 344, I5 = 172 * 64, I6 = 64 * 4;
    constexpr int NIT = I0 + 2 * I1 + I3 + I4 + I5 + 2 * I6;
    for (int it = gw; it < NIT; it += NGW) {
        int r = it;
        if (r < I0) { p0_transpose_item(C, 0, C.w_in, IN_W, r / 273, r % 273, scr); continue; } r -= I0;
        if (r < I1) { p0_transpose_item(C, 1, C.w_pn, D, r / 64, r % 64, scr); continue; } r -= I1;
        if (r < I1) { p0_transpose_item(C, 2, C.w_ps, D, r / 64, r % 64, scr); continue; } r -= I1;
        if (r < I3) { p0_transpose_item(C, 3, C.w_out, D, r / 64, r % 64, scr); continue; } r -= I3;
        if (r < I4) { p0_transpose_item(C, 4, C.w_up, NUP, r / 344, r % 344, scr); continue; } r -= I4;
        if (r < I5) { p0_transpose_item(C, 5, C.w_dn, D, r / 64, r % 64, scr); continue; } r -= I5;
        if (r < I6) { p0_transpose_item(C, 6, C.cmp_w1, 256, r / 4, r % 4, scr); continue; } r -= I6;
        p0_transpose_item(C, 7, C.cmp_w1 + (size_t)4096 * 256, 256, r / 4, r % 4, scr);
    }
    const int gt = C.bid * NTHREADS + C.tid, NGT = C.G * NTHREADS;
    for (int i = gt; i < 16 * 128 * 128; i += NGT) { const int s = i & 127, t = (i >> 7) & 127; C.SGUW[i] = (f16)(s <= t ? C.sgu_w[i] : 0.f); }
    for (int i = gt; i < 2 * 128 * 256; i += NGT) { const int j = i & 255, d = (i >> 8) & 127, kk = i >> 15; C.W2T[i] = (f16)C.cmp_w2[(size_t)kk * 256 * 128 + j * 128 + d]; }
    for (int i = gt; i < 16 * D; i += NGT) C.WG[48 * D + i] = (f16)0.f;
    __syncthreads();
}

__device__ __forceinline__ void p1_norm(Ctx& C) {
    const int gw = C.bid * NWAVES + C.wave, NGW = C.G * NWAVES, lane = C.lane;
    for (int row = gw; row < M; row += NGW) {
        const int b = row >> 13; const f32x4* xr = (const f32x4*)(C.x + (size_t)row * D);
        f32x4 v[16]; float ss = 0.f;
#pragma unroll
        for (int j = 0; j < 16; ++j) { v[j] = xr[lane + 64 * j]; ss += (v[j].x * v[j].x + v[j].y * v[j].y) + (v[j].z * v[j].z + v[j].w * v[j].w); }
        const float rs = 1.0f / sqrtf(wave_sum(ss) * (1.0f / D) + EPS);
        const f32x4* g4 = (const f32x4*)(C.g_norms); const f32x4* sh = (const f32x4*)(C.mod + b * NMOD); const f32x4* sc = (const f32x4*)(C.mod + b * NMOD + D);
        u32x2* o = (u32x2*)(C.H + (size_t)row * D);
#pragma unroll
        for (int j = 0; j < 16; ++j) { const int k = lane + 64 * j; const f32x4 h = v[j] * rs * g4[k] * (sc[k] + 1.0f) + sh[k]; u32x2 w; w.x = pkh(h.x, h.y); w.y = pkh(h.z, h.w); o[k] = w; }
    }
}
__device__ __forceinline__ void p1_quant_wup(Ctx& C) {
    const int gw = C.bid * NWAVES + C.wave, NGW = C.G * NWAVES, lane = C.lane;
    for (int row = gw; row < NUP; row += NGW) {
        const u32x4* wr = (const u32x4*)(C.WUP + (size_t)row * D);
        float v[64]; float amax = 0.f;
#pragma unroll
        for (int j = 0; j < 8; ++j) { const u32x4 wv = wr[lane + 64 * j];
#pragma unroll
            for (int e = 0; e < 4; ++e) { const unsigned wd = wv[e]; float lo, hi;
                if (FFN_BF16) { lo = __builtin_bit_cast(float, wd << 16); hi = __builtin_bit_cast(float, wd & 0xffff0000u); }
                else { const hx2 hv = __builtin_bit_cast(hx2, wd); lo = (float)hv.x; hi = (float)hv.y; }
                v[8 * j + 2 * e] = lo; v[8 * j + 2 * e + 1] = hi; amax = fmaxf(amax, fmaxf(fabsf(lo), fabsf(hi))); } }
        amax = fmaxf(wave_max(amax), 1e-30f);
        const float qs = 127.0f / amax;
        if (lane == 0) ((float*)(C.ws + WS_SW))[row] = amax * (1.0f / 127.0f);
        u32x2* o = (u32x2*)(((signed char*)(C.ws + WS_WUPQ)) + (size_t)row * D);
#pragma unroll
        for (int j = 0; j < 8; ++j) { u32x2 w; w.x = pk_i8(v[8 * j] * qs, v[8 * j + 1] * qs, v[8 * j + 2] * qs, v[8 * j + 3] * qs); w.y = pk_i8(v[8 * j + 4] * qs, v[8 * j + 5] * qs, v[8 * j + 6] * qs, v[8 * j + 7] * qs); o[lane + 64 * j] = w; }
    }
}
__device__ __forceinline__ void p7_norm(Ctx& C) {
    const int gw = C.bid * NWAVES + C.wave, NGW = C.G * NWAVES, lane = C.lane;
    for (int row = gw; row < M; row += NGW) {
        const int b = row >> 13; const hx8* yr = (const hx8*)(C.Y1 + (size_t)row * D); const f32x4* xr = (const f32x4*)(C.x + (size_t)row * D); u32x2* orow = (u32x2*)(C.X1H + (size_t)row * D);
        f32x4 v[16]; float ss = 0.f;
#pragma unroll
        for (int j = 0; j < 8; ++j) { const hx8 hv = yr[lane + 64 * j];
            v[2 * j] = (f32x4){(float)hv[0], (float)hv[1], (float)hv[2], (float)hv[3]}; v[2 * j + 1] = (f32x4){(float)hv[4], (float)hv[5], (float)hv[6], (float)hv[7]}; }
#pragma unroll
        for (int j = 0; j < 16; ++j) ss += (v[j].x * v[j].x + v[j].y * v[j].y) + (v[j].z * v[j].z + v[j].w * v[j].w);
        const float rs = 1.0f / sqrtf(wave_sum(ss) * (1.0f / D) + EPS);
        const f32x4* g1 = (const f32x4*)(C.g_norms + D); const f32x4* gt = (const f32x4*)(C.mod + b * NMOD + 2 * D);
        float s2 = 0.f;
#pragma unroll
        for (int j = 0; j < 16; ++j) { const int k = 2 * (lane + 64 * (j >> 1)) + (j & 1); v[j] = xr[k] + gt[k] * (v[j] * rs * g1[k]); { u32x2 xw; xw.x = pkh(v[j].x, v[j].y); xw.y = pkh(v[j].z, v[j].w); orow[k] = xw; } s2 += (v[j].x * v[j].x + v[j].y * v[j].y) + (v[j].z * v[j].z + v[j].w * v[j].w); }
        const float rs2 = 1.0f / sqrtf(wave_sum(s2) * (1.0f / D) + EPS);
        const f32x4* g2 = (const f32x4*)(C.g_norms + 2 * D); const f32x4* sh = (const f32x4*)(C.mod + b * NMOD + 3 * D); const f32x4* sc = (const f32x4*)(C.mod + b * NMOD + 4 * D);
        float amax = 0.f;
#pragma unroll
        for (int j = 0; j < 16; ++j) { const int k = 2 * (lane + 64 * (j >> 1)) + (j & 1); v[j] = v[j] * rs2 * g2[k] * (sc[k] + 1.0f) + sh[k];
            amax = fmaxf(amax, fmaxf(fmaxf(fabsf(v[j].x), fabsf(v[j].y)), fmaxf(fabsf(v[j].z), fabsf(v[j].w)))); }
        amax = fmaxf(wave_max(amax), 1e-20f);
        const float qs = 127.0f / amax;
        const bool halo = (row & 255) >= 254; const int hrow = M + 2 * (row >> 8) + (row & 1);
        if (lane == 0) { ((float*)(C.ws + WS_SA))[row] = amax * (1.0f / 127.0f); if (halo) ((float*)(C.ws + WS_SA))[hrow] = amax * (1.0f / 127.0f); }
        u32x2* o = (u32x2*)(((signed char*)(C.ws + WS_H2)) + (size_t)row * D); u32x2* oh = (u32x2*)(((signed char*)(C.ws + WS_H2)) + (size_t)hrow * D);
#pragma unroll
        for (int j = 0; j < 8; ++j) { u32x2 w; w.x = pk_i8(v[2 * j].x * qs, v[2 * j].y * qs, v[2 * j].z * qs, v[2 * j].w * qs); w.y = pk_i8(v[2 * j + 1].x * qs, v[2 * j + 1].y * qs, v[2 * j + 1].z * qs, v[2 * j + 1].w * qs);
            o[lane + 64 * j] = w; if (halo) oh[lane + 64 * j] = w; }
    }
}
__device__ __forceinline__ void p11_final(Ctx& C) {
    const int gw = C.bid * NWAVES + C.wave, NGW = C.G * NWAVES, lane = C.lane;
    for (int row = gw; row < M; row += NGW) {
        const int b = row >> 13; f32x4* orow = (f32x4*)(C.out + (size_t)row * D); const hx8* yr = (const hx8*)(C.Y2 + (size_t)row * D); const hx8* xr = (const hx8*)(C.X1H + (size_t)row * D);
        f32x4 v[16]; float ss = 0.f;
#pragma unroll
        for (int j = 0; j < 8; ++j) { const hx8 hv = yr[lane + 64 * j];
            v[2 * j] = (f32x4){(float)hv[0], (float)hv[1], (float)hv[2], (float)hv[3]}; v[2 * j + 1] = (f32x4){(float)hv[4], (float)hv[5], (float)hv[6], (float)hv[7]}; }
#pragma unroll
        for (int j = 0; j < 16; ++j) ss += (v[j].x * v[j].x + v[j].y * v[j].y) + (v[j].z * v[j].z + v[j].w * v[j].w);
        const float rs = 1.0f / sqrtf(wave_sum(ss) * (1.0f / D) + EPS);
        const f32x4* g3 = (const f32x4*)(C.g_norms + 3 * D); const f32x4* gt = (const f32x4*)(C.mod + b * NMOD + 5 * D);
#pragma unroll
        for (int j = 0; j < 8; ++j) { const hx8 xv = xr[lane + 64 * j]; const int k = 2 * (lane + 64 * j);
            const f32x4 x0 = {(float)xv[0], (float)xv[1], (float)xv[2], (float)xv[3]}, x1 = {(float)xv[4], (float)xv[5], (float)xv[6], (float)xv[7]};
            orow[k] = x0 + gt[k] * (v[2 * j] * rs * g3[k]); orow[k + 1] = x1 + gt[k + 1] * (v[2 * j + 1] * rs * g3[k + 1]); }
    }
}

__device__ __forceinline__ void p3_gates_item(Ctx& C, int item) {
    const int lane = C.lane, w = C.wave, qr = lane & 15, q = lane >> 4, mt = w & 3, kh = w >> 2;
    const f16* ap = C.H + (size_t)(item * 64 + mt * 16 + qr) * D + kh * 2048 + 8 * q;
    const f16* bp = C.WG + (size_t)qr * D + kh * 2048 + 8 * q;
    f32x4 acc[3] = {{0.f, 0.f, 0.f, 0.f}, {0.f, 0.f, 0.f, 0.f}, {0.f, 0.f, 0.f, 0.f}};
#pragma unroll 16
    for (int ks = 0; ks < 64; ++ks) { const hx8 a = *(const hx8*)(ap + 32 * ks);
#pragma unroll
        for (int nt = 0; nt < 3; ++nt) { const hx8 b = *(const hx8*)(bp + (size_t)nt * 16 * D + 32 * ks); acc[nt] = __builtin_amdgcn_mfma_f32_16x16x32_f16(a, b, acc[nt], 0, 0, 0); } }
    LAS f32x4* red = (LAS f32x4*)C.lds;
    if (kh == 1) {
#pragma unroll
        for (int nt = 0; nt < 3; ++nt) red[(mt * 3 + nt) * 64 + lane] = acc[nt]; }
    __syncthreads();
    if (kh == 0) {
#pragma unroll
        for (int nt = 0; nt < 3; ++nt) { const f32x4 s = acc[nt] + red[(mt * 3 + nt) * 64 + lane];
#pragma unroll
            for (int i = 0; i < 4; ++i) C.gates[(size_t)(item * 64 + mt * 16 + 4 * q + i) * 48 + nt * 16 + qr] = fsigmoid(s[i]); } }
    __syncthreads();
}
__device__ __forceinline__ void p3_compress_item(Ctx& C, int item) {
    const int lane = C.lane, w = C.wave, qr = lane & 15, q = lane >> 4, kk = item >> 7, R0 = (item & 127) * 32;
    LAS f16* hid = (LAS f16*)C.lds;
    LAS unsigned char* abuf = C.lds + 20480;
    const int srow = C.tid >> 4, sseg = C.tid & 15;
    const f16* sp;
    { const int R = R0 + srow, b = R >> 11, g = (R >> 9) & 3, n = R & 511, nc = n > 510 ? 510 : n; sp = C.KV + (size_t)(b * T + 16 * nc) * 2048 + kk * 512 + g * 128 + 8 * sseg; }
    const int sdst = (srow * 16 + (sseg ^ (srow & 15))) * 16;
    const f16* pb0 = C.W1T + (size_t)(kk * 256 + 32 * w + qr) * D + 8 * q; const f16* pb1 = pb0 + (size_t)16 * D;
    f32x4 acc[2][2] = {{{0.f, 0.f, 0.f, 0.f}, {0.f, 0.f, 0.f, 0.f}}, {{0.f, 0.f, 0.f, 0.f}, {0.f, 0.f, 0.f, 0.f}}};
    hx8 fb[2][8]; hx8 nxt = *(const hx8*)sp; sp += 2048;
#define CM_LOADB(buf) do { _Pragma("unroll") for (int k4 = 0; k4 < 4; ++k4) { fb[buf][2 * k4] = *(const hx8*)(pb0 + 32 * k4); fb[buf][2 * k4 + 1] = *(const hx8*)(pb1 + 32 * k4); } pb0 += 128; pb1 += 128; } while (0)
#define CM_STEP(c, buf) do { *(LAS hx8*)(abuf + ((c) & 1) * 8192 + sdst) = nxt; \
        if ((c) + 1 < 32) { nxt = *(const hx8*)sp; sp += 2048; CM_LOADB((buf) ^ 1); } \
        __syncthreads(); \
        hx8 af_[8]; _Pragma("unroll") for (int i_ = 0; i_ < 8; ++i_) { const int mt_ = i_ >> 2, k4_ = i_ & 3; af_[i_] = *(const LAS hx8*)(abuf + ((c) & 1) * 8192 + ((16 * mt_ + qr) * 16 + ((4 * k4_ + q) ^ qr)) * 16); } \
        _Pragma("unroll") for (int k4 = 0; k4 < 4; ++k4) { \
            acc[0][0] = __builtin_amdgcn_mfma_f32_16x16x32_f16(af_[k4], fb[buf][2 * k4], acc[0][0], 0, 0, 0); acc[0][1] = __builtin_amdgcn_mfma_f32_16x16x32_f16(af_[k4], fb[buf][2 * k4 + 1], acc[0][1], 0, 0, 0); \
            acc[1][0] = __builtin_amdgcn_mfma_f32_16x16x32_f16(af_[4 + k4], fb[buf][2 * k4], acc[1][0], 0, 0, 0); acc[1][1] = __builtin_amdgcn_mfma_f32_16x16x32_f16(af_[4 + k4], fb[buf][2 * k4 + 1], acc[1][1], 0, 0, 0); } } while (0)
    CM_LOADB(0);
#pragma unroll 1
    for (int c = 0; c < 32; c += 2) { CM_STEP(c, 0); CM_STEP(c + 1, 1); }
#undef CM_LOADB
#undef CM_STEP
    __syncthreads();
#pragma unroll
    for (int mt = 0; mt < 2; ++mt)
#pragma unroll
        for (int nt = 0; nt < 2; ++nt) { const int j = 32 * w + 16 * nt + qr; const float pb = C.posw1[kk * 256 + j];
#pragma unroll
            for (int i = 0; i < 4; ++i) hid[(16 * mt + 4 * q + i) * 264 + j] = (f16)fgelu(acc[mt][nt][i] + pb); }
    __syncthreads();
    const f16* wp = C.W2T + (size_t)(kk * 128 + 16 * w + qr) * 256 + 8 * q;
    f32x4 o2[2] = {{0.f, 0.f, 0.f, 0.f}, {0.f, 0.f, 0.f, 0.f}};
#pragma unroll
    for (int ks = 0; ks < 8; ++ks) { const hx8 wf = *(const hx8*)(wp + 32 * ks);
#pragma unroll
        for (int mt = 0; mt < 2; ++mt) { const hx8 hf = *(const LAS hx8*)(hid + (16 * mt + qr) * 264 + 32 * ks + 8 * q);
            if (kk == 0) o2[mt] = __builtin_amdgcn_mfma_f32_16x16x32_f16(wf, hf, o2[mt], 0, 0, 0);
            else o2[mt] = __builtin_amdgcn_mfma_f32_16x16x32_f16(hf, wf, o2[mt], 0, 0, 0); } }
    if (kk == 0) {
#pragma unroll
        for (int mt = 0; mt < 2; ++mt) { const int R = R0 + 16 * mt + qr, n = R & 511, d0 = 16 * w + 4 * q; const bool pad = n == 511;
            float v[4];
#pragma unroll
            for (int i = 0; i < 4; ++i) v[i] = pad ? 0.f : o2[mt][i] + C.cmp_b2[d0 + i];
            u32x2 o; o.x = pkh(v[0], v[1]); o.y = pkh(v[2], v[3]); *(u32x2*)(C.KC + (size_t)R * 128 + d0) = o; }
    } else {
#pragma unroll
        for (int mt = 0; mt < 2; ++mt) { const int Rb = R0 + 16 * mt + 4 * q, bg = Rb >> 9, n0 = Rb & 511, d = 16 * w + qr; const float bb = C.cmp_b2[128 + d];
            float v[4];
#pragma unroll
            for (int i = 0; i < 4; ++i) v[i] = (n0 + i == 511) ? 0.f : o2[mt][i] + bb;
            u32x2 o; o.x = pkh(v[0], v[1]); o.y = pkh(v[2], v[3]); *(u32x2*)(C.VCT + ((size_t)bg * 128 + d) * 512 + n0) = o; }
    }
    __syncthreads();
}
__device__ __forceinline__ void p3_sgu_item(Ctx& C, int item) {
    const int lane = C.lane, w = C.wave, tid = C.tid, qr = lane & 15, q = lane >> 4, r0 = (item >> 1) * 128, half = item & 1;
    LAS float* stats = (LAS float*)C.lds;
    LAS f16* vt = (LAS f16*)(C.lds + 1024);
#pragma unroll 4
    for (int tk = 0; tk < 16; ++tk) { const int s = 16 * w + tk; const f16* vp = C.Z + (size_t)(r0 + s) * D + 2048 + 8 * lane;
        float xv[32]; float sum = 0.f;
#pragma unroll
        for (int jj = 0; jj < 4; ++jj) { const hx8 h = *(const hx8*)(vp + 512 * jj);
#pragma unroll
            for (int e = 0; e < 8; ++e) { xv[8 * jj + e] = (float)h[e]; sum += xv[8 * jj + e]; } }
        const float mu = wave_sum(sum) * (1.0f / 2048.0f); float sq = 0.f;
#pragma unroll
        for (int e = 0; e < 32; ++e) { const float dv = xv[e] - mu; sq += dv * dv; }
        const float var = wave_sum(sq) * (1.0f / 2048.0f);
        if (lane == 0) { stats[2 * s] = mu; stats[2 * s + 1] = 1.0f / sqrtf(var + EPS); } }
    __syncthreads();
    for (int gi = 0; gi < 8; ++gi) { const int hh = half * 8 + gi;
        { const int s = tid >> 2, seg = tid & 3; const float mu = stats[2 * s], rstd = stats[2 * s + 1];
          const f16* vp = C.Z + (size_t)(r0 + s) * D + 2048 + hh * 128 + 32 * seg;
#pragma unroll
          for (int i = 0; i < 4; ++i) { const hx8 h = *(const hx8*)(vp + 8 * i);
#pragma unroll
              for (int e = 0; e < 8; ++e) { const int d = 32 * seg + 8 * i + e; const float y = ((float)h[e] - mu) * rstd * C.ln_g[hh * 128 + d] + C.ln_b[hh * 128 + d]; vt[d * 136 + s] = (f16)y; } } }
        __syncthreads();
        hx8 wf[4];
#pragma unroll
        for (int ks = 0; ks < 4; ++ks) wf[ks] = *(const hx8*)(C.SGUW + ((size_t)(hh * 128 + 16 * w + qr)) * 128 + 32 * ks + 8 * q);
        f32x4 acc[8];
#pragma unroll
        for (int dt = 0; dt < 8; ++dt) { acc[dt] = (f32x4){0.f, 0.f, 0.f, 0.f};
#pragma unroll
            for (int ks = 0; ks < 4; ++ks) { const hx8 af = *(const LAS hx8*)(vt + (16 * dt + qr) * 136 + 32 * ks + 8 * q); acc[dt] = __builtin_amdgcn_mfma_f32_16x16x32_f16(af, wf[ks], acc[dt], 0, 0, 0); } }
        { const int tl = 16 * w + qr; const float bs = C.sgu_b[hh * 128 + tl];
          const f16* up = C.Z + (size_t)(r0 + tl) * D + hh * 128 + 4 * q; f16* yp = C.YAB + (size_t)(r0 + tl) * D + 2048 + hh * 128 + 4 * q;
#pragma unroll
          for (int dt = 0; dt < 8; ++dt) { const hx4 u = *(const hx4*)(up + 16 * dt);
              u32x2 o; o.x = pk_mix((float)u[0] * (acc[dt][0] + bs), (float)u[1] * (acc[dt][1] + bs)); o.y = pk_mix((float)u[2] * (acc[dt][2] + bs), (float)u[3] * (acc[dt][3] + bs));
              *(u32x2*)(yp + 16 * dt) = o; } }
        __syncthreads();
    }
}

constexpr int ATT_LUT = 0, ATT_IMP = 8192, ATT_STG = 40960, STG_BYTES = 32768, STG_V = 16384;
static_assert(ATT_STG + 3 * STG_BYTES <= MISC_OFF, "attention LDS map");
__device__ __forceinline__ int rel_bucket_small(int n) {
    if (n < 16) return n;
    int b = 16;
    b += n >= 19; b += n >= 21; b += n >= 24; b += n >= 27; b += n >= 31; b += n >= 35; b += n >= 40; b += n >= 46; b += n >= 52; b += n >= 59; b += n >= 67; b += n >= 77; b += n >= 87; b += n >= 99; b += n >= 113;
    return b;
}
__device__ __forceinline__ void att_issue(Ctx& C, int s, int n_c, int n_s, int ks0g, int b, int g) {
    const int lane = (int)pg8::opaque((unsigned)C.lane), w = C.wave;
    const f16* kb; const f16* vb; int ldk, ldv, kb0;
    if (s < 2 * n_c) { kb0 = 64 * (s < n_c ? s : s - n_c); kb = C.KC + (size_t)(b * 4 + g) * 512 * 128; ldk = 128; vb = C.VCT + (size_t)(b * 4 + g) * 128 * 512; ldv = 512; }
    else if (s < 2 * n_c + n_s) { kb0 = 64 * (s - 2 * n_c); kb = C.KV + (size_t)b * T * 2048 + 1024 + g * 128; ldk = 2048; vb = C.VT + (size_t)(g * 128) * M + (size_t)b * T; ldv = M; }
    else { kb0 = ks0g + 64 * (s - 2 * n_c - n_s); kb = C.KV + (size_t)b * T * 2048 + 1536 + g * 128; ldk = 2048; vb = C.VT + (size_t)(512 + g * 128) * M + (size_t)b * T; ldv = M; }
    LAS unsigned char* buf = C.lds + ATT_STG + (s % 3) * STG_BYTES;
#pragma unroll
    for (int i = 0; i < 2; ++i) { const int R = 8 * w + 4 * i + (lane >> 4), m = R & 15, key = kb0 + 32 * (R >> 5) + (m >> 2) * 8 + (m & 3) + 4 * ((R >> 4) & 1), cidx = (lane & 15) ^ m;
        __builtin_amdgcn_global_load_lds((const unsigned*)(kb + (size_t)key * ldk + cidx * 8), (LAS unsigned*)(buf + (8 * w + 4 * i) * 256), 16, 0, 0); }
#pragma unroll
    for (int i = 0; i < 2; ++i) { const int dr = 16 * w + 8 * i + (lane >> 3), v = (lane & 7) ^ ((dr & 15) >> 1);
        __builtin_amdgcn_global_load_lds((const unsigned*)(vb + (size_t)dr * ldv + kb0 + 8 * v), (LAS unsigned*)(buf + STG_V + (16 * w + 8 * i) * 128), 16, 0, 0); }
}
#define SB() __builtin_amdgcn_sched_barrier(0)
#define ATT_QK2(TL) do { _Pragma("unroll") for (int scn_ = 0; scn_ < 2; ++scn_) { hx8 kf_[8]; \
        _Pragma("unroll") for (int i_ = 0; i_ < 8; ++i_) { const int kt_ = i_ >> 2, ks_ = i_ & 3; \
            kf_[i_] = *(const LAS hx8*)(bufp + scn_ * 8192 + kt_ * 4096 + qr * 256 + (((4 * ks_ + q) ^ qr) << 4)); } \
        __builtin_amdgcn_s_setprio(1); \
        _Pragma("unroll") for (int t_ = 0; t_ < 2; ++t_) { f32x4 a_ = {0.f, 0.f, 0.f, 0.f}; \
            _Pragma("unroll") for (int ks = 0; ks < 4; ++ks) a_ = __builtin_amdgcn_mfma_f32_16x16x32_f16(kf_[4 * t_ + ks], qf[TL][ks], a_, 0, 0, 0); sv[2 * scn_ + t_] = a_; } \
        __builtin_amdgcn_s_setprio(0); } } while (0)
#define SVJ(tl, j) (sv[(j) >> 2][(j) & 3])
#define ATT_PV2() do { SB(); \
    _Pragma("unroll") for (int sn_ = 0; sn_ < 2; ++sn_) { hx8 vf_[8]; \
        _Pragma("unroll") for (int dt_ = 0; dt_ < 8; ++dt_) vf_[dt_] = *(const LAS hx8*)(bufp + STG_V + qr * 128 + (((4 * sn_ + q) ^ (qr >> 1)) << 4) + dt_ * 2048); \
        _Pragma("unroll") for (int tl_ = 0; tl_ < 2; ++tl_) { if (act[tl_]) { _Pragma("unroll") for (int dt = 0; dt < 8; ++dt) o[tl_][dt] = __builtin_amdgcn_mfma_f32_16x16x32_f16(vf_[dt], pf[tl_][sn_], o[tl_][dt], 0, 0, 0); } } } \
    SB(); } while (0)
#define ATT_MAXUPD(TL, RESCALE_O) do { if (__any(cm_ > m[TL] + 8.0f)) { cm_ = fmaxf(cm_, __shfl_xor(cm_, 16)); cm_ = fmaxf(cm_, __shfl_xor(cm_, 32)); \
    const float mn_ = fmaxf(m[TL], cm_); const float al_ = __builtin_amdgcn_exp2f(m[TL] - mn_); m[TL] = mn_; l[TL] *= al_; \
    if (RESCALE_O) { _Pragma("unroll") for (int dt = 0; dt < 8; ++dt) o[TL][dt] *= al_; } } } while (0)
#define ATT_PACKP(TL) do { _Pragma("unroll") for (int j = 0; j < 8; ++j) { pf[TL][0][j] = (f16)p[j]; pf[TL][1][j] = (f16)p[8 + j]; } } while (0)
#define ATT_SOFTMAX_FAR(TL, cb_, RESCALE_O) do { float mx_ = SVJ(TL, 0); _Pragma("unroll") for (int j = 1; j < 16; ++j) mx_ = fmaxf(mx_, SVJ(TL, j)); \
    float cm_ = mx_ * SC2 + (cb_); ATT_MAXUPD(TL, RESCALE_O); const float off_ = (cb_) - m[TL]; float ps_ = 0.f; \
    _Pragma("unroll") for (int j = 0; j < 16; ++j) { const float e_ = __builtin_amdgcn_exp2f(SVJ(TL, j) * SC2 + off_); ps_ += e_; pf[TL][j >> 3][j & 7] = (f16)e_; } l[TL] += ps_; } while (0)
#define ATT_SOFTMAX_NEAR(TL, RESCALE_O) do { float cm_ = sc[0]; _Pragma("unroll") for (int j = 1; j < 16; ++j) cm_ = fmaxf(cm_, sc[j]); \
    ATT_MAXUPD(TL, RESCALE_O); float ps_ = 0.f; \
    _Pragma("unroll") for (int j = 0; j < 16; ++j) { const float e_ = __builtin_amdgcn_exp2f(sc[j] - m[TL]); ps_ += e_; pf[TL][j >> 3][j & 7] = (f16)e_; } l[TL] += ps_; } while (0)
#define ATT_STAGE_BEGIN() do { if (s + 1 < S) asm volatile("s_waitcnt vmcnt(4)" ::: "memory"); else asm volatile("s_waitcnt vmcnt(0)" ::: "memory"); \
    __builtin_amdgcn_s_barrier(); asm volatile("" ::: "memory"); \
    if (s + 2 < S) att_issue(C, s + 2, n_c, n_s, ks0g, b, g); \
    bufp = C.lds + ATT_STG + (s % 3) * STG_BYTES; } while (0)
constexpr float NEGBIG = -3.0e38f;

__device__ __forceinline__ void p4_attn_unit(Ctx& C, int u) {
    const int lane = C.lane, w = C.wave, qr = lane & 15, q = lane >> 4, tok = qr >> 2, r = qr & 3;
    const int bg = u & 7, b = bg >> 2, g = bg & 3, tj = u >> 3, t0g = tj * 64, t0 = t0g + w * 8, h = g * 4 + r;
    const LAS float* lut = (const LAS float*)(C.lds + ATT_LUT) + h * 128;
    LAS float* imp = (LAS float*)(C.lds + ATT_IMP) + w * 1024;
    const LAS unsigned char* bufp = C.lds + ATT_STG;
    const int n_c = (tj >> 4) + 1, n_s = tj + 1, ks0g = (t0g - 511 < 0 ? 0 : t0g - 511) & ~63, n_w = ((t0g + 63 - ks0g) >> 6) + 1, S = 2 * n_c + n_s + n_w;
    hx8 qf[2][4];
#pragma unroll
    for (int tl = 0; tl < 2; ++tl) { const int t = t0 + 4 * tl + tok; const f16* qp = C.Q + (size_t)(b * T + t) * 2048 + h * 128 + 8 * q;
#pragma unroll
        for (int ks = 0; ks < 4; ++ks) qf[tl][ks] = *(const hx8*)(qp + 32 * ks); }
#define GATE(tl, i) (C.gates[(size_t)(b * T + t0 + 4 * (tl) + tok) * 48 + h * 3 + (i)])
#define YSP(tl) ((f32x4*)(C.ysc + (size_t)(b * T + t0 + 4 * (tl) + tok) * 2048 + h * 128 + 4 * q))
    const float b127 = lut[127];
    f32x4 o[2][8], sv[4]; hx8 pf[2][2]; float sc[16], p[16], m[2], l[2]; bool act[2];
#pragma unroll
    for (int tl = 0; tl < 2; ++tl)
#pragma unroll
        for (int dt = 0; dt < 8; ++dt) o[tl][dt] = (f32x4){0.f, 0.f, 0.f, 0.f};
    for (int i = lane; i < 1024; i += 64) imp[i] = 0.f;
    asm volatile("s_waitcnt vmcnt(0) lgkmcnt(0)" ::: "memory");
    __syncthreads();
    int s = 0;
    att_issue(C, 0, n_c, n_s, ks0g, b, g); att_issue(C, 1, n_c, n_s, ks0g, b, g);

    m[0] = m[1] = -1e30f; l[0] = l[1] = 0.f;
    for (int c = 0; c < n_c; ++c, ++s) {
        ATT_STAGE_BEGIN();
        const int kb0 = 64 * c;
        act[0] = kb0 <= ((t0 + 3 - 31) >> 4); act[1] = kb0 <= ((t0 + 7 - 31) >> 4);
        if (!act[1]) continue;
#pragma unroll
        for (int tl = 0; tl < 2; ++tl) { if (act[tl]) { const int tb = t0 + 4 * tl, t = tb + tok, nmax_t = (t - 31) >> 4;
            ATT_QK2(tl);
            if (kb0 + 63 <= ((tb - 31) >> 4) && tb - 16 * (kb0 + 63) - 31 >= 127) { ATT_SOFTMAX_FAR(tl, b127, false); }
            else {
#pragma unroll
                for (int j = 0; j < 16; ++j) { const int n = kb0 + 32 * (j >> 3) + 8 * q + (j & 7), dist = t - 16 * n - 31;
                    const int di = dist < 0 ? 0 : (dist > 127 ? 127 : dist); const float lv = lut[di]; const float sx = SVJ(tl, j) * SC2 + lv; sc[j] = n <= nmax_t ? sx : NEGBIG; }
                ATT_SOFTMAX_NEAR(tl, false); } } }
    }
    float il[2];
#pragma unroll
    for (int tl = 0; tl < 2; ++tl) { l[tl] += __shfl_xor(l[tl], 16); l[tl] += __shfl_xor(l[tl], 32); il[tl] = l[tl] > 0.f ? 1.0f / l[tl] : 0.f; }
    float carry[2] = {0.f, 0.f};
    for (int c = 0; c < n_c; ++c, ++s) {
        ATT_STAGE_BEGIN();
        const int kb0 = 64 * c;
        act[0] = kb0 <= ((t0 + 3 - 31) >> 4); act[1] = kb0 <= ((t0 + 7 - 31) >> 4);
        if (!act[1]) continue;
#pragma unroll
        for (int tl = 0; tl < 2; ++tl) { if (act[tl]) { const int t = t0 + 4 * tl + tok, nmax_t = (t - 31) >> 4;
            ATT_QK2(tl);
#pragma unroll
            for (int j = 0; j < 16; ++j) { const int n = kb0 + 32 * (j >> 3) + 8 * q + (j & 7), dist = t - 16 * n - 31;
                const int di = dist < 0 ? 0 : (dist > 127 ? 127 : dist); const float lv = lut[di]; const float px = __builtin_amdgcn_exp2f(SVJ(tl, j) * SC2 + lv - m[tl]) * il[tl]; p[j] = n <= nmax_t ? px : 0.f; }
            ATT_PACKP(tl);
#pragma unroll
            for (int scn = 0; scn < 2; ++scn) { float ph[8];
#pragma unroll
                for (int j = 0; j < 8; ++j) { float v = p[8 * scn + j]; v += dpp_f<0xB1>(v); v += dpp_f<0x4E>(v); ph[j] = v; }
                const float t7 = __shfl(ph[7], (lane + 48) & 63);
                const float left = q == 0 ? carry[tl] : t7; carry[tl] = t7;
                if (r == 0) { f32x2 iv; iv.x = left + 2.0f * (ph[0] + ph[1] + ph[2]) + ph[3]; iv.y = ph[3] + 2.0f * (ph[4] + ph[5] + ph[6]) + ph[7];
                    *(LAS f32x2*)(imp + (4 * tl + tok) * 128 + ((kb0 + 32 * scn) >> 2) + 2 * q) = iv; } } } }
        ATT_PV2();
    }
#pragma unroll
    for (int tl = 0; tl < 2; ++tl) { f32x4* ysp = YSP(tl); const float gc = GATE(tl, 0);
#pragma unroll
        for (int dt = 0; dt < 8; ++dt) { ysp[4 * dt] = o[tl][dt] * gc; o[tl][dt] = (f32x4){0.f, 0.f, 0.f, 0.f}; } }
    LDS_WAIT();
    unsigned long long my_lo[2] = {0ull, 0ull}, my_hi[2] = {0ull, 0ull}, U_lo[2] = {0ull, 0ull}, U_hi[2] = {0ull, 0ull};
#pragma unroll
    for (int tk = 0; tk < 8; ++tk) { const int tt = t0 + tk, cur = tt >> 6; unsigned long long lo, hi;
        if (cur < 16) { lo = (1ull << (cur + 1)) - 1ull; hi = 0ull; }
        else {
            LAS float* P = imp + tk * 128;
            const int j0 = lane, j1 = lane + 64;
            const bool c0 = j0 >= 1 && j0 <= cur - 2, c1 = j1 <= cur - 2;
            const float i0 = c0 ? P[j0] : -1.0f, i1 = c1 ? P[j1] : -1.0f;
            LDS_WAIT();
            P[j0] = i0; P[j1] = i1;
            LDS_WAIT();
            int r0 = 0, r1 = 0;
            for (int jp = 0; jp <= cur - 2; jp += 4) { const f32x4 v = *(const LAS f32x4*)(P + jp);
#pragma unroll
                for (int e = 0; e < 4; ++e) { r0 += (v[e] > i0 || (v[e] == i0 && jp + e < j0)) ? 1 : 0; r1 += (v[e] > i1 || (v[e] == i1 && jp + e < j1)) ? 1 : 0; } }
            const bool sel0 = (c0 && r0 < 13) || j0 == 0 || j0 == cur || j0 == cur - 1, sel1 = (c1 && r1 < 13) || j1 == cur || j1 == cur - 1;
            lo = __ballot(sel0); hi = __ballot(sel1);
        }
        U_lo[tk >> 2] |= lo; U_hi[tk >> 2] |= hi; if (tok == (tk & 3)) { my_lo[tk >> 2] = lo; my_hi[tk >> 2] = hi; } }
    m[0] = m[1] = -1e30f; l[0] = l[1] = 0.f;
    for (int jb = 0; jb < n_s; ++jb, ++s) {
        ATT_STAGE_BEGIN();
        bool mine[2];
#pragma unroll
        for (int tl = 0; tl < 2; ++tl) { act[tl] = jb < 64 ? ((U_lo[tl] >> jb) & 1ull) : ((U_hi[tl] >> (jb - 64)) & 1ull); mine[tl] = jb < 64 ? ((my_lo[tl] >> jb) & 1ull) : ((my_hi[tl] >> (jb - 64)) & 1ull); }
        if (!act[0] && !act[1]) continue;
        const int kb0 = 64 * jb;
#pragma unroll
        for (int tl = 0; tl < 2; ++tl) { if (act[tl]) { const int tb = t0 + 4 * tl, t = tb + tok;
            ATT_QK2(tl);
            if (tb - (kb0 + 63) >= 127) { const float cb = mine[tl] ? b127 : NEGBIG; ATT_SOFTMAX_FAR(tl, cb, true); }
            else { const int bd = t - kb0 - 8 * q;
#pragma unroll
                for (int j = 0; j < 16; ++j) { const int dist = bd - 32 * (j >> 3) - (j & 7);
                    const int di = dist < 0 ? 0 : (dist > 127 ? 127 : dist); const float lv = lut[di]; const float sx = SVJ(tl, j) * SC2 + lv; sc[j] = (mine[tl] && dist >= 0) ? sx : NEGBIG; }
                ATT_SOFTMAX_NEAR(tl, true); } } }
        ATT_PV2();
    }
#pragma unroll
    for (int tl = 0; tl < 2; ++tl) { l[tl] += __shfl_xor(l[tl], 16); l[tl] += __shfl_xor(l[tl], 32); const float gl = l[tl] > 0.f ? GATE(tl, 1) / l[tl] : 0.f; f32x4* ysp = YSP(tl);
#pragma unroll
        for (int dt = 0; dt < 8; ++dt) { ysp[4 * dt] = ysp[4 * dt] + o[tl][dt] * gl; o[tl][dt] = (f32x4){0.f, 0.f, 0.f, 0.f}; } }
    m[0] = m[1] = -1e30f; l[0] = l[1] = 0.f;
    for (int k = 0; k < n_w; ++k, ++s) {
        ATT_STAGE_BEGIN();
        const int kb0 = ks0g + 64 * k;
#pragma unroll
        for (int tl = 0; tl < 2; ++tl) { const int tb = t0 + 4 * tl; act[tl] = !(kb0 > tb + 3 || kb0 + 63 < tb - 511); }
        if (!act[0] && !act[1]) continue;
#pragma unroll
        for (int tl = 0; tl < 2; ++tl) { if (act[tl]) { const int tb = t0 + 4 * tl, t = tb + tok;
            ATT_QK2(tl);
            if (tb - (kb0 + 63) >= 127 && tb + 3 - kb0 <= 511) { ATT_SOFTMAX_FAR(tl, b127, true); }
            else { const int bd = t - kb0 - 8 * q;
#pragma unroll
                for (int j = 0; j < 16; ++j) { const int dist = bd - 32 * (j >> 3) - (j & 7);
                    const int di = dist < 0 ? 0 : (dist > 127 ? 127 : dist); const float lv = lut[di]; const float sx = SVJ(tl, j) * SC2 + lv; sc[j] = (dist >= 0 && dist < 512) ? sx : NEGBIG; }
                ATT_SOFTMAX_NEAR(tl, true); } } }
        ATT_PV2();
    }
#pragma unroll
    for (int tl = 0; tl < 2; ++tl) { l[tl] += __shfl_xor(l[tl], 16); l[tl] += __shfl_xor(l[tl], 32); const float gl = l[tl] > 0.f ? GATE(tl, 2) / l[tl] : 0.f; const f32x4* ysp = YSP(tl);
        f16* yp = C.YAB + (size_t)(b * T + t0 + 4 * tl + tok) * D + h * 128 + 4 * q;
#pragma unroll
        for (int dt = 0; dt < 8; ++dt) { const f32x4 yv = ysp[4 * dt] + o[tl][dt] * gl; u32x2 ov; ov.x = pk_mix(yv[0], yv[1]); ov.y = pk_mix(yv[2], yv[3]); *(u32x2*)(yp + 16 * dt) = ov; } }
}
#undef GATE
#undef YSP
__device__ __forceinline__ void p4_attention(Ctx& C) {
    LAS float* lut = (LAS float*)(C.lds + ATT_LUT);
    for (int i = C.tid; i < 16 * 128; i += NTHREADS) { const int hh = i >> 7, n = i & 127; lut[i] = C.rel_table[rel_bucket_small(n) * 16 + hh] * LOG2E; }
    __syncthreads();
    for (int u = C.bid; u < 1024; u += C.G) p4_attn_unit(C, u);
    __syncthreads();
}

__device__ __forceinline__ void p9_fixup(Ctx& C) {
    const int gt = C.bid * NTHREADS + C.tid, NGT = C.G * NTHREADS;
    for (int it = gt; it < 64 * (DFF / 8); it += NGT) {
        const int pm = it / (DFF / 8), c0 = (it % (DFF / 8)) * 8; const bool first = ((pm * 256) & (T - 1)) == 0;
        float res[2][8];
#pragma unroll
        for (int h4 = 0; h4 < 2; ++h4) {
            f32x4 cvv[2][2];
#pragma unroll
            for (int bj = 0; bj < 2; ++bj) { const int cc = c0 + 4 * h4;
                const f32x4 w0 = *(const f32x4*)(C.conv_w + 0 * NUP + bj * DFF + cc), w1 = *(const f32x4*)(C.conv_w + 1 * NUP + bj * DFF + cc), w2 = *(const f32x4*)(C.conv_w + 2 * NUP + bj * DFF + cc), bb = *(const f32x4*)(C.conv_b + bj * DFF + cc);
                const f32x4 a0 = *(const f32x4*)(C.AT + (size_t)((pm * 2 + 0) * 2 + bj) * DFF + cc), a1 = *(const f32x4*)(C.AT + (size_t)((pm * 2 + 1) * 2 + bj) * DFF + cc);
                f32x4 hm2 = {0.f, 0.f, 0.f, 0.f}, hm1 = {0.f, 0.f, 0.f, 0.f};
                if (!first) { hm2 = *(const f32x4*)(C.AH + (size_t)((2 * (pm - 1) + 0) * 2 + bj) * DFF + cc); hm1 = *(const f32x4*)(C.AH + (size_t)((2 * (pm - 1) + 1) * 2 + bj) * DFF + cc); }
                cvv[0][bj] = bb + w0 * hm2 + w1 * hm1 + w2 * a0; cvv[1][bj] = bb + w0 * hm1 + w1 * a0 + w2 * a1; }
#pragma unroll
            for (int j = 0; j < 2; ++j)
#pragma unroll
                for (int i = 0; i < 4; ++i) res[j][4 * h4 + i] = fsilu(cvv[j][0][i]) * cvv[j][1][i]; }
#pragma unroll
        for (int j = 0; j < 2; ++j) { u32x4 ov; ov.x = pk_ffn(res[j][0], res[j][1]); ov.y = pk_ffn(res[j][2], res[j][3]); ov.z = pk_ffn(res[j][4], res[j][5]); ov.w = pk_ffn(res[j][6], res[j][7]);
            *(u32x4*)(C.ACT + (size_t)(pm * 256 + j) * DFF + c0) = ov; }
    }
}

__device__ __forceinline__ void ph2_proj(Ctx& C) {
    { pg8::Gemm g{C.H, C.WIN, M, NPROJ, D}; pg8::StaticOrder S; S.init(M, NPROJ, C.G, C.bid);
      pg8::EpiProj E{C.Q, C.KV, C.Z, C.GA, C.GB};
      pg8::gemm_phase<pg8::EpiProj, pg8::StaticOrder>(C.lds, g, S, E); }
    { pg8::Gemm g{C.WVT, C.H, 1024, M, D}; pg8::StaticOrder S; S.init(1024, M, C.G, C.bid);
      pg8::EpiH16 E{C.VT, M};
      pg8::gemm_phase<pg8::EpiH16, pg8::StaticOrder>(C.lds, g, S, E); }
}
__device__ __forceinline__ void ph3_mixers(Ctx& C) {
    for (int it = C.bid; it < 256; it += C.G) p3_gates_item(C, it);
    if constexpr (((PROBE_DUP) >> 12) & 1) { for (int it = C.bid; it < 256; it += C.G) p3_gates_item(C, it); }
    for (int it = C.bid; it < 256; it += C.G) p3_compress_item(C, it);
    if constexpr (((PROBE_DUP) >> 13) & 1) { for (int it = C.bid; it < 256; it += C.G) p3_compress_item(C, it); }
    for (int it = C.bid; it < 256; it += C.G) p3_sgu_item(C, it);
    if constexpr (((PROBE_DUP) >> 14) & 1) { for (int it = C.bid; it < 256; it += C.G) p3_sgu_item(C, it); }
}
__device__ __forceinline__ void ph5_merge(Ctx& C) {
    pg8::Gemm g{C.YAB, C.WM, M, D, D}; pg8::StaticOrder S; S.init(M, D, C.G, C.bid);
    pg8::EpiMerge E{C.GA, C.GB, C.H};
    pg8::gemm_phase<pg8::EpiMerge, pg8::StaticOrder, true, MIX_BF16 ? 1 : 0>(C.lds, g, S, E);
}
__device__ __forceinline__ void ph6_out(Ctx& C) {
    pg8::Gemm g{C.H, C.WO, M, D, D}; pg8::StaticOrder S; S.init(M, D, C.G, C.bid);
    pg8::EpiH16 E{C.Y1, D};
    pg8::gemm_phase<pg8::EpiH16, pg8::StaticOrder, true, MIX_BF16 ? 1 : 0>(C.lds, g, S, E);
}
__device__ __forceinline__ void ph8_up(Ctx& C) {
    pg8::Gemm g{(const f16*)((signed char*)(C.ws + WS_H2)), (const f16*)((signed char*)(C.ws + WS_WUPQ)), M + 256, NUP, D / 2}; pg8::StaticOrder S; S.init(M + 256, NUP, C.G, C.bid);
    pg8::EpiConv E{C.ws, C.conv_w, C.conv_b, (LAS float*)(C.lds + pg8::STAGE_BYTES), FFN_BF16};
    pg8::gemm_phase<pg8::EpiConv, pg8::StaticOrder, true, 2>(C.lds, g, S, E);
}
__device__ __forceinline__ void ph9_conv(Ctx& C) { p9_fixup(C); }
__device__ __forceinline__ void ph10_down(Ctx& C) {
    pg8::Gemm g{C.ACT, C.WDN, M, D, DFF}; pg8::StaticOrder S; S.init(M, D, C.G, C.bid);
    pg8::EpiH16 E{C.Y2, D};
    pg8::gemm_phase<pg8::EpiH16, pg8::StaticOrder, true, FFN_BF16 ? 1 : 0>(C.lds, g, S, E);
}

constexpr int NPHASE = 12;
__global__ void __launch_bounds__(NTHREADS, 2) fwd_kernel(Args args) {
    extern __shared__ __attribute__((aligned(16))) unsigned char lds_raw[];
    Ctx C;
    C.lds = (LAS unsigned char*)lds_raw;
    C.tid = threadIdx.x; C.lane = C.tid & 63; C.wave = __builtin_amdgcn_readfirstlane(C.tid >> 6); C.G = gridDim.x; C.bid = blockIdx.x;
    C.x = args.in[0]; C.c = args.in[1]; C.w_mod = args.in[2]; C.b_mod = args.in[3]; C.g_norms = args.in[4]; C.w_in = args.in[5]; C.cmp_pos = args.in[6]; C.cmp_w1 = args.in[7];
    C.cmp_b1 = args.in[8]; C.cmp_w2 = args.in[9]; C.cmp_b2 = args.in[10]; C.rel_table = args.in[11]; C.ln_g = args.in[12]; C.ln_b = args.in[13]; C.sgu_w = args.in[14]; C.sgu_b = args.in[15];
    C.w_pn = args.in[16]; C.w_ps = args.in[17]; C.w_out = args.in[18]; C.w_up = args.in[19]; C.conv_w = args.in[20]; C.conv_b = args.in[21]; C.w_dn = args.in[22];
    C.out = args.out; C.ws = args.ws; unsigned char* ws = args.ws;
    C.mod = (float*)(ws + WS_MOD); C.posw1 = (float*)(ws + WS_POSW1); C.gates = (float*)(ws + WS_GATES); C.ysc = (float*)(ws + WS_YSC); C.AH = (float*)(ws + WS_AH); C.AT = (float*)(ws + WS_AT); C.Y1 = (f16*)(ws + WS_Z); C.Y2 = (f16*)(ws + WS_Y2); C.X1H = (f16*)(ws + WS_X1H);
    C.W2T = (f16*)(ws + WS_W2T); C.SGUW = (f16*)(ws + WS_SGUW); C.WG = (f16*)(ws + WS_WG); C.KC = (f16*)(ws + WS_KC); C.VCT = (f16*)(ws + WS_VCT); C.W1T = (f16*)(ws + WS_W1T);
    C.WUP = (f16*)(ws + WS_WUP); C.WDN = (f16*)(ws + WS_WDN); C.WIN = (f16*)(ws + WS_WIN); C.WVT = (f16*)(ws + WS_WVT); C.WM = (f16*)(ws + WS_WM); C.WO = (f16*)(ws + WS_WO);
    C.H = (f16*)(ws + WS_H); C.Q = (f16*)(ws + WS_Q); C.KV = (f16*)(ws + WS_KV); C.VT = (f16*)(ws + WS_VT); C.Z = (f16*)(ws + WS_Z); C.GA = (f16*)(ws + WS_GA); C.GB = (f16*)(ws + WS_GB);
    C.YAB = (f16*)(ws + WS_YAB); C.H2 = (f16*)(ws + WS_H2); C.ACT = (f16*)(ws + WS_ACT);

    volatile LAS unsigned* MISC = (volatile LAS unsigned*)(C.lds + MISC_OFF);
    for (int u = C.tid; u < (LDS_BYTES - MISC_OFF) / 4; u += NTHREADS) MISC[u] = 0u;
    __syncthreads();
    unsigned* barw = (unsigned*)(ws + WS_CTL) + CW_BAR;
    XcdBarrier bar; bar.bar = barw; bar.x = 0; bar.st = nullptr;
    if (MK_N_LAUNCHES == 1) bar = xcd_barrier_post(barw, MISC + 8);
    const int lo = args.ph_lo, hi = args.ph_hi;
#define IN(k) (lo <= (k) && (k) < hi)
#define DUP(k) ((((PROBE_DUP) >> (k)) & 1) != 0)
#define SEAM(k) do { if (IN(k) && IN((k) + 1)) xcd_barrier(bar); } while (0)

    if (IN(0)) { p0_prologue(C); if constexpr (DUP(0)) p0_prologue(C); }
    SEAM(0);
    if (IN(1)) { p1_norm(C); p1_quant_wup(C); if constexpr (DUP(1)) p1_norm(C); }
    SEAM(1);
    if (IN(2)) { ph2_proj(C); if constexpr (DUP(2)) ph2_proj(C); }
    SEAM(2);
    if (IN(3)) { ph3_mixers(C); if constexpr (DUP(3)) ph3_mixers(C); }
    SEAM(3);
    if (IN(4)) { p4_attention(C); if constexpr (DUP(4)) p4_attention(C); }
    SEAM(4);
    if (IN(5)) { ph5_merge(C); if constexpr (DUP(5)) ph5_merge(C); }
    SEAM(5);
    if (IN(6)) { ph6_out(C); if constexpr (DUP(6)) ph6_out(C); }
    SEAM(6);
    if (IN(7)) { p7_norm(C); }
    SEAM(7);
    if (IN(8)) { ph8_up(C); if constexpr (DUP(8)) ph8_up(C); }
    SEAM(8);
    if (IN(9)) { ph9_conv(C); if constexpr (DUP(9)) ph9_conv(C); }
    SEAM(9);
    if (IN(10)) { ph10_down(C); if constexpr (DUP(10)) ph10_down(C); }
    SEAM(10);
    if (IN(11)) { p11_final(C); }
#undef IN
#undef DUP
#undef SEAM
}

extern "C" void kernel_launch(void* const* d_in, const int* in_sizes, int n_in, void* d_out, int out_size, void* d_ws, size_t ws_size, hipStream_t stream) {
    static int grid = 0;
    if (grid == 0) {
        if (n_in != 23 || in_sizes[0] != M * D || out_size != M * D || ws_size < WS_END) { fprintf(stderr, "kernel_launch: unexpected shapes (n_in %d, in0 %d, out %d, ws %zu); nothing launched\n", n_in, n_in > 0 ? in_sizes[0] : -1, out_size, ws_size); grid = -1; return; }
        int dev = 0, cus = 0, per_cu = 0;
        if (hipGetDevice(&dev) != hipSuccess || hipDeviceGetAttribute(&cus, hipDeviceAttributeMultiprocessorCount, dev) != hipSuccess) { grid = -1; return; }
        if (hipFuncSetAttribute((const void*)fwd_kernel, hipFuncAttributeMaxDynamicSharedMemorySize, LDS_BYTES) != hipSuccess) { fprintf(stderr, "kernel_launch: hipFuncSetAttribute failed\n"); grid = -1; return; }
        if (hipOccupancyMaxActiveBlocksPerMultiprocessor(&per_cu, (const void*)fwd_kernel, NTHREADS, LDS_BYTES) != hipSuccess || per_cu < 1) { fprintf(stderr, "kernel_launch: occupancy query reports %d\n", per_cu); }
        (void)hipGetLastError();
        grid = cus;
        if (grid > 256) grid = 256;
    }
    if (grid < 0) return;
    (void)hipMemsetAsync((char*)d_ws + WS_CTL, 0, CTL_BYTES, stream);
    Args a{};
    for (int i = 0; i < 23; ++i) a.in[i] = (const float*)d_in[i];
    a.out = (float*)d_out; a.ws = (unsigned char*)d_ws;
    if (MK_N_LAUNCHES == 1) { a.ph_lo = 0; a.ph_hi = NPHASE; hipLaunchKernelGGL(fwd_kernel, dim3(grid), dim3(NTHREADS), LDS_BYTES, stream, a); }
    else { for (int li = 0; li < NPHASE; ++li) { a.ph_lo = li; a.ph_hi = li + 1; hipLaunchKernelGGL(fwd_kernel, dim3(grid), dim3(NTHREADS), LDS_BYTES, stream, a); } }
}
```

```cpp
#include <hip/hip_runtime.h>
#include <cstdio>
#include <cstdint>

#ifndef MK_N_LAUNCHES
#define MK_N_LAUNCHES 1
#endif

#ifndef PROBE_DUP
#define PROBE_DUP 0
#endif
#define GAS __attribute__((address_space(1)))
#define LAS __attribute__((address_space(3)))
typedef _Float16 f16;
typedef _Float16 hx8 __attribute__((ext_vector_type(8)));
typedef _Float16 hx4 __attribute__((ext_vector_type(4)));
typedef _Float16 hx2 __attribute__((ext_vector_type(2)));
typedef float f32x4 __attribute__((ext_vector_type(4)));
typedef float f32x2 __attribute__((ext_vector_type(2)));
typedef unsigned u32x4 __attribute__((ext_vector_type(4)));
typedef unsigned u32x2 __attribute__((ext_vector_type(2)));
typedef int ix4 __attribute__((ext_vector_type(4)));

constexpr int NB = 2, T = 8192, D = 4096, M = NB * T;
constexpr int NG = 4, HD = 128;
constexpr int DFF = 11008, NUP = 2 * DFF;
constexpr int IN_W = 17456, NPROJ = 16384, NMOD = 6 * D;
constexpr float EPS = 1e-6f;
constexpr float LOG2E = 1.4426950408889634f;
constexpr float SC2 = 0.08838834764831845f * 1.4426950408889634f;

constexpr size_t MiB = 1ull << 20;
constexpr size_t WS_CTL = 0, CTL_BYTES = 1 * MiB;
constexpr size_t WS_MOD = 1 * MiB;
constexpr size_t WS_POSW1 = 1 * MiB + 256 * 1024;
constexpr size_t WS_W2T = 1 * MiB + 384 * 1024;
constexpr size_t WS_SGUW = 2 * MiB;
constexpr size_t WS_WG = 2 * MiB + 512 * 1024;
constexpr size_t WS_KC = 3 * MiB;
constexpr size_t WS_VCT = 4 * MiB;
constexpr size_t WS_GATES = 5 * MiB;
constexpr size_t WS_W1T = 8 * MiB;
constexpr size_t WS_WUP = 16 * MiB;
constexpr size_t WS_WDN = 188 * MiB;
constexpr size_t WS_WIN = 274 * MiB;
constexpr size_t WS_WVT = 402 * MiB;
constexpr size_t WS_WM = 410 * MiB;
constexpr size_t WS_WO = 442 * MiB;
constexpr size_t WS_H = 474 * MiB;
constexpr size_t WS_Q = 602 * MiB;
constexpr size_t WS_KV = 666 * MiB;
constexpr size_t WS_VT = 730 * MiB;
constexpr size_t WS_Z = 762 * MiB;
constexpr size_t WS_GA = 890 * MiB;
constexpr size_t WS_GB = 1018 * MiB;
constexpr size_t WS_YAB = 1146 * MiB;
constexpr size_t WS_H2 = 274 * MiB;
constexpr size_t WS_AH = 406 * MiB;
constexpr size_t WS_AT = 418 * MiB;
constexpr size_t WS_ACT = 1090 * MiB;
constexpr size_t WS_Y2 = 432 * MiB;
constexpr size_t WS_X1H = 602 * MiB;
constexpr size_t WS_YSC = 1274 * MiB;
constexpr size_t WS_SA = 12 * MiB;
constexpr size_t WS_SW = 12 * MiB + 256 * 1024;
constexpr size_t WS_SAH = 12 * MiB + 512 * 1024;
constexpr size_t WS_SWQ = 12 * MiB + 640 * 1024;
constexpr size_t WS_H1Q = 1274 * MiB;
constexpr size_t WS_WINQ = 1338 * MiB;
constexpr size_t WS_WVTQ = 1390 * MiB;
constexpr size_t WS_WUPQ = 1434 * MiB;
constexpr size_t WS_END = 1520 * MiB;

constexpr int CW_BAR = 4096;

constexpr int LDS_BYTES = 147456;
constexpr int MISC_OFF = LDS_BYTES - 512;
constexpr int NWAVES = 8, NTHREADS = 512;

#define LDS_WAIT() asm volatile("s_waitcnt lgkmcnt(0)" ::: "memory")
#define VM_WAIT() asm volatile("s_waitcnt vmcnt(0)" ::: "memory")
__device__ __forceinline__ unsigned pkh(float lo, float hi) { hx2 p; p.x = (f16)lo; p.y = (f16)hi; return __builtin_bit_cast(unsigned, p); }
__device__ __forceinline__ unsigned pkb(float lo, float hi) { unsigned r; asm volatile("v_cvt_pk_bf16_f32 %0, %1, %2" : "=v"(r) : "v"(lo), "v"(hi)); return r; }
#ifndef FFN_BF16
#define FFN_BF16 1
#endif
__device__ __forceinline__ unsigned pk_ffn(float lo, float hi) { return FFN_BF16 ? pkb(lo, hi) : pkh(lo, hi); }
#ifndef MIX_BF16
#define MIX_BF16 1
#endif
__device__ __forceinline__ unsigned pk_mix(float lo, float hi) { return MIX_BF16 ? pkb(lo, hi) : pkh(lo, hi); }
__device__ __forceinline__ float wave_max(float v) {
#pragma unroll
    for (int o = 1; o < 64; o <<= 1) v = fmaxf(v, __shfl_xor(v, o));
    return v;
}
__device__ __forceinline__ unsigned pk_i8(float a, float b, float c, float d) {
    const int ia = (int)__builtin_rintf(a), ib = (int)__builtin_rintf(b), ic = (int)__builtin_rintf(c), id = (int)__builtin_rintf(d);
    return (unsigned)(ia & 255) | ((unsigned)(ib & 255) << 8) | ((unsigned)(ic & 255) << 16) | ((unsigned)(id & 255) << 24);
}
__device__ __forceinline__ float wave_sum(float v) {
#pragma unroll
    for (int o = 1; o < 64; o <<= 1) v += __shfl_xor(v, o);
    return v;
}
__device__ __forceinline__ float fsigmoid(float x) { return __builtin_amdgcn_rcpf(1.0f + __builtin_amdgcn_exp2f(-LOG2E * x)); }
__device__ __forceinline__ float fsilu(float x) { return x * fsigmoid(x); }
__device__ __forceinline__ float fgelu(float x) { const float u = x * (1.0f + 0.044715f * x * x); return x * __builtin_amdgcn_rcpf(1.0f + __builtin_amdgcn_exp2f(-2.302208198f * u)); }
template <int CTRL> __device__ __forceinline__ float dpp_f(float v) { return __builtin_bit_cast(float, __builtin_amdgcn_update_dpp(0, __builtin_bit_cast(int, v), CTRL, 0xF, 0xF, true)); }

namespace pg8 {
constexpr int BM = 256, BK = 64, HALF = 128, HTB = HALF * BK * 2, STAGE_BYTES = 8 * HTB, NXCD = 8, WGM = 8;
__host__ __device__ __forceinline__ int lds_byte(int r, int c) { const int st = (r >> 4) * 2 + (c >> 5), rr = r & 15, cc = c & 31, ob = rr * 64 + cc * 2; return st * 1024 + (ob ^ (((ob >> 9) & 1) << 5)); }
__host__ __device__ __forceinline__ void stage_rc(int b, int& R, int& C) { const int st = b / 1024, sb = b % 1024, swz = sb ^ (((sb >> 9) & 1) << 5); R = (st >> 1) * 16 + swz / 64; C = (st & 1) * 32 + (swz % 64) / 2; }
__host__ __device__ __forceinline__ int perm32(int rho) { const int n = rho >> 4, i = rho & 15; return 8 * (i >> 2) + 4 * n + (i & 3); }

struct Unit { int pm, pn; };
struct Gemm { const f16* A; const f16* Bt; int M, N, K; };

struct StaticOrder {
    int nM, nN, nwg, G, c;
    __host__ __device__ void init(int M_, int N_, int G_, int c_) { nM = M_ / BM; nN = N_ / BM; nwg = nM * nN; G = G_; c = c_; }
    __host__ __device__ bool next(int i, Unit& u) const {
        const long L = (long)i * G + c; if (L >= nwg) return false;
        int wgid = (int)L; { const int q = nwg / NXCD, r = nwg % NXCD, xcd = wgid % NXCD, off = wgid / NXCD; wgid = (xcd < r ? xcd * (q + 1) : r * (q + 1) + (xcd - r) * q) + off; }
        const int nig = WGM * nN, gid = wgid / nig, fm = gid * WGM, gsz = (nM - fm) < WGM ? (nM - fm) : WGM;
        u.pm = fm + ((wgid % nig) % gsz); u.pn = (wgid % nig) / gsz; return true;
    }
    __device__ __forceinline__ void a_ready(const Unit&) const {}
    __device__ __forceinline__ void done(const Unit&) const {}
};

__device__ __forceinline__ u32x4 pack8(const f32x4 v0, const f32x4 v1) { u32x4 w; w.x = pkh(v0[0], v0[1]); w.y = pkh(v0[2], v0[3]); w.z = pkh(v1[0], v1[1]); w.w = pkh(v1[2], v1[3]); return w; }

__device__ __forceinline__ unsigned opaque(unsigned v) { asm volatile("" : "+v"(v)); return v; }
struct EpiF32 {
    static constexpr bool PERM = false, AFTER_DRAIN = false, HAS_MID = false;
    float* C; int ldc;
    __device__ __forceinline__ void mid(f32x4 (&)[2][2][4][2], const Unit&, int, int, int, int) const {}
    __device__ __forceinline__ void operator()(const f32x4 (&acc)[2][2][4][2], const Unit& u, int wr, int wc, int fr, int fq) const {
        const unsigned off = opaque((unsigned)((u.pm * BM + wr * 64 + fr) * ldc + u.pn * BM + wc * 32 + 4 * fq) * 4u);
        char* base = (char*)C;
#pragma unroll
        for (int ai = 0; ai < 2; ++ai)
#pragma unroll
            for (int m = 0; m < 4; ++m) { const unsigned ro = off + (unsigned)((ai * HALF + m * 16) * ldc) * 4u;
#pragma unroll
                for (int bj = 0; bj < 2; ++bj)
#pragma unroll
                    for (int n = 0; n < 2; ++n) *(f32x4*)(base + ro + (bj * HALF + n * 16) * 4) = acc[ai][bj][m][n]; }
    }
};
struct EpiH16 {
    static constexpr bool PERM = true, AFTER_DRAIN = false, HAS_MID = false;
    f16* O; int ldc;
    __device__ __forceinline__ void mid(f32x4 (&)[2][2][4][2], const Unit&, int, int, int, int) const {}
    __device__ __forceinline__ void operator()(const f32x4 (&acc)[2][2][4][2], const Unit& u, int wr, int wc, int fr, int fq) const {
        const unsigned off = opaque((unsigned)((u.pm * BM + wr * 64 + fr) * ldc + u.pn * BM + wc * 32 + 8 * fq) * 2u);
        char* base = (char*)O;
#pragma unroll
        for (int ai = 0; ai < 2; ++ai)
#pragma unroll
            for (int m = 0; m < 4; ++m) { const unsigned ro = off + (unsigned)((ai * HALF + m * 16) * ldc) * 2u;
#pragma unroll
                for (int bj = 0; bj < 2; ++bj) *(u32x4*)(base + ro + bj * HALF * 2) = pack8(acc[ai][bj][m][0], acc[ai][bj][m][1]); }
    }
};
struct EpiProj {
    static constexpr bool PERM = true, AFTER_DRAIN = false, HAS_MID = false;
    f16 *Q, *KV, *Z, *GA, *GB; int pn0;
    __device__ __forceinline__ void mid(f32x4 (&)[2][2][4][2], const Unit&, int, int, int, int) const {}
    __device__ __forceinline__ void operator()(const f32x4 (&acc)[2][2][4][2], const Unit& u, int wr, int wc, int fr, int fq) const {
        const int pn = u.pn + pn0; char* base; int ldc, colt, act;
        if (pn < 8) { base = (char*)Q; ldc = 2048; colt = pn * 256; act = 0; }
        else if (pn < 16) { base = (char*)KV; ldc = 2048; colt = (pn - 8) * 256; act = 0; }
        else if (pn < 32) { base = (char*)Z; ldc = 4096; colt = (pn - 16) * 256; act = 1; }
        else if (pn < 48) { base = (char*)GA; ldc = 4096; colt = (pn - 32) * 256; act = 2; }
        else { base = (char*)GB; ldc = 4096; colt = (pn - 48) * 256; act = 2; }
        const unsigned off = opaque((unsigned)((u.pm * BM + wr * 64 + fr) * ldc + colt + wc * 32 + 8 * fq) * 2u);
#pragma unroll
        for (int ai = 0; ai < 2; ++ai)
#pragma unroll
            for (int m = 0; m < 4; ++m) { const unsigned ro = off + (unsigned)((ai * HALF + m * 16) * ldc) * 2u;
#pragma unroll
                for (int bj = 0; bj < 2; ++bj) { f32x4 v0 = acc[ai][bj][m][0], v1 = acc[ai][bj][m][1];
                    if (act == 1) {
#pragma unroll
                        for (int j = 0; j < 4; ++j) { v0[j] = fgelu(v0[j]); v1[j] = fgelu(v1[j]); } }
                    else if (act == 2) {
#pragma unroll
                        for (int j = 0; j < 4; ++j) { v0[j] = fsigmoid(v0[j]); v1[j] = fsigmoid(v1[j]); } }
                    *(u32x4*)(base + ro + bj * HALF * 2) = pack8(v0, v1); } }
    }
};
struct EpiProjQ {
    static constexpr bool PERM = true, AFTER_DRAIN = false, HAS_MID = false;
    unsigned char* ws; int pn0;
    __device__ __forceinline__ void mid(f32x4 (&)[2][2][4][2], const Unit&, int, int, int, int) const {}
    __device__ __forceinline__ void operator()(const f32x4 (&acc)[2][2][4][2], const Unit& u, int wr, int wc, int fr, int fq) const {
        const int pn = u.pn + pn0; char* base; int ldc, colt, act;
        if (pn < 16) { base = (char*)(ws + WS_KV); ldc = 2048; colt = (pn - 8) * 256; act = 0; }
        else if (pn < 32) { base = (char*)(ws + WS_Z); ldc = 4096; colt = (pn - 16) * 256; act = 1; }
        else if (pn < 48) { base = (char*)(ws + WS_GA); ldc = 4096; colt = (pn - 32) * 256; act = 2; }
        else { base = (char*)(ws + WS_GB); ldc = 4096; colt = (pn - 48) * 256; act = 2; }
        const float* const SA = (const float*)(ws + WS_SAH); const float* const SW = (const float*)(ws + WS_SWQ);
        const unsigned off = opaque((unsigned)((u.pm * BM + wr * 64 + fr) * ldc + colt + wc * 32 + 8 * fq) * 2u);
        const unsigned arow = opaque((unsigned)(u.pm * BM + wr * 64 + fr)), wrow = opaque((unsigned)((pn - 12) * 256 + wc * 32 + 8 * fq));
        f32x4 sw[2][2];
#pragma unroll
        for (int bj = 0; bj < 2; ++bj)
#pragma unroll
            for (int n = 0; n < 2; ++n) sw[bj][n] = *(const f32x4*)(SW + wrow + bj * HALF + 4 * n);
#pragma unroll
        for (int ai = 0; ai < 2; ++ai)
#pragma unroll
            for (int m = 0; m < 4; ++m) { const unsigned ro = off + (unsigned)((ai * HALF + m * 16) * ldc) * 2u; const float sa = SA[arow + ai * HALF + m * 16];
#pragma unroll
                for (int bj = 0; bj < 2; ++bj) { const ix4 i0 = __builtin_bit_cast(ix4, acc[ai][bj][m][0]), i1 = __builtin_bit_cast(ix4, acc[ai][bj][m][1]); f32x4 v0, v1;
#pragma unroll
                    for (int j = 0; j < 4; ++j) { v0[j] = (float)i0[j] * (sa * sw[bj][0][j]); v1[j] = (float)i1[j] * (sa * sw[bj][1][j]); }
                    if (act == 1) {
#pragma unroll
                        for (int j = 0; j < 4; ++j) { v0[j] = fgelu(v0[j]); v1[j] = fgelu(v1[j]); } }
                    else if (act == 2) {
#pragma unroll
                        for (int j = 0; j < 4; ++j) { v0[j] = fsigmoid(v0[j]); v1[j] = fsigmoid(v1[j]); } }
                    *(u32x4*)(base + ro + bj * HALF * 2) = pack8(v0, v1); } }
    }
};
struct EpiVTQ {
    static constexpr bool PERM = true, AFTER_DRAIN = false, HAS_MID = false;
    unsigned char* ws;
    __device__ __forceinline__ void mid(f32x4 (&)[2][2][4][2], const Unit&, int, int, int, int) const {}
    __device__ __forceinline__ void operator()(const f32x4 (&acc)[2][2][4][2], const Unit& u, int wr, int wc, int fr, int fq) const {
        const float* const SA = (const float*)(ws + WS_SAH); const float* const SW = (const float*)(ws + WS_SWQ) + 13312;
        const unsigned off = opaque((unsigned)((u.pm * BM + wr * 64 + fr) * M + u.pn * BM + wc * 32 + 8 * fq) * 2u);
        const unsigned wrow = opaque((unsigned)(u.pm * BM + wr * 64 + fr)), tcol = opaque((unsigned)(u.pn * BM + wc * 32 + 8 * fq));
        char* base = (char*)(ws + WS_VT);
        f32x4 sa[2][2];
#pragma unroll
        for (int bj = 0; bj < 2; ++bj)
#pragma unroll
            for (int n = 0; n < 2; ++n) sa[bj][n] = *(const f32x4*)(SA + tcol + bj * HALF + 4 * n);
#pragma unroll
        for (int ai = 0; ai < 2; ++ai)
#pragma unroll
            for (int m = 0; m < 4; ++m) { const unsigned ro = off + (unsigned)((ai * HALF + m * 16) * M) * 2u; const float sw = SW[wrow + ai * HALF + m * 16];
#pragma unroll
                for (int bj = 0; bj < 2; ++bj) { const ix4 i0 = __builtin_bit_cast(ix4, acc[ai][bj][m][0]), i1 = __builtin_bit_cast(ix4, acc[ai][bj][m][1]); f32x4 v0, v1;
#pragma unroll
                    for (int j = 0; j < 4; ++j) { v0[j] = (float)i0[j] * (sw * sa[bj][0][j]); v1[j] = (float)i1[j] * (sw * sa[bj][1][j]); }
                    *(u32x4*)(base + ro + bj * HALF * 2) = pack8(v0, v1); } }
    }
};
struct EpiMerge {
    static constexpr bool PERM = true, AFTER_DRAIN = false, HAS_MID = true;
    const f16 *GA, *GB; f16* O;
    __device__ __forceinline__ void mid(f32x4 (&acc)[2][2][4][2], const Unit& u, int wr, int wc, int fr, int fq) const {
        const unsigned off = opaque((unsigned)((u.pm * BM + wr * 64 + fr) * D + u.pn * BM + wc * 32 + 8 * fq) * 2u);
        const char* ga = (const char*)GA; const char* gb = (const char*)GB;
#pragma unroll
        for (int ai = 0; ai < 2; ++ai)
#pragma unroll
            for (int m = 0; m < 4; ++m) { const unsigned ro = off + (unsigned)((ai * HALF + m * 16) * D) * 2u;
#pragma unroll
                for (int bj = 0; bj < 2; ++bj) { const hx8 a = *(const hx8*)(ga + ro + bj * HALF * 2), b = *(const hx8*)(gb + ro + bj * HALF * 2);
#pragma unroll
                    for (int j = 0; j < 4; ++j) { acc[ai][bj][m][0][j] *= (float)a[j] * __builtin_amdgcn_rcpf((float)b[j]); acc[ai][bj][m][1][j] *= (float)a[4 + j] * __builtin_amdgcn_rcpf((float)b[4 + j]); } } }
    }
    __device__ __forceinline__ void operator()(const f32x4 (&acc)[2][2][4][2], const Unit& u, int wr, int wc, int fr, int fq) const {
        const unsigned off = opaque((unsigned)((u.pm * BM + wr * 64 + fr) * D + u.pn * BM + wc * 32 + 8 * fq) * 2u);
        const char* gb = (const char*)GB; char* ob = (char*)O;
#pragma unroll
        for (int ai = 0; ai < 2; ++ai)
#pragma unroll
            for (int m = 0; m < 4; ++m) { const unsigned ro = off + (unsigned)((ai * HALF + m * 16) * D) * 2u;
#pragma unroll
                for (int bj = 0; bj < 2; ++bj) { const hx8 b = *(const hx8*)(gb + ro + bj * HALF * 2); f32x4 v0 = acc[ai][bj][m][0], v1 = acc[ai][bj][m][1];
#pragma unroll
                    for (int j = 0; j < 4; ++j) { v0[j] *= (float)b[j]; v1[j] *= (float)b[4 + j]; }
                    u32x4 w; w.x = pk_mix(v0[0], v0[1]); w.y = pk_mix(v0[2], v0[3]); w.z = pk_mix(v1[0], v1[1]); w.w = pk_mix(v1[2], v1[3]);
                    *(u32x4*)(ob + ro + bj * HALF * 2) = w; } }
    }
};

typedef short sx8 __attribute__((ext_vector_type(8)));
template <int CTRL> __device__ __forceinline__ float dpp_mov(float old, float v) { return __builtin_bit_cast(float, __builtin_amdgcn_update_dpp(__builtin_bit_cast(int, old), __builtin_bit_cast(int, v), CTRL, 0xF, 0xF, false)); }
struct EpiConv {
    static constexpr bool PERM = true, AFTER_DRAIN = false, HAS_MID = false;
    unsigned char* ws; const float* cw; const float* cb; LAS float* X; int bf16out;
    __device__ __forceinline__ void mid(f32x4 (&)[2][2][4][2], const Unit&, int, int, int, int) const {}
    static __device__ __forceinline__ f32x4 deq(const f32x4 a, float s) { const ix4 iv = __builtin_bit_cast(ix4, a); return (f32x4){(float)iv[0] * s, (float)iv[1] * s, (float)iv[2] * s, (float)iv[3] * s}; }
    __device__ __forceinline__ void operator()(const f32x4 (&acc)[2][2][4][2], const Unit& u, int wr, int wc, int fr_, int fq_) const {
        const unsigned lane_o = opaque(threadIdx.x & 63u); const int fr = (int)(lane_o & 15u), fq = (int)(lane_o >> 4); (void)fr_; (void)fq_;
        f16* const ACT = (f16*)(ws + WS_ACT); float* const AH = (float*)(ws + WS_AH); float* const AT = (float*)(ws + WS_AT); const float* const SA = (const float*)(ws + WS_SA); const float* const SW = (const float*)(ws + WS_SW);
        const int chl = wc * 32 + 8 * fq;
        const unsigned ch0 = opaque((unsigned)(u.pn * 128 + chl)), wrow = opaque((unsigned)(u.pn * 256 + chl)), arow = opaque((unsigned)(u.pm * BM + wr * 64 + fr));
        float sa[2][4];
#pragma unroll
        for (int ai = 0; ai < 2; ++ai)
#pragma unroll
            for (int m = 0; m < 4; ++m) sa[ai][m] = SA[arow + ai * HALF + m * 16];
        if (fr >= 14) {
#pragma unroll
            for (int ai = 0; ai < 2; ++ai)
#pragma unroll
                for (int bj = 0; bj < 2; ++bj)
#pragma unroll
                    for (int n = 0; n < 2; ++n) *(LAS f32x4*)(X + ((((2 * ai + wr) * 2 + (fr - 14)) * 2 + bj) * 128 + chl + 4 * n)) = deq(acc[ai][bj][3][n], sa[ai][3]);
        }
        asm volatile("s_waitcnt lgkmcnt(0)" ::: "memory"); __builtin_amdgcn_s_barrier(); asm volatile("" ::: "memory");
        if (u.pm == 64) {
            const unsigned hro = opaque((unsigned)((wr * 64 + fr) * 2));
#pragma unroll
            for (int bj = 0; bj < 2; ++bj)
#pragma unroll
                for (int n = 0; n < 2; ++n) { const f32x4 swv = *(const f32x4*)(SW + wrow + bj * 128 + 4 * n);
#pragma unroll
                    for (int m = 0; m < 4; ++m) *(f32x4*)(AH + (size_t)(hro + 32 * m + bj) * DFF + ch0 + 4 * n) = deq(acc[0][bj][m][n], sa[0][m]) * swv; }
            return;
        }
        const unsigned orow = opaque((unsigned)(u.pm * BM + wr * 64 + fr));
#pragma unroll
        for (int n = 0; n < 2; ++n) {
            f32x4 wv[3][2], bv[2];
#pragma unroll
            for (int bj = 0; bj < 2; ++bj) { bv[bj] = *(const f32x4*)(cb + bj * DFF + ch0 + 4 * n); const f32x4 swv = *(const f32x4*)(SW + wrow + bj * 128 + 4 * n);
#pragma unroll
                for (int k = 0; k < 3; ++k) wv[k][bj] = *(const f32x4*)(cw + k * NUP + bj * DFF + ch0 + 4 * n) * swv;
                if (wr == 0 && fr < 2) *(f32x4*)(AT + (size_t)((u.pm * 2 + fr) * 2 + bj) * DFF + ch0 + 4 * n) = deq(acc[0][bj][0][n], sa[0][0]) * swv; }
#pragma unroll
            for (int ai = 0; ai < 2; ++ai) {
                f32x4 E[2];
                const int blk = 2 * ai + wr - 1;
#pragma unroll
                for (int bj = 0; bj < 2; ++bj) { E[bj] = (f32x4){0.f, 0.f, 0.f, 0.f};
                    if (blk >= 0 && fr >= 14) E[bj] = *(const LAS f32x4*)(X + (((blk * 2 + (fr - 14)) * 2 + bj) * 128 + chl + 4 * n)); }
#pragma unroll
                for (int m = 0; m < 4; ++m) {
                    f32x4 cv[2];
#pragma unroll
                    for (int bj = 0; bj < 2; ++bj) { const f32x4 cur = deq(acc[ai][bj][m][n], sa[ai][m]); const f32x4 prv = (m == 0) ? E[bj] : deq(acc[ai][bj][m == 0 ? 0 : m - 1][n], sa[ai][m == 0 ? 0 : m - 1]);
#pragma unroll
                        for (int i = 0; i < 4; ++i) { const float p1 = dpp_mov<0x111>(dpp_mov<0x121>(0.f, prv[i]), cur[i]), p2 = dpp_mov<0x112>(dpp_mov<0x122>(0.f, prv[i]), cur[i]);
                            cv[bj][i] = bv[bj][i] + wv[0][bj][i] * p2 + wv[1][bj][i] * p1 + wv[2][bj][i] * cur[i]; } }
                    float res[4];
#pragma unroll
                    for (int e = 0; e < 4; ++e) res[e] = fsilu(cv[0][e]) * cv[1][e];
                    u32x2 ov;
                    if (bf16out) { ov.x = pkb(res[0], res[1]); ov.y = pkb(res[2], res[3]); }
                    else { ov.x = pkh(res[0], res[1]); ov.y = pkh(res[2], res[3]); }
                    *(u32x2*)(ACT + (size_t)(orow + ai * HALF + m * 16) * DFF + ch0 + 4 * n) = ov;
                }
            }
        }
    }
};

template <class Epi, class Sched, bool ALIGN_EPI = true, int DT = 0  >
__device__ __forceinline__ void gemm_phase(LAS unsigned char* lds, const Gemm g, const Sched& S, const Epi& E) {
    const int tid = threadIdx.x, wid = __builtin_amdgcn_readfirstlane(tid >> 6), lane = tid & 63, wr = wid >> 2, wc = wid & 3, fr = lane & 15, fq = lane >> 4;
    const int K = g.K, nt = K / BK;
    unsigned voffA[2], voffB[2];
#pragma unroll
    for (int i = 0; i < 2; ++i) { int R, C; stage_rc(tid * 16 + i * 8192, R, C); const int Rb = Epi::PERM ? ((R & ~31) + perm32(R & 31)) : R;
        voffA[i] = (unsigned)(R * K + C) * 2u; voffB[i] = (unsigned)(Rb * K + C) * 2u; }
    const size_t kstep = (size_t)(BK * 2);
    const size_t hstep = (size_t)HALF * K * 2;
    const size_t tstep = 2 * hstep;
    const unsigned ldsw = (unsigned)wid * 1024u;
    const int aoff = lds_byte(wr * 64 + fr, fq * 8), boff = lds_byte(wc * 32 + fr, fq * 8);
#define PG8_SA(b, h) (((b) * 2 + (h)) * HTB)
#define PG8_SB(b, h) ((4 + (b) * 2 + (h)) * HTB)
#define PG8_STAGE(bufoff, gbase, voff) do { _Pragma("unroll") for (int _i = 0; _i < 2; ++_i) \
        __builtin_amdgcn_global_load_lds((const unsigned*)((const char*)(gbase) + (voff)[_i]), (LAS unsigned*)(lds + (bufoff) + ldsw + _i * 8192), 16, 0, 0); } while (0)
#define PG8_LDA(dst, b, h) do { _Pragma("unroll") for (int m = 0; m < 4; ++m) _Pragma("unroll") for (int k = 0; k < 2; ++k) dst[m][k] = *(const LAS hx8*)(lds + PG8_SA(b, h) + aoff + m * 2048 + k * 1024); } while (0)
#define PG8_LDB(dst, b, h) do { _Pragma("unroll") for (int n = 0; n < 2; ++n) _Pragma("unroll") for (int k = 0; k < 2; ++k) dst[n][k] = *(const LAS hx8*)(lds + PG8_SB(b, h) + boff + n * 2048 + k * 1024); } while (0)
#define PG8_MMA(ai, bj, At, Bt) do { __builtin_amdgcn_s_setprio(1); _Pragma("unroll") for (int m = 0; m < 4; ++m) _Pragma("unroll") for (int n = 0; n < 2; ++n) _Pragma("unroll") for (int k = 0; k < 2; ++k) \
        { if constexpr (DT == 2) acc[ai][bj][m][n] = __builtin_bit_cast(f32x4, __builtin_amdgcn_mfma_i32_16x16x64_i8(__builtin_bit_cast(ix4, Bt[n][k]), __builtin_bit_cast(ix4, At[m][k]), __builtin_bit_cast(ix4, acc[ai][bj][m][n]), 0, 0, 0)); \
          else if constexpr (DT == 1) acc[ai][bj][m][n] = __builtin_amdgcn_mfma_f32_16x16x32_bf16(__builtin_bit_cast(sx8, Bt[n][k]), __builtin_bit_cast(sx8, At[m][k]), acc[ai][bj][m][n], 0, 0, 0); \
          else acc[ai][bj][m][n] = __builtin_amdgcn_mfma_f32_16x16x32_f16(Bt[n][k], At[m][k], acc[ai][bj][m][n], 0, 0, 0); } __builtin_amdgcn_s_setprio(0); } while (0)
#define PG8_WAIT_V(n) asm volatile("s_waitcnt vmcnt(" #n ")" ::: "memory")
#define PG8_WAIT_L(n) asm volatile("s_waitcnt lgkmcnt(" #n ")" ::: "memory")
#define PG8_BAR __builtin_amdgcn_s_barrier()
#define PG8_SCHED __builtin_amdgcn_sched_barrier(0)
    Unit cur, nxt; int ui = 0;
    if (!S.next(0, cur)) return;
    f32x4 acc[2][2][4][2];
#pragma unroll
    for (int a = 0; a < 2; ++a)
#pragma unroll
        for (int b = 0; b < 2; ++b)
#pragma unroll
            for (int m = 0; m < 4; ++m)
#pragma unroll
                for (int n = 0; n < 2; ++n) acc[a][b][m][n] = (f32x4){0.f, 0.f, 0.f, 0.f};
    hx8 At[4][2], B0[2][2], B1[2][2];
    const char* cA = (const char*)g.A + (size_t)cur.pm * tstep; const char* cB = (const char*)g.Bt + (size_t)cur.pn * tstep;
    S.a_ready(cur);
    PG8_STAGE(PG8_SB(0, 0), cB, voffB); PG8_STAGE(PG8_SB(0, 1), cB + hstep, voffB); PG8_STAGE(PG8_SA(0, 0), cA, voffA); PG8_STAGE(PG8_SA(0, 1), cA + hstep, voffA);
    if (wr == 1) PG8_BAR;
    PG8_WAIT_V(2); PG8_BAR;
    PG8_STAGE(PG8_SB(1, 0), cB + kstep, voffB); PG8_STAGE(PG8_SA(1, 0), cA + kstep, voffA); PG8_STAGE(PG8_SB(1, 1), cB + hstep + kstep, voffB);
    PG8_WAIT_V(6); PG8_BAR;
    for (;;) {
        const bool has_next = S.next(ui + 1, nxt);
        const char* nA = has_next ? (const char*)g.A + (size_t)nxt.pm * tstep : cA; const char* nB = has_next ? (const char*)g.Bt + (size_t)nxt.pn * tstep : cB;
        for (int t = 0; t < nt; t += 2) {
            const bool last = (t == nt - 2);
            const char* a1 = cA + (size_t)(t + 1) * kstep;
            const char* a2 = last ? nA : cA + (size_t)(t + 2) * kstep; const char* b2 = last ? nB : cB + (size_t)(t + 2) * kstep;
            const char* a3 = a2 + kstep; const char* b3 = b2 + kstep;
            if (last && has_next) S.a_ready(nxt);
            if constexpr (Epi::HAS_MID) { if (t == (nt >> 1)) E.mid(acc, cur, wr, wc, fr, fq); }
            PG8_LDB(B0, 0, 0); PG8_LDB(B1, 0, 1); PG8_SCHED; PG8_LDA(At, 0, 0); PG8_STAGE(PG8_SA(1, 1), a1 + hstep, voffA);
            PG8_WAIT_V(8); PG8_WAIT_L(0); PG8_BAR; PG8_MMA(0, 0, At, B0); PG8_MMA(0, 1, At, B1); PG8_BAR; PG8_SCHED;
            PG8_LDA(At, 0, 1); PG8_STAGE(PG8_SB(0, 0), b2, voffB); PG8_STAGE(PG8_SB(0, 1), b2 + hstep, voffB); PG8_STAGE(PG8_SA(0, 0), a2, voffA);
            PG8_WAIT_V(8); PG8_WAIT_L(0); PG8_BAR; PG8_MMA(1, 0, At, B0); PG8_MMA(1, 1, At, B1); PG8_BAR; PG8_SCHED;
            PG8_LDB(B0, 1, 0); PG8_LDB(B1, 1, 1); PG8_SCHED; PG8_LDA(At, 1, 0); PG8_STAGE(PG8_SA(0, 1), a2 + hstep, voffA);
            PG8_WAIT_V(8); PG8_WAIT_L(0); PG8_BAR; PG8_MMA(0, 0, At, B0); PG8_MMA(0, 1, At, B1); PG8_BAR; PG8_SCHED;
            PG8_LDA(At, 1, 1); PG8_STAGE(PG8_SB(1, 0), b3, voffB); PG8_STAGE(PG8_SB(1, 1), b3 + hstep, voffB); PG8_STAGE(PG8_SA(1, 0), a3, voffA);
            PG8_WAIT_V(8); PG8_WAIT_L(0); PG8_BAR; PG8_MMA(1, 0, At, B0); PG8_MMA(1, 1, At, B1); PG8_BAR; PG8_SCHED;
        }
        if constexpr (ALIGN_EPI) { if (wr == 0) PG8_BAR; }
        E(acc, cur, wr, wc, fr, fq); S.done(cur);
        if (!has_next) break;
#pragma unroll
        for (int a = 0; a < 2; ++a)
#pragma unroll
            for (int b = 0; b < 2; ++b)
#pragma unroll
                for (int m = 0; m < 4; ++m)
#pragma unroll
                    for (int n = 0; n < 2; ++n) acc[a][b][m][n] = (f32x4){0.f, 0.f, 0.f, 0.f};
        cur = nxt; cA = nA; cB = nB; ++ui;
        if constexpr (ALIGN_EPI) { if (wr == 1) PG8_BAR; }
    }
    PG8_WAIT_V(0);
    if constexpr (!ALIGN_EPI) { if (wr == 0) PG8_BAR; }
    PG8_BAR;
#undef PG8_SA
#undef PG8_SB
#undef PG8_STAGE
#undef PG8_LDA
#undef PG8_LDB
#undef PG8_MMA
#undef PG8_WAIT_V
#undef PG8_WAIT_L
#undef PG8_BAR
#undef PG8_SCHED
}
}

#define XB_TMO      128
#define XB_XCNT(j)  (256  + 64 * (j))
#define XB_XSUB(j)  (1280 + 64 * (j))
#define XB_XGEN(j)  (2304 + 64 * (j))
#define XB_TOP      3328
#define XB_TOPGEN   3392
#define XCD_BAR_WORDS 3456
#define XB_SPIN_CAP (1u << 18)
__device__ __forceinline__ unsigned xb_ld(unsigned* p)              { return __hip_atomic_load(p, __ATOMIC_RELAXED, __HIP_MEMORY_SCOPE_AGENT); }
__device__ __forceinline__ unsigned xb_add(unsigned* p, unsigned v) { return __hip_atomic_fetch_add(p, v, __ATOMIC_RELAXED, __HIP_MEMORY_SCOPE_AGENT); }
__device__ __forceinline__ unsigned xb_xcc_id() { return (unsigned)__builtin_amdgcn_s_getreg((3 << 11) | 20) & 0xFu; }
#define XB_SPIN(cond, bar) do { unsigned _sp = 0; while (cond) { __builtin_amdgcn_s_sleep(1); \
    if ((++_sp & 255u) == 0u) { if (xb_ld(&(bar)[XB_TMO])) break; if (_sp > XB_SPIN_CAP) { atomicAdd(&(bar)[XB_TMO], 1u); break; } } } } while (0)
struct XcdBarrier { unsigned* bar; unsigned x; volatile LAS unsigned* st; };
__device__ __forceinline__ XcdBarrier xcd_barrier_post(unsigned* bar, volatile LAS unsigned* st) {
    XcdBarrier b; b.bar = bar; b.x = xb_xcc_id(); b.st = st;
    if (threadIdx.x == 0) (void)xb_add(&bar[XB_XCNT(b.x)], 1u);
    return b;
}
__device__ __forceinline__ void xcd_barrier_complete(unsigned* bar, unsigned x, unsigned& nloc, unsigned& nx) {
    const unsigned G = gridDim.x * gridDim.y * gridDim.z;
    unsigned sum, cnt, mine, sp = 0u;
    for (;;) {
        sum = 0u; cnt = 0u; mine = 0u;
#pragma unroll
        for (unsigned j = 0; j < 16; ++j) { const unsigned c = xb_ld(&bar[XB_XCNT(j)]); sum += c; cnt += (c > 0u) ? 1u : 0u; mine = (j == x) ? c : mine; }
        if (sum == G) break;
        __builtin_amdgcn_s_sleep(1);
        if ((++sp & 255u) == 0u) { if (xb_ld(&bar[XB_TMO])) break; if (sp > XB_SPIN_CAP) { atomicAdd(&bar[XB_TMO], 1u); break; } }
    }
    nloc = mine > 0u ? mine : 1u; nx = cnt > 0u ? cnt : 1u;
}
__device__ __forceinline__ void xcd_barrier(const XcdBarrier& b) {
    asm volatile("s_waitcnt vmcnt(0)" ::: "memory");
    __syncthreads();
    if (threadIdx.x == 0) {
        unsigned* bar = b.bar;
        __builtin_amdgcn_s_waitcnt(0);
        unsigned nloc = b.st[0], nx = b.st[1];
        if (nloc == 0u) { xcd_barrier_complete(bar, b.x, nloc, nx); b.st[0] = nloc; b.st[1] = nx; }
        const unsigned old = xb_add(&bar[XB_XSUB(b.x)], 1u);
        const unsigned gen = old / nloc;
        if (old + 1u == (gen + 1u) * nloc) {
            __builtin_amdgcn_fence(__ATOMIC_RELEASE, "agent");
            asm volatile("s_waitcnt vmcnt(0)" ::: "memory");
            const unsigned og = xb_add(&bar[XB_TOP], 1u);
            const unsigned tg = og / nx;
            if (og + 1u == (tg + 1u) * nx) xb_add(&bar[XB_TOPGEN], 1u);
            else XB_SPIN(xb_ld(&bar[XB_TOPGEN]) == tg, bar);
            __builtin_amdgcn_fence(__ATOMIC_ACQUIRE, "agent");
            xb_add(&bar[XB_XGEN(b.x)], 1u);
            asm volatile("s_waitcnt vmcnt(0)" ::: "memory");
        } else {
            XB_SPIN(xb_ld(&bar[XB_XGEN(b.x)]) == gen, bar);
            __builtin_amdgcn_fence(__ATOMIC_ACQUIRE, "agent");
            asm volatile("s_waitcnt vmcnt(0)" ::: "memory");
        }
    }
    __syncthreads();
}

struct Args { const float* in[23]; float* out; unsigned char* ws; int ph_lo, ph_hi; };
struct Ctx {
    LAS unsigned char* lds;
    int tid, lane, wave, G, bid;
    const float *x, *c, *w_mod, *b_mod, *g_norms, *w_in, *cmp_pos, *cmp_w1, *cmp_b1, *cmp_w2, *cmp_b2, *rel_table, *ln_g, *ln_b, *sgu_w, *sgu_b,
                *w_pn, *w_ps, *w_out, *w_up, *conv_w, *conv_b, *w_dn;
    float* out; unsigned char* ws;
    float *mod, *posw1, *gates, *ysc, *AH, *AT; f16 *Y1, *Y2, *X1H, *W2T, *SGUW, *WG, *KC, *VCT, *W1T, *WUP, *WDN, *WIN, *WVT, *WM, *WO, *H, *Q, *KV, *VT, *Z, *GA, *GB, *YAB, *H2, *ACT;
};

__device__ __forceinline__ void p0_mod_item(Ctx& C, int item) {
    LAS float* sc = (LAS float*)C.lds;
    LAS float* red = (LAS float*)(C.lds + 32768);
    for (int i = C.tid; i < 2 * D; i += NTHREADS) sc[i] = fsilu(C.c[i]);
    __syncthreads();
    const int cq = C.tid & 31, kg = C.tid >> 5, n0 = item * 128 + 4 * cq;
    f32x4 a0 = {0.f, 0.f, 0.f, 0.f}, a1 = {0.f, 0.f, 0.f, 0.f};
    const float* wp = C.w_mod + (size_t)(kg * 256) * NMOD + n0;
#pragma unroll 8
    for (int i = 0; i < 256; ++i) { const f32x4 w = *(const f32x4*)(wp + (size_t)i * NMOD); const float s0 = sc[kg * 256 + i], s1 = sc[D + kg * 256 + i]; a0 += w * s0; a1 += w * s1; }
    *(LAS f32x4*)(red + (kg * 2 + 0) * 128 + 4 * cq) = a0; *(LAS f32x4*)(red + (kg * 2 + 1) * 128 + 4 * cq) = a1;
    __syncthreads();
    if (C.tid < 256) { const int b = C.tid >> 7, col = C.tid & 127; float s = 0.f;
#pragma unroll
        for (int k = 0; k < 16; ++k) s += red[(k * 2 + b) * 128 + col];
        C.mod[b * NMOD + item * 128 + col] = s + C.b_mod[item * 128 + col]; }
    __syncthreads();
}
__device__ __forceinline__ void p0_posw1_item(Ctx& C, int item) {
    LAS float* red = (LAS float*)C.lds;
    const int kk = item >> 2, j = (item & 3) * 64 + C.lane; float s = 0.f;
    const float* w = C.cmp_w1 + (size_t)kk * 4096 * 256 + j; const float* pp = C.cmp_pos + kk * 4096;
    for (int k = C.wave * 512; k < C.wave * 512 + 512; ++k) s += pp[k] * w[(size_t)k * 256];
    red[C.wave * 64 + C.lane] = s;
    __syncthreads();
    if (C.wave == 0) { float t = 0.f;
#pragma unroll
        for (int k = 0; k < 8; ++k) t += red[k * 64 + C.lane];
        C.posw1[kk * 256 + j] = t + C.cmp_b1[kk * 256 + j]; }
    __syncthreads();
}
__device__ __forceinline__ f16* win_row(Ctx& C, int n) {
    if (n < 3584) return C.WIN + (size_t)n * D;
    if (n < 4096) return C.WVT + (size_t)(n - 3584) * D;
    if (n < 4608) return C.WIN + (size_t)(n - 512) * D;
    if (n < 5120) return C.WVT + (size_t)(n - 4608 + 512) * D;
    if (n < 5168) return C.WG + (size_t)(n - 5120) * D;
    return C.WIN + (size_t)(n - 5168 + 4096) * D;
}
__device__ __forceinline__ void p0_transpose_item(Ctx& C, int mat, const float* src, int N, int kb, int nb, LAS float* scr) {
    const int lane = C.lane, k0 = kb * 64, n0 = nb * 64, r4 = lane >> 4, c4 = (lane & 15) * 4; const bool ok = n0 + c4 < N;
    const float* sp = src + (size_t)(k0 + r4) * N + (ok ? n0 + c4 : 0);
#pragma unroll
    for (int i = 0; i < 16; ++i) { const f32x4 v = ok ? *(const f32x4*)(sp + (size_t)(4 * i) * N) : (f32x4){0.f, 0.f, 0.f, 0.f};
        LAS float* d = scr + (4 * i + r4) * 65 + c4; d[0] = v.x; d[1] = v.y; d[2] = v.z; d[3] = v.w; }
    LDS_WAIT();
    const int c = lane & 7;
#pragma unroll
    for (int j = 0; j < 8; ++j) { const int nn = (lane >> 3) + 8 * j, ng = n0 + nn;
        if (ng < N) { const LAS float* s = scr + (8 * c) * 65 + nn;
            u32x4 o;
            if ((FFN_BF16 && (mat == 4 || mat == 5)) || (MIX_BF16 && (mat == 1 || mat == 2 || mat == 3))) { o.x = pkb(s[0], s[65]); o.y = pkb(s[2 * 65], s[3 * 65]); o.z = pkb(s[4 * 65], s[5 * 65]); o.w = pkb(s[6 * 65], s[7 * 65]); }
            else { o.x = pkh(s[0], s[65]); o.y = pkh(s[2 * 65], s[3 * 65]); o.z = pkh(s[4 * 65], s[5 * 65]); o.w = pkh(s[6 * 65], s[7 * 65]); }
            f16* rowp;
            if (mat == 0) rowp = win_row(C, ng);
            else if (mat == 1) rowp = C.WM + (size_t)ng * D;
            else if (mat == 2) rowp = C.WM + (size_t)ng * D + 2048;
            else if (mat == 3) rowp = C.WO + (size_t)ng * D;
            else if (mat == 4) { const int isup = ng >= DFF ? 1 : 0, cc = ng - isup * DFF; rowp = C.WUP + (size_t)((cc >> 7) * 256 + isup * 128 + (cc & 127)) * D; }
            else if (mat == 5) rowp = C.WDN + (size_t)ng * DFF;
            else if (mat == 6) rowp = C.W1T + (size_t)ng * D;
            else rowp = C.W1T + (size_t)(256 + ng) * D;
            *(u32x4*)(rowp + k0 + 8 * c) = o; } }
    LDS_WAIT();
}
__device__ __forceinline__ void p0_prologue(Ctx& C) {
    for (int it = C.bid; it < 200; it += C.G) { if (it < 192) p0_mod_item(C, it); else p0_posw1_item(C, it - 192); }
    const int gw = C.bid * NWAVES + C.wave, NGW = C.G * NWAVES;
    LAS float* scr = (LAS float*)(C.lds + C.wave * 16640);
    constexpr int I0 = 64 * 273, I1 = 32 * 64, I3 = 64 * 64, I4 = 64 * 344, I5 = 172 * 64, I6 = 64 * 4;
    constexpr int NIT = I0 + 2 * I1 + I3 + I4 + I5 + 2 * I6;
    for (int it = gw; it < NIT; it += NGW) {
        int r = it;
        if (r < I0) { p0_transpose_item(C, 0, C.w_in, IN_W, r / 273, r % 273, scr); continue; } r -= I0;
        if (r < I1) { p0_transpose_item(C, 1, C.w_pn, D, r / 64, r % 64, scr); continue; } r -= I1;
        if (r < I1) { p0_transpose_item(C, 2, C.w_ps, D, r / 64, r % 64, scr); continue; } r -= I1;
        if (r < I3) { p0_transpose_item(C, 3, C.w_out, D, r / 64, r % 64, scr); continue; } r -= I3;
        if (r < I4) { p0_transpose_item(C, 4, C.w_up, NUP, r / 344, r % 344, scr); continue; } r -= I4;
        if (r < I5) { p0_transpose_item(C, 5, C.w_dn, D, r / 64, r % 64, scr); continue; } r -= I5;
        if (r < I6) { p0_transpose_item(C, 6, C.cmp_w1, 256, r / 4, r % 4, scr); continue; } r -= I6;
        p0_transpose_item(C, 7, C.cmp_w1 + (size_t)4096 * 256, 256, r / 4, r % 4, scr);
    }
    const int gt = C.bid * NTHREADS + C.tid, NGT = C.G * NTHREADS;
    for (int i = gt; i < 16 * 128 * 128; i += NGT) { const int s = i & 127, t = (i >> 7) & 127; C.SGUW[i] = (f16)(s <= t ? C.sgu_w[i] : 0.f); }
    for (int i = gt; i < 2 * 128 * 256; i += NGT) { const int j = i & 255, d = (i >> 8) & 127, kk = i >> 15; C.W2T[i] = (f16)C.cmp_w2[(size_t)kk * 256 * 128 + j * 128 + d]; }
    for (int i = gt; i < 16 * D; i += NGT) C.WG[48 * D + i] = (f16)0.f;
    __syncthreads();
}

__device__ __forceinline__ void p1_norm(Ctx& C) {
    const int gw = C.bid * NWAVES + C.wave, NGW = C.G * NWAVES, lane = C.lane;
    for (int row = gw; row < M; row += NGW) {
        const int b = row >> 13; const f32x4* xr = (const f32x4*)(C.x + (size_t)row * D);
        f32x4 v[16]; float ss = 0.f;
#pragma unroll
        for (int j = 0; j < 16; ++j) { v[j] = xr[lane + 64 * j]; ss += (v[j].x * v[j].x + v[j].y * v[j].y) + (v[j].z * v[j].z + v[j].w * v[j].w); }
        const float rs = 1.0f / sqrtf(wave_sum(ss) * (1.0f / D) + EPS);
        const f32x4* g4 = (const f32x4*)(C.g_norms); const f32x4* sh = (const f32x4*)(C.mod + b * NMOD); const f32x4* sc = (const f32x4*)(C.mod + b * NMOD + D);
        u32x2* o = (u32x2*)(C.H + (size_t)row * D); unsigned* oq = (unsigned*)(C.ws + WS_H1Q + (size_t)row * D);
        float amax = 0.f;
#pragma unroll
        for (int j = 0; j < 16; ++j) { const int k = lane + 64 * j; v[j] = v[j] * rs * g4[k] * (sc[k] + 1.0f) + sh[k]; u32x2 w; w.x = pkh(v[j].x, v[j].y); w.y = pkh(v[j].z, v[j].w); o[k] = w;
            amax = fmaxf(amax, fmaxf(fmaxf(fabsf(v[j].x), fabsf(v[j].y)), fmaxf(fabsf(v[j].z), fabsf(v[j].w)))); }
        amax = fmaxf(wave_max(amax), 1e-20f);
        const float qs = 127.0f / amax;
        if (lane == 0) ((float*)(C.ws + WS_SAH))[row] = amax * (1.0f / 127.0f);
#pragma unroll
        for (int j = 0; j < 16; ++j) oq[lane + 64 * j] = pk_i8(v[j].x * qs, v[j].y * qs, v[j].z * qs, v[j].w * qs);
    }
}
__device__ __forceinline__ void p1_quant_rows(Ctx& C, const f16* src, int nrows, signed char* dst, float* scale, bool bf) {
    const int gw = C.bid * NWAVES + C.wave, NGW = C.G * NWAVES, lane = C.lane;
    for (int row = gw; row < nrows; row += NGW) {
        const u32x4* wr = (const u32x4*)(src + (size_t)row * D);
        float v[64]; float amax = 0.f;
#pragma unroll
        for (int j = 0; j < 8; ++j) { const u32x4 wv = wr[lane + 64 * j];
#pragma unroll
            for (int e = 0; e < 4; ++e) { const unsigned wd = wv[e]; float lo, hi;
                if (bf) { lo = __builtin_bit_cast(float, wd << 16); hi = __builtin_bit_cast(float, wd & 0xffff0000u); }
                else { const hx2 hv = __builtin_bit_cast(hx2, wd); lo = (float)hv.x; hi = (float)hv.y; }
                v[8 * j + 2 * e] = lo; v[8 * j + 2 * e + 1] = hi; amax = fmaxf(amax, fmaxf(fabsf(lo), fabsf(hi))); } }
        amax = fmaxf(wave_max(amax), 1e-30f);
        const float qs = 127.0f / amax;
        if (lane == 0) scale[row] = amax * (1.0f / 127.0f);
        u32x2* o = (u32x2*)(dst + (size_t)row * D);
#pragma unroll
        for (int j = 0; j < 8; ++j) { u32x2 w; w.x = pk_i8(v[8 * j] * qs, v[8 * j + 1] * qs, v[8 * j + 2] * qs, v[8 * j + 3] * qs); w.y = pk_i8(v[8 * j + 4] * qs, v[8 * j + 5] * qs, v[8 * j + 6] * qs, v[8 * j + 7] * qs); o[lane + 64 * j] = w; }
    }
}
__device__ __forceinline__ void p1_quant_weights(Ctx& C) {
    p1_quant_rows(C, C.WIN + (size_t)3072 * D, 13312, (signed char*)(C.ws + WS_WINQ), (float*)(C.ws + WS_SWQ), false);
    p1_quant_rows(C, C.WVT, 1024, (signed char*)(C.ws + WS_WVTQ), (float*)(C.ws + WS_SWQ) + 13312, false);
    p1_quant_rows(C, C.WUP, NUP, (signed char*)(C.ws + WS_WUPQ), (float*)(C.ws + WS_SW), FFN_BF16 != 0);
}
__device__ __forceinline__ void p7_norm(Ctx& C) {
    const int gw = C.bid * NWAVES + C.wave, NGW = C.G * NWAVES, lane = C.lane;
    for (int row = gw; row < M; row += NGW) {
        const int b = row >> 13; const hx8* yr = (const hx8*)(C.Y1 + (size_t)row * D); const f32x4* xr = (const f32x4*)(C.x + (size_t)row * D); u32x2* orow = (u32x2*)(C.X1H + (size_t)row * D);
        f32x4 v[16]; float ss = 0.f;
#pragma unroll
        for (int j = 0; j < 8; ++j) { const hx8 hv = yr[lane + 64 * j];
            v[2 * j] = (f32x4){(float)hv[0], (float)hv[1], (float)hv[2], (float)hv[3]}; v[2 * j + 1] = (f32x4){(float)hv[4], (float)hv[5], (float)hv[6], (float)hv[7]}; }
#pragma unroll
        for (int j = 0; j < 16; ++j) ss += (v[j].x * v[j].x + v[j].y * v[j].y) + (v[j].z * v[j].z + v[j].w * v[j].w);
        const float rs = 1.0f / sqrtf(wave_sum(ss) * (1.0f / D) + EPS);
        const f32x4* g1 = (const f32x4*)(C.g_norms + D); const f32x4* gt = (const f32x4*)(C.mod + b * NMOD + 2 * D);
        float s2 = 0.f;
#pragma unroll
        for (int j = 0; j < 16; ++j) { const int k = 2 * (lane + 64 * (j >> 1)) + (j & 1); v[j] = xr[k] + gt[k] * (v[j] * rs * g1[k]); { u32x2 xw; xw.x = pkh(v[j].x, v[j].y); xw.y = pkh(v[j].z, v[j].w); orow[k] = xw; } s2 += (v[j].x * v[j].x + v[j].y * v[j].y) + (v[j].z * v[j].z + v[j].w * v[j].w); }
        const float rs2 = 1.0f / sqrtf(wave_sum(s2) * (1.0f / D) + EPS);
        const f32x4* g2 = (const f32x4*)(C.g_norms + 2 * D); const f32x4* sh = (const f32x4*)(C.mod + b * NMOD + 3 * D); const f32x4* sc = (const f32x4*)(C.mod + b * NMOD + 4 * D);
        float amax = 0.f;
#pragma unroll
        for (int j = 0; j < 16; ++j) { const int k = 2 * (lane + 64 * (j >> 1)) + (j & 1); v[j] = v[j] * rs2 * g2[k] * (sc[k] + 1.0f) + sh[k];
            amax = fmaxf(amax, fmaxf(fmaxf(fabsf(v[j].x), fabsf(v[j].y)), fmaxf(fabsf(v[j].z), fabsf(v[j].w)))); }
        amax = fmaxf(wave_max(amax), 1e-20f);
        const float qs = 127.0f / amax;
        const bool halo = (row & 255) >= 254; const int hrow = M + 2 * (row >> 8) + (row & 1);
        if (lane == 0) { ((float*)(C.ws + WS_SA))[row] = amax * (1.0f / 127.0f); if (halo) ((float*)(C.ws + WS_SA))[hrow] = amax * (1.0f / 127.0f); }
        u32x2* o = (u32x2*)(((signed char*)(C.ws + WS_H2)) + (size_t)row * D); u32x2* oh = (u32x2*)(((signed char*)(C.ws + WS_H2)) + (size_t)hrow * D);
#pragma unroll
        for (int j = 0; j < 8; ++j) { u32x2 w; w.x = pk_i8(v[2 * j].x * qs, v[2 * j].y * qs, v[2 * j].z * qs, v[2 * j].w * qs); w.y = pk_i8(v[2 * j + 1].x * qs, v[2 * j + 1].y * qs, v[2 * j + 1].z * qs, v[2 * j + 1].w * qs);
            o[lane + 64 * j] = w; if (halo) oh[lane + 64 * j] = w; }
    }
}
__device__ __forceinline__ void p11_final(Ctx& C) {
    const int gw = C.bid * NWAVES + C.wave, NGW = C.G * NWAVES, lane = C.lane;
    for (int row = gw; row < M; row += NGW) {
        const int b = row >> 13; f32x4* orow = (f32x4*)(C.out + (size_t)row * D); const hx8* yr = (const hx8*)(C.Y2 + (size_t)row * D); const hx8* xr = (const hx8*)(C.X1H + (size_t)row * D);
        f32x4 v[16]; float ss = 0.f;
#pragma unroll
        for (int j = 0; j < 8; ++j) { const hx8 hv = yr[lane + 64 * j];
            v[2 * j] = (f32x4){(float)hv[0], (float)hv[1], (float)hv[2], (float)hv[3]}; v[2 * j + 1] = (f32x4){(float)hv[4], (float)hv[5], (float)hv[6], (float)hv[7]}; }
#pragma unroll
        for (int j = 0; j < 16; ++j) ss += (v[j].x * v[j].x + v[j].y * v[j].y) + (v[j].z * v[j].z + v[j].w * v[j].w);
        const float rs = 1.0f / sqrtf(wave_sum(ss) * (1.0f / D) + EPS);
        const f32x4* g3 = (const f32x4*)(C.g_norms + 3 * D); const f32x4* gt = (const f32x4*)(C.mod + b * NMOD + 5 * D);
#pragma unroll
        for (int j = 0; j < 8; ++j) { const hx8 xv = xr[lane + 64 * j]; const int k = 2 * (lane + 64 * j);
            const f32x4 x0 = {(float)xv[0], (float)xv[1], (float)xv[2], (float)xv[3]}, x1 = {(float)xv[4], (float)xv[5], (float)xv[6], (float)xv[7]};
            orow[k] = x0 + gt[k] * (v[2 * j] * rs * g3[k]); orow[k + 1] = x1 + gt[k + 1] * (v[2 * j + 1] * rs * g3[k + 1]); }
    }
}

__device__ __forceinline__ void p3_gates_item(Ctx& C, int item) {
    const int lane = C.lane, w = C.wave, qr = lane & 15, q = lane >> 4, mt = w & 3, kh = w >> 2;
    const f16* ap = C.H + (size_t)(item * 64 + mt * 16 + qr) * D + kh * 2048 + 8 * q;
    const f16* bp = C.WG + (size_t)qr * D + kh * 2048 + 8 * q;
    f32x4 acc[3] = {{0.f, 0.f, 0.f, 0.f}, {0.f, 0.f, 0.f, 0.f}, {0.f, 0.f, 0.f, 0.f}};
#pragma unroll 16
    for (int ks = 0; ks < 64; ++ks) { const hx8 a = *(const hx8*)(ap + 32 * ks);
#pragma unroll
        for (int nt = 0; nt < 3; ++nt) { const hx8 b = *(const hx8*)(bp + (size_t)nt * 16 * D + 32 * ks); acc[nt] = __builtin_amdgcn_mfma_f32_16x16x32_f16(a, b, acc[nt], 0, 0, 0); } }
    LAS f32x4* red = (LAS f32x4*)C.lds;
    if (kh == 1) {
#pragma unroll
        for (int nt = 0; nt < 3; ++nt) red[(mt * 3 + nt) * 64 + lane] = acc[nt]; }
    __syncthreads();
    if (kh == 0) {
#pragma unroll
        for (int nt = 0; nt < 3; ++nt) { const f32x4 s = acc[nt] + red[(mt * 3 + nt) * 64 + lane];
#pragma unroll
            for (int i = 0; i < 4; ++i) C.gates[(size_t)(item * 64 + mt * 16 + 4 * q + i) * 48 + nt * 16 + qr] = fsigmoid(s[i]); } }
    __syncthreads();
}
__device__ __forceinline__ void p3_compress_item(Ctx& C, int item) {
    const int lane = C.lane, w = C.wave, qr = lane & 15, q = lane >> 4, kk = item >> 7, R0 = (item & 127) * 32;
    LAS f16* hid = (LAS f16*)C.lds;
    LAS unsigned char* abuf = C.lds + 20480;
    const int srow = C.tid >> 4, sseg = C.tid & 15;
    const f16* sp;
    { const int R = R0 + srow, b = R >> 11, g = (R >> 9) & 3, n = R & 511, nc = n > 510 ? 510 : n; sp = C.KV + (size_t)(b * T + 16 * nc) * 2048 + kk * 512 + g * 128 + 8 * sseg; }
    const int sdst = (srow * 16 + (sseg ^ (srow & 15))) * 16;
    const f16* pb0 = C.W1T + (size_t)(kk * 256 + 32 * w + qr) * D + 8 * q; const f16* pb1 = pb0 + (size_t)16 * D;
    f32x4 acc[2][2] = {{{0.f, 0.f, 0.f, 0.f}, {0.f, 0.f, 0.f, 0.f}}, {{0.f, 0.f, 0.f, 0.f}, {0.f, 0.f, 0.f, 0.f}}};
    hx8 fb[2][8]; hx8 nxt = *(const hx8*)sp; sp += 2048;
#define CM_LOADB(buf) do { _Pragma("unroll") for (int k4 = 0; k4 < 4; ++k4) { fb[buf][2 * k4] = *(const hx8*)(pb0 + 32 * k4); fb[buf][2 * k4 + 1] = *(const hx8*)(pb1 + 32 * k4); } pb0 += 128; pb1 += 128; } while (0)
#define CM_STEP(c, buf) do { *(LAS hx8*)(abuf + ((c) & 1) * 8192 + sdst) = nxt; \
        if ((c) + 1 < 32) { nxt = *(const hx8*)sp; sp += 2048; CM_LOADB((buf) ^ 1); } \
        __syncthreads(); \
        hx8 af_[8]; _Pragma("unroll") for (int i_ = 0; i_ < 8; ++i_) { const int mt_ = i_ >> 2, k4_ = i_ & 3; af_[i_] = *(const LAS hx8*)(abuf + ((c) & 1) * 8192 + ((16 * mt_ + qr) * 16 + ((4 * k4_ + q) ^ qr)) * 16); } \
        _Pragma("unroll") for (int k4 = 0; k4 < 4; ++k4) { \
            acc[0][0] = __builtin_amdgcn_mfma_f32_16x16x32_f16(af_[k4], fb[buf][2 * k4], acc[0][0], 0, 0, 0); acc[0][1] = __builtin_amdgcn_mfma_f32_16x16x32_f16(af_[k4], fb[buf][2 * k4 + 1], acc[0][1], 0, 0, 0); \
            acc[1][0] = __builtin_amdgcn_mfma_f32_16x16x32_f16(af_[4 + k4], fb[buf][2 * k4], acc[1][0], 0, 0, 0); acc[1][1] = __builtin_amdgcn_mfma_f32_16x16x32_f16(af_[4 + k4], fb[buf][2 * k4 + 1], acc[1][1], 0, 0, 0); } } while (0)
    CM_LOADB(0);
#pragma unroll 1
    for (int c = 0; c < 32; c += 2) { CM_STEP(c, 0); CM_STEP(c + 1, 1); }
#undef CM_LOADB
#undef CM_STEP
    __syncthreads();
#pragma unroll
    for (int mt = 0; mt < 2; ++mt)
#pragma unroll
        for (int nt = 0; nt < 2; ++nt) { const int j = 32 * w + 16 * nt + qr; const float pb = C.posw1[kk * 256 + j];
#pragma unroll
            for (int i = 0; i < 4; ++i) hid[(16 * mt + 4 * q + i) * 264 + j] = (f16)fgelu(acc[mt][nt][i] + pb); }
    __syncthreads();
    const f16* wp = C.W2T + (size_t)(kk * 128 + 16 * w + qr) * 256 + 8 * q;
    f32x4 o2[2] = {{0.f, 0.f, 0.f, 0.f}, {0.f, 0.f, 0.f, 0.f}};
#pragma unroll
    for (int ks = 0; ks < 8; ++ks) { const hx8 wf = *(const hx8*)(wp + 32 * ks);
#pragma unroll
        for (int mt = 0; mt < 2; ++mt) { const hx8 hf = *(const LAS hx8*)(hid + (16 * mt + qr) * 264 + 32 * ks + 8 * q);
            if (kk == 0) o2[mt] = __builtin_amdgcn_mfma_f32_16x16x32_f16(wf, hf, o2[mt], 0, 0, 0);
            else o2[mt] = __builtin_amdgcn_mfma_f32_16x16x32_f16(hf, wf, o2[mt], 0, 0, 0); } }
    if (kk == 0) {
#pragma unroll
        for (int mt = 0; mt < 2; ++mt) { const int R = R0 + 16 * mt + qr, n = R & 511, d0 = 16 * w + 4 * q; const bool pad = n == 511;
            float v[4];
#pragma unroll
            for (int i = 0; i < 4; ++i) v[i] = pad ? 0.f : o2[mt][i] + C.cmp_b2[d0 + i];
            u32x2 o; o.x = pkh(v[0], v[1]); o.y = pkh(v[2], v[3]); *(u32x2*)(C.KC + (size_t)R * 128 + d0) = o; }
    } else {
#pragma unroll
        for (int mt = 0; mt < 2; ++mt) { const int Rb = R0 + 16 * mt + 4 * q, bg = Rb >> 9, n0 = Rb & 511, d = 16 * w + qr; const float bb = C.cmp_b2[128 + d];
            float v[4];
#pragma unroll
            for (int i = 0; i < 4; ++i) v[i] = (n0 + i == 511) ? 0.f : o2[mt][i] + bb;
            u32x2 o; o.x = pkh(v[0], v[1]); o.y = pkh(v[2], v[3]); *(u32x2*)(C.VCT + ((size_t)bg * 128 + d) * 512 + n0) = o; }
    }
    __syncthreads();
}
__device__ __forceinline__ void p3_sgu_item(Ctx& C, int item) {
    const int lane = C.lane, w = C.wave, tid = C.tid, qr = lane & 15, q = lane >> 4, r0 = (item >> 1) * 128, half = item & 1;
    LAS float* stats = (LAS float*)C.lds;
    LAS f16* vt = (LAS f16*)(C.lds + 1024);
#pragma unroll 4
    for (int tk = 0; tk < 16; ++tk) { const int s = 16 * w + tk; const f16* vp = C.Z + (size_t)(r0 + s) * D + 2048 + 8 * lane;
        float xv[32]; float sum = 0.f;
#pragma unroll
        for (int jj = 0; jj < 4; ++jj) { const hx8 h = *(const hx8*)(vp + 512 * jj);
#pragma unroll
            for (int e = 0; e < 8; ++e) { xv[8 * jj + e] = (float)h[e]; sum += xv[8 * jj + e]; } }
        const float mu = wave_sum(sum) * (1.0f / 2048.0f); float sq = 0.f;
#pragma unroll
        for (int e = 0; e < 32; ++e) { const float dv = xv[e] - mu; sq += dv * dv; }
        const float var = wave_sum(sq) * (1.0f / 2048.0f);
        if (lane == 0) { stats[2 * s] = mu; stats[2 * s + 1] = 1.0f / sqrtf(var + EPS); } }
    __syncthreads();
    for (int gi = 0; gi < 8; ++gi) { const int hh = half * 8 + gi;
        { const int s = tid >> 2, seg = tid & 3; const float mu = stats[2 * s], rstd = stats[2 * s + 1];
          const f16* vp = C.Z + (size_t)(r0 + s) * D + 2048 + hh * 128 + 32 * seg;
#pragma unroll
          for (int i = 0; i < 4; ++i) { const hx8 h = *(const hx8*)(vp + 8 * i);
#pragma unroll
              for (int e = 0; e < 8; ++e) { const int d = 32 * seg + 8 * i + e; const float y = ((float)h[e] - mu) * rstd * C.ln_g[hh * 128 + d] + C.ln_b[hh * 128 + d]; vt[d * 136 + s] = (f16)y; } } }
        __syncthreads();
        hx8 wf[4];
#pragma unroll
        for (int ks = 0; ks < 4; ++ks) wf[ks] = *(const hx8*)(C.SGUW + ((size_t)(hh * 128 + 16 * w + qr)) * 128 + 32 * ks + 8 * q);
        f32x4 acc[8];
#pragma unroll
        for (int dt = 0; dt < 8; ++dt) { acc[dt] = (f32x4){0.f, 0.f, 0.f, 0.f};
#pragma unroll
            for (int ks = 0; ks < 4; ++ks) { const hx8 af = *(const LAS hx8*)(vt + (16 * dt + qr) * 136 + 32 * ks + 8 * q); acc[dt] = __builtin_amdgcn_mfma_f32_16x16x32_f16(af, wf[ks], acc[dt], 0, 0, 0); } }
        { const int tl = 16 * w + qr; const float bs = C.sgu_b[hh * 128 + tl];
          const f16* up = C.Z + (size_t)(r0 + tl) * D + hh * 128 + 4 * q; f16* yp = C.YAB + (size_t)(r0 + tl) * D + 2048 + hh * 128 + 4 * q;
#pragma unroll
          for (int dt = 0; dt < 8; ++dt) { const hx4 u = *(const hx4*)(up + 16 * dt);
              u32x2 o; o.x = pk_mix((float)u[0] * (acc[dt][0] + bs), (float)u[1] * (acc[dt][1] + bs)); o.y = pk_mix((float)u[2] * (acc[dt][2] + bs), (float)u[3] * (acc[dt][3] + bs));
              *(u32x2*)(yp + 16 * dt) = o; } }
        __syncthreads();
    }
}

constexpr int ATT_LUT = 0, ATT_IMP = 8192, ATT_STG = 40960, STG_BYTES = 32768, STG_V = 16384;
static_assert(ATT_STG + 3 * STG_BYTES <= MISC_OFF, "attention LDS map");
__device__ __forceinline__ int rel_bucket_small(int n) {
    if (n < 16) return n;
    int b = 16;
    b += n >= 19; b += n >= 21; b += n >= 24; b += n >= 27; b += n >= 31; b += n >= 35; b += n >= 40; b += n >= 46; b += n >= 52; b += n >= 59; b += n >= 67; b += n >= 77; b += n >= 87; b += n >= 99; b += n >= 113;
    return b;
}
__device__ __forceinline__ void att_issue(Ctx& C, int s, int n_c, int n_s, int ks0g, int b, int g) {
    const int lane = (int)pg8::opaque((unsigned)C.lane), w = C.wave;
    const f16* kb; const f16* vb; int ldk, ldv, kb0;
    if (s < 2 * n_c) { kb0 = 64 * (s < n_c ? s : s - n_c); kb = C.KC + (size_t)(b * 4 + g) * 512 * 128; ldk = 128; vb = C.VCT + (size_t)(b * 4 + g) * 128 * 512; ldv = 512; }
    else if (s < 2 * n_c + n_s) { kb0 = 64 * (s - 2 * n_c); kb = C.KV + (size_t)b * T * 2048 + 1024 + g * 128; ldk = 2048; vb = C.VT + (size_t)(g * 128) * M + (size_t)b * T; ldv = M; }
    else { kb0 = ks0g + 64 * (s - 2 * n_c - n_s); kb = C.KV + (size_t)b * T * 2048 + 1536 + g * 128; ldk = 2048; vb = C.VT + (size_t)(512 + g * 128) * M + (size_t)b * T; ldv = M; }
    LAS unsigned char* buf = C.lds + ATT_STG + (s % 3) * STG_BYTES;
#pragma unroll
    for (int i = 0; i < 2; ++i) { const int R = 8 * w + 4 * i + (lane >> 4), m = R & 15, key = kb0 + 32 * (R >> 5) + (m >> 2) * 8 + (m & 3) + 4 * ((R >> 4) & 1), cidx = (lane & 15) ^ m;
        __builtin_amdgcn_global_load_lds((const unsigned*)(kb + (size_t)key * ldk + cidx * 8), (LAS unsigned*)(buf + (8 * w + 4 * i) * 256), 16, 0, 0); }
#pragma unroll
    for (int i = 0; i < 2; ++i) { const int dr = 16 * w + 8 * i + (lane >> 3), v = (lane & 7) ^ ((dr & 15) >> 1);
        __builtin_amdgcn_global_load_lds((const unsigned*)(vb + (size_t)dr * ldv + kb0 + 8 * v), (LAS unsigned*)(buf + STG_V + (16 * w + 8 * i) * 128), 16, 0, 0); }
}
#define SB() __builtin_amdgcn_sched_barrier(0)
#define ATT_QK2(TL) do { _Pragma("unroll") for (int scn_ = 0; scn_ < 2; ++scn_) { hx8 kf_[8]; \
        _Pragma("unroll") for (int i_ = 0; i_ < 8; ++i_) { const int kt_ = i_ >> 2, ks_ = i_ & 3; \
            kf_[i_] = *(const LAS hx8*)(bufp + scn_ * 8192 + kt_ * 4096 + qr * 256 + (((4 * ks_ + q) ^ qr) << 4)); } \
        __builtin_amdgcn_s_setprio(1); \
        _Pragma("unroll") for (int t_ = 0; t_ < 2; ++t_) { f32x4 a_ = {0.f, 0.f, 0.f, 0.f}; \
            _Pragma("unroll") for (int ks = 0; ks < 4; ++ks) a_ = __builtin_amdgcn_mfma_f32_16x16x32_f16(kf_[4 * t_ + ks], qf[TL][ks], a_, 0, 0, 0); sv[2 * scn_ + t_] = a_; } \
        __builtin_amdgcn_s_setprio(0); } } while (0)
#define SVJ(tl, j) (sv[(j) >> 2][(j) & 3])
#define ATT_PV2() do { SB(); \
    _Pragma("unroll") for (int sn_ = 0; sn_ < 2; ++sn_) { hx8 vf_[8]; \
        _Pragma("unroll") for (int dt_ = 0; dt_ < 8; ++dt_) vf_[dt_] = *(const LAS hx8*)(bufp + STG_V + qr * 128 + (((4 * sn_ + q) ^ (qr >> 1)) << 4) + dt_ * 2048); \
        _Pragma("unroll") for (int tl_ = 0; tl_ < 2; ++tl_) { if (act[tl_]) { _Pragma("unroll") for (int dt = 0; dt < 8; ++dt) o[tl_][dt] = __builtin_amdgcn_mfma_f32_16x16x32_f16(vf_[dt], pf[tl_][sn_], o[tl_][dt], 0, 0, 0); } } } \
    SB(); } while (0)
#define ATT_MAXUPD(TL, RESCALE_O) do { if (__any(cm_ > m[TL] + 8.0f)) { cm_ = fmaxf(cm_, __shfl_xor(cm_, 16)); cm_ = fmaxf(cm_, __shfl_xor(cm_, 32)); \
    const float mn_ = fmaxf(m[TL], cm_); const float al_ = __builtin_amdgcn_exp2f(m[TL] - mn_); m[TL] = mn_; l[TL] *= al_; \
    if (RESCALE_O) { _Pragma("unroll") for (int dt = 0; dt < 8; ++dt) o[TL][dt] *= al_; } } } while (0)
#define ATT_PACKP(TL) do { _Pragma("unroll") for (int j = 0; j < 8; ++j) { pf[TL][0][j] = (f16)p[j]; pf[TL][1][j] = (f16)p[8 + j]; } } while (0)
#define ATT_SOFTMAX_FAR(TL, cb_, RESCALE_O) do { float mx_ = SVJ(TL, 0); _Pragma("unroll") for (int j = 1; j < 16; ++j) mx_ = fmaxf(mx_, SVJ(TL, j)); \
    float cm_ = mx_ * SC2 + (cb_); ATT_MAXUPD(TL, RESCALE_O); const float off_ = (cb_) - m[TL]; float ps_ = 0.f; \
    _Pragma("unroll") for (int j = 0; j < 16; ++j) { const float e_ = __builtin_amdgcn_exp2f(SVJ(TL, j) * SC2 + off_); ps_ += e_; pf[TL][j >> 3][j & 7] = (f16)e_; } l[TL] += ps_; } while (0)
#define ATT_SOFTMAX_NEAR(TL, RESCALE_O) do { float cm_ = sc[0]; _Pragma("unroll") for (int j = 1; j < 16; ++j) cm_ = fmaxf(cm_, sc[j]); \
    ATT_MAXUPD(TL, RESCALE_O); float ps_ = 0.f; \
    _Pragma("unroll") for (int j = 0; j < 16; ++j) { const float e_ = __builtin_amdgcn_exp2f(sc[j] - m[TL]); ps_ += e_; pf[TL][j >> 3][j & 7] = (f16)e_; } l[TL] += ps_; } while (0)
#define ATT_STAGE_BEGIN() do { if (s + 1 < S) asm volatile("s_waitcnt vmcnt(4)" ::: "memory"); else asm volatile("s_waitcnt vmcnt(0)" ::: "memory"); \
    __builtin_amdgcn_s_barrier(); asm volatile("" ::: "memory"); \
    if (s + 2 < S) att_issue(C, s + 2, n_c, n_s, ks0g, b, g); \
    bufp = C.lds + ATT_STG + (s % 3) * STG_BYTES; } while (0)
constexpr float NEGBIG = -3.0e38f;

__device__ __forceinline__ void p4_attn_unit(Ctx& C, int u) {
    const int lane = C.lane, w = C.wave, qr = lane & 15, q = lane >> 4, tok = qr >> 2, r = qr & 3;
    const int bg = u & 7, b = bg >> 2, g = bg & 3, tj = u >> 3, t0g = tj * 64, t0 = t0g + w * 8, h = g * 4 + r;
    const LAS float* lut = (const LAS float*)(C.lds + ATT_LUT) + h * 128;
    LAS float* imp = (LAS float*)(C.lds + ATT_IMP) + w * 1024;
    const LAS unsigned char* bufp = C.lds + ATT_STG;
    const int n_c = (tj >> 4) + 1, n_s = tj + 1, ks0g = (t0g - 511 < 0 ? 0 : t0g - 511) & ~63, n_w = ((t0g + 63 - ks0g) >> 6) + 1, S = 2 * n_c + n_s + n_w;
    hx8 qf[2][4];
#pragma unroll
    for (int tl = 0; tl < 2; ++tl) { const int t = t0 + 4 * tl + tok; const f16* qp = C.Q + (size_t)(b * T + t) * 2048 + h * 128 + 8 * q;
#pragma unroll
        for (int ks = 0; ks < 4; ++ks) qf[tl][ks] = *(const hx8*)(qp + 32 * ks); }
#define GATE(tl, i) (C.gates[(size_t)(b * T + t0 + 4 * (tl) + tok) * 48 + h * 3 + (i)])
#define YSP(tl) ((f32x4*)(C.ysc + (size_t)(b * T + t0 + 4 * (tl) + tok) * 2048 + h * 128 + 4 * q))
    const float b127 = lut[127];
    f32x4 o[2][8], sv[4]; hx8 pf[2][2]; float sc[16], p[16], m[2], l[2]; bool act[2];
#pragma unroll
    for (int tl = 0; tl < 2; ++tl)
#pragma unroll
        for (int dt = 0; dt < 8; ++dt) o[tl][dt] = (f32x4){0.f, 0.f, 0.f, 0.f};
    for (int i = lane; i < 1024; i += 64) imp[i] = 0.f;
    asm volatile("s_waitcnt vmcnt(0) lgkmcnt(0)" ::: "memory");
    __syncthreads();
    int s = 0;
    att_issue(C, 0, n_c, n_s, ks0g, b, g); att_issue(C, 1, n_c, n_s, ks0g, b, g);

    m[0] = m[1] = -1e30f; l[0] = l[1] = 0.f;
    for (int c = 0; c < n_c; ++c, ++s) {
        ATT_STAGE_BEGIN();
        const int kb0 = 64 * c;
        act[0] = kb0 <= ((t0 + 3 - 31) >> 4); act[1] = kb0 <= ((t0 + 7 - 31) >> 4);
        if (!act[1]) continue;
#pragma unroll
        for (int tl = 0; tl < 2; ++tl) { if (act[tl]) { const int tb = t0 + 4 * tl, t = tb + tok, nmax_t = (t - 31) >> 4;
            ATT_QK2(tl);
            if (kb0 + 63 <= ((tb - 31) >> 4) && tb - 16 * (kb0 + 63) - 31 >= 127) { ATT_SOFTMAX_FAR(tl, b127, false); }
            else {
#pragma unroll
                for (int j = 0; j < 16; ++j) { const int n = kb0 + 32 * (j >> 3) + 8 * q + (j & 7), dist = t - 16 * n - 31;
                    const int di = dist < 0 ? 0 : (dist > 127 ? 127 : dist); const float lv = lut[di]; const float sx = SVJ(tl, j) * SC2 + lv; sc[j] = n <= nmax_t ? sx : NEGBIG; }
                ATT_SOFTMAX_NEAR(tl, false); } } }
    }
    float il[2];
#pragma unroll
    for (int tl = 0; tl < 2; ++tl) { l[tl] += __shfl_xor(l[tl], 16); l[tl] += __shfl_xor(l[tl], 32); il[tl] = l[tl] > 0.f ? 1.0f / l[tl] : 0.f; }
    float carry[2] = {0.f, 0.f};
    for (int c = 0; c < n_c; ++c, ++s) {
        ATT_STAGE_BEGIN();
        const int kb0 = 64 * c;
        act[0] = kb0 <= ((t0 + 3 - 31) >> 4); act[1] = kb0 <= ((t0 + 7 - 31) >> 4);
        if (!act[1]) continue;
#pragma unroll
        for (int tl = 0; tl < 2; ++tl) { if (act[tl]) { const int t = t0 + 4 * tl + tok, nmax_t = (t - 31) >> 4;
            ATT_QK2(tl);
#pragma unroll
            for (int j = 0; j < 16; ++j) { const int n = kb0 + 32 * (j >> 3) + 8 * q + (j & 7), dist = t - 16 * n - 31;
                const int di = dist < 0 ? 0 : (dist > 127 ? 127 : dist); const float lv = lut[di]; const float px = __builtin_amdgcn_exp2f(SVJ(tl, j) * SC2 + lv - m[tl]) * il[tl]; p[j] = n <= nmax_t ? px : 0.f; }
            ATT_PACKP(tl);
#pragma unroll
            for (int scn = 0; scn < 2; ++scn) { float ph[8];
#pragma unroll
                for (int j = 0; j < 8; ++j) { float v = p[8 * scn + j]; v += dpp_f<0xB1>(v); v += dpp_f<0x4E>(v); ph[j] = v; }
                const float t7 = __shfl(ph[7], (lane + 48) & 63);
                const float left = q == 0 ? carry[tl] : t7; carry[tl] = t7;
                if (r == 0) { f32x2 iv; iv.x = left + 2.0f * (ph[0] + ph[1] + ph[2]) + ph[3]; iv.y = ph[3] + 2.0f * (ph[4] + ph[5] + ph[6]) + ph[7];
                    *(LAS f32x2*)(imp + (4 * tl + tok) * 128 + ((kb0 + 32 * scn) >> 2) + 2 * q) = iv; } } } }
        ATT_PV2();
    }
#pragma unroll
    for (int tl = 0; tl < 2; ++tl) { f32x4* ysp = YSP(tl); const float gc = GATE(tl, 0);
#pragma unroll
        for (int dt = 0; dt < 8; ++dt) { ysp[4 * dt] = o[tl][dt] * gc; o[tl][dt] = (f32x4){0.f, 0.f, 0.f, 0.f}; } }
    LDS_WAIT();
    unsigned long long my_lo[2] = {0ull, 0ull}, my_hi[2] = {0ull, 0ull}, U_lo[2] = {0ull, 0ull}, U_hi[2] = {0ull, 0ull};
#pragma unroll
    for (int tk = 0; tk < 8; ++tk) { const int tt = t0 + tk, cur = tt >> 6; unsigned long long lo, hi;
        if (cur < 16) { lo = (1ull << (cur + 1)) - 1ull; hi = 0ull; }
        else {
            LAS float* P = imp + tk * 128;
            const int j0 = lane, j1 = lane + 64;
            const bool c0 = j0 >= 1 && j0 <= cur - 2, c1 = j1 <= cur - 2;
            const float i0 = c0 ? P[j0] : -1.0f, i1 = c1 ? P[j1] : -1.0f;
            LDS_WAIT();
            P[j0] = i0; P[j1] = i1;
            LDS_WAIT();
            int r0 = 0, r1 = 0;
            for (int jp = 0; jp <= cur - 2; jp += 4) { const f32x4 v = *(const LAS f32x4*)(P + jp);
#pragma unroll
                for (int e = 0; e < 4; ++e) { r0 += (v[e] > i0 || (v[e] == i0 && jp + e < j0)) ? 1 : 0; r1 += (v[e] > i1 || (v[e] == i1 && jp + e < j1)) ? 1 : 0; } }
            const bool sel0 = (c0 && r0 < 13) || j0 == 0 || j0 == cur || j0 == cur - 1, sel1 = (c1 && r1 < 13) || j1 == cur || j1 == cur - 1;
            lo = __ballot(sel0); hi = __ballot(sel1);
        }
        U_lo[tk >> 2] |= lo; U_hi[tk >> 2] |= hi; if (tok == (tk & 3)) { my_lo[tk >> 2] = lo; my_hi[tk >> 2] = hi; } }
    m[0] = m[1] = -1e30f; l[0] = l[1] = 0.f;
    for (int jb = 0; jb < n_s; ++jb, ++s) {
        ATT_STAGE_BEGIN();
        bool mine[2];
#pragma unroll
        for (int tl = 0; tl < 2; ++tl) { act[tl] = jb < 64 ? ((U_lo[tl] >> jb) & 1ull) : ((U_hi[tl] >> (jb - 64)) & 1ull); mine[tl] = jb < 64 ? ((my_lo[tl] >> jb) & 1ull) : ((my_hi[tl] >> (jb - 64)) & 1ull); }
        if (!act[0] && !act[1]) continue;
        const int kb0 = 64 * jb;
#pragma unroll
        for (int tl = 0; tl < 2; ++tl) { if (act[tl]) { const int tb = t0 + 4 * tl, t = tb + tok;
            ATT_QK2(tl);
            if (tb - (kb0 + 63) >= 127) { const float cb = mine[tl] ? b127 : NEGBIG; ATT_SOFTMAX_FAR(tl, cb, true); }
            else { const int bd = t - kb0 - 8 * q;
#pragma unroll
                for (int j = 0; j < 16; ++j) { const int dist = bd - 32 * (j >> 3) - (j & 7);
                    const int di = dist < 0 ? 0 : (dist > 127 ? 127 : dist); const float lv = lut[di]; const float sx = SVJ(tl, j) * SC2 + lv; sc[j] = (mine[tl] && dist >= 0) ? sx : NEGBIG; }
                ATT_SOFTMAX_NEAR(tl, true); } } }
        ATT_PV2();
    }
#pragma unroll
    for (int tl = 0; tl < 2; ++tl) { l[tl] += __shfl_xor(l[tl], 16); l[tl] += __shfl_xor(l[tl], 32); const float gl = l[tl] > 0.f ? GATE(tl, 1) / l[tl] : 0.f; f32x4* ysp = YSP(tl);
#pragma unroll
        for (int dt = 0; dt < 8; ++dt) { ysp[4 * dt] = ysp[4 * dt] + o[tl][dt] * gl; o[tl][dt] = (f32x4){0.f, 0.f, 0.f, 0.f}; } }
    m[0] = m[1] = -1e30f; l[0] = l[1] = 0.f;
    for (int k = 0; k < n_w; ++k, ++s) {
        ATT_STAGE_BEGIN();
        const int kb0 = ks0g + 64 * k;
#pragma unroll
        for (int tl = 0; tl < 2; ++tl) { const int tb = t0 + 4 * tl; act[tl] = !(kb0 > tb + 3 || kb0 + 63 < tb - 511); }
        if (!act[0] && !act[1]) continue;
#pragma unroll
        for (int tl = 0; tl < 2; ++tl) { if (act[tl]) { const int tb = t0 + 4 * tl, t = tb + tok;
            ATT_QK2(tl);
            if (tb - (kb0 + 63) >= 127 && tb + 3 - kb0 <= 511) { ATT_SOFTMAX_FAR(tl, b127, true); }
            else { const int bd = t - kb0 - 8 * q;
#pragma unroll
                for (int j = 0; j < 16; ++j) { const int dist = bd - 32 * (j >> 3) - (j & 7);
                    const int di = dist < 0 ? 0 : (dist > 127 ? 127 : dist); const float lv = lut[di]; const float sx = SVJ(tl, j) * SC2 + lv; sc[j] = (dist >= 0 && dist < 512) ? sx : NEGBIG; }
                ATT_SOFTMAX_NEAR(tl, true); } } }
        ATT_PV2();
    }
#pragma unroll
    for (int tl = 0; tl < 2; ++tl) { l[tl] += __shfl_xor(l[tl], 16); l[tl] += __shfl_xor(l[tl], 32); const float gl = l[tl] > 0.f ? GATE(tl, 2) / l[tl] : 0.f; const f32x4* ysp = YSP(tl);
        f16* yp = C.YAB + (size_t)(b * T + t0 + 4 * tl + tok) * D + h * 128 + 4 * q;
#pragma unroll
        for (int dt = 0; dt < 8; ++dt) { const f32x4 yv = ysp[4 * dt] + o[tl][dt] * gl; u32x2 ov; ov.x = pk_mix(yv[0], yv[1]); ov.y = pk_mix(yv[2], yv[3]); *(u32x2*)(yp + 16 * dt) = ov; } }
}
#undef GATE
#undef YSP
__device__ __forceinline__ void p4_attention(Ctx& C) {
    LAS float* lut = (LAS float*)(C.lds + ATT_LUT);
    for (int i = C.tid; i < 16 * 128; i += NTHREADS) { const int hh = i >> 7, n = i & 127; lut[i] = C.rel_table[rel_bucket_small(n) * 16 + hh] * LOG2E; }
    __syncthreads();
    for (int u = C.bid; u < 1024; u += C.G) p4_attn_unit(C, u);
    __syncthreads();
}

__device__ __forceinline__ void p9_fixup(Ctx& C) {
    const int gt = C.bid * NTHREADS + C.tid, NGT = C.G * NTHREADS;
    for (int it = gt; it < 64 * (DFF / 8); it += NGT) {
        const int pm = it / (DFF / 8), c0 = (it % (DFF / 8)) * 8; const bool first = ((pm * 256) & (T - 1)) == 0;
        float res[2][8];
#pragma unroll
        for (int h4 = 0; h4 < 2; ++h4) {
            f32x4 cvv[2][2];
#pragma unroll
            for (int bj = 0; bj < 2; ++bj) { const int cc = c0 + 4 * h4;
                const f32x4 w0 = *(const f32x4*)(C.conv_w + 0 * NUP + bj * DFF + cc), w1 = *(const f32x4*)(C.conv_w + 1 * NUP + bj * DFF + cc), w2 = *(const f32x4*)(C.conv_w + 2 * NUP + bj * DFF + cc), bb = *(const f32x4*)(C.conv_b + bj * DFF + cc);
                const f32x4 a0 = *(const f32x4*)(C.AT + (size_t)((pm * 2 + 0) * 2 + bj) * DFF + cc), a1 = *(const f32x4*)(C.AT + (size_t)((pm * 2 + 1) * 2 + bj) * DFF + cc);
                f32x4 hm2 = {0.f, 0.f, 0.f, 0.f}, hm1 = {0.f, 0.f, 0.f, 0.f};
                if (!first) { hm2 = *(const f32x4*)(C.AH + (size_t)((2 * (pm - 1) + 0) * 2 + bj) * DFF + cc); hm1 = *(const f32x4*)(C.AH + (size_t)((2 * (pm - 1) + 1) * 2 + bj) * DFF + cc); }
                cvv[0][bj] = bb + w0 * hm2 + w1 * hm1 + w2 * a0; cvv[1][bj] = bb + w0 * hm1 + w1 * a0 + w2 * a1; }
#pragma unroll
            for (int j = 0; j < 2; ++j)
#pragma unroll
                for (int i = 0; i < 4; ++i) res[j][4 * h4 + i] = fsilu(cvv[j][0][i]) * cvv[j][1][i]; }
#pragma unroll
        for (int j = 0; j < 2; ++j) { u32x4 ov; ov.x = pk_ffn(res[j][0], res[j][1]); ov.y = pk_ffn(res[j][2], res[j][3]); ov.z = pk_ffn(res[j][4], res[j][5]); ov.w = pk_ffn(res[j][6], res[j][7]);
            *(u32x4*)(C.ACT + (size_t)(pm * 256 + j) * DFF + c0) = ov; }
    }
}

__device__ __forceinline__ void ph2_proj(Ctx& C) {
    { pg8::Gemm g{C.H, C.WIN, M, 3072, D}; pg8::StaticOrder S; S.init(M, 3072, C.G, C.bid);
      pg8::EpiProj E{C.Q, C.KV, C.Z, C.GA, C.GB, 0};
      pg8::gemm_phase<pg8::EpiProj, pg8::StaticOrder>(C.lds, g, S, E); }
    { pg8::Gemm g{C.H, C.WIN + (size_t)4096 * D, M, 4096, D}; pg8::StaticOrder S; S.init(M, 4096, C.G, C.bid);
      pg8::EpiProj E{C.Q, C.KV, C.Z, C.GA, C.GB, 16};
      pg8::gemm_phase<pg8::EpiProj, pg8::StaticOrder>(C.lds, g, S, E); }
    { pg8::Gemm g{(const f16*)(C.ws + WS_H1Q), (const f16*)(C.ws + WS_WINQ), M, 1024, D / 2}; pg8::StaticOrder S; S.init(M, 1024, C.G, C.bid);
      pg8::EpiProjQ E{C.ws, 12};
      pg8::gemm_phase<pg8::EpiProjQ, pg8::StaticOrder, true, 2>(C.lds, g, S, E); }
    { pg8::Gemm g{(const f16*)(C.ws + WS_H1Q), (const f16*)(C.ws + WS_WINQ + (size_t)5120 * D), M, 8192, D / 2}; pg8::StaticOrder S; S.init(M, 8192, C.G, C.bid);
      pg8::EpiProjQ E{C.ws, 32};
      pg8::gemm_phase<pg8::EpiProjQ, pg8::StaticOrder, true, 2>(C.lds, g, S, E); }
    { pg8::Gemm g{(const f16*)(C.ws + WS_WVTQ), (const f16*)(C.ws + WS_H1Q), 1024, M, D / 2}; pg8::StaticOrder S; S.init(1024, M, C.G, C.bid);
      pg8::EpiVTQ E{C.ws};
      pg8::gemm_phase<pg8::EpiVTQ, pg8::StaticOrder, true, 2>(C.lds, g, S, E); }
}
__device__ __forceinline__ void ph3_mixers(Ctx& C) {
    for (int it = C.bid; it < 256; it += C.G) p3_gates_item(C, it);
    if constexpr (((PROBE_DUP) >> 12) & 1) { for (int it = C.bid; it < 256; it += C.G) p3_gates_item(C, it); }
    for (int it = C.bid; it < 256; it += C.G) p3_compress_item(C, it);
    if constexpr (((PROBE_DUP) >> 13) & 1) { for (int it = C.bid; it < 256; it += C.G) p3_compress_item(C, it); }
    for (int it = C.bid; it < 256; it += C.G) p3_sgu_item(C, it);
    if constexpr (((PROBE_DUP) >> 14) & 1) { for (int it = C.bid; it < 256; it += C.G) p3_sgu_item(C, it); }
}
__device__ __forceinline__ void ph5_merge(Ctx& C) {
    pg8::Gemm g{C.YAB, C.WM, M, D, D}; pg8::StaticOrder S; S.init(M, D, C.G, C.bid);
    pg8::EpiMerge E{C.GA, C.GB, C.H};
    pg8::gemm_phase<pg8::EpiMerge, pg8::StaticOrder, true, MIX_BF16 ? 1 : 0>(C.lds, g, S, E);
}
__device__ __forceinline__ void ph6_out(Ctx& C) {
    pg8::Gemm g{C.H, C.WO, M, D, D}; pg8::StaticOrder S; S.init(M, D, C.G, C.bid);
    pg8::EpiH16 E{C.Y1, D};
    pg8::gemm_phase<pg8::EpiH16, pg8::StaticOrder, true, MIX_BF16 ? 1 : 0>(C.lds, g, S, E);
}
__device__ __forceinline__ void ph8_up(Ctx& C) {
    pg8::Gemm g{(const f16*)((signed char*)(C.ws + WS_H2)), (const f16*)((signed char*)(C.ws + WS_WUPQ)), M + 256, NUP, D / 2}; pg8::StaticOrder S; S.init(M + 256, NUP, C.G, C.bid);
    pg8::EpiConv E{C.ws, C.conv_w, C.conv_b, (LAS float*)(C.lds + pg8::STAGE_BYTES), FFN_BF16};
    pg8::gemm_phase<pg8::EpiConv, pg8::StaticOrder, true, 2>(C.lds, g, S, E);
}
__device__ __forceinline__ void ph9_conv(Ctx& C) { p9_fixup(C); }
__device__ __forceinline__ void ph10_down(Ctx& C) {
    pg8::Gemm g{C.ACT, C.WDN, M, D, DFF}; pg8::StaticOrder S; S.init(M, D, C.G, C.bid);
    pg8::EpiH16 E{C.Y2, D};
    pg8::gemm_phase<pg8::EpiH16, pg8::StaticOrder, true, FFN_BF16 ? 1 : 0>(C.lds, g, S, E);
}

constexpr int NPHASE = 12;
__global__ void __launch_bounds__(NTHREADS, 2) fwd_kernel(Args args) {
    extern __shared__ __attribute__((aligned(16))) unsigned char lds_raw[];
    Ctx C;
    C.lds = (LAS unsigned char*)lds_raw;
    C.tid = threadIdx.x; C.lane = C.tid & 63; C.wave = __builtin_amdgcn_readfirstlane(C.tid >> 6); C.G = gridDim.x; C.bid = blockIdx.x;
    C.x = args.in[0]; C.c = args.in[1]; C.w_mod = args.in[2]; C.b_mod = args.in[3]; C.g_norms = args.in[4]; C.w_in = args.in[5]; C.cmp_pos = args.in[6]; C.cmp_w1 = args.in[7];
    C.cmp_b1 = args.in[8]; C.cmp_w2 = args.in[9]; C.cmp_b2 = args.in[10]; C.rel_table = args.in[11]; C.ln_g = args.in[12]; C.ln_b = args.in[13]; C.sgu_w = args.in[14]; C.sgu_b = args.in[15];
    C.w_pn = args.in[16]; C.w_ps = args.in[17]; C.w_out = args.in[18]; C.w_up = args.in[19]; C.conv_w = args.in[20]; C.conv_b = args.in[21]; C.w_dn = args.in[22];
    C.out = args.out; C.ws = args.ws; unsigned char* ws = args.ws;
    C.mod = (float*)(ws + WS_MOD); C.posw1 = (float*)(ws + WS_POSW1); C.gates = (float*)(ws + WS_GATES); C.ysc = (float*)(ws + WS_YSC); C.AH = (float*)(ws + WS_AH); C.AT = (float*)(ws + WS_AT); C.Y1 = (f16*)(ws + WS_Z); C.Y2 = (f16*)(ws + WS_Y2); C.X1H = (f16*)(ws + WS_X1H);
    C.W2T = (f16*)(ws + WS_W2T); C.SGUW = (f16*)(ws + WS_SGUW); C.WG = (f16*)(ws + WS_WG); C.KC = (f16*)(ws + WS_KC); C.VCT = (f16*)(ws + WS_VCT); C.W1T = (f16*)(ws + WS_W1T);
    C.WUP = (f16*)(ws + WS_WUP); C.WDN = (f16*)(ws + WS_WDN); C.WIN = (f16*)(ws + WS_WIN); C.WVT = (f16*)(ws + WS_WVT); C.WM = (f16*)(ws + WS_WM); C.WO = (f16*)(ws + WS_WO);
    C.H = (f16*)(ws + WS_H); C.Q = (f16*)(ws + WS_Q); C.KV = (f16*)(ws + WS_KV); C.VT = (f16*)(ws + WS_VT); C.Z = (f16*)(ws + WS_Z); C.GA = (f16*)(ws + WS_GA); C.GB = (f16*)(ws + WS_GB);
    C.YAB = (f16*)(ws + WS_YAB); C.H2 = (f16*)(ws + WS_H2); C.ACT = (f16*)(ws + WS_ACT);

    volatile LAS unsigned* MISC = (volatile LAS unsigned*)(C.lds + MISC_OFF);
    for (int u = C.tid; u < (LDS_BYTES - MISC_OFF) / 4; u += NTHREADS) MISC[u] = 0u;
    __syncthreads();
    unsigned* barw = (unsigned*)(ws + WS_CTL) + CW_BAR;
    XcdBarrier bar; bar.bar = barw; bar.x = 0; bar.st = nullptr;
    if (MK_N_LAUNCHES == 1) bar = xcd_barrier_post(barw, MISC + 8);
    const int lo = args.ph_lo, hi = args.ph_hi;
#define IN(k) (lo <= (k) && (k) < hi)
#define DUP(k) ((((PROBE_DUP) >> (k)) & 1) != 0)
#define SEAM(k) do { if (IN(k) && IN((k) + 1)) xcd_barrier(bar); } while (0)

    if (IN(0)) { p0_prologue(C); if constexpr (DUP(0)) p0_prologue(C); }
    SEAM(0);
    if (IN(1)) { p1_norm(C); p1_quant_weights(C); if constexpr (DUP(1)) p1_norm(C); }
    SEAM(1);
    if (IN(2)) { ph2_proj(C); if constexpr (DUP(2)) ph2_proj(C); }
    SEAM(2);
    if (IN(3)) { ph3_mixers(C); if constexpr (DUP(3)) ph3_mixers(C); }
    SEAM(3);
    if (IN(4)) { p4_attention(C); if constexpr (DUP(4)) p4_attention(C); }
    SEAM(4);
    if (IN(5)) { ph5_merge(C); if constexpr (DUP(5)) ph5_merge(C); }
    SEAM(5);
    if (IN(6)) { ph6_out(C); if constexpr (DUP(6)) ph6_out(C); }
    SEAM(6);
    if (IN(7)) { p7_norm(C); }
    SEAM(7);
    if (IN(8)) { ph8_up(C); if constexpr (DUP(8)) ph8_up(C); }
    SEAM(8);
    if (IN(9)) { ph9_conv(C); if constexpr (DUP(9)) ph9_conv(C); }
    SEAM(9);
    if (IN(10)) { ph10_down(C); if constexpr (DUP(10)) ph10_down(C); }
    SEAM(10);
    if (IN(11)) { p11_final(C); }
#undef IN
#undef DUP
#undef SEAM
}

extern "C" void kernel_launch(void* const* d_in, const int* in_sizes, int n_in, void* d_out, int out_size, void* d_ws, size_t ws_size, hipStream_t stream) {
    static int grid = 0;
    if (grid == 0) {
        if (n_in != 23 || in_sizes[0] != M * D || out_size != M * D || ws_size < WS_END) { fprintf(stderr, "kernel_launch: unexpected shapes (n_in %d, in0 %d, out %d, ws %zu); nothing launched\n", n_in, n_in > 0 ? in_sizes[0] : -1, out_size, ws_size); grid = -1; return; }
        int dev = 0, cus = 0, per_cu = 0;
        if (hipGetDevice(&dev) != hipSuccess || hipDeviceGetAttribute(&cus, hipDeviceAttributeMultiprocessorCount, dev) != hipSuccess) { grid = -1; return; }
        if (hipFuncSetAttribute((const void*)fwd_kernel, hipFuncAttributeMaxDynamicSharedMemorySize, LDS_BYTES) != hipSuccess) { fprintf(stderr, "kernel_launch: hipFuncSetAttribute failed\n"); grid = -1; return; }
        if (hipOccupancyMaxActiveBlocksPerMultiprocessor(&per_cu, (const void*)fwd_kernel, NTHREADS, LDS_BYTES) != hipSuccess || per_cu < 1) { fprintf(stderr, "kernel_launch: occupancy query reports %d\n", per_cu); }
        (void)hipGetLastError();
        grid = cus;
        if (grid > 256) grid = 256;
    }
    if (grid < 0) return;
    (void)hipMemsetAsync((char*)d_ws + WS_CTL, 0, CTL_BYTES, stream);
    Args a{};
    for (int i = 0; i < 23; ++i) a.in[i] = (const float*)d_in[i];
    a.out = (float*)d_out; a.ws = (unsigned char*)d_ws;
    if (MK_N_LAUNCHES == 1) { a.ph_lo = 0; a.ph_hi = NPHASE; hipLaunchKernelGGL(fwd_kernel, dim3(grid), dim3(NTHREADS), LDS_BYTES, stream, a); }
    else { for (int li = 0; li < NPHASE; ++li) { a.ph_lo = li; a.ph_hi = li + 1; hipLaunchKernelGGL(fwd_kernel, dim3(grid), dim3(NTHREADS), LDS_BYTES, stream, a); } }
}
```

```cpp
#include <hip/hip_runtime.h>
#include <cstdio>
#include <cstdint>

#ifndef MK_N_LAUNCHES
#define MK_N_LAUNCHES 1
#endif

#ifndef PROBE_DUP
#define PROBE_DUP 0
#endif
#define GAS __attribute__((address_space(1)))
#define LAS __attribute__((address_space(3)))
typedef _Float16 f16;
typedef _Float16 hx8 __attribute__((ext_vector_type(8)));
typedef _Float16 hx4 __attribute__((ext_vector_type(4)));
typedef _Float16 hx2 __attribute__((ext_vector_type(2)));
typedef float f32x4 __attribute__((ext_vector_type(4)));
typedef float f32x2 __attribute__((ext_vector_type(2)));
typedef unsigned u32x4 __attribute__((ext_vector_type(4)));
typedef unsigned u32x2 __attribute__((ext_vector_type(2)));
typedef int ix4 __attribute__((ext_vector_type(4)));

constexpr int NB = 2, T = 8192, D = 4096, M = NB * T;
constexpr int NG = 4, HD = 128;
constexpr int DFF = 11008, NUP = 2 * DFF;
constexpr int IN_W = 17456, NPROJ = 16384, NMOD = 6 * D;
constexpr float EPS = 1e-6f;
constexpr float LOG2E = 1.4426950408889634f;
constexpr float SC2 = 0.08838834764831845f * 1.4426950408889634f;

constexpr size_t MiB = 1ull << 20;
constexpr size_t WS_CTL = 0, CTL_BYTES = 1 * MiB;
constexpr size_t WS_MOD = 1 * MiB;
constexpr size_t WS_POSW1 = 1 * MiB + 256 * 1024;
constexpr size_t WS_W2T = 1 * MiB + 384 * 1024;
constexpr size_t WS_SGUW = 2 * MiB;
constexpr size_t WS_WG = 2 * MiB + 512 * 1024;
constexpr size_t WS_KC = 3 * MiB;
constexpr size_t WS_VCT = 4 * MiB;
constexpr size_t WS_GATES = 5 * MiB;
constexpr size_t WS_W1T = 8 * MiB;
constexpr size_t WS_WUP = 16 * MiB;
constexpr size_t WS_WDN = 188 * MiB;
constexpr size_t WS_WIN = 274 * MiB;
constexpr size_t WS_WVT = 402 * MiB;
constexpr size_t WS_WM = 410 * MiB;
constexpr size_t WS_WO = 442 * MiB;
constexpr size_t WS_H = 474 * MiB;
constexpr size_t WS_Q = 602 * MiB;
constexpr size_t WS_KV = 666 * MiB;
constexpr size_t WS_VT = 730 * MiB;
constexpr size_t WS_Z = 762 * MiB;
constexpr size_t WS_GA = 890 * MiB;
constexpr size_t WS_GB = 1018 * MiB;
constexpr size_t WS_YAB = 1146 * MiB;
constexpr size_t WS_H2 = 274 * MiB;
constexpr size_t WS_AH = 406 * MiB;
constexpr size_t WS_AT = 418 * MiB;
constexpr size_t WS_ACT = 1090 * MiB;
constexpr size_t WS_Y2 = 432 * MiB;
constexpr size_t WS_X1H = 602 * MiB;
constexpr size_t WS_YSC = 1274 * MiB;
constexpr size_t WS_SA = 12 * MiB;
constexpr size_t WS_SW = 12 * MiB + 256 * 1024;
constexpr size_t WS_SAH = 12 * MiB + 512 * 1024;
constexpr size_t WS_SWQ = 12 * MiB + 640 * 1024;
constexpr size_t WS_H1Q = 1274 * MiB;
constexpr size_t WS_WINQ = 1338 * MiB;
constexpr size_t WS_WVTQ = 1390 * MiB;
constexpr size_t WS_WUPQ = 1434 * MiB;
constexpr size_t WS_END = 1520 * MiB;

constexpr int CW_BAR = 4096;

constexpr int LDS_BYTES = 147456;
constexpr int MISC_OFF = LDS_BYTES - 512;
constexpr int NWAVES = 8, NTHREADS = 512;

#define LDS_WAIT() asm volatile("s_waitcnt lgkmcnt(0)" ::: "memory")
#define VM_WAIT() asm volatile("s_waitcnt vmcnt(0)" ::: "memory")
__device__ __forceinline__ unsigned pkh(float lo, float hi) { hx2 p; p.x = (f16)lo; p.y = (f16)hi; return __builtin_bit_cast(unsigned, p); }
__device__ __forceinline__ unsigned pkb(float lo, float hi) { unsigned r; asm volatile("v_cvt_pk_bf16_f32 %0, %1, %2" : "=v"(r) : "v"(lo), "v"(hi)); return r; }
#ifndef FFN_BF16
#define FFN_BF16 1
#endif
__device__ __forceinline__ unsigned pk_ffn(float lo, float hi) { return FFN_BF16 ? pkb(lo, hi) : pkh(lo, hi); }
#ifndef MIX_BF16
#define MIX_BF16 1
#endif
__device__ __forceinline__ unsigned pk_mix(float lo, float hi) { return MIX_BF16 ? pkb(lo, hi) : pkh(lo, hi); }
__device__ __forceinline__ float wave_max(float v) {
#pragma unroll
    for (int o = 1; o < 64; o <<= 1) v = fmaxf(v, __shfl_xor(v, o));
    return v;
}
__device__ __forceinline__ unsigned pk_i8(float a, float b, float c, float d) {
    const int ia = (int)__builtin_rintf(a), ib = (int)__builtin_rintf(b), ic = (int)__builtin_rintf(c), id = (int)__builtin_rintf(d);
    return (unsigned)(ia & 255) | ((unsigned)(ib & 255) << 8) | ((unsigned)(ic & 255) << 16) | ((unsigned)(id & 255) << 24);
}
__device__ __forceinline__ float wave_sum(float v) {
#pragma unroll
    for (int o = 1; o < 64; o <<= 1) v += __shfl_xor(v, o);
    return v;
}
__device__ __forceinline__ float fsigmoid(float x) { return __builtin_amdgcn_rcpf(1.0f + __builtin_amdgcn_exp2f(-LOG2E * x)); }
__device__ __forceinline__ float fsilu(float x) { return x * fsigmoid(x); }
__device__ __forceinline__ float fgelu(float x) { const float u = x * (1.0f + 0.044715f * x * x); return x * __builtin_amdgcn_rcpf(1.0f + __builtin_amdgcn_exp2f(-2.302208198f * u)); }
template <int CTRL> __device__ __forceinline__ float dpp_f(float v) { return __builtin_bit_cast(float, __builtin_amdgcn_update_dpp(0, __builtin_bit_cast(int, v), CTRL, 0xF, 0xF, true)); }

namespace pg8 {
constexpr int BM = 256, BK = 64, HALF = 128, HTB = HALF * BK * 2, STAGE_BYTES = 8 * HTB, NXCD = 8, WGM = 8;
__host__ __device__ __forceinline__ int lds_byte(int r, int c) { const int st = (r >> 4) * 2 + (c >> 5), rr = r & 15, cc = c & 31, ob = rr * 64 + cc * 2; return st * 1024 + (ob ^ (((ob >> 9) & 1) << 5)); }
__host__ __device__ __forceinline__ void stage_rc(int b, int& R, int& C) { const int st = b / 1024, sb = b % 1024, swz = sb ^ (((sb >> 9) & 1) << 5); R = (st >> 1) * 16 + swz / 64; C = (st & 1) * 32 + (swz % 64) / 2; }
__host__ __device__ __forceinline__ int perm32(int rho) { const int n = rho >> 4, i = rho & 15; return 8 * (i >> 2) + 4 * n + (i & 3); }

struct Unit { int pm, pn; };
struct Gemm { const f16* A; const f16* Bt; int M, N, K; };

struct StaticOrder {
    int nM, nN, nwg, G, c;
    __host__ __device__ void init(int M_, int N_, int G_, int c_) { nM = M_ / BM; nN = N_ / BM; nwg = nM * nN; G = G_; c = c_; }
    __host__ __device__ bool next(int i, Unit& u) const {
        const long L = (long)i * G + c; if (L >= nwg) return false;
        int wgid = (int)L; { const int q = nwg / NXCD, r = nwg % NXCD, xcd = wgid % NXCD, off = wgid / NXCD; wgid = (xcd < r ? xcd * (q + 1) : r * (q + 1) + (xcd - r) * q) + off; }
        const int nig = WGM * nN, gid = wgid / nig, fm = gid * WGM, gsz = (nM - fm) < WGM ? (nM - fm) : WGM;
        u.pm = fm + ((wgid % nig) % gsz); u.pn = (wgid % nig) / gsz; return true;
    }
    __device__ __forceinline__ void a_ready(const Unit&) const {}
    __device__ __forceinline__ void done(const Unit&) const {}
};

__device__ __forceinline__ u32x4 pack8(const f32x4 v0, const f32x4 v1) { u32x4 w; w.x = pkh(v0[0], v0[1]); w.y = pkh(v0[2], v0[3]); w.z = pkh(v1[0], v1[1]); w.w = pkh(v1[2], v1[3]); return w; }

__device__ __forceinline__ unsigned opaque(unsigned v) { asm volatile("" : "+v"(v)); return v; }
struct EpiF32 {
    static constexpr bool PERM = false, AFTER_DRAIN = false, HAS_MID = false;
    float* C; int ldc;
    __device__ __forceinline__ void mid(f32x4 (&)[2][2][4][2], const Unit&, int, int, int, int) const {}
    __device__ __forceinline__ void operator()(const f32x4 (&acc)[2][2][4][2], const Unit& u, int wr, int wc, int fr, int fq) const {
        const unsigned off = opaque((unsigned)((u.pm * BM + wr * 64 + fr) * ldc + u.pn * BM + wc * 32 + 4 * fq) * 4u);
        char* base = (char*)C;
#pragma unroll
        for (int ai = 0; ai < 2; ++ai)
#pragma unroll
            for (int m = 0; m < 4; ++m) { const unsigned ro = off + (unsigned)((ai * HALF + m * 16) * ldc) * 4u;
#pragma unroll
                for (int bj = 0; bj < 2; ++bj)
#pragma unroll
                    for (int n = 0; n < 2; ++n) *(f32x4*)(base + ro + (bj * HALF + n * 16) * 4) = acc[ai][bj][m][n]; }
    }
};
struct EpiH16 {
    static constexpr bool PERM = true, AFTER_DRAIN = false, HAS_MID = false;
    f16* O; int ldc;
    __device__ __forceinline__ void mid(f32x4 (&)[2][2][4][2], const Unit&, int, int, int, int) const {}
    __device__ __forceinline__ void operator()(const f32x4 (&acc)[2][2][4][2], const Unit& u, int wr, int wc, int fr, int fq) const {
        const unsigned off = opaque((unsigned)((u.pm * BM + wr * 64 + fr) * ldc + u.pn * BM + wc * 32 + 8 * fq) * 2u);
        char* base = (char*)O;
#pragma unroll
        for (int ai = 0; ai < 2; ++ai)
#pragma unroll
            for (int m = 0; m < 4; ++m) { const unsigned ro = off + (unsigned)((ai * HALF + m * 16) * ldc) * 2u;
#pragma unroll
                for (int bj = 0; bj < 2; ++bj) *(u32x4*)(base + ro + bj * HALF * 2) = pack8(acc[ai][bj][m][0], acc[ai][bj][m][1]); }
    }
};
struct EpiProj {
    static constexpr bool PERM = true, AFTER_DRAIN = false, HAS_MID = false;
    f16 *Q, *KV, *Z, *GA, *GB; int pn0;
    __device__ __forceinline__ void mid(f32x4 (&)[2][2][4][2], const Unit&, int, int, int, int) const {}
    __device__ __forceinline__ void operator()(const f32x4 (&acc)[2][2][4][2], const Unit& u, int wr, int wc, int fr, int fq) const {
        const int pn = u.pn + pn0; char* base; int ldc, colt, act;
        if (pn < 8) { base = (char*)Q; ldc = 2048; colt = pn * 256; act = 0; }
        else if (pn < 16) { base = (char*)KV; ldc = 2048; colt = (pn - 8) * 256; act = 0; }
        else if (pn < 32) { base = (char*)Z; ldc = 4096; colt = (pn - 16) * 256; act = 1; }
        else if (pn < 48) { base = (char*)GA; ldc = 4096; colt = (pn - 32) * 256; act = 2; }
        else { base = (char*)GB; ldc = 4096; colt = (pn - 48) * 256; act = 2; }
        const unsigned off = opaque((unsigned)((u.pm * BM + wr * 64 + fr) * ldc + colt + wc * 32 + 8 * fq) * 2u);
#pragma unroll
        for (int ai = 0; ai < 2; ++ai)
#pragma unroll
            for (int m = 0; m < 4; ++m) { const unsigned ro = off + (unsigned)((ai * HALF + m * 16) * ldc) * 2u;
#pragma unroll
                for (int bj = 0; bj < 2; ++bj) { f32x4 v0 = acc[ai][bj][m][0], v1 = acc[ai][bj][m][1];
                    if (act == 1) {
#pragma unroll
                        for (int j = 0; j < 4; ++j) { v0[j] = fgelu(v0[j]); v1[j] = fgelu(v1[j]); } }
                    else if (act == 2) {
#pragma unroll
                        for (int j = 0; j < 4; ++j) { v0[j] = fsigmoid(v0[j]); v1[j] = fsigmoid(v1[j]); } }
                    *(u32x4*)(base + ro + bj * HALF * 2) = pack8(v0, v1); } }
    }
};
struct EpiProjQ {
    static constexpr bool PERM = true, AFTER_DRAIN = false, HAS_MID = false;
    unsigned char* ws; int pn0;
    __device__ __forceinline__ void mid(f32x4 (&)[2][2][4][2], const Unit&, int, int, int, int) const {}
    __device__ __forceinline__ void operator()(const f32x4 (&acc)[2][2][4][2], const Unit& u, int wr, int wc, int fr, int fq) const {
        const int pn = u.pn + pn0; char* base; int ldc, colt, act;
        if (pn < 16) { base = (char*)(ws + WS_KV); ldc = 2048; colt = (pn - 8) * 256; act = 0; }
        else if (pn < 32) { base = (char*)(ws + WS_Z); ldc = 4096; colt = (pn - 16) * 256; act = 1; }
        else if (pn < 48) { base = (char*)(ws + WS_GA); ldc = 4096; colt = (pn - 32) * 256; act = 2; }
        else { base = (char*)(ws + WS_GB); ldc = 4096; colt = (pn - 48) * 256; act = 2; }
        const float* const SA = (const float*)(ws + WS_SAH); const float* const SW = (const float*)(ws + WS_SWQ);
        const unsigned off = opaque((unsigned)((u.pm * BM + wr * 64 + fr) * ldc + colt + wc * 32 + 8 * fq) * 2u);
        const unsigned arow = opaque((unsigned)(u.pm * BM + wr * 64 + fr)), wrow = opaque((unsigned)((pn - 12) * 256 + wc * 32 + 8 * fq));
        f32x4 sw[2][2];
#pragma unroll
        for (int bj = 0; bj < 2; ++bj)
#pragma unroll
            for (int n = 0; n < 2; ++n) sw[bj][n] = *(const f32x4*)(SW + wrow + bj * HALF + 4 * n);
#pragma unroll
        for (int ai = 0; ai < 2; ++ai)
#pragma unroll
            for (int m = 0; m < 4; ++m) { const unsigned ro = off + (unsigned)((ai * HALF + m * 16) * ldc) * 2u; const float sa = SA[arow + ai * HALF + m * 16];
#pragma unroll
                for (int bj = 0; bj < 2; ++bj) { const ix4 i0 = __builtin_bit_cast(ix4, acc[ai][bj][m][0]), i1 = __builtin_bit_cast(ix4, acc[ai][bj][m][1]); f32x4 v0, v1;
#pragma unroll
                    for (int j = 0; j < 4; ++j) { v0[j] = (float)i0[j] * (sa * sw[bj][0][j]); v1[j] = (float)i1[j] * (sa * sw[bj][1][j]); }
                    if (act == 1) {
#pragma unroll
                        for (int j = 0; j < 4; ++j) { v0[j] = fgelu(v0[j]); v1[j] = fgelu(v1[j]); } }
                    else if (act == 2) {
#pragma unroll
                        for (int j = 0; j < 4; ++j) { v0[j] = fsigmoid(v0[j]); v1[j] = fsigmoid(v1[j]); } }
                    *(u32x4*)(base + ro + bj * HALF * 2) = pack8(v0, v1); } }
    }
};
struct EpiVTQ {
    static constexpr bool PERM = true, AFTER_DRAIN = false, HAS_MID = false;
    unsigned char* ws;
    __device__ __forceinline__ void mid(f32x4 (&)[2][2][4][2], const Unit&, int, int, int, int) const {}
    __device__ __forceinline__ void operator()(const f32x4 (&acc)[2][2][4][2], const Unit& u, int wr, int wc, int fr, int fq) const {
        const float* const SA = (const float*)(ws + WS_SAH); const float* const SW = (const float*)(ws + WS_SWQ) + 13312;
        const unsigned off = opaque((unsigned)((u.pm * BM + wr * 64 + fr) * M + u.pn * BM + wc * 32 + 8 * fq) * 2u);
        const unsigned wrow = opaque((unsigned)(u.pm * BM + wr * 64 + fr)), tcol = opaque((unsigned)(u.pn * BM + wc * 32 + 8 * fq));
        char* base = (char*)(ws + WS_VT);
        f32x4 sa[2][2];
#pragma unroll
        for (int bj = 0; bj < 2; ++bj)
#pragma unroll
            for (int n = 0; n < 2; ++n) sa[bj][n] = *(const f32x4*)(SA + tcol + bj * HALF + 4 * n);
#pragma unroll
        for (int ai = 0; ai < 2; ++ai)
#pragma unroll
            for (int m = 0; m < 4; ++m) { const unsigned ro = off + (unsigned)((ai * HALF + m * 16) * M) * 2u; const float sw = SW[wrow + ai * HALF + m * 16];
#pragma unroll
                for (int bj = 0; bj < 2; ++bj) { const ix4 i0 = __builtin_bit_cast(ix4, acc[ai][bj][m][0]), i1 = __builtin_bit_cast(ix4, acc[ai][bj][m][1]); f32x4 v0, v1;
#pragma unroll
                    for (int j = 0; j < 4; ++j) { v0[j] = (float)i0[j] * (sw * sa[bj][0][j]); v1[j] = (float)i1[j] * (sw * sa[bj][1][j]); }
                    *(u32x4*)(base + ro + bj * HALF * 2) = pack8(v0, v1); } }
    }
};
struct EpiMerge {
    static constexpr bool PERM = true, AFTER_DRAIN = false, HAS_MID = true;
    const f16 *GA, *GB; f16* O;
    __device__ __forceinline__ void mid(f32x4 (&acc)[2][2][4][2], const Unit& u, int wr, int wc, int fr, int fq) const {
        const unsigned off = opaque((unsigned)((u.pm * BM + wr * 64 + fr) * D + u.pn * BM + wc * 32 + 8 * fq) * 2u);
        const char* ga = (const char*)GA; const char* gb = (const char*)GB;
#pragma unroll
        for (int ai = 0; ai < 2; ++ai)
#pragma unroll
            for (int m = 0; m < 4; ++m) { const unsigned ro = off + (unsigned)((ai * HALF + m * 16) * D) * 2u;
#pragma unroll
                for (int bj = 0; bj < 2; ++bj) { const hx8 a = *(const hx8*)(ga + ro + bj * HALF * 2), b = *(const hx8*)(gb + ro + bj * HALF * 2);
#pragma unroll
                    for (int j = 0; j < 4; ++j) { acc[ai][bj][m][0][j] *= (float)a[j] * __builtin_amdgcn_rcpf((float)b[j]); acc[ai][bj][m][1][j] *= (float)a[4 + j] * __builtin_amdgcn_rcpf((float)b[4 + j]); } } }
    }
    __device__ __forceinline__ void operator()(const f32x4 (&acc)[2][2][4][2], const Unit& u, int wr, int wc, int fr, int fq) const {
        const unsigned off = opaque((unsigned)((u.pm * BM + wr * 64 + fr) * D + u.pn * BM + wc * 32 + 8 * fq) * 2u);
        const char* gb = (const char*)GB; char* ob = (char*)O;
#pragma unroll
        for (int ai = 0; ai < 2; ++ai)
#pragma unroll
            for (int m = 0; m < 4; ++m) { const unsigned ro = off + (unsigned)((ai * HALF + m * 16) * D) * 2u;
#pragma unroll
                for (int bj = 0; bj < 2; ++bj) { const hx8 b = *(const hx8*)(gb + ro + bj * HALF * 2); f32x4 v0 = acc[ai][bj][m][0], v1 = acc[ai][bj][m][1];
#pragma unroll
                    for (int j = 0; j < 4; ++j) { v0[j] *= (float)b[j]; v1[j] *= (float)b[4 + j]; }
                    u32x4 w; w.x = pk_mix(v0[0], v0[1]); w.y = pk_mix(v0[2], v0[3]); w.z = pk_mix(v1[0], v1[1]); w.w = pk_mix(v1[2], v1[3]);
                    *(u32x4*)(ob + ro + bj * HALF * 2) = w; } }
    }
};

typedef short sx8 __attribute__((ext_vector_type(8)));
template <int CTRL> __device__ __forceinline__ float dpp_mov(float old, float v) { return __builtin_bit_cast(float, __builtin_amdgcn_update_dpp(__builtin_bit_cast(int, old), __builtin_bit_cast(int, v), CTRL, 0xF, 0xF, false)); }
struct EpiConv {
    static constexpr bool PERM = true, AFTER_DRAIN = false, HAS_MID = false;
    unsigned char* ws; const float* cw; const float* cb; LAS float* X; int bf16out;
    __device__ __forceinline__ void mid(f32x4 (&)[2][2][4][2], const Unit&, int, int, int, int) const {}
    static __device__ __forceinline__ f32x4 deq(const f32x4 a, float s) { const ix4 iv = __builtin_bit_cast(ix4, a); return (f32x4){(float)iv[0] * s, (float)iv[1] * s, (float)iv[2] * s, (float)iv[3] * s}; }
    __device__ __forceinline__ void operator()(const f32x4 (&acc)[2][2][4][2], const Unit& u, int wr, int wc, int fr_, int fq_) const {
        const unsigned lane_o = opaque(threadIdx.x & 63u); const int fr = (int)(lane_o & 15u), fq = (int)(lane_o >> 4); (void)fr_; (void)fq_;
        f16* const ACT = (f16*)(ws + WS_ACT); float* const AH = (float*)(ws + WS_AH); float* const AT = (float*)(ws + WS_AT); const float* const SA = (const float*)(ws + WS_SA); const float* const SW = (const float*)(ws + WS_SW);
        const int chl = wc * 32 + 8 * fq;
        const unsigned ch0 = opaque((unsigned)(u.pn * 128 + chl)), wrow = opaque((unsigned)(u.pn * 256 + chl)), arow = opaque((unsigned)(u.pm * BM + wr * 64 + fr));
        float sa[2][4];
#pragma unroll
        for (int ai = 0; ai < 2; ++ai)
#pragma unroll
            for (int m = 0; m < 4; ++m) sa[ai][m] = SA[arow + ai * HALF + m * 16];
        if (fr >= 14) {
#pragma unroll
            for (int ai = 0; ai < 2; ++ai)
#pragma unroll
                for (int bj = 0; bj < 2; ++bj)
#pragma unroll
                    for (int n = 0; n < 2; ++n) *(LAS f32x4*)(X + ((((2 * ai + wr) * 2 + (fr - 14)) * 2 + bj) * 128 + chl + 4 * n)) = deq(acc[ai][bj][3][n], sa[ai][3]);
        }
        asm volatile("s_waitcnt lgkmcnt(0)" ::: "memory"); __builtin_amdgcn_s_barrier(); asm volatile("" ::: "memory");
        if (u.pm == 64) {
            const unsigned hro = opaque((unsigned)((wr * 64 + fr) * 2));
#pragma unroll
            for (int bj = 0; bj < 2; ++bj)
#pragma unroll
                for (int n = 0; n < 2; ++n) { const f32x4 swv = *(const f32x4*)(SW + wrow + bj * 128 + 4 * n);
#pragma unroll
                    for (int m = 0; m < 4; ++m) *(f32x4*)(AH + (size_t)(hro + 32 * m + bj) * DFF + ch0 + 4 * n) = deq(acc[0][bj][m][n], sa[0][m]) * swv; }
            return;
        }
        const unsigned orow = opaque((unsigned)(u.pm * BM + wr * 64 + fr));
#pragma unroll
        for (int n = 0; n < 2; ++n) {
            f32x4 wv[3][2], bv[2];
#pragma unroll
            for (int bj = 0; bj < 2; ++bj) { bv[bj] = *(const f32x4*)(cb + bj * DFF + ch0 + 4 * n); const f32x4 swv = *(const f32x4*)(SW + wrow + bj * 128 + 4 * n);
#pragma unroll
                for (int k = 0; k < 3; ++k) wv[k][bj] = *(const f32x4*)(cw + k * NUP + bj * DFF + ch0 + 4 * n) * swv;
                if (wr == 0 && fr < 2) *(f32x4*)(AT + (size_t)((u.pm * 2 + fr) * 2 + bj) * DFF + ch0 + 4 * n) = deq(acc[0][bj][0][n], sa[0][0]) * swv; }
#pragma unroll
            for (int ai = 0; ai < 2; ++ai) {
                f32x4 E[2];
                const int blk = 2 * ai + wr - 1;
#pragma unroll
                for (int bj = 0; bj < 2; ++bj) { E[bj] = (f32x4){0.f, 0.f, 0.f, 0.f};
                    if (blk >= 0 && fr >= 14) E[bj] = *(const LAS f32x4*)(X + (((blk * 2 + (fr - 14)) * 2 + bj) * 128 + chl + 4 * n)); }
#pragma unroll
                for (int m = 0; m < 4; ++m) {
                    f32x4 cv[2];
#pragma unroll
                    for (int bj = 0; bj < 2; ++bj) { const f32x4 cur = deq(acc[ai][bj][m][n], sa[ai][m]); const f32x4 prv = (m == 0) ? E[bj] : deq(acc[ai][bj][m == 0 ? 0 : m - 1][n], sa[ai][m == 0 ? 0 : m - 1]);
#pragma unroll
                        for (int i = 0; i < 4; ++i) { const float p1 = dpp_mov<0x111>(dpp_mov<0x121>(0.f, prv[i]), cur[i]), p2 = dpp_mov<0x112>(dpp_mov<0x122>(0.f, prv[i]), cur[i]);
                            cv[bj][i] = bv[bj][i] + wv[0][bj][i] * p2 + wv[1][bj][i] * p1 + wv[2][bj][i] * cur[i]; } }
                    float res[4];
#pragma unroll
                    for (int e = 0; e < 4; ++e) res[e] = fsilu(cv[0][e]) * cv[1][e];
                    u32x2 ov;
                    if (bf16out) { ov.x = pkb(res[0], res[1]); ov.y = pkb(res[2], res[3]); }
                    else { ov.x = pkh(res[0], res[1]); ov.y = pkh(res[2], res[3]); }
                    *(u32x2*)(ACT + (size_t)(orow + ai * HALF + m * 16) * DFF + ch0 + 4 * n) = ov;
                }
            }
        }
    }
};

template <class Epi, class Sched, bool ALIGN_EPI = true, int DT = 0  >
__device__ __forceinline__ void gemm_phase(LAS unsigned char* lds, const Gemm g, const Sched& S, const Epi& E) {
    const int tid = threadIdx.x, wid = __builtin_amdgcn_readfirstlane(tid >> 6), lane = tid & 63, wr = wid >> 2, wc = wid & 3, fr = lane & 15, fq = lane >> 4;
    const int K = g.K, nt = K / BK;
    unsigned voffA[2], voffB[2];
#pragma unroll
    for (int i = 0; i < 2; ++i) { int R, C; stage_rc(tid * 16 + i * 8192, R, C); const int Rb = Epi::PERM ? ((R & ~31) + perm32(R & 31)) : R;
        voffA[i] = (unsigned)(R * K + C) * 2u; voffB[i] = (unsigned)(Rb * K + C) * 2u; }
    const size_t kstep = (size_t)(BK * 2);
    const size_t hstep = (size_t)HALF * K * 2;
    const size_t tstep = 2 * hstep;
    const unsigned ldsw = (unsigned)wid * 1024u;
    const int aoff = lds_byte(wr * 64 + fr, fq * 8), boff = lds_byte(wc * 32 + fr, fq * 8);
#define PG8_SA(b, h) (((b) * 2 + (h)) * HTB)
#define PG8_SB(b, h) ((4 + (b) * 2 + (h)) * HTB)
#define PG8_STAGE(bufoff, gbase, voff) do { _Pragma("unroll") for (int _i = 0; _i < 2; ++_i) \
        __builtin_amdgcn_global_load_lds((const unsigned*)((const char*)(gbase) + (voff)[_i]), (LAS unsigned*)(lds + (bufoff) + ldsw + _i * 8192), 16, 0, 0); } while (0)
#define PG8_LDA(dst, b, h) do { _Pragma("unroll") for (int m = 0; m < 4; ++m) _Pragma("unroll") for (int k = 0; k < 2; ++k) dst[m][k] = *(const LAS hx8*)(lds + PG8_SA(b, h) + aoff + m * 2048 + k * 1024); } while (0)
#define PG8_LDB(dst, b, h) do { _Pragma("unroll") for (int n = 0; n < 2; ++n) _Pragma("unroll") for (int k = 0; k < 2; ++k) dst[n][k] = *(const LAS hx8*)(lds + PG8_SB(b, h) + boff + n * 2048 + k * 1024); } while (0)
#define PG8_MMA(ai, bj, At, Bt) do { __builtin_amdgcn_s_setprio(1); _Pragma("unroll") for (int m = 0; m < 4; ++m) _Pragma("unroll") for (int n = 0; n < 2; ++n) _Pragma("unroll") for (int k = 0; k < 2; ++k) \
        { if constexpr (DT == 2) acc[ai][bj][m][n] = __builtin_bit_cast(f32x4, __builtin_amdgcn_mfma_i32_16x16x64_i8(__builtin_bit_cast(ix4, Bt[n][k]), __builtin_bit_cast(ix4, At[m][k]), __builtin_bit_cast(ix4, acc[ai][bj][m][n]), 0, 0, 0)); \
          else if constexpr (DT == 1) acc[ai][bj][m][n] = __builtin_amdgcn_mfma_f32_16x16x32_bf16(__builtin_bit_cast(sx8, Bt[n][k]), __builtin_bit_cast(sx8, At[m][k]), acc[ai][bj][m][n], 0, 0, 0); \
          else acc[ai][bj][m][n] = __builtin_amdgcn_mfma_f32_16x16x32_f16(Bt[n][k], At[m][k], acc[ai][bj][m][n], 0, 0, 0); } __builtin_amdgcn_s_setprio(0); } while (0)
#define PG8_WAIT_V(n) asm volatile("s_waitcnt vmcnt(" #n ")" ::: "memory")
#define PG8_WAIT_L(n) asm volatile("s_waitcnt lgkmcnt(" #n ")" ::: "memory")
#define PG8_BAR __builtin_amdgcn_s_barrier()
#define PG8_SCHED __builtin_amdgcn_sched_barrier(0)
    Unit cur, nxt; int ui = 0;
    if (!S.next(0, cur)) return;
    f32x4 acc[2][2][4][2];
#pragma unroll
    for (int a = 0; a < 2; ++a)
#pragma unroll
        for (int b = 0; b < 2; ++b)
#pragma unroll
            for (int m = 0; m < 4; ++m)
#pragma unroll
                for (int n = 0; n < 2; ++n) acc[a][b][m][n] = (f32x4){0.f, 0.f, 0.f, 0.f};
    hx8 At[4][2], B0[2][2], B1[2][2];
    const char* cA = (const char*)g.A + (size_t)cur.pm * tstep; const char* cB = (const char*)g.Bt + (size_t)cur.pn * tstep;
    S.a_ready(cur);
    PG8_STAGE(PG8_SB(0, 0), cB, voffB); PG8_STAGE(PG8_SB(0, 1), cB + hstep, voffB); PG8_STAGE(PG8_SA(0, 0), cA, voffA); PG8_STAGE(PG8_SA(0, 1), cA + hstep, voffA);
    if (wr == 1) PG8_BAR;
    PG8_WAIT_V(2); PG8_BAR;
    PG8_STAGE(PG8_SB(1, 0), cB + kstep, voffB); PG8_STAGE(PG8_SA(1, 0), cA + kstep, voffA); PG8_STAGE(PG8_SB(1, 1), cB + hstep + kstep, voffB);
    PG8_WAIT_V(6); PG8_BAR;
    for (;;) {
        const bool has_next = S.next(ui + 1, nxt);
        const char* nA = has_next ? (const char*)g.A + (size_t)nxt.pm * tstep : cA; const char* nB = has_next ? (const char*)g.Bt + (size_t)nxt.pn * tstep : cB;
        for (int t = 0; t < nt; t += 2) {
            const bool last = (t == nt - 2);
            const char* a1 = cA + (size_t)(t + 1) * kstep;
            const char* a2 = last ? nA : cA + (size_t)(t + 2) * kstep; const char* b2 = last ? nB : cB + (size_t)(t + 2) * kstep;
            const char* a3 = a2 + kstep; const char* b3 = b2 + kstep;
            if (last && has_next) S.a_ready(nxt);
            if constexpr (Epi::HAS_MID) { if (t == (nt >> 1)) E.mid(acc, cur, wr, wc, fr, fq); }
            PG8_LDB(B0, 0, 0); PG8_LDB(B1, 0, 1); PG8_SCHED; PG8_LDA(At, 0, 0); PG8_STAGE(PG8_SA(1, 1), a1 + hstep, voffA);
            PG8_WAIT_V(8); PG8_WAIT_L(0); PG8_BAR; PG8_MMA(0, 0, At, B0); PG8_MMA(0, 1, At, B1); PG8_BAR; PG8_SCHED;
            PG8_LDA(At, 0, 1); PG8_STAGE(PG8_SB(0, 0), b2, voffB); PG8_STAGE(PG8_SB(0, 1), b2 + hstep, voffB); PG8_STAGE(PG8_SA(0, 0), a2, voffA);
            PG8_WAIT_V(8); PG8_WAIT_L(0); PG8_BAR; PG8_MMA(1, 0, At, B0); PG8_MMA(1, 1, At, B1); PG8_BAR; PG8_SCHED;
            PG8_LDB(B0, 1, 0); PG8_LDB(B1, 1, 1); PG8_SCHED; PG8_LDA(At, 1, 0); PG8_STAGE(PG8_SA(0, 1), a2 + hstep, voffA);
            PG8_WAIT_V(8); PG8_WAIT_L(0); PG8_BAR; PG8_MMA(0, 0, At, B0); PG8_MMA(0, 1, At, B1); PG8_BAR; PG8_SCHED;
            PG8_LDA(At, 1, 1); PG8_STAGE(PG8_SB(1, 0), b3, voffB); PG8_STAGE(PG8_SB(1, 1), b3 + hstep, voffB); PG8_STAGE(PG8_SA(1, 0), a3, voffA);
            PG8_WAIT_V(8); PG8_WAIT_L(0); PG8_BAR; PG8_MMA(1, 0, At, B0); PG8_MMA(1, 1, At, B1); PG8_BAR; PG8_SCHED;
        }
        if constexpr (ALIGN_EPI) { if (wr == 0) PG8_BAR; }
        E(acc, cur, wr, wc, fr, fq); S.done(cur);
        if (!has_next) break;
#pragma unroll
        for (int a = 0; a < 2; ++a)
#pragma unroll
            for (int b = 0; b < 2; ++b)
#pragma unroll
                for (int m = 0; m < 4; ++m)
#pragma unroll
                    for (int n = 0; n < 2; ++n) acc[a][b][m][n] = (f32x4){0.f, 0.f, 0.f, 0.f};
        cur = nxt; cA = nA; cB = nB; ++ui;
        if constexpr (ALIGN_EPI) { if (wr == 1) PG8_BAR; }
    }
    PG8_WAIT_V(0);
    if constexpr (!ALIGN_EPI) { if (wr == 0) PG8_BAR; }
    PG8_BAR;
#undef PG8_SA
#undef PG8_SB
#undef PG8_STAGE
#undef PG8_LDA
#undef PG8_LDB
#undef PG8_MMA
#undef PG8_WAIT_V
#undef PG8_WAIT_L
#undef PG8_BAR
#undef PG8_SCHED
}
}

#define XB_TMO      128
#define XB_XCNT(j)  (256  + 64 * (j))
#define XB_XSUB(j)  (1280 + 64 * (j))
#define XB_XGEN(j)  (2304 + 64 * (j))
#define XB_TOP      3328
#define XB_TOPGEN   3392
#define XCD_BAR_WORDS 3456
#define XB_SPIN_CAP (1u << 18)
__device__ __forceinline__ unsigned xb_ld(unsigned* p)              { return __hip_atomic_load(p, __ATOMIC_RELAXED, __HIP_MEMORY_SCOPE_AGENT); }
__device__ __forceinline__ unsigned xb_add(unsigned* p, unsigned v) { return __hip_atomic_fetch_add(p, v, __ATOMIC_RELAXED, __HIP_MEMORY_SCOPE_AGENT); }
__device__ __forceinline__ unsigned xb_xcc_id() { return (unsigned)__builtin_amdgcn_s_getreg((3 << 11) | 20) & 0xFu; }
#define XB_SPIN(cond, bar) do { unsigned _sp = 0; while (cond) { __builtin_amdgcn_s_sleep(1); \
    if ((++_sp & 255u) == 0u) { if (xb_ld(&(bar)[XB_TMO])) break; if (_sp > XB_SPIN_CAP) { atomicAdd(&(bar)[XB_TMO], 1u); break; } } } } while (0)
struct XcdBarrier { unsigned* bar; unsigned x; volatile LAS unsigned* st; };
__device__ __forceinline__ XcdBarrier xcd_barrier_post(unsigned* bar, volatile LAS unsigned* st) {
    XcdBarrier b; b.bar = bar; b.x = xb_xcc_id(); b.st = st;
    if (threadIdx.x == 0) (void)xb_add(&bar[XB_XCNT(b.x)], 1u);
    return b;
}
__device__ __forceinline__ void xcd_barrier_complete(unsigned* bar, unsigned x, unsigned& nloc, unsigned& nx) {
    const unsigned G = gridDim.x * gridDim.y * gridDim.z;
    unsigned sum, cnt, mine, sp = 0u;
    for (;;) {
        sum = 0u; cnt = 0u; mine = 0u;
#pragma unroll
        for (unsigned j = 0; j < 16; ++j) { const unsigned c = xb_ld(&bar[XB_XCNT(j)]); sum += c; cnt += (c > 0u) ? 1u : 0u; mine = (j == x) ? c : mine; }
        if (sum == G) break;
        __builtin_amdgcn_s_sleep(1);
        if ((++sp & 255u) == 0u) { if (xb_ld(&bar[XB_TMO])) break; if (sp > XB_SPIN_CAP) { atomicAdd(&bar[XB_TMO], 1u); break; } }
    }
    nloc = mine > 0u ? mine : 1u; nx = cnt > 0u ? cnt : 1u;
}
__device__ __forceinline__ void xcd_barrier(const XcdBarrier& b) {
    asm volatile("s_waitcnt vmcnt(0)" ::: "memory");
    __syncthreads();
    if (threadIdx.x == 0) {
        unsigned* bar = b.bar;
        __builtin_amdgcn_s_waitcnt(0);
        unsigned nloc = b.st[0], nx = b.st[1];
        if (nloc == 0u) { xcd_barrier_complete(bar, b.x, nloc, nx); b.st[0] = nloc; b.st[1] = nx; }
        const unsigned old = xb_add(&bar[XB_XSUB(b.x)], 1u);
        const unsigned gen = old / nloc;
        if (old + 1u == (gen + 1u) * nloc) {
            __builtin_amdgcn_fence(__ATOMIC_RELEASE, "agent");
            asm volatile("s_waitcnt vmcnt(0)" ::: "memory");
            const unsigned og = xb_add(&bar[XB_TOP], 1u);
            const unsigned tg = og / nx;
            if (og + 1u == (tg + 1u) * nx) xb_add(&bar[XB_TOPGEN], 1u);
            else XB_SPIN(xb_ld(&bar[XB_TOPGEN]) == tg, bar);
            __builtin_amdgcn_fence(__ATOMIC_ACQUIRE, "agent");
            xb_add(&bar[XB_XGEN(b.x)], 1u);
            asm volatile("s_waitcnt vmcnt(0)" ::: "memory");
        } else {
            XB_SPIN(xb_ld(&bar[XB_XGEN(b.x)]) == gen, bar);
            __builtin_amdgcn_fence(__ATOMIC_ACQUIRE, "agent");
            asm volatile("s_waitcnt vmcnt(0)" ::: "memory");
        }
    }
    __syncthreads();
}

struct Args { const float* in[23]; float* out; unsigned char* ws; int ph_lo, ph_hi; };
struct Ctx {
    LAS unsigned char* lds;
    int tid, lane, wave, G, bid;
    const float *x, *c, *w_mod, *b_mod, *g_norms, *w_in, *cmp_pos, *cmp_w1, *cmp_b1, *cmp_w2, *cmp_b2, *rel_table, *ln_g, *ln_b, *sgu_w, *sgu_b,
                *w_pn, *w_ps, *w_out, *w_up, *conv_w, *conv_b, *w_dn;
    float* out; unsigned char* ws;
    float *mod, *posw1, *gates, *ysc, *AH, *AT; f16 *Y1, *Y2, *X1H, *W2T, *SGUW, *WG, *KC, *VCT, *W1T, *WUP, *WDN, *WIN, *WVT, *WM, *WO, *H, *Q, *KV, *VT, *Z, *GA, *GB, *YAB, *H2, *ACT;
};

__device__ __forceinline__ void p0_mod_item(Ctx& C, int item) {
    LAS float* sc = (LAS float*)C.lds;
    LAS float* red = (LAS float*)(C.lds + 32768);
    for (int i = C.tid; i < 2 * D; i += NTHREADS) sc[i] = fsilu(C.c[i]);
    __syncthreads();
    const int cq = C.tid & 31, kg = C.tid >> 5, n0 = item * 128 + 4 * cq;
    f32x4 a0 = {0.f, 0.f, 0.f, 0.f}, a1 = {0.f, 0.f, 0.f, 0.f};
    const float* wp = C.w_mod + (size_t)(kg * 256) * NMOD + n0;
#pragma unroll 8
    for (int i = 0; i < 256; ++i) { const f32x4 w = *(const f32x4*)(wp + (size_t)i * NMOD); const float s0 = sc[kg * 256 + i], s1 = sc[D + kg * 256 + i]; a0 += w * s0; a1 += w * s1; }
    *(LAS f32x4*)(red + (kg * 2 + 0) * 128 + 4 * cq) = a0; *(LAS f32x4*)(red + (kg * 2 + 1) * 128 + 4 * cq) = a1;
    __syncthreads();
    if (C.tid < 256) { const int b = C.tid >> 7, col = C.tid & 127; float s = 0.f;
#pragma unroll
        for (int k = 0; k < 16; ++k) s += red[(k * 2 + b) * 128 + col];
        C.mod[b * NMOD + item * 128 + col] = s + C.b_mod[item * 128 + col]; }
    __syncthreads();
}
__device__ __forceinline__ void p0_posw1_item(Ctx& C, int item) {
    LAS float* red = (LAS float*)C.lds;
    const int kk = item >> 2, j = (item & 3) * 64 + C.lane; float s = 0.f;
    const float* w = C.cmp_w1 + (size_t)kk * 4096 * 256 + j; const float* pp = C.cmp_pos + kk * 4096;
    for (int k = C.wave * 512; k < C.wave * 512 + 512; ++k) s += pp[k] * w[(size_t)k * 256];
    red[C.wave * 64 + C.lane] = s;
    __syncthreads();
    if (C.wave == 0) { float t = 0.f;
#pragma unroll
        for (int k = 0; k < 8; ++k) t += red[k * 64 + C.lane];
        C.posw1[kk * 256 + j] = t + C.cmp_b1[kk * 256 + j]; }
    __syncthreads();
}
__device__ __forceinline__ f16* win_row(Ctx& C, int n) {
    if (n < 3584) return C.WIN + (size_t)n * D;
    if (n < 4096) return C.WVT + (size_t)(n - 3584) * D;
    if (n < 4608) return C.WIN + (size_t)(n - 512) * D;
    if (n < 5120) return C.WVT + (size_t)(n - 4608 + 512) * D;
    if (n < 5168) return C.WG + (size_t)(n - 5120) * D;
    return C.WIN + (size_t)(n - 5168 + 4096) * D;
}
__device__ __forceinline__ void p0_transpose_item(Ctx& C, int mat, const float* src, int N, int kb, int nb, LAS float* scr) {
    const int lane = C.lane, k0 = kb * 64, n0 = nb * 64, r4 = lane >> 4, c4 = (lane & 15) * 4; const bool ok = n0 + c4 < N;
    const float* sp = src + (size_t)(k0 + r4) * N + (ok ? n0 + c4 : 0);
#pragma unroll
    for (int i = 0; i < 16; ++i) { const f32x4 v = ok ? *(const f32x4*)(sp + (size_t)(4 * i) * N) : (f32x4){0.f, 0.f, 0.f, 0.f};
        LAS float* d = scr + (4 * i + r4) * 65 + c4; d[0] = v.x; d[1] = v.y; d[2] = v.z; d[3] = v.w; }
    LDS_WAIT();
    const int c = lane & 7;
#pragma unroll
    for (int j = 0; j < 8; ++j) { const int nn = (lane >> 3) + 8 * j, ng = n0 + nn;
        if (ng < N) { const LAS float* s = scr + (8 * c) * 65 + nn;
            u32x4 o;
            if ((FFN_BF16 && (mat == 4 || mat == 5)) || (MIX_BF16 && (mat == 1 || mat == 2 || mat == 3))) { o.x = pkb(s[0], s[65]); o.y = pkb(s[2 * 65], s[3 * 65]); o.z = pkb(s[4 * 65], s[5 * 65]); o.w = pkb(s[6 * 65], s[7 * 65]); }
            else { o.x = pkh(s[0], s[65]); o.y = pkh(s[2 * 65], s[3 * 65]); o.z = pkh(s[4 * 65], s[5 * 65]); o.w = pkh(s[6 * 65], s[7 * 65]); }
            f16* rowp;
            if (mat == 0) rowp = win_row(C, ng);
            else if (mat == 1) rowp = C.WM + (size_t)ng * D;
            else if (mat == 2) rowp = C.WM + (size_t)ng * D + 2048;
            else if (mat == 3) rowp = C.WO + (size_t)ng * D;
            else if (mat == 4) { const int isup = ng >= DFF ? 1 : 0, cc = ng - isup * DFF; rowp = C.WUP + (size_t)((cc >> 7) * 256 + isup * 128 + (cc & 127)) * D; }
            else if (mat == 5) rowp = C.WDN + (size_t)ng * DFF;
            else if (mat == 6) rowp = C.W1T + (size_t)ng * D;
            else rowp = C.W1T + (size_t)(256 + ng) * D;
            *(u32x4*)(rowp + k0 + 8 * c) = o; } }
    LDS_WAIT();
}
__device__ __forceinline__ void p0_prologue(Ctx& C) {
    for (int it = C.bid; it < 200; it += C.G) { if (it < 192) p0_mod_item(C, it); else p0_posw1_item(C, it - 192); }
    const int gw = C.bid * NWAVES + C.wave, NGW = C.G * NWAVES;
    LAS float* scr = (LAS float*)(C.lds + C.wave * 16640);
    constexpr int I0 = 64 * 273, I1 = 32 * 64, I3 = 64 * 64, I4 = 64 * 344, I5 = 172 * 64, I6 = 64 * 4;
    constexpr int NIT = I0 + 2 * I1 + I3 + I4 + I5 + 2 * I6;
    for (int it = gw; it < NIT; it += NGW) {
        int r = it;
        if (r < I0) { p0_transpose_item(C, 0, C.w_in, IN_W, r / 273, r % 273, scr); continue; } r -= I0;
        if (r < I1) { p0_transpose_item(C, 1, C.w_pn, D, r / 64, r % 64, scr); continue; } r -= I1;
        if (r < I1) { p0_transpose_item(C, 2, C.w_ps, D, r / 64, r % 64, scr); continue; } r -= I1;
        if (r < I3) { p0_transpose_item(C, 3, C.w_out, D, r / 64, r % 64, scr); continue; } r -= I3;
        if (r < I4) { p0_transpose_item(C, 4, C.w_up, NUP, r / 344, r % 344, scr); continue; } r -= I4;
        if (r < I5) { p0_transpose_item(C, 5, C.w_dn, D, r / 64, r % 64, scr); continue; } r -= I5;
        if (r < I6) { p0_transpose_item(C, 6, C.cmp_w1, 256, r / 4, r % 4, scr); continue; } r -= I6;
        p0_transpose_item(C, 7, C.cmp_w1 + (size_t)4096 * 256, 256, r / 4, r % 4, scr);
    }
    const int gt = C.bid * NTHREADS + C.tid, NGT = C.G * NTHREADS;
    for (int i = gt; i < 16 * 128 * 128; i += NGT) { const int s = i & 127, t = (i >> 7) & 127; C.SGUW[i] = (f16)(s <= t ? C.sgu_w[i] : 0.f); }
    for (int i = gt; i < 2 * 128 * 256; i += NGT) { const int j = i & 255, d = (i >> 8) & 127, kk = i >> 15; C.W2T[i] = (f16)C.cmp_w2[(size_t)kk * 256 * 128 + j * 128 + d]; }
    for (int i = gt; i < 16 * D; i += NGT) C.WG[48 * D + i] = (f16)0.f;
    __syncthreads();
}

__device__ __forceinline__ void p1_norm(Ctx& C) {
    const int gw = C.bid * NWAVES + C.wave, NGW = C.G * NWAVES, lane = C.lane;
    for (int row = gw; row < M; row += NGW) {
        const int b = row >> 13; const f32x4* xr = (const f32x4*)(C.x + (size_t)row * D);
        f32x4 v[16]; float ss = 0.f;
#pragma unroll
        for (int j = 0; j < 16; ++j) { v[j] = xr[lane + 64 * j]; ss += (v[j].x * v[j].x + v[j].y * v[j].y) + (v[j].z * v[j].z + v[j].w * v[j].w); }
        const float rs = 1.0f / sqrtf(wave_sum(ss) * (1.0f / D) + EPS);
        const f32x4* g4 = (const f32x4*)(C.g_norms); const f32x4* sh = (const f32x4*)(C.mod + b * NMOD); const f32x4* sc = (const f32x4*)(C.mod + b * NMOD + D);
        u32x2* o = (u32x2*)(C.H + (size_t)row * D); unsigned* oq = (unsigned*)(C.ws + WS_H1Q + (size_t)row * D);
        float amax = 0.f;
#pragma unroll
        for (int j = 0; j < 16; ++j) { const int k = lane + 64 * j; v[j] = v[j] * rs * g4[k] * (sc[k] + 1.0f) + sh[k]; u32x2 w; w.x = pkh(v[j].x, v[j].y); w.y = pkh(v[j].z, v[j].w); o[k] = w;
            amax = fmaxf(amax, fmaxf(fmaxf(fabsf(v[j].x), fabsf(v[j].y)), fmaxf(fabsf(v[j].z), fabsf(v[j].w)))); }
        amax = fmaxf(wave_max(amax), 1e-20f);
        const float qs = 127.0f / amax;
        if (lane == 0) ((float*)(C.ws + WS_SAH))[row] = amax * (1.0f / 127.0f);
#pragma unroll
        for (int j = 0; j < 16; ++j) oq[lane + 64 * j] = pk_i8(v[j].x * qs, v[j].y * qs, v[j].z * qs, v[j].w * qs);
    }
}
__device__ __forceinline__ void p1_quant_rows(Ctx& C, const f16* src, int nrows, signed char* dst, float* scale, bool bf) {
    const int gw = C.bid * NWAVES + C.wave, NGW = C.G * NWAVES, lane = C.lane;
    for (int row = gw; row < nrows; row += NGW) {
        const u32x4* wr = (const u32x4*)(src + (size_t)row * D);
        float v[64]; float amax = 0.f;
#pragma unroll
        for (int j = 0; j < 8; ++j) { const u32x4 wv = wr[lane + 64 * j];
#pragma unroll
            for (int e = 0; e < 4; ++e) { const unsigned wd = wv[e]; float lo, hi;
                if (bf) { lo = __builtin_bit_cast(float, wd << 16); hi = __builtin_bit_cast(float, wd & 0xffff0000u); }
                else { const hx2 hv = __builtin_bit_cast(hx2, wd); lo = (float)hv.x; hi = (float)hv.y; }
                v[8 * j + 2 * e] = lo; v[8 * j + 2 * e + 1] = hi; amax = fmaxf(amax, fmaxf(fabsf(lo), fabsf(hi))); } }
        amax = fmaxf(wave_max(amax), 1e-30f);
        const float qs = 127.0f / amax;
        if (lane == 0) scale[row] = amax * (1.0f / 127.0f);
        u32x2* o = (u32x2*)(dst + (size_t)row * D);
#pragma unroll
        for (int j = 0; j < 8; ++j) { u32x2 w; w.x = pk_i8(v[8 * j] * qs, v[8 * j + 1] * qs, v[8 * j + 2] * qs, v[8 * j + 3] * qs); w.y = pk_i8(v[8 * j + 4] * qs, v[8 * j + 5] * qs, v[8 * j + 6] * qs, v[8 * j + 7] * qs); o[lane + 64 * j] = w; }
    }
}
__device__ __forceinline__ void p1_quant_weights(Ctx& C) {
    p1_quant_rows(C, C.WIN + (size_t)3072 * D, 1024, (signed char*)(C.ws + WS_WINQ), (float*)(C.ws + WS_SWQ), false);
    p1_quant_rows(C, C.WIN + (size_t)8192 * D, 8192, (signed char*)(C.ws + WS_WINQ + (size_t)5120 * D), (float*)(C.ws + WS_SWQ) + 5120, false);
    p1_quant_rows(C, C.WVT, 1024, (signed char*)(C.ws + WS_WVTQ), (float*)(C.ws + WS_SWQ) + 13312, false);
    p1_quant_rows(C, C.WUP, NUP, (signed char*)(C.ws + WS_WUPQ), (float*)(C.ws + WS_SW), FFN_BF16 != 0);
}
__device__ __forceinline__ void p7_norm(Ctx& C) {
    const int gw = C.bid * NWAVES + C.wave, NGW = C.G * NWAVES, lane = C.lane;
    for (int row = gw; row < M; row += NGW) {
        const int b = row >> 13; const hx8* yr = (const hx8*)(C.Y1 + (size_t)row * D); const f32x4* xr = (const f32x4*)(C.x + (size_t)row * D); u32x2* orow = (u32x2*)(C.X1H + (size_t)row * D);
        f32x4 v[16]; float ss = 0.f;
#pragma unroll
        for (int j = 0; j < 8; ++j) { const hx8 hv = yr[lane + 64 * j];
            v[2 * j] = (f32x4){(float)hv[0], (float)hv[1], (float)hv[2], (float)hv[3]}; v[2 * j + 1] = (f32x4){(float)hv[4], (float)hv[5], (float)hv[6], (float)hv[7]}; }
#pragma unroll
        for (int j = 0; j < 16; ++j) ss += (v[j].x * v[j].x + v[j].y * v[j].y) + (v[j].z * v[j].z + v[j].w * v[j].w);
        const float rs = 1.0f / sqrtf(wave_sum(ss) * (1.0f / D) + EPS);
        const f32x4* g1 = (const f32x4*)(C.g_norms + D); const f32x4* gt = (const f32x4*)(C.mod + b * NMOD + 2 * D);
        float s2 = 0.f;
#pragma unroll
        for (int j = 0; j < 16; ++j) { const int k = 2 * (lane + 64 * (j >> 1)) + (j & 1); v[j] = xr[k] + gt[k] * (v[j] * rs * g1[k]); { u32x2 xw; xw.x = pkh(v[j].x, v[j].y); xw.y = pkh(v[j].z, v[j].w); orow[k] = xw; } s2 += (v[j].x * v[j].x + v[j].y * v[j].y) + (v[j].z * v[j].z + v[j].w * v[j].w); }
        const float rs2 = 1.0f / sqrtf(wave_sum(s2) * (1.0f / D) + EPS);
        const f32x4* g2 = (const f32x4*)(C.g_norms + 2 * D); const f32x4* sh = (const f32x4*)(C.mod + b * NMOD + 3 * D); const f32x4* sc = (const f32x4*)(C.mod + b * NMOD + 4 * D);
        float amax = 0.f;
#pragma unroll
        for (int j = 0; j < 16; ++j) { const int k = 2 * (lane + 64 * (j >> 1)) + (j & 1); v[j] = v[j] * rs2 * g2[k] * (sc[k] + 1.0f) + sh[k];
            amax = fmaxf(amax, fmaxf(fmaxf(fabsf(v[j].x), fabsf(v[j].y)), fmaxf(fabsf(v[j].z), fabsf(v[j].w)))); }
        amax = fmaxf(wave_max(amax), 1e-20f);
        const float qs = 127.0f / amax;
        const bool halo = (row & 255) >= 254; const int hrow = M + 2 * (row >> 8) + (row & 1);
        if (lane == 0) { ((float*)(C.ws + WS_SA))[row] = amax * (1.0f / 127.0f); if (halo) ((float*)(C.ws + WS_SA))[hrow] = amax * (1.0f / 127.0f); }
        u32x2* o = (u32x2*)(((signed char*)(C.ws + WS_H2)) + (size_t)row * D); u32x2* oh = (u32x2*)(((signed char*)(C.ws + WS_H2)) + (size_t)hrow * D);
#pragma unroll
        for (int j = 0; j < 8; ++j) { u32x2 w; w.x = pk_i8(v[2 * j].x * qs, v[2 * j].y * qs, v[2 * j].z * qs, v[2 * j].w * qs); w.y = pk_i8(v[2 * j + 1].x * qs, v[2 * j + 1].y * qs, v[2 * j + 1].z * qs, v[2 * j + 1].w * qs);
            o[lane + 64 * j] = w; if (halo) oh[lane + 64 * j] = w; }
    }
}
__device__ __forceinline__ void p11_final(Ctx& C) {
    const int gw = C.bid * NWAVES + C.wave, NGW = C.G * NWAVES, lane = C.lane;
    for (int row = gw; row < M; row += NGW) {
        const int b = row >> 13; f32x4* orow = (f32x4*)(C.out + (size_t)row * D); const hx8* yr = (const hx8*)(C.Y2 + (size_t)row * D); const hx8* xr = (const hx8*)(C.X1H + (size_t)row * D);
        f32x4 v[16]; float ss = 0.f;
#pragma unroll
        for (int j = 0; j < 8; ++j) { const hx8 hv = yr[lane + 64 * j];
            v[2 * j] = (f32x4){(float)hv[0], (float)hv[1], (float)hv[2], (float)hv[3]}; v[2 * j + 1] = (f32x4){(float)hv[4], (float)hv[5], (float)hv[6], (float)hv[7]}; }
#pragma unroll
        for (int j = 0; j < 16; ++j) ss += (v[j].x * v[j].x + v[j].y * v[j].y) + (v[j].z * v[j].z + v[j].w * v[j].w);
        const float rs = 1.0f / sqrtf(wave_sum(ss) * (1.0f / D) + EPS);
        const f32x4* g3 = (const f32x4*)(C.g_norms + 3 * D); const f32x4* gt = (const f32x4*)(C.mod + b * NMOD + 5 * D);
#pragma unroll
        for (int j = 0; j < 8; ++j) { const hx8 xv = xr[lane + 64 * j]; const int k = 2 * (lane + 64 * j);
            const f32x4 x0 = {(float)xv[0], (float)xv[1], (float)xv[2], (float)xv[3]}, x1 = {(float)xv[4], (float)xv[5], (float)xv[6], (float)xv[7]};
            orow[k] = x0 + gt[k] * (v[2 * j] * rs * g3[k]); orow[k + 1] = x1 + gt[k + 1] * (v[2 * j + 1] * rs * g3[k + 1]); }
    }
}

__device__ __forceinline__ void p3_gates_item(Ctx& C, int item) {
    const int lane = C.lane, w = C.wave, qr = lane & 15, q = lane >> 4, mt = w & 3, kh = w >> 2;
    const f16* ap = C.H + (size_t)(item * 64 + mt * 16 + qr) * D + kh * 2048 + 8 * q;
    const f16* bp = C.WG + (size_t)qr * D + kh * 2048 + 8 * q;
    f32x4 acc[3] = {{0.f, 0.f, 0.f, 0.f}, {0.f, 0.f, 0.f, 0.f}, {0.f, 0.f, 0.f, 0.f}};
#pragma unroll 16
    for (int ks = 0; ks < 64; ++ks) { const hx8 a = *(const hx8*)(ap + 32 * ks);
#pragma unroll
        for (int nt = 0; nt < 3; ++nt) { const hx8 b = *(const hx8*)(bp + (size_t)nt * 16 * D + 32 * ks); acc[nt] = __builtin_amdgcn_mfma_f32_16x16x32_f16(a, b, acc[nt], 0, 0, 0); } }
    LAS f32x4* red = (LAS f32x4*)C.lds;
    if (kh == 1) {
#pragma unroll
        for (int nt = 0; nt < 3; ++nt) red[(mt * 3 + nt) * 64 + lane] = acc[nt]; }
    __syncthreads();
    if (kh == 0) {
#pragma unroll
        for (int nt = 0; nt < 3; ++nt) { const f32x4 s = acc[nt] + red[(mt * 3 + nt) * 64 + lane];
#pragma unroll
            for (int i = 0; i < 4; ++i) C.gates[(size_t)(item * 64 + mt * 16 + 4 * q + i) * 48 + nt * 16 + qr] = fsigmoid(s[i]); } }
    __syncthreads();
}
__device__ __forceinline__ void p3_compress_item(Ctx& C, int item) {
    const int lane = C.lane, w = C.wave, qr = lane & 15, q = lane >> 4, kk = item >> 7, R0 = (item & 127) * 32;
    LAS f16* hid = (LAS f16*)C.lds;
    LAS unsigned char* abuf = C.lds + 20480;
    const int srow = C.tid >> 4, sseg = C.tid & 15;
    const f16* sp;
    { const int R = R0 + srow, b = R >> 11, g = (R >> 9) & 3, n = R & 511, nc = n > 510 ? 510 : n; sp = C.KV + (size_t)(b * T + 16 * nc) * 2048 + kk * 512 + g * 128 + 8 * sseg; }
    const int sdst = (srow * 16 + (sseg ^ (srow & 15))) * 16;
    const f16* pb0 = C.W1T + (size_t)(kk * 256 + 32 * w + qr) * D + 8 * q; const f16* pb1 = pb0 + (size_t)16 * D;
    f32x4 acc[2][2] = {{{0.f, 0.f, 0.f, 0.f}, {0.f, 0.f, 0.f, 0.f}}, {{0.f, 0.f, 0.f, 0.f}, {0.f, 0.f, 0.f, 0.f}}};
    hx8 fb[2][8]; hx8 nxt = *(const hx8*)sp; sp += 2048;
#define CM_LOADB(buf) do { _Pragma("unroll") for (int k4 = 0; k4 < 4; ++k4) { fb[buf][2 * k4] = *(const hx8*)(pb0 + 32 * k4); fb[buf][2 * k4 + 1] = *(const hx8*)(pb1 + 32 * k4); } pb0 += 128; pb1 += 128; } while (0)
#define CM_STEP(c, buf) do { *(LAS hx8*)(abuf + ((c) & 1) * 8192 + sdst) = nxt; \
        if ((c) + 1 < 32) { nxt = *(const hx8*)sp; sp += 2048; CM_LOADB((buf) ^ 1); } \
        __syncthreads(); \
        hx8 af_[8]; _Pragma("unroll") for (int i_ = 0; i_ < 8; ++i_) { const int mt_ = i_ >> 2, k4_ = i_ & 3; af_[i_] = *(const LAS hx8*)(abuf + ((c) & 1) * 8192 + ((16 * mt_ + qr) * 16 + ((4 * k4_ + q) ^ qr)) * 16); } \
        _Pragma("unroll") for (int k4 = 0; k4 < 4; ++k4) { \
            acc[0][0] = __builtin_amdgcn_mfma_f32_16x16x32_f16(af_[k4], fb[buf][2 * k4], acc[0][0], 0, 0, 0); acc[0][1] = __builtin_amdgcn_mfma_f32_16x16x32_f16(af_[k4], fb[buf][2 * k4 + 1], acc[0][1], 0, 0, 0); \
            acc[1][0] = __builtin_amdgcn_mfma_f32_16x16x32_f16(af_[4 + k4], fb[buf][2 * k4], acc[1][0], 0, 0, 0); acc[1][1] = __builtin_amdgcn_mfma_f32_16x16x32_f16(af_[4 + k4], fb[buf][2 * k4 + 1], acc[1][1], 0, 0, 0); } } while (0)
    CM_LOADB(0);
#pragma unroll 1
    for (int c = 0; c < 32; c += 2) { CM_STEP(c, 0); CM_STEP(c + 1, 1); }
#undef CM_LOADB
#undef CM_STEP
    __syncthreads();
#pragma unroll
    for (int mt = 0; mt < 2; ++mt)
#pragma unroll
        for (int nt = 0; nt < 2; ++nt) { const int j = 32 * w + 16 * nt + qr; const float pb = C.posw1[kk * 256 + j];
#pragma unroll
            for (int i = 0; i < 4; ++i) hid[(16 * mt + 4 * q + i) * 264 + j] = (f16)fgelu(acc[mt][nt][i] + pb); }
    __syncthreads();
    const f16* wp = C.W2T + (size_t)(kk * 128 + 16 * w + qr) * 256 + 8 * q;
    f32x4 o2[2] = {{0.f, 0.f, 0.f, 0.f}, {0.f, 0.f, 0.f, 0.f}};
#pragma unroll
    for (int ks = 0; ks < 8; ++ks) { const hx8 wf = *(const hx8*)(wp + 32 * ks);
#pragma unroll
        for (int mt = 0; mt < 2; ++mt) { const hx8 hf = *(const LAS hx8*)(hid + (16 * mt + qr) * 264 + 32 * ks + 8 * q);
            if (kk == 0) o2[mt] = __builtin_amdgcn_mfma_f32_16x16x32_f16(wf, hf, o2[mt], 0, 0, 0);
            else o2[mt] = __builtin_amdgcn_mfma_f32_16x16x32_f16(hf, wf, o2[mt], 0, 0, 0); } }
    if (kk == 0) {
#pragma unroll
        for (int mt = 0; mt < 2; ++mt) { const int R = R0 + 16 * mt + qr, n = R & 511, d0 = 16 * w + 4 * q; const bool pad = n == 511;
            float v[4];
#pragma unroll
            for (int i = 0; i < 4; ++i) v[i] = pad ? 0.f : o2[mt][i] + C.cmp_b2[d0 + i];
            u32x2 o; o.x = pkh(v[0], v[1]); o.y = pkh(v[2], v[3]); *(u32x2*)(C.KC + (size_t)R * 128 + d0) = o; }
    } else {
#pragma unroll
        for (int mt = 0; mt < 2; ++mt) { const int Rb = R0 + 16 * mt + 4 * q, bg = Rb >> 9, n0 = Rb & 511, d = 16 * w + qr; const float bb = C.cmp_b2[128 + d];
            float v[4];
#pragma unroll
            for (int i = 0; i < 4; ++i) v[i] = (n0 + i == 511) ? 0.f : o2[mt][i] + bb;
            u32x2 o; o.x = pkh(v[0], v[1]); o.y = pkh(v[2], v[3]); *(u32x2*)(C.VCT + ((size_t)bg * 128 + d) * 512 + n0) = o; }
    }
    __syncthreads();
}
__device__ __forceinline__ void p3_sgu_item(Ctx& C, int item) {
    const int lane = C.lane, w = C.wave, tid = C.tid, qr = lane & 15, q = lane >> 4, r0 = (item >> 1) * 128, half = item & 1;
    LAS float* stats = (LAS float*)C.lds;
    LAS f16* vt = (LAS f16*)(C.lds + 1024);
#pragma unroll 4
    for (int tk = 0; tk < 16; ++tk) { const int s = 16 * w + tk; const f16* vp = C.Z + (size_t)(r0 + s) * D + 2048 + 8 * lane;
        float xv[32]; float sum = 0.f;
#pragma unroll
        for (int jj = 0; jj < 4; ++jj) { const hx8 h = *(const hx8*)(vp + 512 * jj);
#pragma unroll
            for (int e = 0; e < 8; ++e) { xv[8 * jj + e] = (float)h[e]; sum += xv[8 * jj + e]; } }
        const float mu = wave_sum(sum) * (1.0f / 2048.0f); float sq = 0.f;
#pragma unroll
        for (int e = 0; e < 32; ++e) { const float dv = xv[e] - mu; sq += dv * dv; }
        const float var = wave_sum(sq) * (1.0f / 2048.0f);
        if (lane == 0) { stats[2 * s] = mu; stats[2 * s + 1] = 1.0f / sqrtf(var + EPS); } }
    __syncthreads();
    for (int gi = 0; gi < 8; ++gi) { const int hh = half * 8 + gi;
        { const int s = tid >> 2, seg = tid & 3; const float mu = stats[2 * s], rstd = stats[2 * s + 1];
          const f16* vp = C.Z + (size_t)(r0 + s) * D + 2048 + hh * 128 + 32 * seg;
#pragma unroll
          for (int i = 0; i < 4; ++i) { const hx8 h = *(const hx8*)(vp + 8 * i);
#pragma unroll
              for (int e = 0; e < 8; ++e) { const int d = 32 * seg + 8 * i + e; const float y = ((float)h[e] - mu) * rstd * C.ln_g[hh * 128 + d] + C.ln_b[hh * 128 + d]; vt[d * 136 + s] = (f16)y; } } }
        __syncthreads();
        hx8 wf[4];
#pragma unroll
        for (int ks = 0; ks < 4; ++ks) wf[ks] = *(const hx8*)(C.SGUW + ((size_t)(hh * 128 + 16 * w + qr)) * 128 + 32 * ks + 8 * q);
        f32x4 acc[8];
#pragma unroll
        for (int dt = 0; dt < 8; ++dt) { acc[dt] = (f32x4){0.f, 0.f, 0.f, 0.f};
#pragma unroll
            for (int ks = 0; ks < 4; ++ks) { const hx8 af = *(const LAS hx8*)(vt + (16 * dt + qr) * 136 + 32 * ks + 8 * q); acc[dt] = __builtin_amdgcn_mfma_f32_16x16x32_f16(af, wf[ks], acc[dt], 0, 0, 0); } }
        { const int tl = 16 * w + qr; const float bs = C.sgu_b[hh * 128 + tl];
          const f16* up = C.Z + (size_t)(r0 + tl) * D + hh * 128 + 4 * q; f16* yp = C.YAB + (size_t)(r0 + tl) * D + 2048 + hh * 128 + 4 * q;
#pragma unroll
          for (int dt = 0; dt < 8; ++dt) { const hx4 u = *(const hx4*)(up + 16 * dt);
              u32x2 o; o.x = pk_mix((float)u[0] * (acc[dt][0] + bs), (float)u[1] * (acc[dt][1] + bs)); o.y = pk_mix((float)u[2] * (acc[dt][2] + bs), (float)u[3] * (acc[dt][3] + bs));
              *(u32x2*)(yp + 16 * dt) = o; } }
        __syncthreads();
    }
}

constexpr int ATT_LUT = 0, ATT_IMP = 8192, ATT_STG = 40960, STG_BYTES = 32768, STG_V = 16384;
static_assert(ATT_STG + 3 * STG_BYTES <= MISC_OFF, "attention LDS map");
__device__ __forceinline__ int rel_bucket_small(int n) {
    if (n < 16) return n;
    int b = 16;
    b += n >= 19; b += n >= 21; b += n >= 24; b += n >= 27; b += n >= 31; b += n >= 35; b += n >= 40; b += n >= 46; b += n >= 52; b += n >= 59; b += n >= 67; b += n >= 77; b += n >= 87; b += n >= 99; b += n >= 113;
    return b;
}
__device__ __forceinline__ void att_issue(Ctx& C, int s, int n_c, int n_s, int ks0g, int b, int g) {
    const int lane = (int)pg8::opaque((unsigned)C.lane), w = C.wave;
    const f16* kb; const f16* vb; int ldk, ldv, kb0;
    if (s < 2 * n_c) { kb0 = 64 * (s < n_c ? s : s - n_c); kb = C.KC + (size_t)(b * 4 + g) * 512 * 128; ldk = 128; vb = C.VCT + (size_t)(b * 4 + g) * 128 * 512; ldv = 512; }
    else if (s < 2 * n_c + n_s) { kb0 = 64 * (s - 2 * n_c); kb = C.KV + (size_t)b * T * 2048 + 1024 + g * 128; ldk = 2048; vb = C.VT + (size_t)(g * 128) * M + (size_t)b * T; ldv = M; }
    else { kb0 = ks0g + 64 * (s - 2 * n_c - n_s); kb = C.KV + (size_t)b * T * 2048 + 1536 + g * 128; ldk = 2048; vb = C.VT + (size_t)(512 + g * 128) * M + (size_t)b * T; ldv = M; }
    LAS unsigned char* buf = C.lds + ATT_STG + (s % 3) * STG_BYTES;
#pragma unroll
    for (int i = 0; i < 2; ++i) { const int R = 8 * w + 4 * i + (lane >> 4), m = R & 15, key = kb0 + 32 * (R >> 5) + (m >> 2) * 8 + (m & 3) + 4 * ((R >> 4) & 1), cidx = (lane & 15) ^ m;
        __builtin_amdgcn_global_load_lds((const unsigned*)(kb + (size_t)key * ldk + cidx * 8), (LAS unsigned*)(buf + (8 * w + 4 * i) * 256), 16, 0, 0); }
#pragma unroll
    for (int i = 0; i < 2; ++i) { const int dr = 16 * w + 8 * i + (lane >> 3), v = (lane & 7) ^ ((dr & 15) >> 1);
        __builtin_amdgcn_global_load_lds((const unsigned*)(vb + (size_t)dr * ldv + kb0 + 8 * v), (LAS unsigned*)(buf + STG_V + (16 * w + 8 * i) * 128), 16, 0, 0); }
}
#define SB() __builtin_amdgcn_sched_barrier(0)
#define ATT_QK2(TL) do { _Pragma("unroll") for (int scn_ = 0; scn_ < 2; ++scn_) { hx8 kf_[8]; \
        _Pragma("unroll") for (int i_ = 0; i_ < 8; ++i_) { const int kt_ = i_ >> 2, ks_ = i_ & 3; \
            kf_[i_] = *(const LAS hx8*)(bufp + scn_ * 8192 + kt_ * 4096 + qr * 256 + (((4 * ks_ + q) ^ qr) << 4)); } \
        __builtin_amdgcn_s_setprio(1); \
        _Pragma("unroll") for (int t_ = 0; t_ < 2; ++t_) { f32x4 a_ = {0.f, 0.f, 0.f, 0.f}; \
            _Pragma("unroll") for (int ks = 0; ks < 4; ++ks) a_ = __builtin_amdgcn_mfma_f32_16x16x32_f16(kf_[4 * t_ + ks], qf[TL][ks], a_, 0, 0, 0); sv[2 * scn_ + t_] = a_; } \
        __builtin_amdgcn_s_setprio(0); } } while (0)
#define SVJ(tl, j) (sv[(j) >> 2][(j) & 3])
#define ATT_PV2() do { SB(); \
    _Pragma("unroll") for (int sn_ = 0; sn_ < 2; ++sn_) { hx8 vf_[8]; \
        _Pragma("unroll") for (int dt_ = 0; dt_ < 8; ++dt_) vf_[dt_] = *(const LAS hx8*)(bufp + STG_V + qr * 128 + (((4 * sn_ + q) ^ (qr >> 1)) << 4) + dt_ * 2048); \
        _Pragma("unroll") for (int tl_ = 0; tl_ < 2; ++tl_) { if (act[tl_]) { _Pragma("unroll") for (int dt = 0; dt < 8; ++dt) o[tl_][dt] = __builtin_amdgcn_mfma_f32_16x16x32_f16(vf_[dt], pf[tl_][sn_], o[tl_][dt], 0, 0, 0); } } } \
    SB(); } while (0)
#define ATT_MAXUPD(TL, RESCALE_O) do { if (__any(cm_ > m[TL] + 8.0f)) { cm_ = fmaxf(cm_, __shfl_xor(cm_, 16)); cm_ = fmaxf(cm_, __shfl_xor(cm_, 32)); \
    const float mn_ = fmaxf(m[TL], cm_); const float al_ = __builtin_amdgcn_exp2f(m[TL] - mn_); m[TL] = mn_; l[TL] *= al_; \
    if (RESCALE_O) { _Pragma("unroll") for (int dt = 0; dt < 8; ++dt) o[TL][dt] *= al_; } } } while (0)
#define ATT_PACKP(TL) do { _Pragma("unroll") for (int j = 0; j < 8; ++j) { pf[TL][0][j] = (f16)p[j]; pf[TL][1][j] = (f16)p[8 + j]; } } while (0)
#define ATT_SOFTMAX_FAR(TL, cb_, RESCALE_O) do { float mx_ = SVJ(TL, 0); _Pragma("unroll") for (int j = 1; j < 16; ++j) mx_ = fmaxf(mx_, SVJ(TL, j)); \
    float cm_ = mx_ * SC2 + (cb_); ATT_MAXUPD(TL, RESCALE_O); const float off_ = (cb_) - m[TL]; float ps_ = 0.f; \
    _Pragma("unroll") for (int j = 0; j < 16; ++j) { const float e_ = __builtin_amdgcn_exp2f(SVJ(TL, j) * SC2 + off_); ps_ += e_; pf[TL][j >> 3][j & 7] = (f16)e_; } l[TL] += ps_; } while (0)
#define ATT_SOFTMAX_NEAR(TL, RESCALE_O) do { float cm_ = sc[0]; _Pragma("unroll") for (int j = 1; j < 16; ++j) cm_ = fmaxf(cm_, sc[j]); \
    ATT_MAXUPD(TL, RESCALE_O); float ps_ = 0.f; \
    _Pragma("unroll") for (int j = 0; j < 16; ++j) { const float e_ = __builtin_amdgcn_exp2f(sc[j] - m[TL]); ps_ += e_; pf[TL][j >> 3][j & 7] = (f16)e_; } l[TL] += ps_; } while (0)
#define ATT_STAGE_BEGIN() do { if (s + 1 < S) asm volatile("s_waitcnt vmcnt(4)" ::: "memory"); else asm volatile("s_waitcnt vmcnt(0)" ::: "memory"); \
    __builtin_amdgcn_s_barrier(); asm volatile("" ::: "memory"); \
    if (s + 2 < S) att_issue(C, s + 2, n_c, n_s, ks0g, b, g); \
    bufp = C.lds + ATT_STG + (s % 3) * STG_BYTES; } while (0)
constexpr float NEGBIG = -3.0e38f;

__device__ __forceinline__ void p4_attn_unit(Ctx& C, int u) {
    const int lane = C.lane, w = C.wave, qr = lane & 15, q = lane >> 4, tok = qr >> 2, r = qr & 3;
    const int bg = u & 7, b = bg >> 2, g = bg & 3, tj = u >> 3, t0g = tj * 64, t0 = t0g + w * 8, h = g * 4 + r;
    const LAS float* lut = (const LAS float*)(C.lds + ATT_LUT) + h * 128;
    LAS float* imp = (LAS float*)(C.lds + ATT_IMP) + w * 1024;
    const LAS unsigned char* bufp = C.lds + ATT_STG;
    const int n_c = (tj >> 4) + 1, n_s = tj + 1, ks0g = (t0g - 511 < 0 ? 0 : t0g - 511) & ~63, n_w = ((t0g + 63 - ks0g) >> 6) + 1, S = 2 * n_c + n_s + n_w;
    hx8 qf[2][4];
#pragma unroll
    for (int tl = 0; tl < 2; ++tl) { const int t = t0 + 4 * tl + tok; const f16* qp = C.Q + (size_t)(b * T + t) * 2048 + h * 128 + 8 * q;
#pragma unroll
        for (int ks = 0; ks < 4; ++ks) qf[tl][ks] = *(const hx8*)(qp + 32 * ks); }
#define GATE(tl, i) (C.gates[(size_t)(b * T + t0 + 4 * (tl) + tok) * 48 + h * 3 + (i)])
#define YSP(tl) ((f32x4*)(C.ysc + (size_t)(b * T + t0 + 4 * (tl) + tok) * 2048 + h * 128 + 4 * q))
    const float b127 = lut[127];
    f32x4 o[2][8], sv[4]; hx8 pf[2][2]; float sc[16], p[16], m[2], l[2]; bool act[2];
#pragma unroll
    for (int tl = 0; tl < 2; ++tl)
#pragma unroll
        for (int dt = 0; dt < 8; ++dt) o[tl][dt] = (f32x4){0.f, 0.f, 0.f, 0.f};
    for (int i = lane; i < 1024; i += 64) imp[i] = 0.f;
    asm volatile("s_waitcnt vmcnt(0) lgkmcnt(0)" ::: "memory");
    __syncthreads();
    int s = 0;
    att_issue(C, 0, n_c, n_s, ks0g, b, g); att_issue(C, 1, n_c, n_s, ks0g, b, g);

    m[0] = m[1] = -1e30f; l[0] = l[1] = 0.f;
    for (int c = 0; c < n_c; ++c, ++s) {
        ATT_STAGE_BEGIN();
        const int kb0 = 64 * c;
        act[0] = kb0 <= ((t0 + 3 - 31) >> 4); act[1] = kb0 <= ((t0 + 7 - 31) >> 4);
        if (!act[1]) continue;
#pragma unroll
        for (int tl = 0; tl < 2; ++tl) { if (act[tl]) { const int tb = t0 + 4 * tl, t = tb + tok, nmax_t = (t - 31) >> 4;
            ATT_QK2(tl);
            if (kb0 + 63 <= ((tb - 31) >> 4) && tb - 16 * (kb0 + 63) - 31 >= 127) { ATT_SOFTMAX_FAR(tl, b127, false); }
            else {
#pragma unroll
                for (int j = 0; j < 16; ++j) { const int n = kb0 + 32 * (j >> 3) + 8 * q + (j & 7), dist = t - 16 * n - 31;
                    const int di = dist < 0 ? 0 : (dist > 127 ? 127 : dist); const float lv = lut[di]; const float sx = SVJ(tl, j) * SC2 + lv; sc[j] = n <= nmax_t ? sx : NEGBIG; }
                ATT_SOFTMAX_NEAR(tl, false); } } }
    }
    float il[2];
#pragma unroll
    for (int tl = 0; tl < 2; ++tl) { l[tl] += __shfl_xor(l[tl], 16); l[tl] += __shfl_xor(l[tl], 32); il[tl] = l[tl] > 0.f ? 1.0f / l[tl] : 0.f; }
    float carry[2] = {0.f, 0.f};
    for (int c = 0; c < n_c; ++c, ++s) {
        ATT_STAGE_BEGIN();
        const int kb0 = 64 * c;
        act[0] = kb0 <= ((t0 + 3 - 31) >> 4); act[1] = kb0 <= ((t0 + 7 - 31) >> 4);
        if (!act[1]) continue;
#pragma unroll
        for (int tl = 0; tl < 2; ++tl) { if (act[tl]) { const int t = t0 + 4 * tl + tok, nmax_t = (t - 31) >> 4;
            ATT_QK2(tl);
#pragma unroll
            for (int j = 0; j < 16; ++j) { const int n = kb0 + 32 * (j >> 3) + 8 * q + (j & 7), dist = t - 16 * n - 31;
                const int di = dist < 0 ? 0 : (dist > 127 ? 127 : dist); const float lv = lut[di]; const float px = __builtin_amdgcn_exp2f(SVJ(tl, j) * SC2 + lv - m[tl]) * il[tl]; p[j] = n <= nmax_t ? px : 0.f; }
            ATT_PACKP(tl);
#pragma unroll
            for (int scn = 0; scn < 2; ++scn) { float ph[8];
#pragma unroll
                for (int j = 0; j < 8; ++j) { float v = p[8 * scn + j]; v += dpp_f<0xB1>(v); v += dpp_f<0x4E>(v); ph[j] = v; }
                const float t7 = __shfl(ph[7], (lane + 48) & 63);
                const float left = q == 0 ? carry[tl] : t7; carry[tl] = t7;
                if (r == 0) { f32x2 iv; iv.x = left + 2.0f * (ph[0] + ph[1] + ph[2]) + ph[3]; iv.y = ph[3] + 2.0f * (ph[4] + ph[5] + ph[6]) + ph[7];
                    *(LAS f32x2*)(imp + (4 * tl + tok) * 128 + ((kb0 + 32 * scn) >> 2) + 2 * q) = iv; } } } }
        ATT_PV2();
    }
#pragma unroll
    for (int tl = 0; tl < 2; ++tl) { f32x4* ysp = YSP(tl); const float gc = GATE(tl, 0);
#pragma unroll
        for (int dt = 0; dt < 8; ++dt) { ysp[4 * dt] = o[tl][dt] * gc; o[tl][dt] = (f32x4){0.f, 0.f, 0.f, 0.f}; } }
    LDS_WAIT();
    unsigned long long my_lo[2] = {0ull, 0ull}, my_hi[2] = {0ull, 0ull}, U_lo[2] = {0ull, 0ull}, U_hi[2] = {0ull, 0ull};
#pragma unroll
    for (int tk = 0; tk < 8; ++tk) { const int tt = t0 + tk, cur = tt >> 6; unsigned long long lo, hi;
        if (cur < 16) { lo = (1ull << (cur + 1)) - 1ull; hi = 0ull; }
        else {
            LAS float* P = imp + tk * 128;
            const int j0 = lane, j1 = lane + 64;
            const bool c0 = j0 >= 1 && j0 <= cur - 2, c1 = j1 <= cur - 2;
            const float i0 = c0 ? P[j0] : -1.0f, i1 = c1 ? P[j1] : -1.0f;
            LDS_WAIT();
            P[j0] = i0; P[j1] = i1;
            LDS_WAIT();
            int r0 = 0, r1 = 0;
            for (int jp = 0; jp <= cur - 2; jp += 4) { const f32x4 v = *(const LAS f32x4*)(P + jp);
#pragma unroll
                for (int e = 0; e < 4; ++e) { r0 += (v[e] > i0 || (v[e] == i0 && jp + e < j0)) ? 1 : 0; r1 += (v[e] > i1 || (v[e] == i1 && jp + e < j1)) ? 1 : 0; } }
            const bool sel0 = (c0 && r0 < 13) || j0 == 0 || j0 == cur || j0 == cur - 1, sel1 = (c1 && r1 < 13) || j1 == cur || j1 == cur - 1;
            lo = __ballot(sel0); hi = __ballot(sel1);
        }
        U_lo[tk >> 2] |= lo; U_hi[tk >> 2] |= hi; if (tok == (tk & 3)) { my_lo[tk >> 2] = lo; my_hi[tk >> 2] = hi; } }
    m[0] = m[1] = -1e30f; l[0] = l[1] = 0.f;
    for (int jb = 0; jb < n_s; ++jb, ++s) {
        ATT_STAGE_BEGIN();
        bool mine[2];
#pragma unroll
        for (int tl = 0; tl < 2; ++tl) { act[tl] = jb < 64 ? ((U_lo[tl] >> jb) & 1ull) : ((U_hi[tl] >> (jb - 64)) & 1ull); mine[tl] = jb < 64 ? ((my_lo[tl] >> jb) & 1ull) : ((my_hi[tl] >> (jb - 64)) & 1ull); }
        if (!act[0] && !act[1]) continue;
        const int kb0 = 64 * jb;
#pragma unroll
        for (int tl = 0; tl < 2; ++tl) { if (act[tl]) { const int tb = t0 + 4 * tl, t = tb + tok;
            ATT_QK2(tl);
            if (tb - (kb0 + 63) >= 127) { const float cb = mine[tl] ? b127 : NEGBIG; ATT_SOFTMAX_FAR(tl, cb, true); }
            else { const int bd = t - kb0 - 8 * q;
#pragma unroll
                for (int j = 0; j < 16; ++j) { const int dist = bd - 32 * (j >> 3) - (j & 7);
                    const int di = dist < 0 ? 0 : (dist > 127 ? 127 : dist); const float lv = lut[di]; const float sx = SVJ(tl, j) * SC2 + lv; sc[j] = (mine[tl] && dist >= 0) ? sx : NEGBIG; }
                ATT_SOFTMAX_NEAR(tl, true); } } }
        ATT_PV2();
    }
#pragma unroll
    for (int tl = 0; tl < 2; ++tl) { l[tl] += __shfl_xor(l[tl], 16); l[tl] += __shfl_xor(l[tl], 32); const float gl = l[tl] > 0.f ? GATE(tl, 1) / l[tl] : 0.f; f32x4* ysp = YSP(tl);
#pragma unroll
        for (int dt = 0; dt < 8; ++dt) { ysp[4 * dt] = ysp[4 * dt] + o[tl][dt] * gl; o[tl][dt] = (f32x4){0.f, 0.f, 0.f, 0.f}; } }
    m[0] = m[1] = -1e30f; l[0] = l[1] = 0.f;
    for (int k = 0; k < n_w; ++k, ++s) {
        ATT_STAGE_BEGIN();
        const int kb0 = ks0g + 64 * k;
#pragma unroll
        for (int tl = 0; tl < 2; ++tl) { const int tb = t0 + 4 * tl; act[tl] = !(kb0 > tb + 3 || kb0 + 63 < tb - 511); }
        if (!act[0] && !act[1]) continue;
#pragma unroll
        for (int tl = 0; tl < 2; ++tl) { if (act[tl]) { const int tb = t0 + 4 * tl, t = tb + tok;
            ATT_QK2(tl);
            if (tb - (kb0 + 63) >= 127 && tb + 3 - kb0 <= 511) { ATT_SOFTMAX_FAR(tl, b127, true); }
            else { const int bd = t - kb0 - 8 * q;
#pragma unroll
                for (int j = 0; j < 16; ++j) { const int dist = bd - 32 * (j >> 3) - (j & 7);
                    const int di = dist < 0 ? 0 : (dist > 127 ? 127 : dist); const float lv = lut[di]; const float sx = SVJ(tl, j) * SC2 + lv; sc[j] = (dist >= 0 && dist < 512) ? sx : NEGBIG; }
                ATT_SOFTMAX_NEAR(tl, true); } } }
        ATT_PV2();
    }
#pragma unroll
    for (int tl = 0; tl < 2; ++tl) { l[tl] += __shfl_xor(l[tl], 16); l[tl] += __shfl_xor(l[tl], 32); const float gl = l[tl] > 0.f ? GATE(tl, 2) / l[tl] : 0.f; const f32x4* ysp = YSP(tl);
        f16* yp = C.YAB + (size_t)(b * T + t0 + 4 * tl + tok) * D + h * 128 + 4 * q;
#pragma unroll
        for (int dt = 0; dt < 8; ++dt) { const f32x4 yv = ysp[4 * dt] + o[tl][dt] * gl; u32x2 ov; ov.x = pk_mix(yv[0], yv[1]); ov.y = pk_mix(yv[2], yv[3]); *(u32x2*)(yp + 16 * dt) = ov; } }
}
#undef GATE
#undef YSP
__device__ __forceinline__ void p4_attention(Ctx& C) {
    LAS float* lut = (LAS float*)(C.lds + ATT_LUT);
    for (int i = C.tid; i < 16 * 128; i += NTHREADS) { const int hh = i >> 7, n = i & 127; lut[i] = C.rel_table[rel_bucket_small(n) * 16 + hh] * LOG2E; }
    __syncthreads();
    for (int u = C.bid; u < 1024; u += C.G) p4_attn_unit(C, u);
    __syncthreads();
}

__device__ __forceinline__ void p9_fixup(Ctx& C) {
    const int gt = C.bid * NTHREADS + C.tid, NGT = C.G * NTHREADS;
    for (int it = gt; it < 64 * (DFF / 8); it += NGT) {
        const int pm = it / (DFF / 8), c0 = (it % (DFF / 8)) * 8; const bool first = ((pm * 256) & (T - 1)) == 0;
        float res[2][8];
#pragma unroll
        for (int h4 = 0; h4 < 2; ++h4) {
            f32x4 cvv[2][2];
#pragma unroll
            for (int bj = 0; bj < 2; ++bj) { const int cc = c0 + 4 * h4;
                const f32x4 w0 = *(const f32x4*)(C.conv_w + 0 * NUP + bj * DFF + cc), w1 = *(const f32x4*)(C.conv_w + 1 * NUP + bj * DFF + cc), w2 = *(const f32x4*)(C.conv_w + 2 * NUP + bj * DFF + cc), bb = *(const f32x4*)(C.conv_b + bj * DFF + cc);
                const f32x4 a0 = *(const f32x4*)(C.AT + (size_t)((pm * 2 + 0) * 2 + bj) * DFF + cc), a1 = *(const f32x4*)(C.AT + (size_t)((pm * 2 + 1) * 2 + bj) * DFF + cc);
                f32x4 hm2 = {0.f, 0.f, 0.f, 0.f}, hm1 = {0.f, 0.f, 0.f, 0.f};
                if (!first) { hm2 = *(const f32x4*)(C.AH + (size_t)((2 * (pm - 1) + 0) * 2 + bj) * DFF + cc); hm1 = *(const f32x4*)(C.AH + (size_t)((2 * (pm - 1) + 1) * 2 + bj) * DFF + cc); }
                cvv[0][bj] = bb + w0 * hm2 + w1 * hm1 + w2 * a0; cvv[1][bj] = bb + w0 * hm1 + w1 * a0 + w2 * a1; }
#pragma unroll
            for (int j = 0; j < 2; ++j)
#pragma unroll
                for (int i = 0; i < 4; ++i) res[j][4 * h4 + i] = fsilu(cvv[j][0][i]) * cvv[j][1][i]; }
#pragma unroll
        for (int j = 0; j < 2; ++j) { u32x4 ov; ov.x = pk_ffn(res[j][0], res[j][1]); ov.y = pk_ffn(res[j][2], res[j][3]); ov.z = pk_ffn(res[j][4], res[j][5]); ov.w = pk_ffn(res[j][6], res[j][7]);
            *(u32x4*)(C.ACT + (size_t)(pm * 256 + j) * DFF + c0) = ov; }
    }
}

__device__ __forceinline__ void ph2_proj(Ctx& C) {
    { pg8::Gemm g{C.H, C.WIN, M, 3072, D}; pg8::StaticOrder S; S.init(M, 3072, C.G, C.bid);
      pg8::EpiProj E{C.Q, C.KV, C.Z, C.GA, C.GB, 0};
      pg8::gemm_phase<pg8::EpiProj, pg8::StaticOrder>(C.lds, g, S, E); }
    { pg8::Gemm g{C.H, C.WIN + (size_t)4096 * D, M, 4096, D}; pg8::StaticOrder S; S.init(M, 4096, C.G, C.bid);
      pg8::EpiProj E{C.Q, C.KV, C.Z, C.GA, C.GB, 16};
      pg8::gemm_phase<pg8::EpiProj, pg8::StaticOrder>(C.lds, g, S, E); }
    { pg8::Gemm g{(const f16*)(C.ws + WS_H1Q), (const f16*)(C.ws + WS_WINQ), M, 1024, D / 2}; pg8::StaticOrder S; S.init(M, 1024, C.G, C.bid);
      pg8::EpiProjQ E{C.ws, 12};
      pg8::gemm_phase<pg8::EpiProjQ, pg8::StaticOrder, true, 2>(C.lds, g, S, E); }
    { pg8::Gemm g{(const f16*)(C.ws + WS_H1Q), (const f16*)(C.ws + WS_WINQ + (size_t)5120 * D), M, 8192, D / 2}; pg8::StaticOrder S; S.init(M, 8192, C.G, C.bid);
      pg8::EpiProjQ E{C.ws, 32};
      pg8::gemm_phase<pg8::EpiProjQ, pg8::StaticOrder, true, 2>(C.lds, g, S, E); }
    { pg8::Gemm g{(const f16*)(C.ws + WS_WVTQ), (const f16*)(C.ws + WS_H1Q), 1024, M, D / 2}; pg8::StaticOrder S; S.init(1024, M, C.G, C.bid);
      pg8::EpiVTQ E{C.ws};
      pg8::gemm_phase<pg8::EpiVTQ, pg8::StaticOrder, true, 2>(C.lds, g, S, E); }
}
__device__ __forceinline__ void ph3_mixers(Ctx& C) {
    for (int it = C.bid; it < 256; it += C.G) p3_gates_item(C, it);
    if constexpr (((PROBE_DUP) >> 12) & 1) { for (int it = C.bid; it < 256; it += C.G) p3_gates_item(C, it); }
    for (int it = C.bid; it < 256; it += C.G) p3_compress_item(C, it);
    if constexpr (((PROBE_DUP) >> 13) & 1) { for (int it = C.bid; it < 256; it += C.G) p3_compress_item(C, it); }
    for (int it = C.bid; it < 256; it += C.G) p3_sgu_item(C, it);
    if constexpr (((PROBE_DUP) >> 14) & 1) { for (int it = C.bid; it < 256; it += C.G) p3_sgu_item(C, it); }
}
__device__ __forceinline__ void ph5_merge(Ctx& C) {
    pg8::Gemm g{C.YAB, C.WM, M, D, D}; pg8::StaticOrder S; S.init(M, D, C.G, C.bid);
    pg8::EpiMerge E{C.GA, C.GB, C.H};
    pg8::gemm_phase<pg8::EpiMerge, pg8::StaticOrder, true, MIX_BF16 ? 1 : 0>(C.lds, g, S, E);
}
__device__ __forceinline__ void ph6_out(Ctx& C) {
    pg8::Gemm g{C.H, C.WO, M, D, D}; pg8::StaticOrder S; S.init(M, D, C.G, C.bid);
    pg8::EpiH16 E{C.Y1, D};
    pg8::gemm_phase<pg8::EpiH16, pg8::StaticOrder, true, MIX_BF16 ? 1 : 0>(C.lds, g, S, E);
}
__device__ __forceinline__ void ph8_up(Ctx& C) {
    pg8::Gemm g{(const f16*)((signed char*)(C.ws + WS_H2)), (const f16*)((signed char*)(C.ws + WS_WUPQ)), M + 256, NUP, D / 2}; pg8::StaticOrder S; S.init(M + 256, NUP, C.G, C.bid);
    pg8::EpiConv E{C.ws, C.conv_w, C.conv_b, (LAS float*)(C.lds + pg8::STAGE_BYTES), FFN_BF16};
    pg8::gemm_phase<pg8::EpiConv, pg8::StaticOrder, true, 2>(C.lds, g, S, E);
}
__device__ __forceinline__ void ph9_conv(Ctx& C) { p9_fixup(C); }
__device__ __forceinline__ void ph10_down(Ctx& C) {
    pg8::Gemm g{C.ACT, C.WDN, M, D, DFF}; pg8::StaticOrder S; S.init(M, D, C.G, C.bid);
    pg8::EpiH16 E{C.Y2, D};
    pg8::gemm_phase<pg8::EpiH16, pg8::StaticOrder, true, FFN_BF16 ? 1 : 0>(C.lds, g, S, E);
}

constexpr int NPHASE = 12;
__global__ void __launch_bounds__(NTHREADS, 2) fwd_kernel(Args args) {
    extern __shared__ __attribute__((aligned(16))) unsigned char lds_raw[];
    Ctx C;
    C.lds = (LAS unsigned char*)lds_raw;
    C.tid = threadIdx.x; C.lane = C.tid & 63; C.wave = __builtin_amdgcn_readfirstlane(C.tid >> 6); C.G = gridDim.x; C.bid = blockIdx.x;
    C.x = args.in[0]; C.c = args.in[1]; C.w_mod = args.in[2]; C.b_mod = args.in[3]; C.g_norms = args.in[4]; C.w_in = args.in[5]; C.cmp_pos = args.in[6]; C.cmp_w1 = args.in[7];
    C.cmp_b1 = args.in[8]; C.cmp_w2 = args.in[9]; C.cmp_b2 = args.in[10]; C.rel_table = args.in[11]; C.ln_g = args.in[12]; C.ln_b = args.in[13]; C.sgu_w = args.in[14]; C.sgu_b = args.in[15];
    C.w_pn = args.in[16]; C.w_ps = args.in[17]; C.w_out = args.in[18]; C.w_up = args.in[19]; C.conv_w = args.in[20]; C.conv_b = args.in[21]; C.w_dn = args.in[22];
    C.out = args.out; C.ws = args.ws; unsigned char* ws = args.ws;
    C.mod = (float*)(ws + WS_MOD); C.posw1 = (float*)(ws + WS_POSW1); C.gates = (float*)(ws + WS_GATES); C.ysc = (float*)(ws + WS_YSC); C.AH = (float*)(ws + WS_AH); C.AT = (float*)(ws + WS_AT); C.Y1 = (f16*)(ws + WS_Z); C.Y2 = (f16*)(ws + WS_Y2); C.X1H = (f16*)(ws + WS_X1H);
    C.W2T = (f16*)(ws + WS_W2T); C.SGUW = (f16*)(ws + WS_SGUW); C.WG = (f16*)(ws + WS_WG); C.KC = (f16*)(ws + WS_KC); C.VCT = (f16*)(ws + WS_VCT); C.W1T = (f16*)(ws + WS_W1T);
    C.WUP = (f16*)(ws + WS_WUP); C.WDN = (f16*)(ws + WS_WDN); C.WIN = (f16*)(ws + WS_WIN); C.WVT = (f16*)(ws + WS_WVT); C.WM = (f16*)(ws + WS_WM); C.WO = (f16*)(ws + WS_WO);
    C.H = (f16*)(ws + WS_H); C.Q = (f16*)(ws + WS_Q); C.KV = (f16*)(ws + WS_KV); C.VT = (f16*)(ws + WS_VT); C.Z = (f16*)(ws + WS_Z); C.GA = (f16*)(ws + WS_GA); C.GB = (f16*)(ws + WS_GB);
    C.YAB = (f16*)(ws + WS_YAB); C.H2 = (f16*)(ws + WS_H2); C.ACT = (f16*)(ws + WS_ACT);

    volatile LAS unsigned* MISC = (volatile LAS unsigned*)(C.lds + MISC_OFF);
    for (int u = C.tid; u < (LDS_BYTES - MISC_OFF) / 4; u += NTHREADS) MISC[u] = 0u;
    __syncthreads();
    unsigned* barw = (unsigned*)(ws + WS_CTL) + CW_BAR;
    XcdBarrier bar; bar.bar = barw; bar.x = 0; bar.st = nullptr;
    if (MK_N_LAUNCHES == 1) bar = xcd_barrier_post(barw, MISC + 8);
    const int lo = args.ph_lo, hi = args.ph_hi;
#define IN(k) (lo <= (k) && (k) < hi)
#define DUP(k) ((((PROBE_DUP) >> (k)) & 1) != 0)
#define SEAM(k) do { if (IN(k) && IN((k) + 1)) xcd_barrier(bar); } while (0)

    if (IN(0)) { p0_prologue(C); if constexpr (DUP(0)) p0_prologue(C); }
    SEAM(0);
    if (IN(1)) { p1_norm(C); p1_quant_weights(C); if constexpr (DUP(1)) p1_norm(C); }
    SEAM(1);
    if (IN(2)) { ph2_proj(C); if constexpr (DUP(2)) ph2_proj(C); }
    SEAM(2);
    if (IN(3)) { ph3_mixers(C); if constexpr (DUP(3)) ph3_mixers(C); }
    SEAM(3);
    if (IN(4)) { p4_attention(C); if constexpr (DUP(4)) p4_attention(C); }
    SEAM(4);
    if (IN(5)) { ph5_merge(C); if constexpr (DUP(5)) ph5_merge(C); }
    SEAM(5);
    if (IN(6)) { ph6_out(C); if constexpr (DUP(6)) ph6_out(C); }
    SEAM(6);
    if (IN(7)) { p7_norm(C); }
    SEAM(7);
    if (IN(8)) { ph8_up(C); if constexpr (DUP(8)) ph8_up(C); }
    SEAM(8);
    if (IN(9)) { ph9_conv(C); if constexpr (DUP(9)) ph9_conv(C); }
    SEAM(9);
    if (IN(10)) { ph10_down(C); if constexpr (DUP(10)) ph10_down(C); }
    SEAM(10);
    if (IN(11)) { p11_final(C); }
#undef IN
#undef DUP
#undef SEAM
}

extern "C" void kernel_launch(void* const* d_in, const int* in_sizes, int n_in, void* d_out, int out_size, void* d_ws, size_t ws_size, hipStream_t stream) {
    static int grid = 0;
    if (grid == 0) {
        if (n_in != 23 || in_sizes[0] != M * D || out_size != M * D || ws_size < WS_END) { fprintf(stderr, "kernel_launch: unexpected shapes (n_in %d, in0 %d, out %d, ws %zu); nothing launched\n", n_in, n_in > 0 ? in_sizes[0] : -1, out_size, ws_size); grid = -1; return; }
        int dev = 0, cus = 0, per_cu = 0;
        if (hipGetDevice(&dev) != hipSuccess || hipDeviceGetAttribute(&cus, hipDeviceAttributeMultiprocessorCount, dev) != hipSuccess) { grid = -1; return; }
        if (hipFuncSetAttribute((const void*)fwd_kernel, hipFuncAttributeMaxDynamicSharedMemorySize, LDS_BYTES) != hipSuccess) { fprintf(stderr, "kernel_launch: hipFuncSetAttribute failed\n"); grid = -1; return; }
        if (hipOccupancyMaxActiveBlocksPerMultiprocessor(&per_cu, (const void*)fwd_kernel, NTHREADS, LDS_BYTES) != hipSuccess || per_cu < 1) { fprintf(stderr, "kernel_launch: occupancy query reports %d\n", per_cu); }
        (void)hipGetLastError();
        grid = cus;
        if (grid > 256) grid = 256;
    }
    if (grid < 0) return;
    (void)hipMemsetAsync((char*)d_ws + WS_CTL, 0, CTL_BYTES, stream);
    Args a{};
    for (int i = 0; i < 23; ++i) a.in[i] = (const float*)d_in[i];
    a.out = (float*)d_out; a.ws = (unsigned char*)d_ws;
    if (MK_N_LAUNCHES == 1) { a.ph_lo = 0; a.ph_hi = NPHASE; hipLaunchKernelGGL(fwd_kernel, dim3(grid), dim3(NTHREADS), LDS_BYTES, stream, a); }
    else { for (int li = 0; li < NPHASE; ++li) { a.ph_lo = li; a.ph_hi = li + 1; hipLaunchKernelGGL(fwd_kernel, dim3(grid), dim3(NTHREADS), LDS_BYTES, stream, a); } }
}
```

```cpp
#include <hip/hip_runtime.h>
#include <cstdio>
#include <cstdint>

#ifndef MK_N_LAUNCHES
#define MK_N_LAUNCHES 1
#endif

#ifndef PROBE_DUP
#define PROBE_DUP 0
#endif
#define GAS __attribute__((address_space(1)))
#define LAS __attribute__((address_space(3)))
typedef _Float16 f16;
typedef _Float16 hx8 __attribute__((ext_vector_type(8)));
typedef _Float16 hx4 __attribute__((ext_vector_type(4)));
typedef _Float16 hx2 __attribute__((ext_vector_type(2)));
typedef float f32x4 __attribute__((ext_vector_type(4)));
typedef float f32x2 __attribute__((ext_vector_type(2)));
typedef unsigned u32x4 __attribute__((ext_vector_type(4)));
typedef unsigned u32x2 __attribute__((ext_vector_type(2)));
typedef int ix4 __attribute__((ext_vector_type(4)));

constexpr int NB = 2, T = 8192, D = 4096, M = NB * T;
constexpr int NG = 4, HD = 128;
constexpr int DFF = 11008, NUP = 2 * DFF;
constexpr int IN_W = 17456, NPROJ = 16384, NMOD = 6 * D;
constexpr float EPS = 1e-6f;
constexpr float LOG2E = 1.4426950408889634f;
constexpr float SC2 = 0.08838834764831845f * 1.4426950408889634f;

constexpr size_t MiB = 1ull << 20;
constexpr size_t WS_CTL = 0, CTL_BYTES = 1 * MiB;
constexpr size_t WS_MOD = 1 * MiB;
constexpr size_t WS_POSW1 = 1 * MiB + 256 * 1024;
constexpr size_t WS_W2T = 1 * MiB + 384 * 1024;
constexpr size_t WS_SGUW = 2 * MiB;
constexpr size_t WS_WG = 2 * MiB + 512 * 1024;
constexpr size_t WS_KC = 3 * MiB;
constexpr size_t WS_VCT = 4 * MiB;
constexpr size_t WS_GATES = 5 * MiB;
constexpr size_t WS_W1T = 8 * MiB;
constexpr size_t WS_WUP = 16 * MiB;
constexpr size_t WS_WDN = 188 * MiB;
constexpr size_t WS_WIN = 274 * MiB;
constexpr size_t WS_WVT = 402 * MiB;
constexpr size_t WS_WM = 410 * MiB;
constexpr size_t WS_WO = 442 * MiB;
constexpr size_t WS_H = 474 * MiB;
constexpr size_t WS_Q = 602 * MiB;
constexpr size_t WS_KV = 666 * MiB;
constexpr size_t WS_VT = 730 * MiB;
constexpr size_t WS_Z = 762 * MiB;
constexpr size_t WS_GA = 890 * MiB;
constexpr size_t WS_GB = 1018 * MiB;
constexpr size_t WS_YAB = 1146 * MiB;
constexpr size_t WS_H2 = 274 * MiB;
constexpr size_t WS_AH = 406 * MiB;
constexpr size_t WS_AT = 418 * MiB;
constexpr size_t WS_ACT = 1090 * MiB;
constexpr size_t WS_Y2 = 432 * MiB;
constexpr size_t WS_X1H = 602 * MiB;
constexpr size_t WS_YSC = 1274 * MiB;
constexpr size_t WS_SA = 12 * MiB;
constexpr size_t WS_SW = 12 * MiB + 256 * 1024;
constexpr size_t WS_SAH = 12 * MiB + 512 * 1024;
constexpr size_t WS_SWQ = 12 * MiB + 640 * 1024;
constexpr size_t WS_H1Q = 1274 * MiB;
constexpr size_t WS_WINQ = 1338 * MiB;
constexpr size_t WS_WVTQ = 1390 * MiB;
constexpr size_t WS_WUPQ = 1434 * MiB;
constexpr size_t WS_END = 1520 * MiB;

constexpr int CW_BAR = 4096;

constexpr int LDS_BYTES = 147456;
constexpr int MISC_OFF = LDS_BYTES - 512;
constexpr int NWAVES = 8, NTHREADS = 512;

#define LDS_WAIT() asm volatile("s_waitcnt lgkmcnt(0)" ::: "memory")
#define VM_WAIT() asm volatile("s_waitcnt vmcnt(0)" ::: "memory")
__device__ __forceinline__ unsigned pkh(float lo, float hi) { hx2 p; p.x = (f16)lo; p.y = (f16)hi; return __builtin_bit_cast(unsigned, p); }
__device__ __forceinline__ unsigned pkb(float lo, float hi) { unsigned r; asm volatile("v_cvt_pk_bf16_f32 %0, %1, %2" : "=v"(r) : "v"(lo), "v"(hi)); return r; }
#ifndef FFN_BF16
#define FFN_BF16 1
#endif
__device__ __forceinline__ unsigned pk_ffn(float lo, float hi) { return FFN_BF16 ? pkb(lo, hi) : pkh(lo, hi); }
#ifndef MIX_BF16
#define MIX_BF16 1
#endif
__device__ __forceinline__ unsigned pk_mix(float lo, float hi) { return MIX_BF16 ? pkb(lo, hi) : pkh(lo, hi); }
__device__ __forceinline__ float wave_max(float v) {
#pragma unroll
    for (int o = 1; o < 64; o <<= 1) v = fmaxf(v, __shfl_xor(v, o));
    return v;
}
__device__ __forceinline__ unsigned pk_i8(float a, float b, float c, float d) {
    const int ia = (int)__builtin_rintf(a), ib = (int)__builtin_rintf(b), ic = (int)__builtin_rintf(c), id = (int)__builtin_rintf(d);
    return (unsigned)(ia & 255) | ((unsigned)(ib & 255) << 8) | ((unsigned)(ic & 255) << 16) | ((unsigned)(id & 255) << 24);
}
__device__ __forceinline__ void fwht64(float (&t)[64]) {
#pragma unroll
    for (int h = 1; h < 64; h <<= 1)
#pragma unroll
        for (int i = 0; i < 64; ++i) if ((i & h) == 0) { const float a = t[i], b = t[i + h]; t[i] = a + b; t[i + h] = a - b; }
#pragma unroll
    for (int i = 0; i < 64; ++i) t[i] *= 0.125f;
}
__device__ __forceinline__ float wave_sum(float v) {
#pragma unroll
    for (int o = 1; o < 64; o <<= 1) v += __shfl_xor(v, o);
    return v;
}
__device__ __forceinline__ float fsigmoid(float x) { return __builtin_amdgcn_rcpf(1.0f + __builtin_amdgcn_exp2f(-LOG2E * x)); }
__device__ __forceinline__ float fsilu(float x) { return x * fsigmoid(x); }
__device__ __forceinline__ float fgelu(float x) { const float u = x * (1.0f + 0.044715f * x * x); return x * __builtin_amdgcn_rcpf(1.0f + __builtin_amdgcn_exp2f(-2.302208198f * u)); }
template <int CTRL> __device__ __forceinline__ float dpp_f(float v) { return __builtin_bit_cast(float, __builtin_amdgcn_update_dpp(0, __builtin_bit_cast(int, v), CTRL, 0xF, 0xF, true)); }

namespace pg8 {
constexpr int BM = 256, BK = 64, HALF = 128, HTB = HALF * BK * 2, STAGE_BYTES = 8 * HTB, NXCD = 8, WGM = 8;
__host__ __device__ __forceinline__ int lds_byte(int r, int c) { const int st = (r >> 4) * 2 + (c >> 5), rr = r & 15, cc = c & 31, ob = rr * 64 + cc * 2; return st * 1024 + (ob ^ (((ob >> 9) & 1) << 5)); }
__host__ __device__ __forceinline__ void stage_rc(int b, int& R, int& C) { const int st = b / 1024, sb = b % 1024, swz = sb ^ (((sb >> 9) & 1) << 5); R = (st >> 1) * 16 + swz / 64; C = (st & 1) * 32 + (swz % 64) / 2; }
__host__ __device__ __forceinline__ int perm32(int rho) { const int n = rho >> 4, i = rho & 15; return 8 * (i >> 2) + 4 * n + (i & 3); }

struct Unit { int pm, pn; };
struct Gemm { const f16* A; const f16* Bt; int M, N, K; };

struct StaticOrder {
    int nM, nN, nwg, G, c;
    __host__ __device__ void init(int M_, int N_, int G_, int c_) { nM = M_ / BM; nN = N_ / BM; nwg = nM * nN; G = G_; c = c_; }
    __host__ __device__ bool next(int i, Unit& u) const {
        const long L = (long)i * G + c; if (L >= nwg) return false;
        int wgid = (int)L; { const int q = nwg / NXCD, r = nwg % NXCD, xcd = wgid % NXCD, off = wgid / NXCD; wgid = (xcd < r ? xcd * (q + 1) : r * (q + 1) + (xcd - r) * q) + off; }
        const int nig = WGM * nN, gid = wgid / nig, fm = gid * WGM, gsz = (nM - fm) < WGM ? (nM - fm) : WGM;
        u.pm = fm + ((wgid % nig) % gsz); u.pn = (wgid % nig) / gsz; return true;
    }
    __device__ __forceinline__ void a_ready(const Unit&) const {}
    __device__ __forceinline__ void done(const Unit&) const {}
};

__device__ __forceinline__ u32x4 pack8(const f32x4 v0, const f32x4 v1) { u32x4 w; w.x = pkh(v0[0], v0[1]); w.y = pkh(v0[2], v0[3]); w.z = pkh(v1[0], v1[1]); w.w = pkh(v1[2], v1[3]); return w; }

__device__ __forceinline__ unsigned opaque(unsigned v) { asm volatile("" : "+v"(v)); return v; }
struct EpiF32 {
    static constexpr bool PERM = false, AFTER_DRAIN = false, HAS_MID = false;
    float* C; int ldc;
    __device__ __forceinline__ void mid(f32x4 (&)[2][2][4][2], const Unit&, int, int, int, int) const {}
    __device__ __forceinline__ void operator()(const f32x4 (&acc)[2][2][4][2], const Unit& u, int wr, int wc, int fr, int fq) const {
        const unsigned off = opaque((unsigned)((u.pm * BM + wr * 64 + fr) * ldc + u.pn * BM + wc * 32 + 4 * fq) * 4u);
        char* base = (char*)C;
#pragma unroll
        for (int ai = 0; ai < 2; ++ai)
#pragma unroll
            for (int m = 0; m < 4; ++m) { const unsigned ro = off + (unsigned)((ai * HALF + m * 16) * ldc) * 4u;
#pragma unroll
                for (int bj = 0; bj < 2; ++bj)
#pragma unroll
                    for (int n = 0; n < 2; ++n) *(f32x4*)(base + ro + (bj * HALF + n * 16) * 4) = acc[ai][bj][m][n]; }
    }
};
struct EpiH16 {
    static constexpr bool PERM = true, AFTER_DRAIN = false, HAS_MID = false;
    f16* O; int ldc;
    __device__ __forceinline__ void mid(f32x4 (&)[2][2][4][2], const Unit&, int, int, int, int) const {}
    __device__ __forceinline__ void operator()(const f32x4 (&acc)[2][2][4][2], const Unit& u, int wr, int wc, int fr, int fq) const {
        const unsigned off = opaque((unsigned)((u.pm * BM + wr * 64 + fr) * ldc + u.pn * BM + wc * 32 + 8 * fq) * 2u);
        char* base = (char*)O;
#pragma unroll
        for (int ai = 0; ai < 2; ++ai)
#pragma unroll
            for (int m = 0; m < 4; ++m) { const unsigned ro = off + (unsigned)((ai * HALF + m * 16) * ldc) * 2u;
#pragma unroll
                for (int bj = 0; bj < 2; ++bj) *(u32x4*)(base + ro + bj * HALF * 2) = pack8(acc[ai][bj][m][0], acc[ai][bj][m][1]); }
    }
};
struct EpiProj {
    static constexpr bool PERM = true, AFTER_DRAIN = false, HAS_MID = false;
    f16 *Q, *KV, *Z, *GA, *GB; int pn0;
    __device__ __forceinline__ void mid(f32x4 (&)[2][2][4][2], const Unit&, int, int, int, int) const {}
    __device__ __forceinline__ void operator()(const f32x4 (&acc)[2][2][4][2], const Unit& u, int wr, int wc, int fr, int fq) const {
        const int pn = u.pn + pn0; char* base; int ldc, colt, act;
        if (pn < 8) { base = (char*)Q; ldc = 2048; colt = pn * 256; act = 0; }
        else if (pn < 16) { base = (char*)KV; ldc = 2048; colt = (pn - 8) * 256; act = 0; }
        else if (pn < 32) { base = (char*)Z; ldc = 4096; colt = (pn - 16) * 256; act = 1; }
        else if (pn < 48) { base = (char*)GA; ldc = 4096; colt = (pn - 32) * 256; act = 2; }
        else { base = (char*)GB; ldc = 4096; colt = (pn - 48) * 256; act = 2; }
        const unsigned off = opaque((unsigned)((u.pm * BM + wr * 64 + fr) * ldc + colt + wc * 32 + 8 * fq) * 2u);
#pragma unroll
        for (int ai = 0; ai < 2; ++ai)
#pragma unroll
            for (int m = 0; m < 4; ++m) { const unsigned ro = off + (unsigned)((ai * HALF + m * 16) * ldc) * 2u;
#pragma unroll
                for (int bj = 0; bj < 2; ++bj) { f32x4 v0 = acc[ai][bj][m][0], v1 = acc[ai][bj][m][1];
                    if (act == 1) {
#pragma unroll
                        for (int j = 0; j < 4; ++j) { v0[j] = fgelu(v0[j]); v1[j] = fgelu(v1[j]); } }
                    else if (act == 2) {
#pragma unroll
                        for (int j = 0; j < 4; ++j) { v0[j] = fsigmoid(v0[j]); v1[j] = fsigmoid(v1[j]); } }
                    *(u32x4*)(base + ro + bj * HALF * 2) = pack8(v0, v1); } }
    }
};
struct EpiProjQ {
    static constexpr bool PERM = true, AFTER_DRAIN = false, HAS_MID = false;
    unsigned char* ws; int pn0;
    __device__ __forceinline__ void mid(f32x4 (&)[2][2][4][2], const Unit&, int, int, int, int) const {}
    __device__ __forceinline__ void operator()(const f32x4 (&acc)[2][2][4][2], const Unit& u, int wr, int wc, int fr, int fq) const {
        const int pn = u.pn + pn0; char* base; int ldc, colt, act;
        if (pn < 16) { base = (char*)(ws + WS_KV); ldc = 2048; colt = (pn - 8) * 256; act = 0; }
        else if (pn < 32) { base = (char*)(ws + WS_Z); ldc = 4096; colt = (pn - 16) * 256; act = 1; }
        else if (pn < 48) { base = (char*)(ws + WS_GA); ldc = 4096; colt = (pn - 32) * 256; act = 2; }
        else { base = (char*)(ws + WS_GB); ldc = 4096; colt = (pn - 48) * 256; act = 2; }
        const float* const SA = (const float*)(ws + WS_SAH); const float* const SW = (const float*)(ws + WS_SWQ);
        const unsigned off = opaque((unsigned)((u.pm * BM + wr * 64 + fr) * ldc + colt + wc * 32 + 8 * fq) * 2u);
        const unsigned arow = opaque((unsigned)(u.pm * BM + wr * 64 + fr)), wrow = opaque((unsigned)((pn - 12) * 256 + wc * 32 + 8 * fq));
        f32x4 sw[2][2];
#pragma unroll
        for (int bj = 0; bj < 2; ++bj)
#pragma unroll
            for (int n = 0; n < 2; ++n) sw[bj][n] = *(const f32x4*)(SW + wrow + bj * HALF + 4 * n);
#pragma unroll
        for (int ai = 0; ai < 2; ++ai)
#pragma unroll
            for (int m = 0; m < 4; ++m) { const unsigned ro = off + (unsigned)((ai * HALF + m * 16) * ldc) * 2u; const float sa = SA[arow + ai * HALF + m * 16];
#pragma unroll
                for (int bj = 0; bj < 2; ++bj) { const ix4 i0 = __builtin_bit_cast(ix4, acc[ai][bj][m][0]), i1 = __builtin_bit_cast(ix4, acc[ai][bj][m][1]); f32x4 v0, v1;
#pragma unroll
                    for (int j = 0; j < 4; ++j) { v0[j] = (float)i0[j] * (sa * sw[bj][0][j]); v1[j] = (float)i1[j] * (sa * sw[bj][1][j]); }
                    if (act == 1) {
#pragma unroll
                        for (int j = 0; j < 4; ++j) { v0[j] = fgelu(v0[j]); v1[j] = fgelu(v1[j]); } }
                    else if (act == 2) {
#pragma unroll
                        for (int j = 0; j < 4; ++j) { v0[j] = fsigmoid(v0[j]); v1[j] = fsigmoid(v1[j]); } }
                    *(u32x4*)(base + ro + bj * HALF * 2) = pack8(v0, v1); } }
    }
};
struct EpiVTQ {
    static constexpr bool PERM = true, AFTER_DRAIN = false, HAS_MID = false;
    unsigned char* ws;
    __device__ __forceinline__ void mid(f32x4 (&)[2][2][4][2], const Unit&, int, int, int, int) const {}
    __device__ __forceinline__ void operator()(const f32x4 (&acc)[2][2][4][2], const Unit& u, int wr, int wc, int fr, int fq) const {
        const float* const SA = (const float*)(ws + WS_SAH); const float* const SW = (const float*)(ws + WS_SWQ) + 13312;
        const unsigned off = opaque((unsigned)((u.pm * BM + wr * 64 + fr) * M + u.pn * BM + wc * 32 + 8 * fq) * 2u);
        const unsigned wrow = opaque((unsigned)(u.pm * BM + wr * 64 + fr)), tcol = opaque((unsigned)(u.pn * BM + wc * 32 + 8 * fq));
        char* base = (char*)(ws + WS_VT);
        f32x4 sa[2][2];
#pragma unroll
        for (int bj = 0; bj < 2; ++bj)
#pragma unroll
            for (int n = 0; n < 2; ++n) sa[bj][n] = *(const f32x4*)(SA + tcol + bj * HALF + 4 * n);
#pragma unroll
        for (int ai = 0; ai < 2; ++ai)
#pragma unroll
            for (int m = 0; m < 4; ++m) { const unsigned ro = off + (unsigned)((ai * HALF + m * 16) * M) * 2u; const float sw = SW[wrow + ai * HALF + m * 16];
#pragma unroll
                for (int bj = 0; bj < 2; ++bj) { const ix4 i0 = __builtin_bit_cast(ix4, acc[ai][bj][m][0]), i1 = __builtin_bit_cast(ix4, acc[ai][bj][m][1]); f32x4 v0, v1;
#pragma unroll
                    for (int j = 0; j < 4; ++j) { v0[j] = (float)i0[j] * (sw * sa[bj][0][j]); v1[j] = (float)i1[j] * (sw * sa[bj][1][j]); }
                    *(u32x4*)(base + ro + bj * HALF * 2) = pack8(v0, v1); } }
    }
};
struct EpiMerge {
    static constexpr bool PERM = true, AFTER_DRAIN = false, HAS_MID = true;
    const f16 *GA, *GB; f16* O;
    __device__ __forceinline__ void mid(f32x4 (&acc)[2][2][4][2], const Unit& u, int wr, int wc, int fr, int fq) const {
        const unsigned off = opaque((unsigned)((u.pm * BM + wr * 64 + fr) * D + u.pn * BM + wc * 32 + 8 * fq) * 2u);
        const char* ga = (const char*)GA; const char* gb = (const char*)GB;
#pragma unroll
        for (int ai = 0; ai < 2; ++ai)
#pragma unroll
            for (int m = 0; m < 4; ++m) { const unsigned ro = off + (unsigned)((ai * HALF + m * 16) * D) * 2u;
#pragma unroll
                for (int bj = 0; bj < 2; ++bj) { const hx8 a = *(const hx8*)(ga + ro + bj * HALF * 2), b = *(const hx8*)(gb + ro + bj * HALF * 2);
#pragma unroll
                    for (int j = 0; j < 4; ++j) { acc[ai][bj][m][0][j] *= (float)a[j] * __builtin_amdgcn_rcpf((float)b[j]); acc[ai][bj][m][1][j] *= (float)a[4 + j] * __builtin_amdgcn_rcpf((float)b[4 + j]); } } }
    }
    __device__ __forceinline__ void operator()(const f32x4 (&acc)[2][2][4][2], const Unit& u, int wr, int wc, int fr, int fq) const {
        const unsigned off = opaque((unsigned)((u.pm * BM + wr * 64 + fr) * D + u.pn * BM + wc * 32 + 8 * fq) * 2u);
        const char* gb = (const char*)GB; char* ob = (char*)O;
#pragma unroll
        for (int ai = 0; ai < 2; ++ai)
#pragma unroll
            for (int m = 0; m < 4; ++m) { const unsigned ro = off + (unsigned)((ai * HALF + m * 16) * D) * 2u;
#pragma unroll
                for (int bj = 0; bj < 2; ++bj) { const hx8 b = *(const hx8*)(gb + ro + bj * HALF * 2); f32x4 v0 = acc[ai][bj][m][0], v1 = acc[ai][bj][m][1];
#pragma unroll
                    for (int j = 0; j < 4; ++j) { v0[j] *= (float)b[j]; v1[j] *= (float)b[4 + j]; }
                    u32x4 w; w.x = pk_mix(v0[0], v0[1]); w.y = pk_mix(v0[2], v0[3]); w.z = pk_mix(v1[0], v1[1]); w.w = pk_mix(v1[2], v1[3]);
                    *(u32x4*)(ob + ro + bj * HALF * 2) = w; } }
    }
};

typedef short sx8 __attribute__((ext_vector_type(8)));
template <int CTRL> __device__ __forceinline__ float dpp_mov(float old, float v) { return __builtin_bit_cast(float, __builtin_amdgcn_update_dpp(__builtin_bit_cast(int, old), __builtin_bit_cast(int, v), CTRL, 0xF, 0xF, false)); }
struct EpiConv {
    static constexpr bool PERM = true, AFTER_DRAIN = false, HAS_MID = false;
    unsigned char* ws; const float* cw; const float* cb; LAS float* X; int bf16out;
    __device__ __forceinline__ void mid(f32x4 (&)[2][2][4][2], const Unit&, int, int, int, int) const {}
    static __device__ __forceinline__ f32x4 deq(const f32x4 a, float s) { const ix4 iv = __builtin_bit_cast(ix4, a); return (f32x4){(float)iv[0] * s, (float)iv[1] * s, (float)iv[2] * s, (float)iv[3] * s}; }
    __device__ __forceinline__ void operator()(const f32x4 (&acc)[2][2][4][2], const Unit& u, int wr, int wc, int fr_, int fq_) const {
        const unsigned lane_o = opaque(threadIdx.x & 63u); const int fr = (int)(lane_o & 15u), fq = (int)(lane_o >> 4); (void)fr_; (void)fq_;
        f16* const ACT = (f16*)(ws + WS_ACT); float* const AH = (float*)(ws + WS_AH); float* const AT = (float*)(ws + WS_AT); const float* const SA = (const float*)(ws + WS_SA); const float* const SW = (const float*)(ws + WS_SW);
        const int chl = wc * 32 + 8 * fq;
        const unsigned ch0 = opaque((unsigned)(u.pn * 128 + chl)), wrow = opaque((unsigned)(u.pn * 256 + chl)), arow = opaque((unsigned)(u.pm * BM + wr * 64 + fr));
        float sa[2][4];
#pragma unroll
        for (int ai = 0; ai < 2; ++ai)
#pragma unroll
            for (int m = 0; m < 4; ++m) sa[ai][m] = SA[arow + ai * HALF + m * 16];
        if (fr >= 14) {
#pragma unroll
            for (int ai = 0; ai < 2; ++ai)
#pragma unroll
                for (int bj = 0; bj < 2; ++bj)
#pragma unroll
                    for (int n = 0; n < 2; ++n) *(LAS f32x4*)(X + ((((2 * ai + wr) * 2 + (fr - 14)) * 2 + bj) * 128 + chl + 4 * n)) = deq(acc[ai][bj][3][n], sa[ai][3]);
        }
        asm volatile("s_waitcnt lgkmcnt(0)" ::: "memory"); __builtin_amdgcn_s_barrier(); asm volatile("" ::: "memory");
        if (u.pm == 64) {
            const unsigned hro = opaque((unsigned)((wr * 64 + fr) * 2));
#pragma unroll
            for (int bj = 0; bj < 2; ++bj)
#pragma unroll
                for (int n = 0; n < 2; ++n) { const f32x4 swv = *(const f32x4*)(SW + wrow + bj * 128 + 4 * n);
#pragma unroll
                    for (int m = 0; m < 4; ++m) *(f32x4*)(AH + (size_t)(hro + 32 * m + bj) * DFF + ch0 + 4 * n) = deq(acc[0][bj][m][n], sa[0][m]) * swv; }
            return;
        }
        const unsigned orow = opaque((unsigned)(u.pm * BM + wr * 64 + fr));
#pragma unroll
        for (int n = 0; n < 2; ++n) {
            f32x4 wv[3][2], bv[2];
#pragma unroll
            for (int bj = 0; bj < 2; ++bj) { bv[bj] = *(const f32x4*)(cb + bj * DFF + ch0 + 4 * n); const f32x4 swv = *(const f32x4*)(SW + wrow + bj * 128 + 4 * n);
#pragma unroll
                for (int k = 0; k < 3; ++k) wv[k][bj] = *(const f32x4*)(cw + k * NUP + bj * DFF + ch0 + 4 * n) * swv;
                if (wr == 0 && fr < 2) *(f32x4*)(AT + (size_t)((u.pm * 2 + fr) * 2 + bj) * DFF + ch0 + 4 * n) = deq(acc[0][bj][0][n], sa[0][0]) * swv; }
#pragma unroll
            for (int ai = 0; ai < 2; ++ai) {
                f32x4 E[2];
                const int blk = 2 * ai + wr - 1;
#pragma unroll
                for (int bj = 0; bj < 2; ++bj) { E[bj] = (f32x4){0.f, 0.f, 0.f, 0.f};
                    if (blk >= 0 && fr >= 14) E[bj] = *(const LAS f32x4*)(X + (((blk * 2 + (fr - 14)) * 2 + bj) * 128 + chl + 4 * n)); }
#pragma unroll
                for (int m = 0; m < 4; ++m) {
                    f32x4 cv[2];
#pragma unroll
                    for (int bj = 0; bj < 2; ++bj) { const f32x4 cur = deq(acc[ai][bj][m][n], sa[ai][m]); const f32x4 prv = (m == 0) ? E[bj] : deq(acc[ai][bj][m == 0 ? 0 : m - 1][n], sa[ai][m == 0 ? 0 : m - 1]);
#pragma unroll
                        for (int i = 0; i < 4; ++i) { const float p1 = dpp_mov<0x111>(dpp_mov<0x121>(0.f, prv[i]), cur[i]), p2 = dpp_mov<0x112>(dpp_mov<0x122>(0.f, prv[i]), cur[i]);
                            cv[bj][i] = bv[bj][i] + wv[0][bj][i] * p2 + wv[1][bj][i] * p1 + wv[2][bj][i] * cur[i]; } }
                    float res[4];
#pragma unroll
                    for (int e = 0; e < 4; ++e) res[e] = fsilu(cv[0][e]) * cv[1][e];
                    u32x2 ov;
                    if (bf16out) { ov.x = pkb(res[0], res[1]); ov.y = pkb(res[2], res[3]); }
                    else { ov.x = pkh(res[0], res[1]); ov.y = pkh(res[2], res[3]); }
                    *(u32x2*)(ACT + (size_t)(orow + ai * HALF + m * 16) * DFF + ch0 + 4 * n) = ov;
                }
            }
        }
    }
};

template <class Epi, class Sched, bool ALIGN_EPI = true, int DT = 0  >
__device__ __forceinline__ void gemm_phase(LAS unsigned char* lds, const Gemm g, const Sched& S, const Epi& E) {
    const int tid = threadIdx.x, wid = __builtin_amdgcn_readfirstlane(tid >> 6), lane = tid & 63, wr = wid >> 2, wc = wid & 3, fr = lane & 15, fq = lane >> 4;
    const int K = g.K, nt = K / BK;
    unsigned voffA[2], voffB[2];
#pragma unroll
    for (int i = 0; i < 2; ++i) { int R, C; stage_rc(tid * 16 + i * 8192, R, C); const int Rb = Epi::PERM ? ((R & ~31) + perm32(R & 31)) : R;
        voffA[i] = (unsigned)(R * K + C) * 2u; voffB[i] = (unsigned)(Rb * K + C) * 2u; }
    const size_t kstep = (size_t)(BK * 2);
    const size_t hstep = (size_t)HALF * K * 2;
    const size_t tstep = 2 * hstep;
    const unsigned ldsw = (unsigned)wid * 1024u;
    const int aoff = lds_byte(wr * 64 + fr, fq * 8), boff = lds_byte(wc * 32 + fr, fq * 8);
#define PG8_SA(b, h) (((b) * 2 + (h)) * HTB)
#define PG8_SB(b, h) ((4 + (b) * 2 + (h)) * HTB)
#define PG8_STAGE(bufoff, gbase, voff) do { _Pragma("unroll") for (int _i = 0; _i < 2; ++_i) \
        __builtin_amdgcn_global_load_lds((const unsigned*)((const char*)(gbase) + (voff)[_i]), (LAS unsigned*)(lds + (bufoff) + ldsw + _i * 8192), 16, 0, 0); } while (0)
#define PG8_LDA(dst, b, h) do { _Pragma("unroll") for (int m = 0; m < 4; ++m) _Pragma("unroll") for (int k = 0; k < 2; ++k) dst[m][k] = *(const LAS hx8*)(lds + PG8_SA(b, h) + aoff + m * 2048 + k * 1024); } while (0)
#define PG8_LDB(dst, b, h) do { _Pragma("unroll") for (int n = 0; n < 2; ++n) _Pragma("unroll") for (int k = 0; k < 2; ++k) dst[n][k] = *(const LAS hx8*)(lds + PG8_SB(b, h) + boff + n * 2048 + k * 1024); } while (0)
#define PG8_MMA(ai, bj, At, Bt) do { __builtin_amdgcn_s_setprio(1); _Pragma("unroll") for (int m = 0; m < 4; ++m) _Pragma("unroll") for (int n = 0; n < 2; ++n) _Pragma("unroll") for (int k = 0; k < 2; ++k) \
        { if constexpr (DT == 2) acc[ai][bj][m][n] = __builtin_bit_cast(f32x4, __builtin_amdgcn_mfma_i32_16x16x64_i8(__builtin_bit_cast(ix4, Bt[n][k]), __builtin_bit_cast(ix4, At[m][k]), __builtin_bit_cast(ix4, acc[ai][bj][m][n]), 0, 0, 0)); \
          else if constexpr (DT == 1) acc[ai][bj][m][n] = __builtin_amdgcn_mfma_f32_16x16x32_bf16(__builtin_bit_cast(sx8, Bt[n][k]), __builtin_bit_cast(sx8, At[m][k]), acc[ai][bj][m][n], 0, 0, 0); \
          else acc[ai][bj][m][n] = __builtin_amdgcn_mfma_f32_16x16x32_f16(Bt[n][k], At[m][k], acc[ai][bj][m][n], 0, 0, 0); } __builtin_amdgcn_s_setprio(0); } while (0)
#define PG8_WAIT_V(n) asm volatile("s_waitcnt vmcnt(" #n ")" ::: "memory")
#define PG8_WAIT_L(n) asm volatile("s_waitcnt lgkmcnt(" #n ")" ::: "memory")
#define PG8_BAR __builtin_amdgcn_s_barrier()
#define PG8_SCHED __builtin_amdgcn_sched_barrier(0)
    Unit cur, nxt; int ui = 0;
    if (!S.next(0, cur)) return;
    f32x4 acc[2][2][4][2];
#pragma unroll
    for (int a = 0; a < 2; ++a)
#pragma unroll
        for (int b = 0; b < 2; ++b)
#pragma unroll
            for (int m = 0; m < 4; ++m)
#pragma unroll
                for (int n = 0; n < 2; ++n) acc[a][b][m][n] = (f32x4){0.f, 0.f, 0.f, 0.f};
    hx8 At[4][2], B0[2][2], B1[2][2];
    const char* cA = (const char*)g.A + (size_t)cur.pm * tstep; const char* cB = (const char*)g.Bt + (size_t)cur.pn * tstep;
    S.a_ready(cur);
    PG8_STAGE(PG8_SB(0, 0), cB, voffB); PG8_STAGE(PG8_SB(0, 1), cB + hstep, voffB); PG8_STAGE(PG8_SA(0, 0), cA, voffA); PG8_STAGE(PG8_SA(0, 1), cA + hstep, voffA);
    if (wr == 1) PG8_BAR;
    PG8_WAIT_V(2); PG8_BAR;
    PG8_STAGE(PG8_SB(1, 0), cB + kstep, voffB); PG8_STAGE(PG8_SA(1, 0), cA + kstep, voffA); PG8_STAGE(PG8_SB(1, 1), cB + hstep + kstep, voffB);
    PG8_WAIT_V(6); PG8_BAR;
    for (;;) {
        const bool has_next = S.next(ui + 1, nxt);
        const char* nA = has_next ? (const char*)g.A + (size_t)nxt.pm * tstep : cA; const char* nB = has_next ? (const char*)g.Bt + (size_t)nxt.pn * tstep : cB;
        for (int t = 0; t < nt; t += 2) {
            const bool last = (t == nt - 2);
            const char* a1 = cA + (size_t)(t + 1) * kstep;
            const char* a2 = last ? nA : cA + (size_t)(t + 2) * kstep; const char* b2 = last ? nB : cB + (size_t)(t + 2) * kstep;
            const char* a3 = a2 + kstep; const char* b3 = b2 + kstep;
            if (last && has_next) S.a_ready(nxt);
            if constexpr (Epi::HAS_MID) { if (t == (nt >> 1)) E.mid(acc, cur, wr, wc, fr, fq); }
            PG8_LDB(B0, 0, 0); PG8_LDB(B1, 0, 1); PG8_SCHED; PG8_LDA(At, 0, 0); PG8_STAGE(PG8_SA(1, 1), a1 + hstep, voffA);
            PG8_WAIT_V(8); PG8_WAIT_L(0); PG8_BAR; PG8_MMA(0, 0, At, B0); PG8_MMA(0, 1, At, B1); PG8_BAR; PG8_SCHED;
            PG8_LDA(At, 0, 1); PG8_STAGE(PG8_SB(0, 0), b2, voffB); PG8_STAGE(PG8_SB(0, 1), b2 + hstep, voffB); PG8_STAGE(PG8_SA(0, 0), a2, voffA);
            PG8_WAIT_V(8); PG8_WAIT_L(0); PG8_BAR; PG8_MMA(1, 0, At, B0); PG8_MMA(1, 1, At, B1); PG8_BAR; PG8_SCHED;
            PG8_LDB(B0, 1, 0); PG8_LDB(B1, 1, 1); PG8_SCHED; PG8_LDA(At, 1, 0); PG8_STAGE(PG8_SA(0, 1), a2 + hstep, voffA);
            PG8_WAIT_V(8); PG8_WAIT_L(0); PG8_BAR; PG8_MMA(0, 0, At, B0); PG8_MMA(0, 1, At, B1); PG8_BAR; PG8_SCHED;
            PG8_LDA(At, 1, 1); PG8_STAGE(PG8_SB(1, 0), b3, voffB); PG8_STAGE(PG8_SB(1, 1), b3 + hstep, voffB); PG8_STAGE(PG8_SA(1, 0), a3, voffA);
            PG8_WAIT_V(8); PG8_WAIT_L(0); PG8_BAR; PG8_MMA(1, 0, At, B0); PG8_MMA(1, 1, At, B1); PG8_BAR; PG8_SCHED;
        }
        if constexpr (ALIGN_EPI) { if (wr == 0) PG8_BAR; }
        E(acc, cur, wr, wc, fr, fq); S.done(cur);
        if (!has_next) break;
#pragma unroll
        for (int a = 0; a < 2; ++a)
#pragma unroll
            for (int b = 0; b < 2; ++b)
#pragma unroll
                for (int m = 0; m < 4; ++m)
#pragma unroll
                    for (int n = 0; n < 2; ++n) acc[a][b][m][n] = (f32x4){0.f, 0.f, 0.f, 0.f};
        cur = nxt; cA = nA; cB = nB; ++ui;
        if constexpr (ALIGN_EPI) { if (wr == 1) PG8_BAR; }
    }
    PG8_WAIT_V(0);
    if constexpr (!ALIGN_EPI) { if (wr == 0) PG8_BAR; }
    PG8_BAR;
#undef PG8_SA
#undef PG8_SB
#undef PG8_STAGE
#undef PG8_LDA
#undef PG8_LDB
#undef PG8_MMA
#undef PG8_WAIT_V
#undef PG8_WAIT_L
#undef PG8_BAR
#undef PG8_SCHED
}
}

#define XB_TMO      128
#define XB_XCNT(j)  (256  + 64 * (j))
#define XB_XSUB(j)  (1280 + 64 * (j))
#define XB_XGEN(j)  (2304 + 64 * (j))
#define XB_TOP      3328
#define XB_TOPGEN   3392
#define XCD_BAR_WORDS 3456
#define XB_SPIN_CAP (1u << 18)
__device__ __forceinline__ unsigned xb_ld(unsigned* p)              { return __hip_atomic_load(p, __ATOMIC_RELAXED, __HIP_MEMORY_SCOPE_AGENT); }
__device__ __forceinline__ unsigned xb_add(unsigned* p, unsigned v) { return __hip_atomic_fetch_add(p, v, __ATOMIC_RELAXED, __HIP_MEMORY_SCOPE_AGENT); }
__device__ __forceinline__ unsigned xb_xcc_id() { return (unsigned)__builtin_amdgcn_s_getreg((3 << 11) | 20) & 0xFu; }
#define XB_SPIN(cond, bar) do { unsigned _sp = 0; while (cond) { __builtin_amdgcn_s_sleep(1); \
    if ((++_sp & 255u) == 0u) { if (xb_ld(&(bar)[XB_TMO])) break; if (_sp > XB_SPIN_CAP) { atomicAdd(&(bar)[XB_TMO], 1u); break; } } } } while (0)
struct XcdBarrier { unsigned* bar; unsigned x; volatile LAS unsigned* st; };
__device__ __forceinline__ XcdBarrier xcd_barrier_post(unsigned* bar, volatile LAS unsigned* st) {
    XcdBarrier b; b.bar = bar; b.x = xb_xcc_id(); b.st = st;
    if (threadIdx.x == 0) (void)xb_add(&bar[XB_XCNT(b.x)], 1u);
    return b;
}
__device__ __forceinline__ void xcd_barrier_complete(unsigned* bar, unsigned x, unsigned& nloc, unsigned& nx) {
    const unsigned G = gridDim.x * gridDim.y * gridDim.z;
    unsigned sum, cnt, mine, sp = 0u;
    for (;;) {
        sum = 0u; cnt = 0u; mine = 0u;
#pragma unroll
        for (unsigned j = 0; j < 16; ++j) { const unsigned c = xb_ld(&bar[XB_XCNT(j)]); sum += c; cnt += (c > 0u) ? 1u : 0u; mine = (j == x) ? c : mine; }
        if (sum == G) break;
        __builtin_amdgcn_s_sleep(1);
        if ((++sp & 255u) == 0u) { if (xb_ld(&bar[XB_TMO])) break; if (sp > XB_SPIN_CAP) { atomicAdd(&bar[XB_TMO], 1u); break; } }
    }
    nloc = mine > 0u ? mine : 1u; nx = cnt > 0u ? cnt : 1u;
}
__device__ __forceinline__ void xcd_barrier(const XcdBarrier& b) {
    asm volatile("s_waitcnt vmcnt(0)" ::: "memory");
    __syncthreads();
    if (threadIdx.x == 0) {
        unsigned* bar = b.bar;
        __builtin_amdgcn_s_waitcnt(0);
        unsigned nloc = b.st[0], nx = b.st[1];
        if (nloc == 0u) { xcd_barrier_complete(bar, b.x, nloc, nx); b.st[0] = nloc; b.st[1] = nx; }
        const unsigned old = xb_add(&bar[XB_XSUB(b.x)], 1u);
        const unsigned gen = old / nloc;
        if (old + 1u == (gen + 1u) * nloc) {
            __builtin_amdgcn_fence(__ATOMIC_RELEASE, "agent");
            asm volatile("s_waitcnt vmcnt(0)" ::: "memory");
            const unsigned og = xb_add(&bar[XB_TOP], 1u);
            const unsigned tg = og / nx;
            if (og + 1u == (tg + 1u) * nx) xb_add(&bar[XB_TOPGEN], 1u);
            else XB_SPIN(xb_ld(&bar[XB_TOPGEN]) == tg, bar);
            __builtin_amdgcn_fence(__ATOMIC_ACQUIRE, "agent");
            xb_add(&bar[XB_XGEN(b.x)], 1u);
            asm volatile("s_waitcnt vmcnt(0)" ::: "memory");
        } else {
            XB_SPIN(xb_ld(&bar[XB_XGEN(b.x)]) == gen, bar);
            __builtin_amdgcn_fence(__ATOMIC_ACQUIRE, "agent");
            asm volatile("s_waitcnt vmcnt(0)" ::: "memory");
        }
    }
    __syncthreads();
}

struct Args { const float* in[23]; float* out; unsigned char* ws; int ph_lo, ph_hi; };
struct Ctx {
    LAS unsigned char* lds;
    int tid, lane, wave, G, bid;
    const float *x, *c, *w_mod, *b_mod, *g_norms, *w_in, *cmp_pos, *cmp_w1, *cmp_b1, *cmp_w2, *cmp_b2, *rel_table, *ln_g, *ln_b, *sgu_w, *sgu_b,
                *w_pn, *w_ps, *w_out, *w_up, *conv_w, *conv_b, *w_dn;
    float* out; unsigned char* ws;
    float *mod, *posw1, *gates, *ysc, *AH, *AT; f16 *Y1, *Y2, *X1H, *W2T, *SGUW, *WG, *KC, *VCT, *W1T, *WUP, *WDN, *WIN, *WVT, *WM, *WO, *H, *Q, *KV, *VT, *Z, *GA, *GB, *YAB, *H2, *ACT;
};

__device__ __forceinline__ void p0_mod_item(Ctx& C, int item) {
    LAS float* sc = (LAS float*)C.lds;
    LAS float* red = (LAS float*)(C.lds + 32768);
    for (int i = C.tid; i < 2 * D; i += NTHREADS) sc[i] = fsilu(C.c[i]);
    __syncthreads();
    const int cq = C.tid & 31, kg = C.tid >> 5, n0 = item * 128 + 4 * cq;
    f32x4 a0 = {0.f, 0.f, 0.f, 0.f}, a1 = {0.f, 0.f, 0.f, 0.f};
    const float* wp = C.w_mod + (size_t)(kg * 256) * NMOD + n0;
#pragma unroll 8
    for (int i = 0; i < 256; ++i) { const f32x4 w = *(const f32x4*)(wp + (size_t)i * NMOD); const float s0 = sc[kg * 256 + i], s1 = sc[D + kg * 256 + i]; a0 += w * s0; a1 += w * s1; }
    *(LAS f32x4*)(red + (kg * 2 + 0) * 128 + 4 * cq) = a0; *(LAS f32x4*)(red + (kg * 2 + 1) * 128 + 4 * cq) = a1;
    __syncthreads();
    if (C.tid < 256) { const int b = C.tid >> 7, col = C.tid & 127; float s = 0.f;
#pragma unroll
        for (int k = 0; k < 16; ++k) s += red[(k * 2 + b) * 128 + col];
        C.mod[b * NMOD + item * 128 + col] = s + C.b_mod[item * 128 + col]; }
    __syncthreads();
}
__device__ __forceinline__ void p0_posw1_item(Ctx& C, int item) {
    LAS float* red = (LAS float*)C.lds;
    const int kk = item >> 2, j = (item & 3) * 64 + C.lane; float s = 0.f;
    const float* w = C.cmp_w1 + (size_t)kk * 4096 * 256 + j; const float* pp = C.cmp_pos + kk * 4096;
    for (int k = C.wave * 512; k < C.wave * 512 + 512; ++k) s += pp[k] * w[(size_t)k * 256];
    red[C.wave * 64 + C.lane] = s;
    __syncthreads();
    if (C.wave == 0) { float t = 0.f;
#pragma unroll
        for (int k = 0; k < 8; ++k) t += red[k * 64 + C.lane];
        C.posw1[kk * 256 + j] = t + C.cmp_b1[kk * 256 + j]; }
    __syncthreads();
}
__device__ __forceinline__ f16* win_row(Ctx& C, int n) {
    if (n < 3584) return C.WIN + (size_t)n * D;
    if (n < 4096) return C.WVT + (size_t)(n - 3584) * D;
    if (n < 4608) return C.WIN + (size_t)(n - 512) * D;
    if (n < 5120) return C.WVT + (size_t)(n - 4608 + 512) * D;
    if (n < 5168) return C.WG + (size_t)(n - 5120) * D;
    return C.WIN + (size_t)(n - 5168 + 4096) * D;
}
__device__ __forceinline__ void p0_transpose_item(Ctx& C, int mat, const float* src, int N, int kb, int nb, LAS float* scr) {
    const int lane = C.lane, k0 = kb * 64, n0 = nb * 64, r4 = lane >> 4, c4 = (lane & 15) * 4; const bool ok = n0 + c4 < N;
    const float* sp = src + (size_t)(k0 + r4) * N + (ok ? n0 + c4 : 0);
#pragma unroll
    for (int i = 0; i < 16; ++i) { const f32x4 v = ok ? *(const f32x4*)(sp + (size_t)(4 * i) * N) : (f32x4){0.f, 0.f, 0.f, 0.f};
        LAS float* d = scr + (4 * i + r4) * 65 + c4; d[0] = v.x; d[1] = v.y; d[2] = v.z; d[3] = v.w; }
    LDS_WAIT();
    const int c = lane & 7;
#pragma unroll
    for (int j = 0; j < 8; ++j) { const int nn = (lane >> 3) + 8 * j, ng = n0 + nn;
        if (ng < N) { const LAS float* s = scr + (8 * c) * 65 + nn;
            u32x4 o;
            if ((FFN_BF16 && (mat == 4 || mat == 5)) || (MIX_BF16 && (mat == 1 || mat == 2 || mat == 3))) { o.x = pkb(s[0], s[65]); o.y = pkb(s[2 * 65], s[3 * 65]); o.z = pkb(s[4 * 65], s[5 * 65]); o.w = pkb(s[6 * 65], s[7 * 65]); }
            else { o.x = pkh(s[0], s[65]); o.y = pkh(s[2 * 65], s[3 * 65]); o.z = pkh(s[4 * 65], s[5 * 65]); o.w = pkh(s[6 * 65], s[7 * 65]); }
            f16* rowp;
            if (mat == 0) rowp = win_row(C, ng);
            else if (mat == 1) rowp = C.WM + (size_t)ng * D;
            else if (mat == 2) rowp = C.WM + (size_t)ng * D + 2048;
            else if (mat == 3) rowp = C.WO + (size_t)ng * D;
            else if (mat == 4) { const int isup = ng >= DFF ? 1 : 0, cc = ng - isup * DFF; rowp = C.WUP + (size_t)((cc >> 7) * 256 + isup * 128 + (cc & 127)) * D; }
            else if (mat == 5) rowp = C.WDN + (size_t)ng * DFF;
            else if (mat == 6) rowp = C.W1T + (size_t)ng * D;
            else rowp = C.W1T + (size_t)(256 + ng) * D;
            *(u32x4*)(rowp + k0 + 8 * c) = o; } }
    LDS_WAIT();
}
__device__ __forceinline__ void p0_prologue(Ctx& C) {
    for (int it = C.bid; it < 200; it += C.G) { if (it < 192) p0_mod_item(C, it); else p0_posw1_item(C, it - 192); }
    const int gw = C.bid * NWAVES + C.wave, NGW = C.G * NWAVES;
    LAS float* scr = (LAS float*)(C.lds + C.wave * 16640);
    constexpr int I0 = 64 * 273, I1 = 32 * 64, I3 = 64 * 64, I4 = 64 * 344, I5 = 172 * 64, I6 = 64 * 4;
    constexpr int NIT = I0 + 2 * I1 + I3 + I4 + I5 + 2 * I6;
    for (int it = gw; it < NIT; it += NGW) {
        int r = it;
        if (r < I0) { p0_transpose_item(C, 0, C.w_in, IN_W, r / 273, r % 273, scr); continue; } r -= I0;
        if (r < I1) { p0_transpose_item(C, 1, C.w_pn, D, r / 64, r % 64, scr); continue; } r -= I1;
        if (r < I1) { p0_transpose_item(C, 2, C.w_ps, D, r / 64, r % 64, scr); continue; } r -= I1;
        if (r < I3) { p0_transpose_item(C, 3, C.w_out, D, r / 64, r % 64, scr); continue; } r -= I3;
        if (r < I4) { p0_transpose_item(C, 4, C.w_up, NUP, r / 344, r % 344, scr); continue; } r -= I4;
        if (r < I5) { p0_transpose_item(C, 5, C.w_dn, D, r / 64, r % 64, scr); continue; } r -= I5;
        if (r < I6) { p0_transpose_item(C, 6, C.cmp_w1, 256, r / 4, r % 4, scr); continue; } r -= I6;
        p0_transpose_item(C, 7, C.cmp_w1 + (size_t)4096 * 256, 256, r / 4, r % 4, scr);
    }
    const int gt = C.bid * NTHREADS + C.tid, NGT = C.G * NTHREADS;
    for (int i = gt; i < 16 * 128 * 128; i += NGT) { const int s = i & 127, t = (i >> 7) & 127; C.SGUW[i] = (f16)(s <= t ? C.sgu_w[i] : 0.f); }
    for (int i = gt; i < 2 * 128 * 256; i += NGT) { const int j = i & 255, d = (i >> 8) & 127, kk = i >> 15; C.W2T[i] = (f16)C.cmp_w2[(size_t)kk * 256 * 128 + j * 128 + d]; }
    for (int i = gt; i < 16 * D; i += NGT) C.WG[48 * D + i] = (f16)0.f;
    __syncthreads();
}

__device__ __forceinline__ void p1_norm(Ctx& C) {
    const int gw = C.bid * NWAVES + C.wave, NGW = C.G * NWAVES, lane = C.lane;
    for (int row = gw; row < M; row += NGW) {
        const int b = row >> 13; const f32x4* xr = (const f32x4*)(C.x + (size_t)row * D);
        f32x4 v[16]; float ss = 0.f;
#pragma unroll
        for (int j = 0; j < 16; ++j) { v[j] = xr[2 * (lane + 64 * (j >> 1)) + (j & 1)]; ss += (v[j].x * v[j].x + v[j].y * v[j].y) + (v[j].z * v[j].z + v[j].w * v[j].w); }
        const float rs = 1.0f / sqrtf(wave_sum(ss) * (1.0f / D) + EPS);
        const f32x4* g4 = (const f32x4*)(C.g_norms); const f32x4* sh = (const f32x4*)(C.mod + b * NMOD); const f32x4* sc = (const f32x4*)(C.mod + b * NMOD + D);
        u32x4* o = (u32x4*)(C.H + (size_t)row * D); u32x2* oq = (u32x2*)(C.ws + WS_H1Q + (size_t)row * D);
        float t[64];
#pragma unroll
        for (int j = 0; j < 16; ++j) { const int k = 2 * (lane + 64 * (j >> 1)) + (j & 1); v[j] = v[j] * rs * g4[k] * (sc[k] + 1.0f) + sh[k]; t[4 * j] = v[j].x; t[4 * j + 1] = v[j].y; t[4 * j + 2] = v[j].z; t[4 * j + 3] = v[j].w; }
#pragma unroll
        for (int jj = 0; jj < 8; ++jj) { u32x4 w; w.x = pkh(v[2 * jj].x, v[2 * jj].y); w.y = pkh(v[2 * jj].z, v[2 * jj].w); w.z = pkh(v[2 * jj + 1].x, v[2 * jj + 1].y); w.w = pkh(v[2 * jj + 1].z, v[2 * jj + 1].w); o[lane + 64 * jj] = w; }
        fwht64(t);
        float amax = 0.f;
#pragma unroll
        for (int i = 0; i < 64; ++i) amax = fmaxf(amax, fabsf(t[i]));
        amax = fmaxf(wave_max(amax), 1e-20f);
        const float qs = 127.0f / amax;
        if (lane == 0) ((float*)(C.ws + WS_SAH))[row] = amax * (1.0f / 127.0f);
#pragma unroll
        for (int jj = 0; jj < 8; ++jj) { u32x2 w; w.x = pk_i8(t[8 * jj] * qs, t[8 * jj + 1] * qs, t[8 * jj + 2] * qs, t[8 * jj + 3] * qs); w.y = pk_i8(t[8 * jj + 4] * qs, t[8 * jj + 5] * qs, t[8 * jj + 6] * qs, t[8 * jj + 7] * qs); oq[lane + 64 * jj] = w; }
    }
}
__device__ __forceinline__ void p1_quant_rows(Ctx& C, const f16* src, int nrows, signed char* dst, float* scale, bool bf, bool rot) {
    const int gw = C.bid * NWAVES + C.wave, NGW = C.G * NWAVES, lane = C.lane;
    for (int row = gw; row < nrows; row += NGW) {
        const u32x4* wr = (const u32x4*)(src + (size_t)row * D);
        float v[64]; float amax = 0.f;
#pragma unroll
        for (int j = 0; j < 8; ++j) { const u32x4 wv = wr[lane + 64 * j];
#pragma unroll
            for (int e = 0; e < 4; ++e) { const unsigned wd = wv[e]; float lo, hi;
                if (bf) { lo = __builtin_bit_cast(float, wd << 16); hi = __builtin_bit_cast(float, wd & 0xffff0000u); }
                else { const hx2 hv = __builtin_bit_cast(hx2, wd); lo = (float)hv.x; hi = (float)hv.y; }
                v[8 * j + 2 * e] = lo; v[8 * j + 2 * e + 1] = hi; } }
        if (rot) fwht64(v);
#pragma unroll
        for (int i = 0; i < 64; ++i) amax = fmaxf(amax, fabsf(v[i]));
        amax = fmaxf(wave_max(amax), 1e-30f);
        const float qs = 127.0f / amax;
        if (lane == 0) scale[row] = amax * (1.0f / 127.0f);
        u32x2* o = (u32x2*)(dst + (size_t)row * D);
#pragma unroll
        for (int j = 0; j < 8; ++j) { u32x2 w; w.x = pk_i8(v[8 * j] * qs, v[8 * j + 1] * qs, v[8 * j + 2] * qs, v[8 * j + 3] * qs); w.y = pk_i8(v[8 * j + 4] * qs, v[8 * j + 5] * qs, v[8 * j + 6] * qs, v[8 * j + 7] * qs); o[lane + 64 * j] = w; }
    }
}
__device__ __forceinline__ void p1_quant_weights(Ctx& C) {
    p1_quant_rows(C, C.WIN + (size_t)3072 * D, 13312, (signed char*)(C.ws + WS_WINQ), (float*)(C.ws + WS_SWQ), false, true);
    p1_quant_rows(C, C.WVT, 1024, (signed char*)(C.ws + WS_WVTQ), (float*)(C.ws + WS_SWQ) + 13312, false, true);
    p1_quant_rows(C, C.WUP, NUP, (signed char*)(C.ws + WS_WUPQ), (float*)(C.ws + WS_SW), FFN_BF16 != 0, true);
}
__device__ __forceinline__ void p7_norm(Ctx& C) {
    const int gw = C.bid * NWAVES + C.wave, NGW = C.G * NWAVES, lane = C.lane;
    for (int row = gw; row < M; row += NGW) {
        const int b = row >> 13; const hx8* yr = (const hx8*)(C.Y1 + (size_t)row * D); const f32x4* xr = (const f32x4*)(C.x + (size_t)row * D); u32x2* orow = (u32x2*)(C.X1H + (size_t)row * D);
        f32x4 v[16]; float ss = 0.f;
#pragma unroll
        for (int j = 0; j < 8; ++j) { const hx8 hv = yr[lane + 64 * j];
            v[2 * j] = (f32x4){(float)hv[0], (float)hv[1], (float)hv[2], (float)hv[3]}; v[2 * j + 1] = (f32x4){(float)hv[4], (float)hv[5], (float)hv[6], (float)hv[7]}; }
#pragma unroll
        for (int j = 0; j < 16; ++j) ss += (v[j].x * v[j].x + v[j].y * v[j].y) + (v[j].z * v[j].z + v[j].w * v[j].w);
        const float rs = 1.0f / sqrtf(wave_sum(ss) * (1.0f / D) + EPS);
        const f32x4* g1 = (const f32x4*)(C.g_norms + D); const f32x4* gt = (const f32x4*)(C.mod + b * NMOD + 2 * D);
        float s2 = 0.f;
#pragma unroll
        for (int j = 0; j < 16; ++j) { const int k = 2 * (lane + 64 * (j >> 1)) + (j & 1); v[j] = xr[k] + gt[k] * (v[j] * rs * g1[k]); { u32x2 xw; xw.x = pkh(v[j].x, v[j].y); xw.y = pkh(v[j].z, v[j].w); orow[k] = xw; } s2 += (v[j].x * v[j].x + v[j].y * v[j].y) + (v[j].z * v[j].z + v[j].w * v[j].w); }
        const float rs2 = 1.0f / sqrtf(wave_sum(s2) * (1.0f / D) + EPS);
        const f32x4* g2 = (const f32x4*)(C.g_norms + 2 * D); const f32x4* sh = (const f32x4*)(C.mod + b * NMOD + 3 * D); const f32x4* sc = (const f32x4*)(C.mod + b * NMOD + 4 * D);
        float amax = 0.f;
        { float t[64];
#pragma unroll
          for (int j = 0; j < 16; ++j) { const int k = 2 * (lane + 64 * (j >> 1)) + (j & 1); const f32x4 hv = v[j] * rs2 * g2[k] * (sc[k] + 1.0f) + sh[k]; t[4 * j] = hv.x; t[4 * j + 1] = hv.y; t[4 * j + 2] = hv.z; t[4 * j + 3] = hv.w; }
          fwht64(t);
#pragma unroll
          for (int j = 0; j < 16; ++j) { v[j] = (f32x4){t[4 * j], t[4 * j + 1], t[4 * j + 2], t[4 * j + 3]};
              amax = fmaxf(amax, fmaxf(fmaxf(fabsf(v[j].x), fabsf(v[j].y)), fmaxf(fabsf(v[j].z), fabsf(v[j].w)))); } }
        amax = fmaxf(wave_max(amax), 1e-20f);
        const float qs = 127.0f / amax;
        const bool halo = (row & 255) >= 254; const int hrow = M + 2 * (row >> 8) + (row & 1);
        if (lane == 0) { ((float*)(C.ws + WS_SA))[row] = amax * (1.0f / 127.0f); if (halo) ((float*)(C.ws + WS_SA))[hrow] = amax * (1.0f / 127.0f); }
        u32x2* o = (u32x2*)(((signed char*)(C.ws + WS_H2)) + (size_t)row * D); u32x2* oh = (u32x2*)(((signed char*)(C.ws + WS_H2)) + (size_t)hrow * D);
#pragma unroll
        for (int j = 0; j < 8; ++j) { u32x2 w; w.x = pk_i8(v[2 * j].x * qs, v[2 * j].y * qs, v[2 * j].z * qs, v[2 * j].w * qs); w.y = pk_i8(v[2 * j + 1].x * qs, v[2 * j + 1].y * qs, v[2 * j + 1].z * qs, v[2 * j + 1].w * qs);
            o[lane + 64 * j] = w; if (halo) oh[lane + 64 * j] = w; }
    }
}
__device__ __forceinline__ void p11_final(Ctx& C) {
    const int gw = C.bid * NWAVES + C.wave, NGW = C.G * NWAVES, lane = C.lane;
    for (int row = gw; row < M; row += NGW) {
        const int b = row >> 13; f32x4* orow = (f32x4*)(C.out + (size_t)row * D); const hx8* yr = (const hx8*)(C.Y2 + (size_t)row * D); const hx8* xr = (const hx8*)(C.X1H + (size_t)row * D);
        f32x4 v[16]; float ss = 0.f;
#pragma unroll
        for (int j = 0; j < 8; ++j) { const hx8 hv = yr[lane + 64 * j];
            v[2 * j] = (f32x4){(float)hv[0], (float)hv[1], (float)hv[2], (float)hv[3]}; v[2 * j + 1] = (f32x4){(float)hv[4], (float)hv[5], (float)hv[6], (float)hv[7]}; }
#pragma unroll
        for (int j = 0; j < 16; ++j) ss += (v[j].x * v[j].x + v[j].y * v[j].y) + (v[j].z * v[j].z + v[j].w * v[j].w);
        const float rs = 1.0f / sqrtf(wave_sum(ss) * (1.0f / D) + EPS);
        const f32x4* g3 = (const f32x4*)(C.g_norms + 3 * D); const f32x4* gt = (const f32x4*)(C.mod + b * NMOD + 5 * D);
#pragma unroll
        for (int j = 0; j < 8; ++j) { const hx8 xv = xr[lane + 64 * j]; const int k = 2 * (lane + 64 * j);
            const f32x4 x0 = {(float)xv[0], (float)xv[1], (float)xv[2], (float)xv[3]}, x1 = {(float)xv[4], (float)xv[5], (float)xv[6], (float)xv[7]};
            orow[k] = x0 + gt[k] * (v[2 * j] * rs * g3[k]); orow[k + 1] = x1 + gt[k + 1] * (v[2 * j + 1] * rs * g3[k + 1]); }
    }
}

__device__ __forceinline__ void p3_gates_item(Ctx& C, int item) {
    const int lane = C.lane, w = C.wave, qr = lane & 15, q = lane >> 4, mt = w & 3, kh = w >> 2;
    const f16* ap = C.H + (size_t)(item * 64 + mt * 16 + qr) * D + kh * 2048 + 8 * q;
    const f16* bp = C.WG + (size_t)qr * D + kh * 2048 + 8 * q;
    f32x4 acc[3] = {{0.f, 0.f, 0.f, 0.f}, {0.f, 0.f, 0.f, 0.f}, {0.f, 0.f, 0.f, 0.f}};
#pragma unroll 16
    for (int ks = 0; ks < 64; ++ks) { const hx8 a = *(const hx8*)(ap + 32 * ks);
#pragma unroll
        for (int nt = 0; nt < 3; ++nt) { const hx8 b = *(const hx8*)(bp + (size_t)nt * 16 * D + 32 * ks); acc[nt] = __builtin_amdgcn_mfma_f32_16x16x32_f16(a, b, acc[nt], 0, 0, 0); } }
    LAS f32x4* red = (LAS f32x4*)C.lds;
    if (kh == 1) {
#pragma unroll
        for (int nt = 0; nt < 3; ++nt) red[(mt * 3 + nt) * 64 + lane] = acc[nt]; }
    __syncthreads();
    if (kh == 0) {
#pragma unroll
        for (int nt = 0; nt < 3; ++nt) { const f32x4 s = acc[nt] + red[(mt * 3 + nt) * 64 + lane];
#pragma unroll
            for (int i = 0; i < 4; ++i) C.gates[(size_t)(item * 64 + mt * 16 + 4 * q + i) * 48 + nt * 16 + qr] = fsigmoid(s[i]); } }
    __syncthreads();
}
__device__ __forceinline__ void p3_compress_item(Ctx& C, int item) {
    const int lane = C.lane, w = C.wave, qr = lane & 15, q = lane >> 4, kk = item >> 7, R0 = (item & 127) * 32;
    LAS f16* hid = (LAS f16*)C.lds;
    LAS unsigned char* abuf = C.lds + 20480;
    const int srow = C.tid >> 4, sseg = C.tid & 15;
    const f16* sp;
    { const int R = R0 + srow, b = R >> 11, g = (R >> 9) & 3, n = R & 511, nc = n > 510 ? 510 : n; sp = C.KV + (size_t)(b * T + 16 * nc) * 2048 + kk * 512 + g * 128 + 8 * sseg; }
    const int sdst = (srow * 16 + (sseg ^ (srow & 15))) * 16;
    const f16* pb0 = C.W1T + (size_t)(kk * 256 + 32 * w + qr) * D + 8 * q; const f16* pb1 = pb0 + (size_t)16 * D;
    f32x4 acc[2][2] = {{{0.f, 0.f, 0.f, 0.f}, {0.f, 0.f, 0.f, 0.f}}, {{0.f, 0.f, 0.f, 0.f}, {0.f, 0.f, 0.f, 0.f}}};
    hx8 fb[2][8]; hx8 nxt = *(const hx8*)sp; sp += 2048;
#define CM_LOADB(buf) do { _Pragma("unroll") for (int k4 = 0; k4 < 4; ++k4) { fb[buf][2 * k4] = *(const hx8*)(pb0 + 32 * k4); fb[buf][2 * k4 + 1] = *(const hx8*)(pb1 + 32 * k4); } pb0 += 128; pb1 += 128; } while (0)
#define CM_STEP(c, buf) do { *(LAS hx8*)(abuf + ((c) & 1) * 8192 + sdst) = nxt; \
        if ((c) + 1 < 32) { nxt = *(const hx8*)sp; sp += 2048; CM_LOADB((buf) ^ 1); } \
        __syncthreads(); \
        hx8 af_[8]; _Pragma("unroll") for (int i_ = 0; i_ < 8; ++i_) { const int mt_ = i_ >> 2, k4_ = i_ & 3; af_[i_] = *(const LAS hx8*)(abuf + ((c) & 1) * 8192 + ((16 * mt_ + qr) * 16 + ((4 * k4_ + q) ^ qr)) * 16); } \
        _Pragma("unroll") for (int k4 = 0; k4 < 4; ++k4) { \
            acc[0][0] = __builtin_amdgcn_mfma_f32_16x16x32_f16(af_[k4], fb[buf][2 * k4], acc[0][0], 0, 0, 0); acc[0][1] = __builtin_amdgcn_mfma_f32_16x16x32_f16(af_[k4], fb[buf][2 * k4 + 1], acc[0][1], 0, 0, 0); \
            acc[1][0] = __builtin_amdgcn_mfma_f32_16x16x32_f16(af_[4 + k4], fb[buf][2 * k4], acc[1][0], 0, 0, 0); acc[1][1] = __builtin_amdgcn_mfma_f32_16x16x32_f16(af_[4 + k4], fb[buf][2 * k4 + 1], acc[1][1], 0, 0, 0); } } while (0)
    CM_LOADB(0);
#pragma unroll 1
    for (int c = 0; c < 32; c += 2) { CM_STEP(c, 0); CM_STEP(c + 1, 1); }
#undef CM_LOADB
#undef CM_STEP
    __syncthreads();
#pragma unroll
    for (int mt = 0; mt < 2; ++mt)
#pragma unroll
        for (int nt = 0; nt < 2; ++nt) { const int j = 32 * w + 16 * nt + qr; const float pb = C.posw1[kk * 256 + j];
#pragma unroll
            for (int i = 0; i < 4; ++i) hid[(16 * mt + 4 * q + i) * 264 + j] = (f16)fgelu(acc[mt][nt][i] + pb); }
    __syncthreads();
    const f16* wp = C.W2T + (size_t)(kk * 128 + 16 * w + qr) * 256 + 8 * q;
    f32x4 o2[2] = {{0.f, 0.f, 0.f, 0.f}, {0.f, 0.f, 0.f, 0.f}};
#pragma unroll
    for (int ks = 0; ks < 8; ++ks) { const hx8 wf = *(const hx8*)(wp + 32 * ks);
#pragma unroll
        for (int mt = 0; mt < 2; ++mt) { const hx8 hf = *(const LAS hx8*)(hid + (16 * mt + qr) * 264 + 32 * ks + 8 * q);
            if (kk == 0) o2[mt] = __builtin_amdgcn_mfma_f32_16x16x32_f16(wf, hf, o2[mt], 0, 0, 0);
            else o2[mt] = __builtin_amdgcn_mfma_f32_16x16x32_f16(hf, wf, o2[mt], 0, 0, 0); } }
    if (kk == 0) {
#pragma unroll
        for (int mt = 0; mt < 2; ++mt) { const int R = R0 + 16 * mt + qr, n = R & 511, d0 = 16 * w + 4 * q; const bool pad = n == 511;
            float v[4];
#pragma unroll
            for (int i = 0; i < 4; ++i) v[i] = pad ? 0.f : o2[mt][i] + C.cmp_b2[d0 + i];
            u32x2 o; o.x = pkh(v[0], v[1]); o.y = pkh(v[2], v[3]); *(u32x2*)(C.KC + (size_t)R * 128 + d0) = o; }
    } else {
#pragma unroll
        for (int mt = 0; mt < 2; ++mt) { const int Rb = R0 + 16 * mt + 4 * q, bg = Rb >> 9, n0 = Rb & 511, d = 16 * w + qr; const float bb = C.cmp_b2[128 + d];
            float v[4];
#pragma unroll
            for (int i = 0; i < 4; ++i) v[i] = (n0 + i == 511) ? 0.f : o2[mt][i] + bb;
            u32x2 o; o.x = pkh(v[0], v[1]); o.y = pkh(v[2], v[3]); *(u32x2*)(C.VCT + ((size_t)bg * 128 + d) * 512 + n0) = o; }
    }
    __syncthreads();
}
__device__ __forceinline__ void p3_sgu_item(Ctx& C, int item) {
    const int lane = C.lane, w = C.wave, tid = C.tid, qr = lane & 15, q = lane >> 4, r0 = (item >> 1) * 128, half = item & 1;
    LAS float* stats = (LAS float*)C.lds;
    LAS f16* vt = (LAS f16*)(C.lds + 1024);
#pragma unroll 4
    for (int tk = 0; tk < 16; ++tk) { const int s = 16 * w + tk; const f16* vp = C.Z + (size_t)(r0 + s) * D + 2048 + 8 * lane;
        float xv[32]; float sum = 0.f;
#pragma unroll
        for (int jj = 0; jj < 4; ++jj) { const hx8 h = *(const hx8*)(vp + 512 * jj);
#pragma unroll
            for (int e = 0; e < 8; ++e) { xv[8 * jj + e] = (float)h[e]; sum += xv[8 * jj + e]; } }
        const float mu = wave_sum(sum) * (1.0f / 2048.0f); float sq = 0.f;
#pragma unroll
        for (int e = 0; e < 32; ++e) { const float dv = xv[e] - mu; sq += dv * dv; }
        const float var = wave_sum(sq) * (1.0f / 2048.0f);
        if (lane == 0) { stats[2 * s] = mu; stats[2 * s + 1] = 1.0f / sqrtf(var + EPS); } }
    __syncthreads();
    for (int gi = 0; gi < 8; ++gi) { const int hh = half * 8 + gi;
        { const int s = tid >> 2, seg = tid & 3; const float mu = stats[2 * s], rstd = stats[2 * s + 1];
          const f16* vp = C.Z + (size_t)(r0 + s) * D + 2048 + hh * 128 + 32 * seg;
#pragma unroll
          for (int i = 0; i < 4; ++i) { const hx8 h = *(const hx8*)(vp + 8 * i);
#pragma unroll
              for (int e = 0; e < 8; ++e) { const int d = 32 * seg + 8 * i + e; const float y = ((float)h[e] - mu) * rstd * C.ln_g[hh * 128 + d] + C.ln_b[hh * 128 + d]; vt[d * 136 + s] = (f16)y; } } }
        __syncthreads();
        hx8 wf[4];
#pragma unroll
        for (int ks = 0; ks < 4; ++ks) wf[ks] = *(const hx8*)(C.SGUW + ((size_t)(hh * 128 + 16 * w + qr)) * 128 + 32 * ks + 8 * q);
        f32x4 acc[8];
#pragma unroll
        for (int dt = 0; dt < 8; ++dt) { acc[dt] = (f32x4){0.f, 0.f, 0.f, 0.f};
#pragma unroll
            for (int ks = 0; ks < 4; ++ks) { const hx8 af = *(const LAS hx8*)(vt + (16 * dt + qr) * 136 + 32 * ks + 8 * q); acc[dt] = __builtin_amdgcn_mfma_f32_16x16x32_f16(af, wf[ks], acc[dt], 0, 0, 0); } }
        { const int tl = 16 * w + qr; const float bs = C.sgu_b[hh * 128 + tl];
          const f16* up = C.Z + (size_t)(r0 + tl) * D + hh * 128 + 4 * q; f16* yp = C.YAB + (size_t)(r0 + tl) * D + 2048 + hh * 128 + 4 * q;
#pragma unroll
          for (int dt = 0; dt < 8; ++dt) { const hx4 u = *(const hx4*)(up + 16 * dt);
              u32x2 o; o.x = pk_mix((float)u[0] * (acc[dt][0] + bs), (float)u[1] * (acc[dt][1] + bs)); o.y = pk_mix((float)u[2] * (acc[dt][2] + bs), (float)u[3] * (acc[dt][3] + bs));
              *(u32x2*)(yp + 16 * dt) = o; } }
        __syncthreads();
    }
}

constexpr int ATT_LUT = 0, ATT_IMP = 8192, ATT_STG = 40960, STG_BYTES = 32768, STG_V = 16384;
static_assert(ATT_STG + 3 * STG_BYTES <= MISC_OFF, "attention LDS map");
__device__ __forceinline__ int rel_bucket_small(int n) {
    if (n < 16) return n;
    int b = 16;
    b += n >= 19; b += n >= 21; b += n >= 24; b += n >= 27; b += n >= 31; b += n >= 35; b += n >= 40; b += n >= 46; b += n >= 52; b += n >= 59; b += n >= 67; b += n >= 77; b += n >= 87; b += n >= 99; b += n >= 113;
    return b;
}
__device__ __forceinline__ void att_issue(Ctx& C, int s, int n_c, int n_s, int ks0g, int b, int g) {
    const int lane = (int)pg8::opaque((unsigned)C.lane), w = C.wave;
    const f16* kb; const f16* vb; int ldk, ldv, kb0;
    if (s < 2 * n_c) { kb0 = 64 * (s < n_c ? s : s - n_c); kb = C.KC + (size_t)(b * 4 + g) * 512 * 128; ldk = 128; vb = C.VCT + (size_t)(b * 4 + g) * 128 * 512; ldv = 512; }
    else if (s < 2 * n_c + n_s) { kb0 = 64 * (s - 2 * n_c); kb = C.KV + (size_t)b * T * 2048 + 1024 + g * 128; ldk = 2048; vb = C.VT + (size_t)(g * 128) * M + (size_t)b * T; ldv = M; }
    else { kb0 = ks0g + 64 * (s - 2 * n_c - n_s); kb = C.KV + (size_t)b * T * 2048 + 1536 + g * 128; ldk = 2048; vb = C.VT + (size_t)(512 + g * 128) * M + (size_t)b * T; ldv = M; }
    LAS unsigned char* buf = C.lds + ATT_STG + (s % 3) * STG_BYTES;
#pragma unroll
    for (int i = 0; i < 2; ++i) { const int R = 8 * w + 4 * i + (lane >> 4), m = R & 15, key = kb0 + 32 * (R >> 5) + (m >> 2) * 8 + (m & 3) + 4 * ((R >> 4) & 1), cidx = (lane & 15) ^ m;
        __builtin_amdgcn_global_load_lds((const unsigned*)(kb + (size_t)key * ldk + cidx * 8), (LAS unsigned*)(buf + (8 * w + 4 * i) * 256), 16, 0, 0); }
#pragma unroll
    for (int i = 0; i < 2; ++i) { const int dr = 16 * w + 8 * i + (lane >> 3), v = (lane & 7) ^ ((dr & 15) >> 1);
        __builtin_amdgcn_global_load_lds((const unsigned*)(vb + (size_t)dr * ldv + kb0 + 8 * v), (LAS unsigned*)(buf + STG_V + (16 * w + 8 * i) * 128), 16, 0, 0); }
}
#define SB() __builtin_amdgcn_sched_barrier(0)
#define ATT_QK2(TL) do { _Pragma("unroll") for (int scn_ = 0; scn_ < 2; ++scn_) { hx8 kf_[8]; \
        _Pragma("unroll") for (int i_ = 0; i_ < 8; ++i_) { const int kt_ = i_ >> 2, ks_ = i_ & 3; \
            kf_[i_] = *(const LAS hx8*)(bufp + scn_ * 8192 + kt_ * 4096 + qr * 256 + (((4 * ks_ + q) ^ qr) << 4)); } \
        __builtin_amdgcn_s_setprio(1); \
        _Pragma("unroll") for (int t_ = 0; t_ < 2; ++t_) { f32x4 a_ = {0.f, 0.f, 0.f, 0.f}; \
            _Pragma("unroll") for (int ks = 0; ks < 4; ++ks) a_ = __builtin_amdgcn_mfma_f32_16x16x32_f16(kf_[4 * t_ + ks], qf[TL][ks], a_, 0, 0, 0); sv[2 * scn_ + t_] = a_; } \
        __builtin_amdgcn_s_setprio(0); } } while (0)
#define SVJ(tl, j) (sv[(j) >> 2][(j) & 3])
#define ATT_PV2() do { SB(); \
    _Pragma("unroll") for (int sn_ = 0; sn_ < 2; ++sn_) { hx8 vf_[8]; \
        _Pragma("unroll") for (int dt_ = 0; dt_ < 8; ++dt_) vf_[dt_] = *(const LAS hx8*)(bufp + STG_V + qr * 128 + (((4 * sn_ + q) ^ (qr >> 1)) << 4) + dt_ * 2048); \
        _Pragma("unroll") for (int tl_ = 0; tl_ < 2; ++tl_) { if (act[tl_]) { _Pragma("unroll") for (int dt = 0; dt < 8; ++dt) o[tl_][dt] = __builtin_amdgcn_mfma_f32_16x16x32_f16(vf_[dt], pf[tl_][sn_], o[tl_][dt], 0, 0, 0); } } } \
    SB(); } while (0)
#define ATT_MAXUPD(TL, RESCALE_O) do { if (__any(cm_ > m[TL] + 8.0f)) { cm_ = fmaxf(cm_, __shfl_xor(cm_, 16)); cm_ = fmaxf(cm_, __shfl_xor(cm_, 32)); \
    const float mn_ = fmaxf(m[TL], cm_); const float al_ = __builtin_amdgcn_exp2f(m[TL] - mn_); m[TL] = mn_; l[TL] *= al_; \
    if (RESCALE_O) { _Pragma("unroll") for (int dt = 0; dt < 8; ++dt) o[TL][dt] *= al_; } } } while (0)
#define ATT_PACKP(TL) do { _Pragma("unroll") for (int j = 0; j < 8; ++j) { pf[TL][0][j] = (f16)p[j]; pf[TL][1][j] = (f16)p[8 + j]; } } while (0)
#define ATT_SOFTMAX_FAR(TL, cb_, RESCALE_O) do { float mx_ = SVJ(TL, 0); _Pragma("unroll") for (int j = 1; j < 16; ++j) mx_ = fmaxf(mx_, SVJ(TL, j)); \
    float cm_ = mx_ * SC2 + (cb_); ATT_MAXUPD(TL, RESCALE_O); const float off_ = (cb_) - m[TL]; float ps_ = 0.f; \
    _Pragma("unroll") for (int j = 0; j < 16; ++j) { const float e_ = __builtin_amdgcn_exp2f(SVJ(TL, j) * SC2 + off_); ps_ += e_; pf[TL][j >> 3][j & 7] = (f16)e_; } l[TL] += ps_; } while (0)
#define ATT_SOFTMAX_NEAR(TL, RESCALE_O) do { float cm_ = sc[0]; _Pragma("unroll") for (int j = 1; j < 16; ++j) cm_ = fmaxf(cm_, sc[j]); \
    ATT_MAXUPD(TL, RESCALE_O); float ps_ = 0.f; \
    _Pragma("unroll") for (int j = 0; j < 16; ++j) { const float e_ = __builtin_amdgcn_exp2f(sc[j] - m[TL]); ps_ += e_; pf[TL][j >> 3][j & 7] = (f16)e_; } l[TL] += ps_; } while (0)
#define ATT_STAGE_BEGIN() do { if (s + 1 < S) asm volatile("s_waitcnt vmcnt(4)" ::: "memory"); else asm volatile("s_waitcnt vmcnt(0)" ::: "memory"); \
    __builtin_amdgcn_s_barrier(); asm volatile("" ::: "memory"); \
    if (s + 2 < S) att_issue(C, s + 2, n_c, n_s, ks0g, b, g); \
    bufp = C.lds + ATT_STG + (s % 3) * STG_BYTES; } while (0)
constexpr float NEGBIG = -3.0e38f;

__device__ __forceinline__ void p4_attn_unit(Ctx& C, int u) {
    const int lane = C.lane, w = C.wave, qr = lane & 15, q = lane >> 4, tok = qr >> 2, r = qr & 3;
    const int bg = u & 7, b = bg >> 2, g = bg & 3, tj = u >> 3, t0g = tj * 64, t0 = t0g + w * 8, h = g * 4 + r;
    const LAS float* lut = (const LAS float*)(C.lds + ATT_LUT) + h * 128;
    LAS float* imp = (LAS float*)(C.lds + ATT_IMP) + w * 1024;
    const LAS unsigned char* bufp = C.lds + ATT_STG;
    const int n_c = (tj >> 4) + 1, n_s = tj + 1, ks0g = (t0g - 511 < 0 ? 0 : t0g - 511) & ~63, n_w = ((t0g + 63 - ks0g) >> 6) + 1, S = 2 * n_c + n_s + n_w;
    hx8 qf[2][4];
#pragma unroll
    for (int tl = 0; tl < 2; ++tl) { const int t = t0 + 4 * tl + tok; const f16* qp = C.Q + (size_t)(b * T + t) * 2048 + h * 128 + 8 * q;
#pragma unroll
        for (int ks = 0; ks < 4; ++ks) qf[tl][ks] = *(const hx8*)(qp + 32 * ks); }
#define GATE(tl, i) (C.gates[(size_t)(b * T + t0 + 4 * (tl) + tok) * 48 + h * 3 + (i)])
#define YSP(tl) ((f32x4*)(C.ysc + (size_t)(b * T + t0 + 4 * (tl) + tok) * 2048 + h * 128 + 4 * q))
    const float b127 = lut[127];
    f32x4 o[2][8], sv[4]; hx8 pf[2][2]; float sc[16], p[16], m[2], l[2]; bool act[2];
#pragma unroll
    for (int tl = 0; tl < 2; ++tl)
#pragma unroll
        for (int dt = 0; dt < 8; ++dt) o[tl][dt] = (f32x4){0.f, 0.f, 0.f, 0.f};
    for (int i = lane; i < 1024; i += 64) imp[i] = 0.f;
    asm volatile("s_waitcnt vmcnt(0) lgkmcnt(0)" ::: "memory");
    __syncthreads();
    int s = 0;
    att_issue(C, 0, n_c, n_s, ks0g, b, g); att_issue(C, 1, n_c, n_s, ks0g, b, g);

    m[0] = m[1] = -1e30f; l[0] = l[1] = 0.f;
    for (int c = 0; c < n_c; ++c, ++s) {
        ATT_STAGE_BEGIN();
        const int kb0 = 64 * c;
        act[0] = kb0 <= ((t0 + 3 - 31) >> 4); act[1] = kb0 <= ((t0 + 7 - 31) >> 4);
        if (!act[1]) continue;
#pragma unroll
        for (int tl = 0; tl < 2; ++tl) { if (act[tl]) { const int tb = t0 + 4 * tl, t = tb + tok, nmax_t = (t - 31) >> 4;
            ATT_QK2(tl);
            if (kb0 + 63 <= ((tb - 31) >> 4) && tb - 16 * (kb0 + 63) - 31 >= 127) { ATT_SOFTMAX_FAR(tl, b127, false); }
            else {
#pragma unroll
                for (int j = 0; j < 16; ++j) { const int n = kb0 + 32 * (j >> 3) + 8 * q + (j & 7), dist = t - 16 * n - 31;
                    const int di = dist < 0 ? 0 : (dist > 127 ? 127 : dist); const float lv = lut[di]; const float sx = SVJ(tl, j) * SC2 + lv; sc[j] = n <= nmax_t ? sx : NEGBIG; }
                ATT_SOFTMAX_NEAR(tl, false); } } }
    }
    float il[2];
#pragma unroll
    for (int tl = 0; tl < 2; ++tl) { l[tl] += __shfl_xor(l[tl], 16); l[tl] += __shfl_xor(l[tl], 32); il[tl] = l[tl] > 0.f ? 1.0f / l[tl] : 0.f; }
    float carry[2] = {0.f, 0.f};
    for (int c = 0; c < n_c; ++c, ++s) {
        ATT_STAGE_BEGIN();
        const int kb0 = 64 * c;
        act[0] = kb0 <= ((t0 + 3 - 31) >> 4); act[1] = kb0 <= ((t0 + 7 - 31) >> 4);
        if (!act[1]) continue;
#pragma unroll
        for (int tl = 0; tl < 2; ++tl) { if (act[tl]) { const int t = t0 + 4 * tl + tok, nmax_t = (t - 31) >> 4;
            ATT_QK2(tl);
#pragma unroll
            for (int j = 0; j < 16; ++j) { const int n = kb0 + 32 * (j >> 3) + 8 * q + (j & 7), dist = t - 16 * n - 31;
                const int di = dist < 0 ? 0 : (dist > 127 ? 127 : dist); const float lv = lut[di]; const float px = __builtin_amdgcn_exp2f(SVJ(tl, j) * SC2 + lv - m[tl]) * il[tl]; p[j] = n <= nmax_t ? px : 0.f; }
            ATT_PACKP(tl);
#pragma unroll
            for (int scn = 0; scn < 2; ++scn) { float ph[8];
#pragma unroll
                for (int j = 0; j < 8; ++j) { float v = p[8 * scn + j]; v += dpp_f<0xB1>(v); v += dpp_f<0x4E>(v); ph[j] = v; }
                const float t7 = __shfl(ph[7], (lane + 48) & 63);
                const float left = q == 0 ? carry[tl] : t7; carry[tl] = t7;
                if (r == 0) { f32x2 iv; iv.x = left + 2.0f * (ph[0] + ph[1] + ph[2]) + ph[3]; iv.y = ph[3] + 2.0f * (ph[4] + ph[5] + ph[6]) + ph[7];
                    *(LAS f32x2*)(imp + (4 * tl + tok) * 128 + ((kb0 + 32 * scn) >> 2) + 2 * q) = iv; } } } }
        ATT_PV2();
    }
#pragma unroll
    for (int tl = 0; tl < 2; ++tl) { f32x4* ysp = YSP(tl); const float gc = GATE(tl, 0);
#pragma unroll
        for (int dt = 0; dt < 8; ++dt) { ysp[4 * dt] = o[tl][dt] * gc; o[tl][dt] = (f32x4){0.f, 0.f, 0.f, 0.f}; } }
    LDS_WAIT();
    unsigned long long my_lo[2] = {0ull, 0ull}, my_hi[2] = {0ull, 0ull}, U_lo[2] = {0ull, 0ull}, U_hi[2] = {0ull, 0ull};
#pragma unroll
    for (int tk = 0; tk < 8; ++tk) { const int tt = t0 + tk, cur = tt >> 6; unsigned long long lo, hi;
        if (cur < 16) { lo = (1ull << (cur + 1)) - 1ull; hi = 0ull; }
        else {
            LAS float* P = imp + tk * 128;
            const int j0 = lane, j1 = lane + 64;
            const bool c0 = j0 >= 1 && j0 <= cur - 2, c1 = j1 <= cur - 2;
            const float i0 = c0 ? P[j0] : -1.0f, i1 = c1 ? P[j1] : -1.0f;
            LDS_WAIT();
            P[j0] = i0; P[j1] = i1;
            LDS_WAIT();
            int r0 = 0, r1 = 0;
            for (int jp = 0; jp <= cur - 2; jp += 4) { const f32x4 v = *(const LAS f32x4*)(P + jp);
#pragma unroll
                for (int e = 0; e < 4; ++e) { r0 += (v[e] > i0 || (v[e] == i0 && jp + e < j0)) ? 1 : 0; r1 += (v[e] > i1 || (v[e] == i1 && jp + e < j1)) ? 1 : 0; } }
            const bool sel0 = (c0 && r0 < 13) || j0 == 0 || j0 == cur || j0 == cur - 1, sel1 = (c1 && r1 < 13) || j1 == cur || j1 == cur - 1;
            lo = __ballot(sel0); hi = __ballot(sel1);
        }
        U_lo[tk >> 2] |= lo; U_hi[tk >> 2] |= hi; if (tok == (tk & 3)) { my_lo[tk >> 2] = lo; my_hi[tk >> 2] = hi; } }
    m[0] = m[1] = -1e30f; l[0] = l[1] = 0.f;
    for (int jb = 0; jb < n_s; ++jb, ++s) {
        ATT_STAGE_BEGIN();
        bool mine[2];
#pragma unroll
        for (int tl = 0; tl < 2; ++tl) { act[tl] = jb < 64 ? ((U_lo[tl] >> jb) & 1ull) : ((U_hi[tl] >> (jb - 64)) & 1ull); mine[tl] = jb < 64 ? ((my_lo[tl] >> jb) & 1ull) : ((my_hi[tl] >> (jb - 64)) & 1ull); }
        if (!act[0] && !act[1]) continue;
        const int kb0 = 64 * jb;
#pragma unroll
        for (int tl = 0; tl < 2; ++tl) { if (act[tl]) { const int tb = t0 + 4 * tl, t = tb + tok;
            ATT_QK2(tl);
            if (tb - (kb0 + 63) >= 127) { const float cb = mine[tl] ? b127 : NEGBIG; ATT_SOFTMAX_FAR(tl, cb, true); }
            else { const int bd = t - kb0 - 8 * q;
#pragma unroll
                for (int j = 0; j < 16; ++j) { const int dist = bd - 32 * (j >> 3) - (j & 7);
                    const int di = dist < 0 ? 0 : (dist > 127 ? 127 : dist); const float lv = lut[di]; const float sx = SVJ(tl, j) * SC2 + lv; sc[j] = (mine[tl] && dist >= 0) ? sx : NEGBIG; }
                ATT_SOFTMAX_NEAR(tl, true); } } }
        ATT_PV2();
    }
#pragma unroll
    for (int tl = 0; tl < 2; ++tl) { l[tl] += __shfl_xor(l[tl], 16); l[tl] += __shfl_xor(l[tl], 32); const float gl = l[tl] > 0.f ? GATE(tl, 1) / l[tl] : 0.f; f32x4* ysp = YSP(tl);
#pragma unroll
        for (int dt = 0; dt < 8; ++dt) { ysp[4 * dt] = ysp[4 * dt] + o[tl][dt] * gl; o[tl][dt] = (f32x4){0.f, 0.f, 0.f, 0.f}; } }
    m[0] = m[1] = -1e30f; l[0] = l[1] = 0.f;
    for (int k = 0; k < n_w; ++k, ++s) {
        ATT_STAGE_BEGIN();
        const int kb0 = ks0g + 64 * k;
#pragma unroll
        for (int tl = 0; tl < 2; ++tl) { const int tb = t0 + 4 * tl; act[tl] = !(kb0 > tb + 3 || kb0 + 63 < tb - 511); }
        if (!act[0] && !act[1]) continue;
#pragma unroll
        for (int tl = 0; tl < 2; ++tl) { if (act[tl]) { const int tb = t0 + 4 * tl, t = tb + tok;
            ATT_QK2(tl);
            if (tb - (kb0 + 63) >= 127 && tb + 3 - kb0 <= 511) { ATT_SOFTMAX_FAR(tl, b127, true); }
            else { const int bd = t - kb0 - 8 * q;
#pragma unroll
                for (int j = 0; j < 16; ++j) { const int dist = bd - 32 * (j >> 3) - (j & 7);
                    const int di = dist < 0 ? 0 : (dist > 127 ? 127 : dist); const float lv = lut[di]; const float sx = SVJ(tl, j) * SC2 + lv; sc[j] = (dist >= 0 && dist < 512) ? sx : NEGBIG; }
                ATT_SOFTMAX_NEAR(tl, true); } } }
        ATT_PV2();
    }
#pragma unroll
    for (int tl = 0; tl < 2; ++tl) { l[tl] += __shfl_xor(l[tl], 16); l[tl] += __shfl_xor(l[tl], 32); const float gl = l[tl] > 0.f ? GATE(tl, 2) / l[tl] : 0.f; const f32x4* ysp = YSP(tl);
        f16* yp = C.YAB + (size_t)(b * T + t0 + 4 * tl + tok) * D + h * 128 + 4 * q;
#pragma unroll
        for (int dt = 0; dt < 8; ++dt) { const f32x4 yv = ysp[4 * dt] + o[tl][dt] * gl; u32x2 ov; ov.x = pk_mix(yv[0], yv[1]); ov.y = pk_mix(yv[2], yv[3]); *(u32x2*)(yp + 16 * dt) = ov; } }
}
#undef GATE
#undef YSP
__device__ __forceinline__ void p4_attention(Ctx& C) {
    LAS float* lut = (LAS float*)(C.lds + ATT_LUT);
    for (int i = C.tid; i < 16 * 128; i += NTHREADS) { const int hh = i >> 7, n = i & 127; lut[i] = C.rel_table[rel_bucket_small(n) * 16 + hh] * LOG2E; }
    __syncthreads();
    for (int u = C.bid; u < 1024; u += C.G) p4_attn_unit(C, u);
    __syncthreads();
}

__device__ __forceinline__ void p9_fixup(Ctx& C) {
    const int gt = C.bid * NTHREADS + C.tid, NGT = C.G * NTHREADS;
    for (int it = gt; it < 64 * (DFF / 8); it += NGT) {
        const int pm = it / (DFF / 8), c0 = (it % (DFF / 8)) * 8; const bool first = ((pm * 256) & (T - 1)) == 0;
        float res[2][8];
#pragma unroll
        for (int h4 = 0; h4 < 2; ++h4) {
            f32x4 cvv[2][2];
#pragma unroll
            for (int bj = 0; bj < 2; ++bj) { const int cc = c0 + 4 * h4;
                const f32x4 w0 = *(const f32x4*)(C.conv_w + 0 * NUP + bj * DFF + cc), w1 = *(const f32x4*)(C.conv_w + 1 * NUP + bj * DFF + cc), w2 = *(const f32x4*)(C.conv_w + 2 * NUP + bj * DFF + cc), bb = *(const f32x4*)(C.conv_b + bj * DFF + cc);
                const f32x4 a0 = *(const f32x4*)(C.AT + (size_t)((pm * 2 + 0) * 2 + bj) * DFF + cc), a1 = *(const f32x4*)(C.AT + (size_t)((pm * 2 + 1) * 2 + bj) * DFF + cc);
                f32x4 hm2 = {0.f, 0.f, 0.f, 0.f}, hm1 = {0.f, 0.f, 0.f, 0.f};
                if (!first) { hm2 = *(const f32x4*)(C.AH + (size_t)((2 * (pm - 1) + 0) * 2 + bj) * DFF + cc); hm1 = *(const f32x4*)(C.AH + (size_t)((2 * (pm - 1) + 1) * 2 + bj) * DFF + cc); }
                cvv[0][bj] = bb + w0 * hm2 + w1 * hm1 + w2 * a0; cvv[1][bj] = bb + w0 * hm1 + w1 * a0 + w2 * a1; }
#pragma unroll
            for (int j = 0; j < 2; ++j)
#pragma unroll
                for (int i = 0; i < 4; ++i) res[j][4 * h4 + i] = fsilu(cvv[j][0][i]) * cvv[j][1][i]; }
#pragma unroll
        for (int j = 0; j < 2; ++j) { u32x4 ov; ov.x = pk_ffn(res[j][0], res[j][1]); ov.y = pk_ffn(res[j][2], res[j][3]); ov.z = pk_ffn(res[j][4], res[j][5]); ov.w = pk_ffn(res[j][6], res[j][7]);
            *(u32x4*)(C.ACT + (size_t)(pm * 256 + j) * DFF + c0) = ov; }
    }
}

__device__ __forceinline__ void ph2_proj(Ctx& C) {
    { pg8::Gemm g{C.H, C.WIN, M, 3072, D}; pg8::StaticOrder S; S.init(M, 3072, C.G, C.bid);
      pg8::EpiProj E{C.Q, C.KV, C.Z, C.GA, C.GB, 0};
      pg8::gemm_phase<pg8::EpiProj, pg8::StaticOrder>(C.lds, g, S, E); }
    { pg8::Gemm g{(const f16*)(C.ws + WS_H1Q), (const f16*)(C.ws + WS_WINQ), M, 13312, D / 2}; pg8::StaticOrder S; S.init(M, 13312, C.G, C.bid);
      pg8::EpiProjQ E{C.ws, 12};
      pg8::gemm_phase<pg8::EpiProjQ, pg8::StaticOrder, true, 2>(C.lds, g, S, E); }
    { pg8::Gemm g{(const f16*)(C.ws + WS_WVTQ), (const f16*)(C.ws + WS_H1Q), 1024, M, D / 2}; pg8::StaticOrder S; S.init(1024, M, C.G, C.bid);
      pg8::EpiVTQ E{C.ws};
      pg8::gemm_phase<pg8::EpiVTQ, pg8::StaticOrder, true, 2>(C.lds, g, S, E); }
}
__device__ __forceinline__ void ph3_mixers(Ctx& C) {
    for (int it = C.bid; it < 256; it += C.G) p3_gates_item(C, it);
    if constexpr (((PROBE_DUP) >> 12) & 1) { for (int it = C.bid; it < 256; it += C.G) p3_gates_item(C, it); }
    for (int it = C.bid; it < 256; it += C.G) p3_compress_item(C, it);
    if constexpr (((PROBE_DUP) >> 13) & 1) { for (int it = C.bid; it < 256; it += C.G) p3_compress_item(C, it); }
    for (int it = C.bid; it < 256; it += C.G) p3_sgu_item(C, it);
    if constexpr (((PROBE_DUP) >> 14) & 1) { for (int it = C.bid; it < 256; it += C.G) p3_sgu_item(C, it); }
}
__device__ __forceinline__ void ph5_merge(Ctx& C) {
    pg8::Gemm g{C.YAB, C.WM, M, D, D}; pg8::StaticOrder S; S.init(M, D, C.G, C.bid);
    pg8::EpiMerge E{C.GA, C.GB, C.H};
    pg8::gemm_phase<pg8::EpiMerge, pg8::StaticOrder, true, MIX_BF16 ? 1 : 0>(C.lds, g, S, E);
}
__device__ __forceinline__ void ph6_out(Ctx& C) {
    pg8::Gemm g{C.H, C.WO, M, D, D}; pg8::StaticOrder S; S.init(M, D, C.G, C.bid);
    pg8::EpiH16 E{C.Y1, D};
    pg8::gemm_phase<pg8::EpiH16, pg8::StaticOrder, true, MIX_BF16 ? 1 : 0>(C.lds, g, S, E);
}
__device__ __forceinline__ void ph8_up(Ctx& C) {
    pg8::Gemm g{(const f16*)((signed char*)(C.ws + WS_H2)), (const f16*)((signed char*)(C.ws + WS_WUPQ)), M + 256, NUP, D / 2}; pg8::StaticOrder S; S.init(M + 256, NUP, C.G, C.bid);
    pg8::EpiConv E{C.ws, C.conv_w, C.conv_b, (LAS float*)(C.lds + pg8::STAGE_BYTES), FFN_BF16};
    pg8::gemm_phase<pg8::EpiConv, pg8::StaticOrder, true, 2>(C.lds, g, S, E);
}
__device__ __forceinline__ void ph9_conv(Ctx& C) { p9_fixup(C); }
__device__ __forceinline__ void ph10_down(Ctx& C) {
    pg8::Gemm g{C.ACT, C.WDN, M, D, DFF}; pg8::StaticOrder S; S.init(M, D, C.G, C.bid);
    pg8::EpiH16 E{C.Y2, D};
    pg8::gemm_phase<pg8::EpiH16, pg8::StaticOrder, true, FFN_BF16 ? 1 : 0>(C.lds, g, S, E);
}

constexpr int NPHASE = 12;
__global__ void __launch_bounds__(NTHREADS, 2) fwd_kernel(Args args) {
    extern __shared__ __attribute__((aligned(16))) unsigned char lds_raw[];
    Ctx C;
    C.lds = (LAS unsigned char*)lds_raw;
    C.tid = threadIdx.x; C.lane = C.tid & 63; C.wave = __builtin_amdgcn_readfirstlane(C.tid >> 6); C.G = gridDim.x; C.bid = blockIdx.x;
    C.x = args.in[0]; C.c = args.in[1]; C.w_mod = args.in[2]; C.b_mod = args.in[3]; C.g_norms = args.in[4]; C.w_in = args.in[5]; C.cmp_pos = args.in[6]; C.cmp_w1 = args.in[7];
    C.cmp_b1 = args.in[8]; C.cmp_w2 = args.in[9]; C.cmp_b2 = args.in[10]; C.rel_table = args.in[11]; C.ln_g = args.in[12]; C.ln_b = args.in[13]; C.sgu_w = args.in[14]; C.sgu_b = args.in[15];
    C.w_pn = args.in[16]; C.w_ps = args.in[17]; C.w_out = args.in[18]; C.w_up = args.in[19]; C.conv_w = args.in[20]; C.conv_b = args.in[21]; C.w_dn = args.in[22];
    C.out = args.out; C.ws = args.ws; unsigned char* ws = args.ws;
    C.mod = (float*)(ws + WS_MOD); C.posw1 = (float*)(ws + WS_POSW1); C.gates = (float*)(ws + WS_GATES); C.ysc = (float*)(ws + WS_YSC); C.AH = (float*)(ws + WS_AH); C.AT = (float*)(ws + WS_AT); C.Y1 = (f16*)(ws + WS_Z); C.Y2 = (f16*)(ws + WS_Y2); C.X1H = (f16*)(ws + WS_X1H);
    C.W2T = (f16*)(ws + WS_W2T); C.SGUW = (f16*)(ws + WS_SGUW); C.WG = (f16*)(ws + WS_WG); C.KC = (f16*)(ws + WS_KC); C.VCT = (f16*)(ws + WS_VCT); C.W1T = (f16*)(ws + WS_W1T);
    C.WUP = (f16*)(ws + WS_WUP); C.WDN = (f16*)(ws + WS_WDN); C.WIN = (f16*)(ws + WS_WIN); C.WVT = (f16*)(ws + WS_WVT); C.WM = (f16*)(ws + WS_WM); C.WO = (f16*)(ws + WS_WO);
    C.H = (f16*)(ws + WS_H); C.Q = (f16*)(ws + WS_Q); C.KV = (f16*)(ws + WS_KV); C.VT = (f16*)(ws + WS_VT); C.Z = (f16*)(ws + WS_Z); C.GA = (f16*)(ws + WS_GA); C.GB = (f16*)(ws + WS_GB);
    C.YAB = (f16*)(ws + WS_YAB); C.H2 = (f16*)(ws + WS_H2); C.ACT = (f16*)(ws + WS_ACT);

    volatile LAS unsigned* MISC = (volatile LAS unsigned*)(C.lds + MISC_OFF);
    for (int u = C.tid; u < (LDS_BYTES - MISC_OFF) / 4; u += NTHREADS) MISC[u] = 0u;
    __syncthreads();
    unsigned* barw = (unsigned*)(ws + WS_CTL) + CW_BAR;
    XcdBarrier bar; bar.bar = barw; bar.x = 0; bar.st = nullptr;
    if (MK_N_LAUNCHES == 1) bar = xcd_barrier_post(barw, MISC + 8);
    const int lo = args.ph_lo, hi = args.ph_hi;
#define IN(k) (lo <= (k) && (k) < hi)
#define DUP(k) ((((PROBE_DUP) >> (k)) & 1) != 0)
#define SEAM(k) do { if (IN(k) && IN((k) + 1)) xcd_barrier(bar); } while (0)

    if (IN(0)) { p0_prologue(C); if constexpr (DUP(0)) p0_prologue(C); }
    SEAM(0);
    if (IN(1)) { p1_norm(C); p1_quant_weights(C); if constexpr (DUP(1)) p1_norm(C); }
    SEAM(1);
    if (IN(2)) { ph2_proj(C); if constexpr (DUP(2)) ph2_proj(C); }
    SEAM(2);
    if (IN(3)) { ph3_mixers(C); if constexpr (DUP(3)) ph3_mixers(C); }
    SEAM(3);
    if (IN(4)) { p4_attention(C); if constexpr (DUP(4)) p4_attention(C); }
    SEAM(4);
    if (IN(5)) { ph5_merge(C); if constexpr (DUP(5)) ph5_merge(C); }
    SEAM(5);
    if (IN(6)) { ph6_out(C); if constexpr (DUP(6)) ph6_out(C); }
    SEAM(6);
    if (IN(7)) { p7_norm(C); }
    SEAM(7);
    if (IN(8)) { ph8_up(C); if constexpr (DUP(8)) ph8_up(C); }
    SEAM(8);
    if (IN(9)) { ph9_conv(C); if constexpr (DUP(9)) ph9_conv(C); }
    SEAM(9);
    if (IN(10)) { ph10_down(C); if constexpr (DUP(10)) ph10_down(C); }
    SEAM(10);
    if (IN(11)) { p11_final(C); }
#undef IN
#undef DUP
#undef SEAM
}

extern "C" void kernel_launch(void* const* d_in, const int* in_sizes, int n_in, void* d_out, int out_size, void* d_ws, size_t ws_size, hipStream_t stream) {
    static int grid = 0;
    if (grid == 0) {
        if (n_in != 23 || in_sizes[0] != M * D || out_size != M * D || ws_size < WS_END) { fprintf(stderr, "kernel_launch: unexpected shapes (n_in %d, in0 %d, out %d, ws %zu); nothing launched\n", n_in, n_in > 0 ? in_sizes[0] : -1, out_size, ws_size); grid = -1; return; }
        int dev = 0, cus = 0, per_cu = 0;
        if (hipGetDevice(&dev) != hipSuccess || hipDeviceGetAttribute(&cus, hipDeviceAttributeMultiprocessorCount, dev) != hipSuccess) { grid = -1; return; }
        if (hipFuncSetAttribute((const void*)fwd_kernel, hipFuncAttributeMaxDynamicSharedMemorySize, LDS_BYTES) != hipSuccess) { fprintf(stderr, "kernel_launch: hipFuncSetAttribute failed\n"); grid = -1; return; }
        if (hipOccupancyMaxActiveBlocksPerMultiprocessor(&per_cu, (const void*)fwd_kernel, NTHREADS, LDS_BYTES) != hipSuccess || per_cu < 1) { fprintf(stderr, "kernel_launch: occupancy query reports %d\n", per_cu); }
        (void)hipGetLastError();
        grid = cus;
        if (grid > 256) grid = 256;
    }
    if (grid < 0) return;
    (void)hipMemsetAsync((char*)d_ws + WS_CTL, 0, CTL_BYTES, stream);
    Args a{};
    for (int i = 0; i < 23; ++i) a.in[i] = (const float*)d_in[i];
    a.out = (float*)d_out; a.ws = (unsigned char*)d_ws;
    if (MK_N_LAUNCHES == 1) { a.ph_lo = 0; a.ph_hi = NPHASE; hipLaunchKernelGGL(fwd_kernel, dim3(grid), dim3(NTHREADS), LDS_BYTES, stream, a); }
    else { for (int li = 0; li < NPHASE; ++li) { a.ph_lo = li; a.ph_hi = li + 1; hipLaunchKernelGGL(fwd_kernel, dim3(grid), dim3(NTHREADS), LDS_BYTES, stream, a); } }
}
```

```cpp
#include <hip/hip_runtime.h>
#include <cstdio>
#include <cstdint>

#ifndef MK_N_LAUNCHES
#define MK_N_LAUNCHES 1
#endif

#ifndef PROBE_DUP
#define PROBE_DUP 0
#endif
#define GAS __attribute__((address_space(1)))
#define LAS __attribute__((address_space(3)))
typedef _Float16 f16;
typedef _Float16 hx8 __attribute__((ext_vector_type(8)));
typedef _Float16 hx4 __attribute__((ext_vector_type(4)));
typedef _Float16 hx2 __attribute__((ext_vector_type(2)));
typedef float f32x4 __attribute__((ext_vector_type(4)));
typedef float f32x2 __attribute__((ext_vector_type(2)));
typedef unsigned u32x4 __attribute__((ext_vector_type(4)));
typedef unsigned u32x2 __attribute__((ext_vector_type(2)));
typedef int ix4 __attribute__((ext_vector_type(4)));

constexpr int NB = 2, T = 8192, D = 4096, M = NB * T;
constexpr int NG = 4, HD = 128;
constexpr int DFF = 11008, NUP = 2 * DFF;
constexpr int IN_W = 17456, NPROJ = 16384, NMOD = 6 * D;
constexpr float EPS = 1e-6f;
constexpr float LOG2E = 1.4426950408889634f;
constexpr float SC2 = 0.08838834764831845f * 1.4426950408889634f;

constexpr size_t MiB = 1ull << 20;
constexpr size_t WS_CTL = 0, CTL_BYTES = 1 * MiB;
constexpr size_t WS_MOD = 1 * MiB;
constexpr size_t WS_POSW1 = 1 * MiB + 256 * 1024;
constexpr size_t WS_W2T = 1 * MiB + 384 * 1024;
constexpr size_t WS_SGUW = 2 * MiB;
constexpr size_t WS_WG = 2 * MiB + 512 * 1024;
constexpr size_t WS_KC = 3 * MiB;
constexpr size_t WS_VCT = 4 * MiB;
constexpr size_t WS_GATES = 5 * MiB;
constexpr size_t WS_W1T = 8 * MiB;
constexpr size_t WS_WUP = 16 * MiB;
constexpr size_t WS_WDN = 188 * MiB;
constexpr size_t WS_WIN = 274 * MiB;
constexpr size_t WS_WVT = 402 * MiB;
constexpr size_t WS_WM = 410 * MiB;
constexpr size_t WS_WO = 442 * MiB;
constexpr size_t WS_H = 474 * MiB;
constexpr size_t WS_Q = 602 * MiB;
constexpr size_t WS_KV = 666 * MiB;
constexpr size_t WS_VT = 730 * MiB;
constexpr size_t WS_Z = 762 * MiB;
constexpr size_t WS_GA = 890 * MiB;
constexpr size_t WS_GB = 1018 * MiB;
constexpr size_t WS_YAB = 1146 * MiB;
constexpr size_t WS_H2 = 274 * MiB;
constexpr size_t WS_AH = 406 * MiB;
constexpr size_t WS_AT = 418 * MiB;
constexpr size_t WS_ACT = 1090 * MiB;
constexpr size_t WS_Y2 = 432 * MiB;
constexpr size_t WS_X1H = 602 * MiB;
constexpr size_t WS_YSC = 1274 * MiB;
constexpr size_t WS_SA = 12 * MiB;
constexpr size_t WS_SW = 12 * MiB + 256 * 1024;
constexpr size_t WS_SAH = 12 * MiB + 512 * 1024;
constexpr size_t WS_SWQ = 12 * MiB + 640 * 1024;
constexpr size_t WS_H1Q = 1274 * MiB;
constexpr size_t WS_WINQ = 1338 * MiB;
constexpr size_t WS_WVTQ = 1390 * MiB;
constexpr size_t WS_SACT = 12 * MiB + 784 * 1024;
constexpr size_t WS_SWDN = 12 * MiB + 848 * 1024;
constexpr size_t WS_ACTQ = 730 * MiB;
constexpr size_t WS_WDNQ = 1520 * MiB;
constexpr size_t WS_WUPQ = 1434 * MiB;
constexpr size_t WS_END = 1563 * MiB;

constexpr int CW_BAR = 4096;

constexpr int LDS_BYTES = 147456;
constexpr int MISC_OFF = LDS_BYTES - 512;
constexpr int NWAVES = 8, NTHREADS = 512;

#define LDS_WAIT() asm volatile("s_waitcnt lgkmcnt(0)" ::: "memory")
#define VM_WAIT() asm volatile("s_waitcnt vmcnt(0)" ::: "memory")
__device__ __forceinline__ unsigned pkh(float lo, float hi) { hx2 p; p.x = (f16)lo; p.y = (f16)hi; return __builtin_bit_cast(unsigned, p); }
__device__ __forceinline__ unsigned pkb(float lo, float hi) { unsigned r; asm volatile("v_cvt_pk_bf16_f32 %0, %1, %2" : "=v"(r) : "v"(lo), "v"(hi)); return r; }
#ifndef FFN_BF16
#define FFN_BF16 1
#endif
__device__ __forceinline__ unsigned pk_ffn(float lo, float hi) { return FFN_BF16 ? pkb(lo, hi) : pkh(lo, hi); }
#ifndef MIX_BF16
#define MIX_BF16 1
#endif
__device__ __forceinline__ unsigned pk_mix(float lo, float hi) { return MIX_BF16 ? pkb(lo, hi) : pkh(lo, hi); }
__device__ __forceinline__ float wave_max(float v) {
#pragma unroll
    for (int o = 1; o < 64; o <<= 1) v = fmaxf(v, __shfl_xor(v, o));
    return v;
}
__device__ __forceinline__ unsigned pk_i8(float a, float b, float c, float d) {
    a = fminf(fmaxf(a, -127.f), 127.f); b = fminf(fmaxf(b, -127.f), 127.f); c = fminf(fmaxf(c, -127.f), 127.f); d = fminf(fmaxf(d, -127.f), 127.f);
    const int ia = (int)__builtin_rintf(a), ib = (int)__builtin_rintf(b), ic = (int)__builtin_rintf(c), id = (int)__builtin_rintf(d);
    return (unsigned)(ia & 255) | ((unsigned)(ib & 255) << 8) | ((unsigned)(ic & 255) << 16) | ((unsigned)(id & 255) << 24);
}
__device__ __forceinline__ void fwht64(float (&t)[64]) {
#pragma unroll
    for (int h = 1; h < 64; h <<= 1)
#pragma unroll
        for (int i = 0; i < 64; ++i) if ((i & h) == 0) { const float a = t[i], b = t[i + h]; t[i] = a + b; t[i + h] = a - b; }
#pragma unroll
    for (int i = 0; i < 64; ++i) t[i] *= 0.125f;
}
__device__ __forceinline__ void fwht8(float (&t)[8]) {
#pragma unroll
    for (int h = 1; h < 8; h <<= 1)
#pragma unroll
        for (int i = 0; i < 8; ++i) if ((i & h) == 0) { const float a = t[i], b = t[i + h]; t[i] = a + b; t[i + h] = a - b; }
#pragma unroll
    for (int i = 0; i < 8; ++i) t[i] *= 0.35355339059f;
}
__device__ __forceinline__ float wave_sum(float v) {
#pragma unroll
    for (int o = 1; o < 64; o <<= 1) v += __shfl_xor(v, o);
    return v;
}
__device__ __forceinline__ float fsigmoid(float x) { return __builtin_amdgcn_rcpf(1.0f + __builtin_amdgcn_exp2f(-LOG2E * x)); }
__device__ __forceinline__ float fsilu(float x) { return x * fsigmoid(x); }
__device__ __forceinline__ float fgelu(float x) { const float u = x * (1.0f + 0.044715f * x * x); return x * __builtin_amdgcn_rcpf(1.0f + __builtin_amdgcn_exp2f(-2.302208198f * u)); }
template <int CTRL> __device__ __forceinline__ float dpp_f(float v) { return __builtin_bit_cast(float, __builtin_amdgcn_update_dpp(0, __builtin_bit_cast(int, v), CTRL, 0xF, 0xF, true)); }

namespace pg8 {
constexpr int BM = 256, BK = 64, HALF = 128, HTB = HALF * BK * 2, STAGE_BYTES = 8 * HTB, NXCD = 8, WGM = 8;
__host__ __device__ __forceinline__ int lds_byte(int r, int c) { const int st = (r >> 4) * 2 + (c >> 5), rr = r & 15, cc = c & 31, ob = rr * 64 + cc * 2; return st * 1024 + (ob ^ (((ob >> 9) & 1) << 5)); }
__host__ __device__ __forceinline__ void stage_rc(int b, int& R, int& C) { const int st = b / 1024, sb = b % 1024, swz = sb ^ (((sb >> 9) & 1) << 5); R = (st >> 1) * 16 + swz / 64; C = (st & 1) * 32 + (swz % 64) / 2; }
__host__ __device__ __forceinline__ int perm32(int rho) { const int n = rho >> 4, i = rho & 15; return 8 * (i >> 2) + 4 * n + (i & 3); }

struct Unit { int pm, pn; };
struct Gemm { const f16* A; const f16* Bt; int M, N, K; };

struct StaticOrder {
    int nM, nN, nwg, G, c;
    __host__ __device__ void init(int M_, int N_, int G_, int c_) { nM = M_ / BM; nN = N_ / BM; nwg = nM * nN; G = G_; c = c_; }
    __host__ __device__ bool next(int i, Unit& u) const {
        const long L = (long)i * G + c; if (L >= nwg) return false;
        int wgid = (int)L; { const int q = nwg / NXCD, r = nwg % NXCD, xcd = wgid % NXCD, off = wgid / NXCD; wgid = (xcd < r ? xcd * (q + 1) : r * (q + 1) + (xcd - r) * q) + off; }
        const int nig = WGM * nN, gid = wgid / nig, fm = gid * WGM, gsz = (nM - fm) < WGM ? (nM - fm) : WGM;
        u.pm = fm + ((wgid % nig) % gsz); u.pn = (wgid % nig) / gsz; return true;
    }
    __device__ __forceinline__ void a_ready(const Unit&) const {}
    __device__ __forceinline__ void done(const Unit&) const {}
};

__device__ __forceinline__ u32x4 pack8(const f32x4 v0, const f32x4 v1) { u32x4 w; w.x = pkh(v0[0], v0[1]); w.y = pkh(v0[2], v0[3]); w.z = pkh(v1[0], v1[1]); w.w = pkh(v1[2], v1[3]); return w; }

__device__ __forceinline__ unsigned opaque(unsigned v) { asm volatile("" : "+v"(v)); return v; }
struct EpiF32 {
    static constexpr bool PERM = false, AFTER_DRAIN = false, HAS_MID = false;
    float* C; int ldc;
    __device__ __forceinline__ void mid(f32x4 (&)[2][2][4][2], const Unit&, int, int, int, int) const {}
    __device__ __forceinline__ void operator()(const f32x4 (&acc)[2][2][4][2], const Unit& u, int wr, int wc, int fr, int fq) const {
        const unsigned off = opaque((unsigned)((u.pm * BM + wr * 64 + fr) * ldc + u.pn * BM + wc * 32 + 4 * fq) * 4u);
        char* base = (char*)C;
#pragma unroll
        for (int ai = 0; ai < 2; ++ai)
#pragma unroll
            for (int m = 0; m < 4; ++m) { const unsigned ro = off + (unsigned)((ai * HALF + m * 16) * ldc) * 4u;
#pragma unroll
                for (int bj = 0; bj < 2; ++bj)
#pragma unroll
                    for (int n = 0; n < 2; ++n) *(f32x4*)(base + ro + (bj * HALF + n * 16) * 4) = acc[ai][bj][m][n]; }
    }
};
struct EpiH16 {
    static constexpr bool PERM = true, AFTER_DRAIN = false, HAS_MID = false;
    f16* O; int ldc;
    __device__ __forceinline__ void mid(f32x4 (&)[2][2][4][2], const Unit&, int, int, int, int) const {}
    __device__ __forceinline__ void operator()(const f32x4 (&acc)[2][2][4][2], const Unit& u, int wr, int wc, int fr, int fq) const {
        const unsigned off = opaque((unsigned)((u.pm * BM + wr * 64 + fr) * ldc + u.pn * BM + wc * 32 + 8 * fq) * 2u);
        char* base = (char*)O;
#pragma unroll
        for (int ai = 0; ai < 2; ++ai)
#pragma unroll
            for (int m = 0; m < 4; ++m) { const unsigned ro = off + (unsigned)((ai * HALF + m * 16) * ldc) * 2u;
#pragma unroll
                for (int bj = 0; bj < 2; ++bj) *(u32x4*)(base + ro + bj * HALF * 2) = pack8(acc[ai][bj][m][0], acc[ai][bj][m][1]); }
    }
};
struct EpiProj {
    static constexpr bool PERM = true, AFTER_DRAIN = false, HAS_MID = false;
    f16 *Q, *KV, *Z, *GA, *GB; int pn0;
    __device__ __forceinline__ void mid(f32x4 (&)[2][2][4][2], const Unit&, int, int, int, int) const {}
    __device__ __forceinline__ void operator()(const f32x4 (&acc)[2][2][4][2], const Unit& u, int wr, int wc, int fr, int fq) const {
        const int pn = u.pn + pn0; char* base; int ldc, colt, act;
        if (pn < 8) { base = (char*)Q; ldc = 2048; colt = pn * 256; act = 0; }
        else if (pn < 16) { base = (char*)KV; ldc = 2048; colt = (pn - 8) * 256; act = 0; }
        else if (pn < 32) { base = (char*)Z; ldc = 4096; colt = (pn - 16) * 256; act = 1; }
        else if (pn < 48) { base = (char*)GA; ldc = 4096; colt = (pn - 32) * 256; act = 2; }
        else { base = (char*)GB; ldc = 4096; colt = (pn - 48) * 256; act = 2; }
        const unsigned off = opaque((unsigned)((u.pm * BM + wr * 64 + fr) * ldc + colt + wc * 32 + 8 * fq) * 2u);
#pragma unroll
        for (int ai = 0; ai < 2; ++ai)
#pragma unroll
            for (int m = 0; m < 4; ++m) { const unsigned ro = off + (unsigned)((ai * HALF + m * 16) * ldc) * 2u;
#pragma unroll
                for (int bj = 0; bj < 2; ++bj) { f32x4 v0 = acc[ai][bj][m][0], v1 = acc[ai][bj][m][1];
                    if (act == 1) {
#pragma unroll
                        for (int j = 0; j < 4; ++j) { v0[j] = fgelu(v0[j]); v1[j] = fgelu(v1[j]); } }
                    else if (act == 2) {
#pragma unroll
                        for (int j = 0; j < 4; ++j) { v0[j] = fsigmoid(v0[j]); v1[j] = fsigmoid(v1[j]); } }
                    *(u32x4*)(base + ro + bj * HALF * 2) = pack8(v0, v1); } }
    }
};
struct EpiProjQ {
    static constexpr bool PERM = true, AFTER_DRAIN = false, HAS_MID = false;
    unsigned char* ws; int pn0;
    __device__ __forceinline__ void mid(f32x4 (&)[2][2][4][2], const Unit&, int, int, int, int) const {}
    __device__ __forceinline__ void operator()(const f32x4 (&acc)[2][2][4][2], const Unit& u, int wr, int wc, int fr, int fq) const {
        const int pn = u.pn + pn0; char* base; int ldc, colt, act;
        if (pn < 16) { base = (char*)(ws + WS_KV); ldc = 2048; colt = (pn - 8) * 256; act = 0; }
        else if (pn < 32) { base = (char*)(ws + WS_Z); ldc = 4096; colt = (pn - 16) * 256; act = 1; }
        else if (pn < 48) { base = (char*)(ws + WS_GA); ldc = 4096; colt = (pn - 32) * 256; act = 2; }
        else { base = (char*)(ws + WS_GB); ldc = 4096; colt = (pn - 48) * 256; act = 2; }
        const float* const SA = (const float*)(ws + WS_SAH); const float* const SW = (const float*)(ws + WS_SWQ);
        const unsigned off = opaque((unsigned)((u.pm * BM + wr * 64 + fr) * ldc + colt + wc * 32 + 8 * fq) * 2u);
        const unsigned arow = opaque((unsigned)(u.pm * BM + wr * 64 + fr)), wrow = opaque((unsigned)((pn - 12) * 256 + wc * 32 + 8 * fq));
        f32x4 sw[2][2];
#pragma unroll
        for (int bj = 0; bj < 2; ++bj)
#pragma unroll
            for (int n = 0; n < 2; ++n) sw[bj][n] = *(const f32x4*)(SW + wrow + bj * HALF + 4 * n);
#pragma unroll
        for (int ai = 0; ai < 2; ++ai)
#pragma unroll
            for (int m = 0; m < 4; ++m) { const unsigned ro = off + (unsigned)((ai * HALF + m * 16) * ldc) * 2u; const float sa = SA[arow + ai * HALF + m * 16];
#pragma unroll
                for (int bj = 0; bj < 2; ++bj) { const ix4 i0 = __builtin_bit_cast(ix4, acc[ai][bj][m][0]), i1 = __builtin_bit_cast(ix4, acc[ai][bj][m][1]); f32x4 v0, v1;
#pragma unroll
                    for (int j = 0; j < 4; ++j) { v0[j] = (float)i0[j] * (sa * sw[bj][0][j]); v1[j] = (float)i1[j] * (sa * sw[bj][1][j]); }
                    if (act == 1) {
#pragma unroll
                        for (int j = 0; j < 4; ++j) { v0[j] = fgelu(v0[j]); v1[j] = fgelu(v1[j]); } }
                    else if (act == 2) {
#pragma unroll
                        for (int j = 0; j < 4; ++j) { v0[j] = fsigmoid(v0[j]); v1[j] = fsigmoid(v1[j]); } }
                    *(u32x4*)(base + ro + bj * HALF * 2) = pack8(v0, v1); } }
    }
};
struct EpiH16Q {
    static constexpr bool PERM = true, AFTER_DRAIN = false, HAS_MID = false;
    f16* O; int ldc; const float* SA; const float* SW;
    __device__ __forceinline__ void mid(f32x4 (&)[2][2][4][2], const Unit&, int, int, int, int) const {}
    __device__ __forceinline__ void operator()(const f32x4 (&acc)[2][2][4][2], const Unit& u, int wr, int wc, int fr, int fq) const {
        const unsigned off = opaque((unsigned)((u.pm * BM + wr * 64 + fr) * ldc + u.pn * BM + wc * 32 + 8 * fq) * 2u);
        const unsigned arow = opaque((unsigned)(u.pm * BM + wr * 64 + fr)), wrow = opaque((unsigned)(u.pn * BM + wc * 32 + 8 * fq));
        char* base = (char*)O;
        f32x4 sw[2][2];
#pragma unroll
        for (int bj = 0; bj < 2; ++bj)
#pragma unroll
            for (int n = 0; n < 2; ++n) sw[bj][n] = *(const f32x4*)(SW + wrow + bj * HALF + 4 * n);
#pragma unroll
        for (int ai = 0; ai < 2; ++ai)
#pragma unroll
            for (int m = 0; m < 4; ++m) { const unsigned ro = off + (unsigned)((ai * HALF + m * 16) * ldc) * 2u; const float sa = SA[arow + ai * HALF + m * 16];
#pragma unroll
                for (int bj = 0; bj < 2; ++bj) { const ix4 i0 = __builtin_bit_cast(ix4, acc[ai][bj][m][0]), i1 = __builtin_bit_cast(ix4, acc[ai][bj][m][1]); f32x4 v0, v1;
#pragma unroll
                    for (int j = 0; j < 4; ++j) { v0[j] = (float)i0[j] * (sa * sw[bj][0][j]); v1[j] = (float)i1[j] * (sa * sw[bj][1][j]); }
                    *(u32x4*)(base + ro + bj * HALF * 2) = pack8(v0, v1); } }
    }
};
struct EpiVTQ {
    static constexpr bool PERM = true, AFTER_DRAIN = false, HAS_MID = false;
    unsigned char* ws;
    __device__ __forceinline__ void mid(f32x4 (&)[2][2][4][2], const Unit&, int, int, int, int) const {}
    __device__ __forceinline__ void operator()(const f32x4 (&acc)[2][2][4][2], const Unit& u, int wr, int wc, int fr, int fq) const {
        const float* const SA = (const float*)(ws + WS_SAH); const float* const SW = (const float*)(ws + WS_SWQ) + 13312;
        const unsigned off = opaque((unsigned)((u.pm * BM + wr * 64 + fr) * M + u.pn * BM + wc * 32 + 8 * fq) * 2u);
        const unsigned wrow = opaque((unsigned)(u.pm * BM + wr * 64 + fr)), tcol = opaque((unsigned)(u.pn * BM + wc * 32 + 8 * fq));
        char* base = (char*)(ws + WS_VT);
        f32x4 sa[2][2];
#pragma unroll
        for (int bj = 0; bj < 2; ++bj)
#pragma unroll
            for (int n = 0; n < 2; ++n) sa[bj][n] = *(const f32x4*)(SA + tcol + bj * HALF + 4 * n);
#pragma unroll
        for (int ai = 0; ai < 2; ++ai)
#pragma unroll
            for (int m = 0; m < 4; ++m) { const unsigned ro = off + (unsigned)((ai * HALF + m * 16) * M) * 2u; const float sw = SW[wrow + ai * HALF + m * 16];
#pragma unroll
                for (int bj = 0; bj < 2; ++bj) { const ix4 i0 = __builtin_bit_cast(ix4, acc[ai][bj][m][0]), i1 = __builtin_bit_cast(ix4, acc[ai][bj][m][1]); f32x4 v0, v1;
#pragma unroll
                    for (int j = 0; j < 4; ++j) { v0[j] = (float)i0[j] * (sw * sa[bj][0][j]); v1[j] = (float)i1[j] * (sw * sa[bj][1][j]); }
                    *(u32x4*)(base + ro + bj * HALF * 2) = pack8(v0, v1); } }
    }
};
struct EpiMerge {
    static constexpr bool PERM = true, AFTER_DRAIN = false, HAS_MID = true;
    const f16 *GA, *GB; f16* O;
    __device__ __forceinline__ void mid(f32x4 (&acc)[2][2][4][2], const Unit& u, int wr, int wc, int fr, int fq) const {
        const unsigned off = opaque((unsigned)((u.pm * BM + wr * 64 + fr) * D + u.pn * BM + wc * 32 + 8 * fq) * 2u);
        const char* ga = (const char*)GA; const char* gb = (const char*)GB;
#pragma unroll
        for (int ai = 0; ai < 2; ++ai)
#pragma unroll
            for (int m = 0; m < 4; ++m) { const unsigned ro = off + (unsigned)((ai * HALF + m * 16) * D) * 2u;
#pragma unroll
                for (int bj = 0; bj < 2; ++bj) { const hx8 a = *(const hx8*)(ga + ro + bj * HALF * 2), b = *(const hx8*)(gb + ro + bj * HALF * 2);
#pragma unroll
                    for (int j = 0; j < 4; ++j) { acc[ai][bj][m][0][j] *= (float)a[j] * __builtin_amdgcn_rcpf((float)b[j]); acc[ai][bj][m][1][j] *= (float)a[4 + j] * __builtin_amdgcn_rcpf((float)b[4 + j]); } } }
    }
    __device__ __forceinline__ void operator()(const f32x4 (&acc)[2][2][4][2], const Unit& u, int wr, int wc, int fr, int fq) const {
        const unsigned off = opaque((unsigned)((u.pm * BM + wr * 64 + fr) * D + u.pn * BM + wc * 32 + 8 * fq) * 2u);
        const char* gb = (const char*)GB; char* ob = (char*)O;
#pragma unroll
        for (int ai = 0; ai < 2; ++ai)
#pragma unroll
            for (int m = 0; m < 4; ++m) { const unsigned ro = off + (unsigned)((ai * HALF + m * 16) * D) * 2u;
#pragma unroll
                for (int bj = 0; bj < 2; ++bj) { const hx8 b = *(const hx8*)(gb + ro + bj * HALF * 2); f32x4 v0 = acc[ai][bj][m][0], v1 = acc[ai][bj][m][1];
#pragma unroll
                    for (int j = 0; j < 4; ++j) { v0[j] *= (float)b[j]; v1[j] *= (float)b[4 + j]; }
                    u32x4 w; w.x = pk_mix(v0[0], v0[1]); w.y = pk_mix(v0[2], v0[3]); w.z = pk_mix(v1[0], v1[1]); w.w = pk_mix(v1[2], v1[3]);
                    *(u32x4*)(ob + ro + bj * HALF * 2) = w; } }
    }
};

typedef short sx8 __attribute__((ext_vector_type(8)));
template <int CTRL> __device__ __forceinline__ float dpp_mov(float old, float v) { return __builtin_bit_cast(float, __builtin_amdgcn_update_dpp(__builtin_bit_cast(int, old), __builtin_bit_cast(int, v), CTRL, 0xF, 0xF, false)); }
struct EpiConv {
    static constexpr bool PERM = true, AFTER_DRAIN = false, HAS_MID = false;
    unsigned char* ws; const float* cw; const float* cb; LAS float* X; int bf16out;
    __device__ __forceinline__ void mid(f32x4 (&)[2][2][4][2], const Unit&, int, int, int, int) const {}
    static __device__ __forceinline__ f32x4 deq(const f32x4 a, float s) { const ix4 iv = __builtin_bit_cast(ix4, a); return (f32x4){(float)iv[0] * s, (float)iv[1] * s, (float)iv[2] * s, (float)iv[3] * s}; }
    __device__ __forceinline__ void operator()(const f32x4 (&acc)[2][2][4][2], const Unit& u, int wr, int wc, int fr_, int fq_) const {
        const unsigned lane_o = opaque(threadIdx.x & 63u); const int fr = (int)(lane_o & 15u), fq = (int)(lane_o >> 4); (void)fr_; (void)fq_;
        f16* const ACT = (f16*)(ws + WS_ACT); float* const AH = (float*)(ws + WS_AH); float* const AT = (float*)(ws + WS_AT); const float* const SA = (const float*)(ws + WS_SA); const float* const SW = (const float*)(ws + WS_SW);
        const int chl = wc * 32 + 8 * fq;
        const unsigned ch0 = opaque((unsigned)(u.pn * 128 + chl)), wrow = opaque((unsigned)(u.pn * 256 + chl)), arow = opaque((unsigned)(u.pm * BM + wr * 64 + fr));
        float sa[2][4];
#pragma unroll
        for (int ai = 0; ai < 2; ++ai)
#pragma unroll
            for (int m = 0; m < 4; ++m) sa[ai][m] = SA[arow + ai * HALF + m * 16];
        if (fr >= 14) {
#pragma unroll
            for (int ai = 0; ai < 2; ++ai)
#pragma unroll
                for (int bj = 0; bj < 2; ++bj)
#pragma unroll
                    for (int n = 0; n < 2; ++n) *(LAS f32x4*)(X + ((((2 * ai + wr) * 2 + (fr - 14)) * 2 + bj) * 128 + chl + 4 * n)) = deq(acc[ai][bj][3][n], sa[ai][3]);
        }
        asm volatile("s_waitcnt lgkmcnt(0)" ::: "memory"); __builtin_amdgcn_s_barrier(); asm volatile("" ::: "memory");
        if (u.pm == 64) {
            const unsigned hro = opaque((unsigned)((wr * 64 + fr) * 2));
#pragma unroll
            for (int bj = 0; bj < 2; ++bj)
#pragma unroll
                for (int n = 0; n < 2; ++n) { const f32x4 swv = *(const f32x4*)(SW + wrow + bj * 128 + 4 * n);
#pragma unroll
                    for (int m = 0; m < 4; ++m) *(f32x4*)(AH + (size_t)(hro + 32 * m + bj) * DFF + ch0 + 4 * n) = deq(acc[0][bj][m][n], sa[0][m]) * swv; }
            return;
        }
        const unsigned orow = opaque((unsigned)(u.pm * BM + wr * 64 + fr));
#pragma unroll
        for (int n = 0; n < 2; ++n) {
            f32x4 wv[3][2], bv[2];
#pragma unroll
            for (int bj = 0; bj < 2; ++bj) { bv[bj] = *(const f32x4*)(cb + bj * DFF + ch0 + 4 * n); const f32x4 swv = *(const f32x4*)(SW + wrow + bj * 128 + 4 * n);
#pragma unroll
                for (int k = 0; k < 3; ++k) wv[k][bj] = *(const f32x4*)(cw + k * NUP + bj * DFF + ch0 + 4 * n) * swv;
                if (wr == 0 && fr < 2) *(f32x4*)(AT + (size_t)((u.pm * 2 + fr) * 2 + bj) * DFF + ch0 + 4 * n) = deq(acc[0][bj][0][n], sa[0][0]) * swv; }
#pragma unroll
            for (int ai = 0; ai < 2; ++ai) {
                f32x4 E[2];
                const int blk = 2 * ai + wr - 1;
#pragma unroll
                for (int bj = 0; bj < 2; ++bj) { E[bj] = (f32x4){0.f, 0.f, 0.f, 0.f};
                    if (blk >= 0 && fr >= 14) E[bj] = *(const LAS f32x4*)(X + (((blk * 2 + (fr - 14)) * 2 + bj) * 128 + chl + 4 * n)); }
#pragma unroll
                for (int m = 0; m < 4; ++m) {
                    f32x4 cv[2];
#pragma unroll
                    for (int bj = 0; bj < 2; ++bj) { const f32x4 cur = deq(acc[ai][bj][m][n], sa[ai][m]); const f32x4 prv = (m == 0) ? E[bj] : deq(acc[ai][bj][m == 0 ? 0 : m - 1][n], sa[ai][m == 0 ? 0 : m - 1]);
#pragma unroll
                        for (int i = 0; i < 4; ++i) { const float p1 = dpp_mov<0x111>(dpp_mov<0x121>(0.f, prv[i]), cur[i]), p2 = dpp_mov<0x112>(dpp_mov<0x122>(0.f, prv[i]), cur[i]);
                            cv[bj][i] = bv[bj][i] + wv[0][bj][i] * p2 + wv[1][bj][i] * p1 + wv[2][bj][i] * cur[i]; } }
                    float res[4];
#pragma unroll
                    for (int e = 0; e < 4; ++e) res[e] = fsilu(cv[0][e]) * cv[1][e];
                    u32x2 ov;
                    if (bf16out) { ov.x = pkb(res[0], res[1]); ov.y = pkb(res[2], res[3]); }
                    else { ov.x = pkh(res[0], res[1]); ov.y = pkh(res[2], res[3]); }
                    *(u32x2*)(ACT + (size_t)(orow + ai * HALF + m * 16) * DFF + ch0 + 4 * n) = ov;
                }
            }
        }
    }
};

template <class Epi, class Sched, bool ALIGN_EPI = true, int DT = 0  >
__device__ __forceinline__ void gemm_phase(LAS unsigned char* lds, const Gemm g, const Sched& S, const Epi& E) {
    const int tid = threadIdx.x, wid = __builtin_amdgcn_readfirstlane(tid >> 6), lane = tid & 63, wr = wid >> 2, wc = wid & 3, fr = lane & 15, fq = lane >> 4;
    const int K = g.K, nt = K / BK;
    unsigned voffA[2], voffB[2];
#pragma unroll
    for (int i = 0; i < 2; ++i) { int R, C; stage_rc(tid * 16 + i * 8192, R, C); const int Rb = Epi::PERM ? ((R & ~31) + perm32(R & 31)) : R;
        voffA[i] = (unsigned)(R * K + C) * 2u; voffB[i] = (unsigned)(Rb * K + C) * 2u; }
    const size_t kstep = (size_t)(BK * 2);
    const size_t hstep = (size_t)HALF * K * 2;
    const size_t tstep = 2 * hstep;
    const unsigned ldsw = (unsigned)wid * 1024u;
    const int aoff = lds_byte(wr * 64 + fr, fq * 8), boff = lds_byte(wc * 32 + fr, fq * 8);
#define PG8_SA(b, h) (((b) * 2 + (h)) * HTB)
#define PG8_SB(b, h) ((4 + (b) * 2 + (h)) * HTB)
#define PG8_STAGE(bufoff, gbase, voff) do { _Pragma("unroll") for (int _i = 0; _i < 2; ++_i) \
        __builtin_amdgcn_global_load_lds((const unsigned*)((const char*)(gbase) + (voff)[_i]), (LAS unsigned*)(lds + (bufoff) + ldsw + _i * 8192), 16, 0, 0); } while (0)
#define PG8_LDA(dst, b, h) do { _Pragma("unroll") for (int m = 0; m < 4; ++m) _Pragma("unroll") for (int k = 0; k < 2; ++k) dst[m][k] = *(const LAS hx8*)(lds + PG8_SA(b, h) + aoff + m * 2048 + k * 1024); } while (0)
#define PG8_LDB(dst, b, h) do { _Pragma("unroll") for (int n = 0; n < 2; ++n) _Pragma("unroll") for (int k = 0; k < 2; ++k) dst[n][k] = *(const LAS hx8*)(lds + PG8_SB(b, h) + boff + n * 2048 + k * 1024); } while (0)
#define PG8_MMA(ai, bj, At, Bt) do { __builtin_amdgcn_s_setprio(1); _Pragma("unroll") for (int m = 0; m < 4; ++m) _Pragma("unroll") for (int n = 0; n < 2; ++n) _Pragma("unroll") for (int k = 0; k < 2; ++k) \
        { if constexpr (DT == 2) acc[ai][bj][m][n] = __builtin_bit_cast(f32x4, __builtin_amdgcn_mfma_i32_16x16x64_i8(__builtin_bit_cast(ix4, Bt[n][k]), __builtin_bit_cast(ix4, At[m][k]), __builtin_bit_cast(ix4, acc[ai][bj][m][n]), 0, 0, 0)); \
          else if constexpr (DT == 1) acc[ai][bj][m][n] = __builtin_amdgcn_mfma_f32_16x16x32_bf16(__builtin_bit_cast(sx8, Bt[n][k]), __builtin_bit_cast(sx8, At[m][k]), acc[ai][bj][m][n], 0, 0, 0); \
          else acc[ai][bj][m][n] = __builtin_amdgcn_mfma_f32_16x16x32_f16(Bt[n][k], At[m][k], acc[ai][bj][m][n], 0, 0, 0); } __builtin_amdgcn_s_setprio(0); } while (0)
#define PG8_WAIT_V(n) asm volatile("s_waitcnt vmcnt(" #n ")" ::: "memory")
#define PG8_WAIT_L(n) asm volatile("s_waitcnt lgkmcnt(" #n ")" ::: "memory")
#define PG8_BAR __builtin_amdgcn_s_barrier()
#define PG8_SCHED __builtin_amdgcn_sched_barrier(0)
    Unit cur, nxt; int ui = 0;
    if (!S.next(0, cur)) return;
    f32x4 acc[2][2][4][2];
#pragma unroll
    for (int a = 0; a < 2; ++a)
#pragma unroll
        for (int b = 0; b < 2; ++b)
#pragma unroll
            for (int m = 0; m < 4; ++m)
#pragma unroll
                for (int n = 0; n < 2; ++n) acc[a][b][m][n] = (f32x4){0.f, 0.f, 0.f, 0.f};
    hx8 At[4][2], B0[2][2], B1[2][2];
    const char* cA = (const char*)g.A + (size_t)cur.pm * tstep; const char* cB = (const char*)g.Bt + (size_t)cur.pn * tstep;
    S.a_ready(cur);
    PG8_STAGE(PG8_SB(0, 0), cB, voffB); PG8_STAGE(PG8_SB(0, 1), cB + hstep, voffB); PG8_STAGE(PG8_SA(0, 0), cA, voffA); PG8_STAGE(PG8_SA(0, 1), cA + hstep, voffA);
    if (wr == 1) PG8_BAR;
    PG8_WAIT_V(2); PG8_BAR;
    PG8_STAGE(PG8_SB(1, 0), cB + kstep, voffB); PG8_STAGE(PG8_SA(1, 0), cA + kstep, voffA); PG8_STAGE(PG8_SB(1, 1), cB + hstep + kstep, voffB);
    PG8_WAIT_V(6); PG8_BAR;
    for (;;) {
        const bool has_next = S.next(ui + 1, nxt);
        const char* nA = has_next ? (const char*)g.A + (size_t)nxt.pm * tstep : cA; const char* nB = has_next ? (const char*)g.Bt + (size_t)nxt.pn * tstep : cB;
        for (int t = 0; t < nt; t += 2) {
            const bool last = (t == nt - 2);
            const char* a1 = cA + (size_t)(t + 1) * kstep;
            const char* a2 = last ? nA : cA + (size_t)(t + 2) * kstep; const char* b2 = last ? nB : cB + (size_t)(t + 2) * kstep;
            const char* a3 = a2 + kstep; const char* b3 = b2 + kstep;
            if (last && has_next) S.a_ready(nxt);
            if constexpr (Epi::HAS_MID) { if (t == (nt >> 1)) E.mid(acc, cur, wr, wc, fr, fq); }
            PG8_LDB(B0, 0, 0); PG8_LDB(B1, 0, 1); PG8_SCHED; PG8_LDA(At, 0, 0); PG8_STAGE(PG8_SA(1, 1), a1 + hstep, voffA);
            PG8_WAIT_V(8); PG8_WAIT_L(0); PG8_BAR; PG8_MMA(0, 0, At, B0); PG8_MMA(0, 1, At, B1); PG8_BAR; PG8_SCHED;
            PG8_LDA(At, 0, 1); PG8_STAGE(PG8_SB(0, 0), b2, voffB); PG8_STAGE(PG8_SB(0, 1), b2 + hstep, voffB); PG8_STAGE(PG8_SA(0, 0), a2, voffA);
            PG8_WAIT_V(8); PG8_WAIT_L(0); PG8_BAR; PG8_MMA(1, 0, At, B0); PG8_MMA(1, 1, At, B1); PG8_BAR; PG8_SCHED;
            PG8_LDB(B0, 1, 0); PG8_LDB(B1, 1, 1); PG8_SCHED; PG8_LDA(At, 1, 0); PG8_STAGE(PG8_SA(0, 1), a2 + hstep, voffA);
            PG8_WAIT_V(8); PG8_WAIT_L(0); PG8_BAR; PG8_MMA(0, 0, At, B0); PG8_MMA(0, 1, At, B1); PG8_BAR; PG8_SCHED;
            PG8_LDA(At, 1, 1); PG8_STAGE(PG8_SB(1, 0), b3, voffB); PG8_STAGE(PG8_SB(1, 1), b3 + hstep, voffB); PG8_STAGE(PG8_SA(1, 0), a3, voffA);
            PG8_WAIT_V(8); PG8_WAIT_L(0); PG8_BAR; PG8_MMA(1, 0, At, B0); PG8_MMA(1, 1, At, B1); PG8_BAR; PG8_SCHED;
        }
        if constexpr (ALIGN_EPI) { if (wr == 0) PG8_BAR; }
        E(acc, cur, wr, wc, fr, fq); S.done(cur);
        if (!has_next) break;
#pragma unroll
        for (int a = 0; a < 2; ++a)
#pragma unroll
            for (int b = 0; b < 2; ++b)
#pragma unroll
                for (int m = 0; m < 4; ++m)
#pragma unroll
                    for (int n = 0; n < 2; ++n) acc[a][b][m][n] = (f32x4){0.f, 0.f, 0.f, 0.f};
        cur = nxt; cA = nA; cB = nB; ++ui;
        if constexpr (ALIGN_EPI) { if (wr == 1) PG8_BAR; }
    }
    PG8_WAIT_V(0);
    if constexpr (!ALIGN_EPI) { if (wr == 0) PG8_BAR; }
    PG8_BAR;
#undef PG8_SA
#undef PG8_SB
#undef PG8_STAGE
#undef PG8_LDA
#undef PG8_LDB
#undef PG8_MMA
#undef PG8_WAIT_V
#undef PG8_WAIT_L
#undef PG8_BAR
#undef PG8_SCHED
}
}

#define XB_TMO      128
#define XB_XCNT(j)  (256  + 64 * (j))
#define XB_XSUB(j)  (1280 + 64 * (j))
#define XB_XGEN(j)  (2304 + 64 * (j))
#define XB_TOP      3328
#define XB_TOPGEN   3392
#define XCD_BAR_WORDS 3456
#define XB_SPIN_CAP (1u << 18)
__device__ __forceinline__ unsigned xb_ld(unsigned* p)              { return __hip_atomic_load(p, __ATOMIC_RELAXED, __HIP_MEMORY_SCOPE_AGENT); }
__device__ __forceinline__ unsigned xb_add(unsigned* p, unsigned v) { return __hip_atomic_fetch_add(p, v, __ATOMIC_RELAXED, __HIP_MEMORY_SCOPE_AGENT); }
__device__ __forceinline__ unsigned xb_xcc_id() { return (unsigned)__builtin_amdgcn_s_getreg((3 << 11) | 20) & 0xFu; }
#define XB_SPIN(cond, bar) do { unsigned _sp = 0; while (cond) { __builtin_amdgcn_s_sleep(1); \
    if ((++_sp & 255u) == 0u) { if (xb_ld(&(bar)[XB_TMO])) break; if (_sp > XB_SPIN_CAP) { atomicAdd(&(bar)[XB_TMO], 1u); break; } } } } while (0)
struct XcdBarrier { unsigned* bar; unsigned x; volatile LAS unsigned* st; };
__device__ __forceinline__ XcdBarrier xcd_barrier_post(unsigned* bar, volatile LAS unsigned* st) {
    XcdBarrier b; b.bar = bar; b.x = xb_xcc_id(); b.st = st;
    if (threadIdx.x == 0) (void)xb_add(&bar[XB_XCNT(b.x)], 1u);
    return b;
}
__device__ __forceinline__ void xcd_barrier_complete(unsigned* bar, unsigned x, unsigned& nloc, unsigned& nx) {
    const unsigned G = gridDim.x * gridDim.y * gridDim.z;
    unsigned sum, cnt, mine, sp = 0u;
    for (;;) {
        sum = 0u; cnt = 0u; mine = 0u;
#pragma unroll
        for (unsigned j = 0; j < 16; ++j) { const unsigned c = xb_ld(&bar[XB_XCNT(j)]); sum += c; cnt += (c > 0u) ? 1u : 0u; mine = (j == x) ? c : mine; }
        if (sum == G) break;
        __builtin_amdgcn_s_sleep(1);
        if ((++sp & 255u) == 0u) { if (xb_ld(&bar[XB_TMO])) break; if (sp > XB_SPIN_CAP) { atomicAdd(&bar[XB_TMO], 1u); break; } }
    }
    nloc = mine > 0u ? mine : 1u; nx = cnt > 0u ? cnt : 1u;
}
__device__ __forceinline__ void xcd_barrier(const XcdBarrier& b) {
    asm volatile("s_waitcnt vmcnt(0)" ::: "memory");
    __syncthreads();
    if (threadIdx.x == 0) {
        unsigned* bar = b.bar;
        __builtin_amdgcn_s_waitcnt(0);
        unsigned nloc = b.st[0], nx = b.st[1];
        if (nloc == 0u) { xcd_barrier_complete(bar, b.x, nloc, nx); b.st[0] = nloc; b.st[1] = nx; }
        const unsigned old = xb_add(&bar[XB_XSUB(b.x)], 1u);
        const unsigned gen = old / nloc;
        if (old + 1u == (gen + 1u) * nloc) {
            __builtin_amdgcn_fence(__ATOMIC_RELEASE, "agent");
            asm volatile("s_waitcnt vmcnt(0)" ::: "memory");
            const unsigned og = xb_add(&bar[XB_TOP], 1u);
            const unsigned tg = og / nx;
            if (og + 1u == (tg + 1u) * nx) xb_add(&bar[XB_TOPGEN], 1u);
            else XB_SPIN(xb_ld(&bar[XB_TOPGEN]) == tg, bar);
            __builtin_amdgcn_fence(__ATOMIC_ACQUIRE, "agent");
            xb_add(&bar[XB_XGEN(b.x)], 1u);
            asm volatile("s_waitcnt vmcnt(0)" ::: "memory");
        } else {
            XB_SPIN(xb_ld(&bar[XB_XGEN(b.x)]) == gen, bar);
            __builtin_amdgcn_fence(__ATOMIC_ACQUIRE, "agent");
            asm volatile("s_waitcnt vmcnt(0)" ::: "memory");
        }
    }
    __syncthreads();
}

struct Args { const float* in[23]; float* out; unsigned char* ws; int ph_lo, ph_hi; };
struct Ctx {
    LAS unsigned char* lds;
    int tid, lane, wave, G, bid;
    const float *x, *c, *w_mod, *b_mod, *g_norms, *w_in, *cmp_pos, *cmp_w1, *cmp_b1, *cmp_w2, *cmp_b2, *rel_table, *ln_g, *ln_b, *sgu_w, *sgu_b,
                *w_pn, *w_ps, *w_out, *w_up, *conv_w, *conv_b, *w_dn;
    float* out; unsigned char* ws;
    float *mod, *posw1, *gates, *ysc, *AH, *AT; f16 *Y1, *Y2, *X1H, *W2T, *SGUW, *WG, *KC, *VCT, *W1T, *WUP, *WDN, *WIN, *WVT, *WM, *WO, *H, *Q, *KV, *VT, *Z, *GA, *GB, *YAB, *H2, *ACT;
};

__device__ __forceinline__ void p0_mod_item(Ctx& C, int item) {
    LAS float* sc = (LAS float*)C.lds;
    LAS float* red = (LAS float*)(C.lds + 32768);
    for (int i = C.tid; i < 2 * D; i += NTHREADS) sc[i] = fsilu(C.c[i]);
    __syncthreads();
    const int cq = C.tid & 31, kg = C.tid >> 5, n0 = item * 128 + 4 * cq;
    f32x4 a0 = {0.f, 0.f, 0.f, 0.f}, a1 = {0.f, 0.f, 0.f, 0.f};
    const float* wp = C.w_mod + (size_t)(kg * 256) * NMOD + n0;
#pragma unroll 8
    for (int i = 0; i < 256; ++i) { const f32x4 w = *(const f32x4*)(wp + (size_t)i * NMOD); const float s0 = sc[kg * 256 + i], s1 = sc[D + kg * 256 + i]; a0 += w * s0; a1 += w * s1; }
    *(LAS f32x4*)(red + (kg * 2 + 0) * 128 + 4 * cq) = a0; *(LAS f32x4*)(red + (kg * 2 + 1) * 128 + 4 * cq) = a1;
    __syncthreads();
    if (C.tid < 256) { const int b = C.tid >> 7, col = C.tid & 127; float s = 0.f;
#pragma unroll
        for (int k = 0; k < 16; ++k) s += red[(k * 2 + b) * 128 + col];
        C.mod[b * NMOD + item * 128 + col] = s + C.b_mod[item * 128 + col]; }
    __syncthreads();
}
__device__ __forceinline__ void p0_posw1_item(Ctx& C, int item) {
    LAS float* red = (LAS float*)C.lds;
    const int kk = item >> 2, j = (item & 3) * 64 + C.lane; float s = 0.f;
    const float* w = C.cmp_w1 + (size_t)kk * 4096 * 256 + j; const float* pp = C.cmp_pos + kk * 4096;
    for (int k = C.wave * 512; k < C.wave * 512 + 512; ++k) s += pp[k] * w[(size_t)k * 256];
    red[C.wave * 64 + C.lane] = s;
    __syncthreads();
    if (C.wave == 0) { float t = 0.f;
#pragma unroll
        for (int k = 0; k < 8; ++k) t += red[k * 64 + C.lane];
        C.posw1[kk * 256 + j] = t + C.cmp_b1[kk * 256 + j]; }
    __syncthreads();
}
__device__ __forceinline__ f16* win_row(Ctx& C, int n) {
    if (n < 3584) return C.WIN + (size_t)n * D;
    if (n < 4096) return C.WVT + (size_t)(n - 3584) * D;
    if (n < 4608) return C.WIN + (size_t)(n - 512) * D;
    if (n < 5120) return C.WVT + (size_t)(n - 4608 + 512) * D;
    if (n < 5168) return C.WG + (size_t)(n - 5120) * D;
    return C.WIN + (size_t)(n - 5168 + 4096) * D;
}
__device__ __forceinline__ void p0_transpose_item(Ctx& C, int mat, const float* src, int N, int kb, int nb, LAS float* scr) {
    const int lane = C.lane, k0 = kb * 64, n0 = nb * 64, r4 = lane >> 4, c4 = (lane & 15) * 4; const bool ok = n0 + c4 < N;
    const float* sp = src + (size_t)(k0 + r4) * N + (ok ? n0 + c4 : 0);
#pragma unroll
    for (int i = 0; i < 16; ++i) { const f32x4 v = ok ? *(const f32x4*)(sp + (size_t)(4 * i) * N) : (f32x4){0.f, 0.f, 0.f, 0.f};
        LAS float* d = scr + (4 * i + r4) * 65 + c4; d[0] = v.x; d[1] = v.y; d[2] = v.z; d[3] = v.w; }
    LDS_WAIT();
    const int c = lane & 7;
#pragma unroll
    for (int j = 0; j < 8; ++j) { const int nn = (lane >> 3) + 8 * j, ng = n0 + nn;
        if (ng < N) { const LAS float* s = scr + (8 * c) * 65 + nn;
            u32x4 o;
            if ((FFN_BF16 && (mat == 4 || mat == 5)) || (MIX_BF16 && (mat == 1 || mat == 2 || mat == 3))) { o.x = pkb(s[0], s[65]); o.y = pkb(s[2 * 65], s[3 * 65]); o.z = pkb(s[4 * 65], s[5 * 65]); o.w = pkb(s[6 * 65], s[7 * 65]); }
            else { o.x = pkh(s[0], s[65]); o.y = pkh(s[2 * 65], s[3 * 65]); o.z = pkh(s[4 * 65], s[5 * 65]); o.w = pkh(s[6 * 65], s[7 * 65]); }
            f16* rowp;
            if (mat == 0) rowp = win_row(C, ng);
            else if (mat == 1) rowp = C.WM + (size_t)ng * D;
            else if (mat == 2) rowp = C.WM + (size_t)ng * D + 2048;
            else if (mat == 3) rowp = C.WO + (size_t)ng * D;
            else if (mat == 4) { const int isup = ng >= DFF ? 1 : 0, cc = ng - isup * DFF; rowp = C.WUP + (size_t)((cc >> 7) * 256 + isup * 128 + (cc & 127)) * D; }
            else if (mat == 5) rowp = C.WDN + (size_t)ng * DFF;
            else if (mat == 6) rowp = C.W1T + (size_t)ng * D;
            else rowp = C.W1T + (size_t)(256 + ng) * D;
            *(u32x4*)(rowp + k0 + 8 * c) = o; } }
    LDS_WAIT();
}
__device__ __forceinline__ void p0_prologue(Ctx& C) {
    for (int it = C.bid; it < 200; it += C.G) { if (it < 192) p0_mod_item(C, it); else p0_posw1_item(C, it - 192); }
    const int gw = C.bid * NWAVES + C.wave, NGW = C.G * NWAVES;
    LAS float* scr = (LAS float*)(C.lds + C.wave * 16640);
    constexpr int I0 = 64 * 273, I1 = 32 * 64, I3 = 64 * 64, I4 = 64 * 344, I5 = 172 * 64, I6 = 64 * 4;
    constexpr int NIT = I0 + 2 * I1 + I3 + I4 + I5 + 2 * I6;
    for (int it = gw; it < NIT; it += NGW) {
        int r = it;
        if (r < I0) { p0_transpose_item(C, 0, C.w_in, IN_W, r / 273, r % 273, scr); continue; } r -= I0;
        if (r < I1) { p0_transpose_item(C, 1, C.w_pn, D, r / 64, r % 64, scr); continue; } r -= I1;
        if (r < I1) { p0_transpose_item(C, 2, C.w_ps, D, r / 64, r % 64, scr); continue; } r -= I1;
        if (r < I3) { p0_transpose_item(C, 3, C.w_out, D, r / 64, r % 64, scr); continue; } r -= I3;
        if (r < I4) { p0_transpose_item(C, 4, C.w_up, NUP, r / 344, r % 344, scr); continue; } r -= I4;
        if (r < I5) { p0_transpose_item(C, 5, C.w_dn, D, r / 64, r % 64, scr); continue; } r -= I5;
        if (r < I6) { p0_transpose_item(C, 6, C.cmp_w1, 256, r / 4, r % 4, scr); continue; } r -= I6;
        p0_transpose_item(C, 7, C.cmp_w1 + (size_t)4096 * 256, 256, r / 4, r % 4, scr);
    }
    const int gt = C.bid * NTHREADS + C.tid, NGT = C.G * NTHREADS;
    for (int i = gt; i < 16 * 128 * 128; i += NGT) { const int s = i & 127, t = (i >> 7) & 127; C.SGUW[i] = (f16)(s <= t ? C.sgu_w[i] : 0.f); }
    for (int i = gt; i < 2 * 128 * 256; i += NGT) { const int j = i & 255, d = (i >> 8) & 127, kk = i >> 15; C.W2T[i] = (f16)C.cmp_w2[(size_t)kk * 256 * 128 + j * 128 + d]; }
    for (int i = gt; i < 16 * D; i += NGT) C.WG[48 * D + i] = (f16)0.f;
    __syncthreads();
}

__device__ __forceinline__ void p1_norm(Ctx& C) {
    const int gw = C.bid * NWAVES + C.wave, NGW = C.G * NWAVES, lane = C.lane;
    for (int row = gw; row < M; row += NGW) {
        const int b = row >> 13; const f32x4* xr = (const f32x4*)(C.x + (size_t)row * D);
        f32x4 v[16]; float ss = 0.f;
#pragma unroll
        for (int j = 0; j < 16; ++j) { v[j] = xr[2 * (lane + 64 * (j >> 1)) + (j & 1)]; ss += (v[j].x * v[j].x + v[j].y * v[j].y) + (v[j].z * v[j].z + v[j].w * v[j].w); }
        const float rs = 1.0f / sqrtf(wave_sum(ss) * (1.0f / D) + EPS);
        const f32x4* g4 = (const f32x4*)(C.g_norms); const f32x4* sh = (const f32x4*)(C.mod + b * NMOD); const f32x4* sc = (const f32x4*)(C.mod + b * NMOD + D);
        u32x4* o = (u32x4*)(C.H + (size_t)row * D); u32x2* oq = (u32x2*)(C.ws + WS_H1Q + (size_t)row * D);
        float t[64];
#pragma unroll
        for (int j = 0; j < 16; ++j) { const int k = 2 * (lane + 64 * (j >> 1)) + (j & 1); v[j] = v[j] * rs * g4[k] * (sc[k] + 1.0f) + sh[k]; t[4 * j] = v[j].x; t[4 * j + 1] = v[j].y; t[4 * j + 2] = v[j].z; t[4 * j + 3] = v[j].w; }
#pragma unroll
        for (int jj = 0; jj < 8; ++jj) { u32x4 w; w.x = pkh(v[2 * jj].x, v[2 * jj].y); w.y = pkh(v[2 * jj].z, v[2 * jj].w); w.z = pkh(v[2 * jj + 1].x, v[2 * jj + 1].y); w.w = pkh(v[2 * jj + 1].z, v[2 * jj + 1].w); o[lane + 64 * jj] = w; }
        fwht64(t);
        float amax = 0.f;
#pragma unroll
        for (int i = 0; i < 64; ++i) amax = fmaxf(amax, fabsf(t[i]));
        amax = fmaxf(wave_max(amax), 1e-20f);
        const float qs = 127.0f / amax;
        if (lane == 0) ((float*)(C.ws + WS_SAH))[row] = amax * (1.0f / 127.0f);
#pragma unroll
        for (int jj = 0; jj < 8; ++jj) { u32x2 w; w.x = pk_i8(t[8 * jj] * qs, t[8 * jj + 1] * qs, t[8 * jj + 2] * qs, t[8 * jj + 3] * qs); w.y = pk_i8(t[8 * jj + 4] * qs, t[8 * jj + 5] * qs, t[8 * jj + 6] * qs, t[8 * jj + 7] * qs); oq[lane + 64 * jj] = w; }
    }
}
__device__ __forceinline__ void p1_quant_rows(Ctx& C, const f16* src, int nrows, signed char* dst, float* scale, bool bf, bool rot) {
    const int gw = C.bid * NWAVES + C.wave, NGW = C.G * NWAVES, lane = C.lane;
    for (int row = gw; row < nrows; row += NGW) {
        const u32x4* wr = (const u32x4*)(src + (size_t)row * D);
        float v[64]; float amax = 0.f;
#pragma unroll
        for (int j = 0; j < 8; ++j) { const u32x4 wv = wr[lane + 64 * j];
#pragma unroll
            for (int e = 0; e < 4; ++e) { const unsigned wd = wv[e]; float lo, hi;
                if (bf) { lo = __builtin_bit_cast(float, wd << 16); hi = __builtin_bit_cast(float, wd & 0xffff0000u); }
                else { const hx2 hv = __builtin_bit_cast(hx2, wd); lo = (float)hv.x; hi = (float)hv.y; }
                v[8 * j + 2 * e] = lo; v[8 * j + 2 * e + 1] = hi; } }
        if (rot) fwht64(v);
#pragma unroll
        for (int i = 0; i < 64; ++i) amax = fmaxf(amax, fabsf(v[i]));
        amax = fmaxf(wave_max(amax), 1e-30f);
        const float qs = 127.0f / amax;
        if (lane == 0) scale[row] = amax * (1.0f / 127.0f);
        u32x2* o = (u32x2*)(dst + (size_t)row * D);
#pragma unroll
        for (int j = 0; j < 8; ++j) { u32x2 w; w.x = pk_i8(v[8 * j] * qs, v[8 * j + 1] * qs, v[8 * j + 2] * qs, v[8 * j + 3] * qs); w.y = pk_i8(v[8 * j + 4] * qs, v[8 * j + 5] * qs, v[8 * j + 6] * qs, v[8 * j + 7] * qs); o[lane + 64 * j] = w; }
    }
}
__device__ __forceinline__ void rot128(float (&t)[8], int lane) {
#pragma unroll
    for (int h = 1; h < 8; h <<= 1)
#pragma unroll
        for (int i = 0; i < 8; ++i) if ((i & h) == 0) { const float a = t[i], b = t[i + h]; t[i] = a + b; t[i + h] = a - b; }
    const float s1 = (lane & 1) ? -1.f : 1.f, s2 = (lane & 2) ? -1.f : 1.f, s3 = (lane & 4) ? -1.f : 1.f, s4 = (lane & 8) ? -1.f : 1.f;
#pragma unroll
    for (int e = 0; e < 8; ++e) { float x = t[e];
        x = dpp_f<0xB1>(x) + s1 * x; x = dpp_f<0x4E>(x) + s2 * x; x = dpp_f<0x141>(x) + s3 * x; x = dpp_f<0x140>(x) + s4 * x;
        t[e] = x * 0.08838834764831845f; }
}
__device__ __forceinline__ void quant_rows_ff(Ctx& C, const f16* src, int nrows, signed char* dst, float* scale, bool bf, bool rms) {
    const int gw = C.bid * NWAVES + C.wave, NGW = C.G * NWAVES, lane = C.lane;
    for (int row = gw; row < nrows; row += NGW) {
        const u32x4* wr = (const u32x4*)(src + (size_t)row * DFF);
        float amax = 0.f;
#pragma unroll 2
        for (int c0 = 0; c0 < DFF / 8; c0 += 64) { const int c = c0 + lane; const bool ok = c < DFF / 8; float t[8];
            const u32x4 wv = ok ? wr[c] : (u32x4){0u, 0u, 0u, 0u};
#pragma unroll
            for (int e = 0; e < 4; ++e) { const unsigned wd = wv[e];
                if (bf) { t[2 * e] = __builtin_bit_cast(float, wd << 16); t[2 * e + 1] = __builtin_bit_cast(float, wd & 0xffff0000u); }
                else { const hx2 hv = __builtin_bit_cast(hx2, wd); t[2 * e] = (float)hv.x; t[2 * e + 1] = (float)hv.y; } }
            if (rms) {
#pragma unroll
                for (int e = 0; e < 8; ++e) amax += t[e] * t[e];
            } else { rot128(t, lane);
#pragma unroll
                for (int e = 0; e < 8; ++e) amax = fmaxf(amax, fabsf(t[e])); } }
        amax = rms ? fmaxf(5.0f * sqrtf(wave_sum(amax) * (1.0f / DFF)), 1e-30f) : fmaxf(wave_max(amax), 1e-30f);
        const float qs = 127.0f / amax;
        if (lane == 0) scale[row] = amax * (1.0f / 127.0f);
        u32x2* o = (u32x2*)(dst + (size_t)row * DFF);
#pragma unroll 2
        for (int c0 = 0; c0 < DFF / 8; c0 += 64) { const int c = c0 + lane; const bool ok = c < DFF / 8; float t[8];
            const u32x4 wv = ok ? wr[c] : (u32x4){0u, 0u, 0u, 0u};
#pragma unroll
            for (int e = 0; e < 4; ++e) { const unsigned wd = wv[e];
                if (bf) { t[2 * e] = __builtin_bit_cast(float, wd << 16); t[2 * e + 1] = __builtin_bit_cast(float, wd & 0xffff0000u); }
                else { const hx2 hv = __builtin_bit_cast(hx2, wd); t[2 * e] = (float)hv.x; t[2 * e + 1] = (float)hv.y; } }
            rot128(t, lane);
            if (ok) { u32x2 w; w.x = pk_i8(t[0] * qs, t[1] * qs, t[2] * qs, t[3] * qs); w.y = pk_i8(t[4] * qs, t[5] * qs, t[6] * qs, t[7] * qs); o[c] = w; } }
    }
}
__device__ __forceinline__ void p1_quant_weights(Ctx& C) {
    quant_rows_ff(C, C.WDN, D, (signed char*)(C.ws + WS_WDNQ), (float*)(C.ws + WS_SWDN), FFN_BF16 != 0, false);
    p1_quant_rows(C, C.WIN + (size_t)3072 * D, 13312, (signed char*)(C.ws + WS_WINQ), (float*)(C.ws + WS_SWQ), false, true);
    p1_quant_rows(C, C.WVT, 1024, (signed char*)(C.ws + WS_WVTQ), (float*)(C.ws + WS_SWQ) + 13312, false, true);
    p1_quant_rows(C, C.WUP, NUP, (signed char*)(C.ws + WS_WUPQ), (float*)(C.ws + WS_SW), FFN_BF16 != 0, true);
}
__device__ __forceinline__ void p7_norm(Ctx& C) {
    const int gw = C.bid * NWAVES + C.wave, NGW = C.G * NWAVES, lane = C.lane;
    for (int row = gw; row < M; row += NGW) {
        const int b = row >> 13; const hx8* yr = (const hx8*)(C.Y1 + (size_t)row * D); const f32x4* xr = (const f32x4*)(C.x + (size_t)row * D); u32x2* orow = (u32x2*)(C.X1H + (size_t)row * D);
        f32x4 v[16]; float ss = 0.f;
#pragma unroll
        for (int j = 0; j < 8; ++j) { const hx8 hv = yr[lane + 64 * j];
            v[2 * j] = (f32x4){(float)hv[0], (float)hv[1], (float)hv[2], (float)hv[3]}; v[2 * j + 1] = (f32x4){(float)hv[4], (float)hv[5], (float)hv[6], (float)hv[7]}; }
#pragma unroll
        for (int j = 0; j < 16; ++j) ss += (v[j].x * v[j].x + v[j].y * v[j].y) + (v[j].z * v[j].z + v[j].w * v[j].w);
        const float rs = 1.0f / sqrtf(wave_sum(ss) * (1.0f / D) + EPS);
        const f32x4* g1 = (const f32x4*)(C.g_norms + D); const f32x4* gt = (const f32x4*)(C.mod + b * NMOD + 2 * D);
        float s2 = 0.f;
#pragma unroll
        for (int j = 0; j < 16; ++j) { const int k = 2 * (lane + 64 * (j >> 1)) + (j & 1); v[j] = xr[k] + gt[k] * (v[j] * rs * g1[k]); { u32x2 xw; xw.x = pkh(v[j].x, v[j].y); xw.y = pkh(v[j].z, v[j].w); orow[k] = xw; } s2 += (v[j].x * v[j].x + v[j].y * v[j].y) + (v[j].z * v[j].z + v[j].w * v[j].w); }
        const float rs2 = 1.0f / sqrtf(wave_sum(s2) * (1.0f / D) + EPS);
        const f32x4* g2 = (const f32x4*)(C.g_norms + 2 * D); const f32x4* sh = (const f32x4*)(C.mod + b * NMOD + 3 * D); const f32x4* sc = (const f32x4*)(C.mod + b * NMOD + 4 * D);
        float amax = 0.f;
        { float t[64];
#pragma unroll
          for (int j = 0; j < 16; ++j) { const int k = 2 * (lane + 64 * (j >> 1)) + (j & 1); const f32x4 hv = v[j] * rs2 * g2[k] * (sc[k] + 1.0f) + sh[k]; t[4 * j] = hv.x; t[4 * j + 1] = hv.y; t[4 * j + 2] = hv.z; t[4 * j + 3] = hv.w; }
          fwht64(t);
#pragma unroll
          for (int j = 0; j < 16; ++j) { v[j] = (f32x4){t[4 * j], t[4 * j + 1], t[4 * j + 2], t[4 * j + 3]};
              amax = fmaxf(amax, fmaxf(fmaxf(fabsf(v[j].x), fabsf(v[j].y)), fmaxf(fabsf(v[j].z), fabsf(v[j].w)))); } }
        amax = fmaxf(wave_max(amax), 1e-20f);
        const float qs = 127.0f / amax;
        const bool halo = (row & 255) >= 254; const int hrow = M + 2 * (row >> 8) + (row & 1);
        if (lane == 0) { ((float*)(C.ws + WS_SA))[row] = amax * (1.0f / 127.0f); if (halo) ((float*)(C.ws + WS_SA))[hrow] = amax * (1.0f / 127.0f); }
        u32x2* o = (u32x2*)(((signed char*)(C.ws + WS_H2)) + (size_t)row * D); u32x2* oh = (u32x2*)(((signed char*)(C.ws + WS_H2)) + (size_t)hrow * D);
#pragma unroll
        for (int j = 0; j < 8; ++j) { u32x2 w; w.x = pk_i8(v[2 * j].x * qs, v[2 * j].y * qs, v[2 * j].z * qs, v[2 * j].w * qs); w.y = pk_i8(v[2 * j + 1].x * qs, v[2 * j + 1].y * qs, v[2 * j + 1].z * qs, v[2 * j + 1].w * qs);
            o[lane + 64 * j] = w; if (halo) oh[lane + 64 * j] = w; }
    }
}
__device__ __forceinline__ void p11_final(Ctx& C) {
    const int gw = C.bid * NWAVES + C.wave, NGW = C.G * NWAVES, lane = C.lane;
    for (int row = gw; row < M; row += NGW) {
        const int b = row >> 13; f32x4* orow = (f32x4*)(C.out + (size_t)row * D); const hx8* yr = (const hx8*)(C.Y2 + (size_t)row * D); const hx8* xr = (const hx8*)(C.X1H + (size_t)row * D);
        f32x4 v[16]; float ss = 0.f;
#pragma unroll
        for (int j = 0; j < 8; ++j) { const hx8 hv = yr[lane + 64 * j];
            v[2 * j] = (f32x4){(float)hv[0], (float)hv[1], (float)hv[2], (float)hv[3]}; v[2 * j + 1] = (f32x4){(float)hv[4], (float)hv[5], (float)hv[6], (float)hv[7]}; }
#pragma unroll
        for (int j = 0; j < 16; ++j) ss += (v[j].x * v[j].x + v[j].y * v[j].y) + (v[j].z * v[j].z + v[j].w * v[j].w);
        const float rs = 1.0f / sqrtf(wave_sum(ss) * (1.0f / D) + EPS);
        const f32x4* g3 = (const f32x4*)(C.g_norms + 3 * D); const f32x4* gt = (const f32x4*)(C.mod + b * NMOD + 5 * D);
#pragma unroll
        for (int j = 0; j < 8; ++j) { const hx8 xv = xr[lane + 64 * j]; const int k = 2 * (lane + 64 * j);
            const f32x4 x0 = {(float)xv[0], (float)xv[1], (float)xv[2], (float)xv[3]}, x1 = {(float)xv[4], (float)xv[5], (float)xv[6], (float)xv[7]};
            orow[k] = x0 + gt[k] * (v[2 * j] * rs * g3[k]); orow[k + 1] = x1 + gt[k + 1] * (v[2 * j + 1] * rs * g3[k + 1]); }
    }
}

__device__ __forceinline__ void p3_gates_item(Ctx& C, int item) {
    const int lane = C.lane, w = C.wave, qr = lane & 15, q = lane >> 4, mt = w & 3, kh = w >> 2;
    const f16* ap = C.H + (size_t)(item * 64 + mt * 16 + qr) * D + kh * 2048 + 8 * q;
    const f16* bp = C.WG + (size_t)qr * D + kh * 2048 + 8 * q;
    f32x4 acc[3] = {{0.f, 0.f, 0.f, 0.f}, {0.f, 0.f, 0.f, 0.f}, {0.f, 0.f, 0.f, 0.f}};
#pragma unroll 16
    for (int ks = 0; ks < 64; ++ks) { const hx8 a = *(const hx8*)(ap + 32 * ks);
#pragma unroll
        for (int nt = 0; nt < 3; ++nt) { const hx8 b = *(const hx8*)(bp + (size_t)nt * 16 * D + 32 * ks); acc[nt] = __builtin_amdgcn_mfma_f32_16x16x32_f16(a, b, acc[nt], 0, 0, 0); } }
    LAS f32x4* red = (LAS f32x4*)C.lds;
    if (kh == 1) {
#pragma unroll
        for (int nt = 0; nt < 3; ++nt) red[(mt * 3 + nt) * 64 + lane] = acc[nt]; }
    __syncthreads();
    if (kh == 0) {
#pragma unroll
        for (int nt = 0; nt < 3; ++nt) { const f32x4 s = acc[nt] + red[(mt * 3 + nt) * 64 + lane];
#pragma unroll
            for (int i = 0; i < 4; ++i) C.gates[(size_t)(item * 64 + mt * 16 + 4 * q + i) * 48 + nt * 16 + qr] = fsigmoid(s[i]); } }
    __syncthreads();
}
__device__ __forceinline__ void p3_compress_item(Ctx& C, int item) {
    const int lane = C.lane, w = C.wave, qr = lane & 15, q = lane >> 4, kk = item >> 7, R0 = (item & 127) * 32;
    LAS f16* hid = (LAS f16*)C.lds;
    LAS unsigned char* abuf = C.lds + 20480;
    const int srow = C.tid >> 4, sseg = C.tid & 15;
    const f16* sp;
    { const int R = R0 + srow, b = R >> 11, g = (R >> 9) & 3, n = R & 511, nc = n > 510 ? 510 : n; sp = C.KV + (size_t)(b * T + 16 * nc) * 2048 + kk * 512 + g * 128 + 8 * sseg; }
    const int sdst = (srow * 16 + (sseg ^ (srow & 15))) * 16;
    const f16* pb0 = C.W1T + (size_t)(kk * 256 + 32 * w + qr) * D + 8 * q; const f16* pb1 = pb0 + (size_t)16 * D;
    f32x4 acc[2][2] = {{{0.f, 0.f, 0.f, 0.f}, {0.f, 0.f, 0.f, 0.f}}, {{0.f, 0.f, 0.f, 0.f}, {0.f, 0.f, 0.f, 0.f}}};
    hx8 fb[2][8]; hx8 nxt = *(const hx8*)sp; sp += 2048;
#define CM_LOADB(buf) do { _Pragma("unroll") for (int k4 = 0; k4 < 4; ++k4) { fb[buf][2 * k4] = *(const hx8*)(pb0 + 32 * k4); fb[buf][2 * k4 + 1] = *(const hx8*)(pb1 + 32 * k4); } pb0 += 128; pb1 += 128; } while (0)
#define CM_STEP(c, buf) do { *(LAS hx8*)(abuf + ((c) & 1) * 8192 + sdst) = nxt; \
        if ((c) + 1 < 32) { nxt = *(const hx8*)sp; sp += 2048; CM_LOADB((buf) ^ 1); } \
        __syncthreads(); \
        hx8 af_[8]; _Pragma("unroll") for (int i_ = 0; i_ < 8; ++i_) { const int mt_ = i_ >> 2, k4_ = i_ & 3; af_[i_] = *(const LAS hx8*)(abuf + ((c) & 1) * 8192 + ((16 * mt_ + qr) * 16 + ((4 * k4_ + q) ^ qr)) * 16); } \
        _Pragma("unroll") for (int k4 = 0; k4 < 4; ++k4) { \
            acc[0][0] = __builtin_amdgcn_mfma_f32_16x16x32_f16(af_[k4], fb[buf][2 * k4], acc[0][0], 0, 0, 0); acc[0][1] = __builtin_amdgcn_mfma_f32_16x16x32_f16(af_[k4], fb[buf][2 * k4 + 1], acc[0][1], 0, 0, 0); \
            acc[1][0] = __builtin_amdgcn_mfma_f32_16x16x32_f16(af_[4 + k4], fb[buf][2 * k4], acc[1][0], 0, 0, 0); acc[1][1] = __builtin_amdgcn_mfma_f32_16x16x32_f16(af_[4 + k4], fb[buf][2 * k4 + 1], acc[1][1], 0, 0, 0); } } while (0)
    CM_LOADB(0);
#pragma unroll 1
    for (int c = 0; c < 32; c += 2) { CM_STEP(c, 0); CM_STEP(c + 1, 1); }
#undef CM_LOADB
#undef CM_STEP
    __syncthreads();
#pragma unroll
    for (int mt = 0; mt < 2; ++mt)
#pragma unroll
        for (int nt = 0; nt < 2; ++nt) { const int j = 32 * w + 16 * nt + qr; const float pb = C.posw1[kk * 256 + j];
#pragma unroll
            for (int i = 0; i < 4; ++i) hid[(16 * mt + 4 * q + i) * 264 + j] = (f16)fgelu(acc[mt][nt][i] + pb); }
    __syncthreads();
    const f16* wp = C.W2T + (size_t)(kk * 128 + 16 * w + qr) * 256 + 8 * q;
    f32x4 o2[2] = {{0.f, 0.f, 0.f, 0.f}, {0.f, 0.f, 0.f, 0.f}};
#pragma unroll
    for (int ks = 0; ks < 8; ++ks) { const hx8 wf = *(const hx8*)(wp + 32 * ks);
#pragma unroll
        for (int mt = 0; mt < 2; ++mt) { const hx8 hf = *(const LAS hx8*)(hid + (16 * mt + qr) * 264 + 32 * ks + 8 * q);
            if (kk == 0) o2[mt] = __builtin_amdgcn_mfma_f32_16x16x32_f16(wf, hf, o2[mt], 0, 0, 0);
            else o2[mt] = __builtin_amdgcn_mfma_f32_16x16x32_f16(hf, wf, o2[mt], 0, 0, 0); } }
    if (kk == 0) {
#pragma unroll
        for (int mt = 0; mt < 2; ++mt) { const int R = R0 + 16 * mt + qr, n = R & 511, d0 = 16 * w + 4 * q; const bool pad = n == 511;
            float v[4];
#pragma unroll
            for (int i = 0; i < 4; ++i) v[i] = pad ? 0.f : o2[mt][i] + C.cmp_b2[d0 + i];
            u32x2 o; o.x = pkh(v[0], v[1]); o.y = pkh(v[2], v[3]); *(u32x2*)(C.KC + (size_t)R * 128 + d0) = o; }
    } else {
#pragma unroll
        for (int mt = 0; mt < 2; ++mt) { const int Rb = R0 + 16 * mt + 4 * q, bg = Rb >> 9, n0 = Rb & 511, d = 16 * w + qr; const float bb = C.cmp_b2[128 + d];
            float v[4];
#pragma unroll
            for (int i = 0; i < 4; ++i) v[i] = (n0 + i == 511) ? 0.f : o2[mt][i] + bb;
            u32x2 o; o.x = pkh(v[0], v[1]); o.y = pkh(v[2], v[3]); *(u32x2*)(C.VCT + ((size_t)bg * 128 + d) * 512 + n0) = o; }
    }
    __syncthreads();
}
__device__ __forceinline__ void p3_sgu_item(Ctx& C, int item) {
    const int lane = C.lane, w = C.wave, tid = C.tid, qr = lane & 15, q = lane >> 4, r0 = (item >> 1) * 128, half = item & 1;
    LAS float* stats = (LAS float*)C.lds;
    LAS f16* vt = (LAS f16*)(C.lds + 1024);
#pragma unroll 4
    for (int tk = 0; tk < 16; ++tk) { const int s = 16 * w + tk; const f16* vp = C.Z + (size_t)(r0 + s) * D + 2048 + 8 * lane;
        float xv[32]; float sum = 0.f;
#pragma unroll
        for (int jj = 0; jj < 4; ++jj) { const hx8 h = *(const hx8*)(vp + 512 * jj);
#pragma unroll
            for (int e = 0; e < 8; ++e) { xv[8 * jj + e] = (float)h[e]; sum += xv[8 * jj + e]; } }
        const float mu = wave_sum(sum) * (1.0f / 2048.0f); float sq = 0.f;
#pragma unroll
        for (int e = 0; e < 32; ++e) { const float dv = xv[e] - mu; sq += dv * dv; }
        const float var = wave_sum(sq) * (1.0f / 2048.0f);
        if (lane == 0) { stats[2 * s] = mu; stats[2 * s + 1] = 1.0f / sqrtf(var + EPS); } }
    __syncthreads();
    for (int gi = 0; gi < 8; ++gi) { const int hh = half * 8 + gi;
        { const int s = tid >> 2, seg = tid & 3; const float mu = stats[2 * s], rstd = stats[2 * s + 1];
          const f16* vp = C.Z + (size_t)(r0 + s) * D + 2048 + hh * 128 + 32 * seg;
#pragma unroll
          for (int i = 0; i < 4; ++i) { const hx8 h = *(const hx8*)(vp + 8 * i);
#pragma unroll
              for (int e = 0; e < 8; ++e) { const int d = 32 * seg + 8 * i + e; const float y = ((float)h[e] - mu) * rstd * C.ln_g[hh * 128 + d] + C.ln_b[hh * 128 + d]; vt[d * 136 + s] = (f16)y; } } }
        __syncthreads();
        hx8 wf[4];
#pragma unroll
        for (int ks = 0; ks < 4; ++ks) wf[ks] = *(const hx8*)(C.SGUW + ((size_t)(hh * 128 + 16 * w + qr)) * 128 + 32 * ks + 8 * q);
        f32x4 acc[8];
#pragma unroll
        for (int dt = 0; dt < 8; ++dt) { acc[dt] = (f32x4){0.f, 0.f, 0.f, 0.f};
#pragma unroll
            for (int ks = 0; ks < 4; ++ks) { const hx8 af = *(const LAS hx8*)(vt + (16 * dt + qr) * 136 + 32 * ks + 8 * q); acc[dt] = __builtin_amdgcn_mfma_f32_16x16x32_f16(af, wf[ks], acc[dt], 0, 0, 0); } }
        { const int tl = 16 * w + qr; const float bs = C.sgu_b[hh * 128 + tl];
          const f16* up = C.Z + (size_t)(r0 + tl) * D + hh * 128 + 4 * q; f16* yp = C.YAB + (size_t)(r0 + tl) * D + 2048 + hh * 128 + 4 * q;
#pragma unroll
          for (int dt = 0; dt < 8; ++dt) { const hx4 u = *(const hx4*)(up + 16 * dt);
              u32x2 o; o.x = pk_mix((float)u[0] * (acc[dt][0] + bs), (float)u[1] * (acc[dt][1] + bs)); o.y = pk_mix((float)u[2] * (acc[dt][2] + bs), (float)u[3] * (acc[dt][3] + bs));
              *(u32x2*)(yp + 16 * dt) = o; } }
        __syncthreads();
    }
}

constexpr int ATT_LUT = 0, ATT_IMP = 8192, ATT_STG = 40960, STG_BYTES = 32768, STG_V = 16384;
static_assert(ATT_STG + 3 * STG_BYTES <= MISC_OFF, "attention LDS map");
__device__ __forceinline__ int rel_bucket_small(int n) {
    if (n < 16) return n;
    int b = 16;
    b += n >= 19; b += n >= 21; b += n >= 24; b += n >= 27; b += n >= 31; b += n >= 35; b += n >= 40; b += n >= 46; b += n >= 52; b += n >= 59; b += n >= 67; b += n >= 77; b += n >= 87; b += n >= 99; b += n >= 113;
    return b;
}
__device__ __forceinline__ void att_issue(Ctx& C, int s, int n_c, int n_s, int ks0g, int b, int g) {
    const int lane = (int)pg8::opaque((unsigned)C.lane), w = C.wave;
    const f16* kb; const f16* vb; int ldk, ldv, kb0;
    if (s < 2 * n_c) { kb0 = 64 * (s < n_c ? s : s - n_c); kb = C.KC + (size_t)(b * 4 + g) * 512 * 128; ldk = 128; vb = C.VCT + (size_t)(b * 4 + g) * 128 * 512; ldv = 512; }
    else if (s < 2 * n_c + n_s) { kb0 = 64 * (s - 2 * n_c); kb = C.KV + (size_t)b * T * 2048 + 1024 + g * 128; ldk = 2048; vb = C.VT + (size_t)(g * 128) * M + (size_t)b * T; ldv = M; }
    else { kb0 = ks0g + 64 * (s - 2 * n_c - n_s); kb = C.KV + (size_t)b * T * 2048 + 1536 + g * 128; ldk = 2048; vb = C.VT + (size_t)(512 + g * 128) * M + (size_t)b * T; ldv = M; }
    LAS unsigned char* buf = C.lds + ATT_STG + (s % 3) * STG_BYTES;
#pragma unroll
    for (int i = 0; i < 2; ++i) { const int R = 8 * w + 4 * i + (lane >> 4), m = R & 15, key = kb0 + 32 * (R >> 5) + (m >> 2) * 8 + (m & 3) + 4 * ((R >> 4) & 1), cidx = (lane & 15) ^ m;
        __builtin_amdgcn_global_load_lds((const unsigned*)(kb + (size_t)key * ldk + cidx * 8), (LAS unsigned*)(buf + (8 * w + 4 * i) * 256), 16, 0, 0); }
#pragma unroll
    for (int i = 0; i < 2; ++i) { const int dr = 16 * w + 8 * i + (lane >> 3), v = (lane & 7) ^ ((dr & 15) >> 1);
        __builtin_amdgcn_global_load_lds((const unsigned*)(vb + (size_t)dr * ldv + kb0 + 8 * v), (LAS unsigned*)(buf + STG_V + (16 * w + 8 * i) * 128), 16, 0, 0); }
}
#define SB() __builtin_amdgcn_sched_barrier(0)
#define ATT_QK2(TL) do { _Pragma("unroll") for (int scn_ = 0; scn_ < 2; ++scn_) { hx8 kf_[8]; \
        _Pragma("unroll") for (int i_ = 0; i_ < 8; ++i_) { const int kt_ = i_ >> 2, ks_ = i_ & 3; \
            kf_[i_] = *(const LAS hx8*)(bufp + scn_ * 8192 + kt_ * 4096 + qr * 256 + (((4 * ks_ + q) ^ qr) << 4)); } \
        __builtin_amdgcn_s_setprio(1); \
        _Pragma("unroll") for (int t_ = 0; t_ < 2; ++t_) { f32x4 a_ = {0.f, 0.f, 0.f, 0.f}; \
            _Pragma("unroll") for (int ks = 0; ks < 4; ++ks) a_ = __builtin_amdgcn_mfma_f32_16x16x32_f16(kf_[4 * t_ + ks], qf[TL][ks], a_, 0, 0, 0); sv[2 * scn_ + t_] = a_; } \
        __builtin_amdgcn_s_setprio(0); } } while (0)
#define SVJ(tl, j) (sv[(j) >> 2][(j) & 3])
#define ATT_PV2() do { SB(); \
    _Pragma("unroll") for (int sn_ = 0; sn_ < 2; ++sn_) { hx8 vf_[8]; \
        _Pragma("unroll") for (int dt_ = 0; dt_ < 8; ++dt_) vf_[dt_] = *(const LAS hx8*)(bufp + STG_V + qr * 128 + (((4 * sn_ + q) ^ (qr >> 1)) << 4) + dt_ * 2048); \
        _Pragma("unroll") for (int tl_ = 0; tl_ < 2; ++tl_) { if (act[tl_]) { _Pragma("unroll") for (int dt = 0; dt < 8; ++dt) o[tl_][dt] = __builtin_amdgcn_mfma_f32_16x16x32_f16(vf_[dt], pf[tl_][sn_], o[tl_][dt], 0, 0, 0); } } } \
    SB(); } while (0)
#define ATT_MAXUPD(TL, RESCALE_O) do { if (__any(cm_ > m[TL] + 8.0f)) { cm_ = fmaxf(cm_, __shfl_xor(cm_, 16)); cm_ = fmaxf(cm_, __shfl_xor(cm_, 32)); \
    const float mn_ = fmaxf(m[TL], cm_); const float al_ = __builtin_amdgcn_exp2f(m[TL] - mn_); m[TL] = mn_; l[TL] *= al_; \
    if (RESCALE_O) { _Pragma("unroll") for (int dt = 0; dt < 8; ++dt) o[TL][dt] *= al_; } } } while (0)
#define ATT_PACKP(TL) do { _Pragma("unroll") for (int j = 0; j < 8; ++j) { pf[TL][0][j] = (f16)p[j]; pf[TL][1][j] = (f16)p[8 + j]; } } while (0)
#define ATT_SOFTMAX_FAR(TL, cb_, RESCALE_O) do { float mx_ = SVJ(TL, 0); _Pragma("unroll") for (int j = 1; j < 16; ++j) mx_ = fmaxf(mx_, SVJ(TL, j)); \
    float cm_ = mx_ * SC2 + (cb_); ATT_MAXUPD(TL, RESCALE_O); const float off_ = (cb_) - m[TL]; float ps_ = 0.f; \
    _Pragma("unroll") for (int j = 0; j < 16; ++j) { const float e_ = __builtin_amdgcn_exp2f(SVJ(TL, j) * SC2 + off_); ps_ += e_; pf[TL][j >> 3][j & 7] = (f16)e_; } l[TL] += ps_; } while (0)
#define ATT_SOFTMAX_NEAR(TL, RESCALE_O) do { float cm_ = sc[0]; _Pragma("unroll") for (int j = 1; j < 16; ++j) cm_ = fmaxf(cm_, sc[j]); \
    ATT_MAXUPD(TL, RESCALE_O); float ps_ = 0.f; \
    _Pragma("unroll") for (int j = 0; j < 16; ++j) { const float e_ = __builtin_amdgcn_exp2f(sc[j] - m[TL]); ps_ += e_; pf[TL][j >> 3][j & 7] = (f16)e_; } l[TL] += ps_; } while (0)
#define ATT_STAGE_BEGIN() do { if (s + 1 < S) asm volatile("s_waitcnt vmcnt(4)" ::: "memory"); else asm volatile("s_waitcnt vmcnt(0)" ::: "memory"); \
    __builtin_amdgcn_s_barrier(); asm volatile("" ::: "memory"); \
    if (s + 2 < S) att_issue(C, s + 2, n_c, n_s, ks0g, b, g); \
    bufp = C.lds + ATT_STG + (s % 3) * STG_BYTES; } while (0)
constexpr float NEGBIG = -3.0e38f;

__device__ __forceinline__ void p4_attn_unit(Ctx& C, int u) {
    const int lane = C.lane, w = C.wave, qr = lane & 15, q = lane >> 4, tok = qr >> 2, r = qr & 3;
    const int bg = u & 7, b = bg >> 2, g = bg & 3, tj = u >> 3, t0g = tj * 64, t0 = t0g + w * 8, h = g * 4 + r;
    const LAS float* lut = (const LAS float*)(C.lds + ATT_LUT) + h * 128;
    LAS float* imp = (LAS float*)(C.lds + ATT_IMP) + w * 1024;
    const LAS unsigned char* bufp = C.lds + ATT_STG;
    const int n_c = (tj >> 4) + 1, n_s = tj + 1, ks0g = (t0g - 511 < 0 ? 0 : t0g - 511) & ~63, n_w = ((t0g + 63 - ks0g) >> 6) + 1, S = 2 * n_c + n_s + n_w;
    hx8 qf[2][4];
#pragma unroll
    for (int tl = 0; tl < 2; ++tl) { const int t = t0 + 4 * tl + tok; const f16* qp = C.Q + (size_t)(b * T + t) * 2048 + h * 128 + 8 * q;
#pragma unroll
        for (int ks = 0; ks < 4; ++ks) qf[tl][ks] = *(const hx8*)(qp + 32 * ks); }
#define GATE(tl, i) (C.gates[(size_t)(b * T + t0 + 4 * (tl) + tok) * 48 + h * 3 + (i)])
#define YSP(tl) ((f32x4*)(C.ysc + (size_t)(b * T + t0 + 4 * (tl) + tok) * 2048 + h * 128 + 4 * q))
    const float b127 = lut[127];
    f32x4 o[2][8], sv[4]; hx8 pf[2][2]; float sc[16], p[16], m[2], l[2]; bool act[2];
#pragma unroll
    for (int tl = 0; tl < 2; ++tl)
#pragma unroll
        for (int dt = 0; dt < 8; ++dt) o[tl][dt] = (f32x4){0.f, 0.f, 0.f, 0.f};
    for (int i = lane; i < 1024; i += 64) imp[i] = 0.f;
    asm volatile("s_waitcnt vmcnt(0) lgkmcnt(0)" ::: "memory");
    __syncthreads();
    int s = 0;
    att_issue(C, 0, n_c, n_s, ks0g, b, g); att_issue(C, 1, n_c, n_s, ks0g, b, g);

    m[0] = m[1] = -1e30f; l[0] = l[1] = 0.f;
    for (int c = 0; c < n_c; ++c, ++s) {
        ATT_STAGE_BEGIN();
        const int kb0 = 64 * c;
        act[0] = kb0 <= ((t0 + 3 - 31) >> 4); act[1] = kb0 <= ((t0 + 7 - 31) >> 4);
        if (!act[1]) continue;
#pragma unroll
        for (int tl = 0; tl < 2; ++tl) { if (act[tl]) { const int tb = t0 + 4 * tl, t = tb + tok, nmax_t = (t - 31) >> 4;
            ATT_QK2(tl);
            if (kb0 + 63 <= ((tb - 31) >> 4) && tb - 16 * (kb0 + 63) - 31 >= 127) { ATT_SOFTMAX_FAR(tl, b127, false); }
            else {
#pragma unroll
                for (int j = 0; j < 16; ++j) { const int n = kb0 + 32 * (j >> 3) + 8 * q + (j & 7), dist = t - 16 * n - 31;
                    const int di = dist < 0 ? 0 : (dist > 127 ? 127 : dist); const float lv = lut[di]; const float sx = SVJ(tl, j) * SC2 + lv; sc[j] = n <= nmax_t ? sx : NEGBIG; }
                ATT_SOFTMAX_NEAR(tl, false); } } }
    }
    float il[2];
#pragma unroll
    for (int tl = 0; tl < 2; ++tl) { l[tl] += __shfl_xor(l[tl], 16); l[tl] += __shfl_xor(l[tl], 32); il[tl] = l[tl] > 0.f ? 1.0f / l[tl] : 0.f; }
    float carry[2] = {0.f, 0.f};
    for (int c = 0; c < n_c; ++c, ++s) {
        ATT_STAGE_BEGIN();
        const int kb0 = 64 * c;
        act[0] = kb0 <= ((t0 + 3 - 31) >> 4); act[1] = kb0 <= ((t0 + 7 - 31) >> 4);
        if (!act[1]) continue;
#pragma unroll
        for (int tl = 0; tl < 2; ++tl) { if (act[tl]) { const int t = t0 + 4 * tl + tok, nmax_t = (t - 31) >> 4;
            ATT_QK2(tl);
#pragma unroll
            for (int j = 0; j < 16; ++j) { const int n = kb0 + 32 * (j >> 3) + 8 * q + (j & 7), dist = t - 16 * n - 31;
                const int di = dist < 0 ? 0 : (dist > 127 ? 127 : dist); const float lv = lut[di]; const float px = __builtin_amdgcn_exp2f(SVJ(tl, j) * SC2 + lv - m[tl]) * il[tl]; p[j] = n <= nmax_t ? px : 0.f; }
            ATT_PACKP(tl);
#pragma unroll
            for (int scn = 0; scn < 2; ++scn) { float ph[8];
#pragma unroll
                for (int j = 0; j < 8; ++j) { float v = p[8 * scn + j]; v += dpp_f<0xB1>(v); v += dpp_f<0x4E>(v); ph[j] = v; }
                const float t7 = __shfl(ph[7], (lane + 48) & 63);
                const float left = q == 0 ? carry[tl] : t7; carry[tl] = t7;
                if (r == 0) { f32x2 iv; iv.x = left + 2.0f * (ph[0] + ph[1] + ph[2]) + ph[3]; iv.y = ph[3] + 2.0f * (ph[4] + ph[5] + ph[6]) + ph[7];
                    *(LAS f32x2*)(imp + (4 * tl + tok) * 128 + ((kb0 + 32 * scn) >> 2) + 2 * q) = iv; } } } }
        ATT_PV2();
    }
#pragma unroll
    for (int tl = 0; tl < 2; ++tl) { f32x4* ysp = YSP(tl); const float gc = GATE(tl, 0);
#pragma unroll
        for (int dt = 0; dt < 8; ++dt) { ysp[4 * dt] = o[tl][dt] * gc; o[tl][dt] = (f32x4){0.f, 0.f, 0.f, 0.f}; } }
    LDS_WAIT();
    unsigned long long my_lo[2] = {0ull, 0ull}, my_hi[2] = {0ull, 0ull}, U_lo[2] = {0ull, 0ull}, U_hi[2] = {0ull, 0ull};
#pragma unroll
    for (int tk = 0; tk < 8; ++tk) { const int tt = t0 + tk, cur = tt >> 6; unsigned long long lo, hi;
        if (cur < 16) { lo = (1ull << (cur + 1)) - 1ull; hi = 0ull; }
        else {
            LAS float* P = imp + tk * 128;
            const int j0 = lane, j1 = lane + 64;
            const bool c0 = j0 >= 1 && j0 <= cur - 2, c1 = j1 <= cur - 2;
            const float i0 = c0 ? P[j0] : -1.0f, i1 = c1 ? P[j1] : -1.0f;
            LDS_WAIT();
            P[j0] = i0; P[j1] = i1;
            LDS_WAIT();
            int r0 = 0, r1 = 0;
            for (int jp = 0; jp <= cur - 2; jp += 4) { const f32x4 v = *(const LAS f32x4*)(P + jp);
#pragma unroll
                for (int e = 0; e < 4; ++e) { r0 += (v[e] > i0 || (v[e] == i0 && jp + e < j0)) ? 1 : 0; r1 += (v[e] > i1 || (v[e] == i1 && jp + e < j1)) ? 1 : 0; } }
            const bool sel0 = (c0 && r0 < 13) || j0 == 0 || j0 == cur || j0 == cur - 1, sel1 = (c1 && r1 < 13) || j1 == cur || j1 == cur - 1;
            lo = __ballot(sel0); hi = __ballot(sel1);
        }
        U_lo[tk >> 2] |= lo; U_hi[tk >> 2] |= hi; if (tok == (tk & 3)) { my_lo[tk >> 2] = lo; my_hi[tk >> 2] = hi; } }
    m[0] = m[1] = -1e30f; l[0] = l[1] = 0.f;
    for (int jb = 0; jb < n_s; ++jb, ++s) {
        ATT_STAGE_BEGIN();
        bool mine[2];
#pragma unroll
        for (int tl = 0; tl < 2; ++tl) { act[tl] = jb < 64 ? ((U_lo[tl] >> jb) & 1ull) : ((U_hi[tl] >> (jb - 64)) & 1ull); mine[tl] = jb < 64 ? ((my_lo[tl] >> jb) & 1ull) : ((my_hi[tl] >> (jb - 64)) & 1ull); }
        if (!act[0] && !act[1]) continue;
        const int kb0 = 64 * jb;
#pragma unroll
        for (int tl = 0; tl < 2; ++tl) { if (act[tl]) { const int tb = t0 + 4 * tl, t = tb + tok;
            ATT_QK2(tl);
            if (tb - (kb0 + 63) >= 127) { const float cb = mine[tl] ? b127 : NEGBIG; ATT_SOFTMAX_FAR(tl, cb, true); }
            else { const int bd = t - kb0 - 8 * q;
#pragma unroll
                for (int j = 0; j < 16; ++j) { const int dist = bd - 32 * (j >> 3) - (j & 7);
                    const int di = dist < 0 ? 0 : (dist > 127 ? 127 : dist); const float lv = lut[di]; const float sx = SVJ(tl, j) * SC2 + lv; sc[j] = (mine[tl] && dist >= 0) ? sx : NEGBIG; }
                ATT_SOFTMAX_NEAR(tl, true); } } }
        ATT_PV2();
    }
#pragma unroll
    for (int tl = 0; tl < 2; ++tl) { l[tl] += __shfl_xor(l[tl], 16); l[tl] += __shfl_xor(l[tl], 32); const float gl = l[tl] > 0.f ? GATE(tl, 1) / l[tl] : 0.f; f32x4* ysp = YSP(tl);
#pragma unroll
        for (int dt = 0; dt < 8; ++dt) { ysp[4 * dt] = ysp[4 * dt] + o[tl][dt] * gl; o[tl][dt] = (f32x4){0.f, 0.f, 0.f, 0.f}; } }
    m[0] = m[1] = -1e30f; l[0] = l[1] = 0.f;
    for (int k = 0; k < n_w; ++k, ++s) {
        ATT_STAGE_BEGIN();
        const int kb0 = ks0g + 64 * k;
#pragma unroll
        for (int tl = 0; tl < 2; ++tl) { const int tb = t0 + 4 * tl; act[tl] = !(kb0 > tb + 3 || kb0 + 63 < tb - 511); }
        if (!act[0] && !act[1]) continue;
#pragma unroll
        for (int tl = 0; tl < 2; ++tl) { if (act[tl]) { const int tb = t0 + 4 * tl, t = tb + tok;
            ATT_QK2(tl);
            if (tb - (kb0 + 63) >= 127 && tb + 3 - kb0 <= 511) { ATT_SOFTMAX_FAR(tl, b127, true); }
            else { const int bd = t - kb0 - 8 * q;
#pragma unroll
                for (int j = 0; j < 16; ++j) { const int dist = bd - 32 * (j >> 3) - (j & 7);
                    const int di = dist < 0 ? 0 : (dist > 127 ? 127 : dist); const float lv = lut[di]; const float sx = SVJ(tl, j) * SC2 + lv; sc[j] = (dist >= 0 && dist < 512) ? sx : NEGBIG; }
                ATT_SOFTMAX_NEAR(tl, true); } } }
        ATT_PV2();
    }
#pragma unroll
    for (int tl = 0; tl < 2; ++tl) { l[tl] += __shfl_xor(l[tl], 16); l[tl] += __shfl_xor(l[tl], 32); const float gl = l[tl] > 0.f ? GATE(tl, 2) / l[tl] : 0.f; const f32x4* ysp = YSP(tl);
        f16* yp = C.YAB + (size_t)(b * T + t0 + 4 * tl + tok) * D + h * 128 + 4 * q;
#pragma unroll
        for (int dt = 0; dt < 8; ++dt) { const f32x4 yv = ysp[4 * dt] + o[tl][dt] * gl; u32x2 ov; ov.x = pk_mix(yv[0], yv[1]); ov.y = pk_mix(yv[2], yv[3]); *(u32x2*)(yp + 16 * dt) = ov; } }
}
#undef GATE
#undef YSP
__device__ __forceinline__ void p4_attention(Ctx& C) {
    LAS float* lut = (LAS float*)(C.lds + ATT_LUT);
    for (int i = C.tid; i < 16 * 128; i += NTHREADS) { const int hh = i >> 7, n = i & 127; lut[i] = C.rel_table[rel_bucket_small(n) * 16 + hh] * LOG2E; }
    __syncthreads();
    for (int u = C.bid; u < 1024; u += C.G) p4_attn_unit(C, u);
    __syncthreads();
}

__device__ __forceinline__ void p9_fixup(Ctx& C) {
    const int gt = C.bid * NTHREADS + C.tid, NGT = C.G * NTHREADS;
    for (int it = gt; it < 64 * (DFF / 8); it += NGT) {
        const int pm = it / (DFF / 8), c0 = (it % (DFF / 8)) * 8; const bool first = ((pm * 256) & (T - 1)) == 0;
        float res[2][8];
#pragma unroll
        for (int h4 = 0; h4 < 2; ++h4) {
            f32x4 cvv[2][2];
#pragma unroll
            for (int bj = 0; bj < 2; ++bj) { const int cc = c0 + 4 * h4;
                const f32x4 w0 = *(const f32x4*)(C.conv_w + 0 * NUP + bj * DFF + cc), w1 = *(const f32x4*)(C.conv_w + 1 * NUP + bj * DFF + cc), w2 = *(const f32x4*)(C.conv_w + 2 * NUP + bj * DFF + cc), bb = *(const f32x4*)(C.conv_b + bj * DFF + cc);
                const f32x4 a0 = *(const f32x4*)(C.AT + (size_t)((pm * 2 + 0) * 2 + bj) * DFF + cc), a1 = *(const f32x4*)(C.AT + (size_t)((pm * 2 + 1) * 2 + bj) * DFF + cc);
                f32x4 hm2 = {0.f, 0.f, 0.f, 0.f}, hm1 = {0.f, 0.f, 0.f, 0.f};
                if (!first) { hm2 = *(const f32x4*)(C.AH + (size_t)((2 * (pm - 1) + 0) * 2 + bj) * DFF + cc); hm1 = *(const f32x4*)(C.AH + (size_t)((2 * (pm - 1) + 1) * 2 + bj) * DFF + cc); }
                cvv[0][bj] = bb + w0 * hm2 + w1 * hm1 + w2 * a0; cvv[1][bj] = bb + w0 * hm1 + w1 * a0 + w2 * a1; }
#pragma unroll
            for (int j = 0; j < 2; ++j)
#pragma unroll
                for (int i = 0; i < 4; ++i) res[j][4 * h4 + i] = fsilu(cvv[j][0][i]) * cvv[j][1][i]; }
#pragma unroll
        for (int j = 0; j < 2; ++j) { u32x4 ov; ov.x = pk_ffn(res[j][0], res[j][1]); ov.y = pk_ffn(res[j][2], res[j][3]); ov.z = pk_ffn(res[j][4], res[j][5]); ov.w = pk_ffn(res[j][6], res[j][7]);
            *(u32x4*)(C.ACT + (size_t)(pm * 256 + j) * DFF + c0) = ov; }
    }
}

__device__ __forceinline__ void ph2_proj(Ctx& C) {
    { pg8::Gemm g{C.H, C.WIN, M, 3072, D}; pg8::StaticOrder S; S.init(M, 3072, C.G, C.bid);
      pg8::EpiProj E{C.Q, C.KV, C.Z, C.GA, C.GB, 0};
      pg8::gemm_phase<pg8::EpiProj, pg8::StaticOrder>(C.lds, g, S, E); }
    { pg8::Gemm g{(const f16*)(C.ws + WS_H1Q), (const f16*)(C.ws + WS_WINQ), M, 13312, D / 2}; pg8::StaticOrder S; S.init(M, 13312, C.G, C.bid);
      pg8::EpiProjQ E{C.ws, 12};
      pg8::gemm_phase<pg8::EpiProjQ, pg8::StaticOrder, true, 2>(C.lds, g, S, E); }
    { pg8::Gemm g{(const f16*)(C.ws + WS_WVTQ), (const f16*)(C.ws + WS_H1Q), 1024, M, D / 2}; pg8::StaticOrder S; S.init(1024, M, C.G, C.bid);
      pg8::EpiVTQ E{C.ws};
      pg8::gemm_phase<pg8::EpiVTQ, pg8::StaticOrder, true, 2>(C.lds, g, S, E); }
}
__device__ __forceinline__ void ph3_mixers(Ctx& C) {
    for (int it = C.bid; it < 256; it += C.G) p3_gates_item(C, it);
    if constexpr (((PROBE_DUP) >> 12) & 1) { for (int it = C.bid; it < 256; it += C.G) p3_gates_item(C, it); }
    for (int it = C.bid; it < 256; it += C.G) p3_compress_item(C, it);
    if constexpr (((PROBE_DUP) >> 13) & 1) { for (int it = C.bid; it < 256; it += C.G) p3_compress_item(C, it); }
    for (int it = C.bid; it < 256; it += C.G) p3_sgu_item(C, it);
    if constexpr (((PROBE_DUP) >> 14) & 1) { for (int it = C.bid; it < 256; it += C.G) p3_sgu_item(C, it); }
}
__device__ __forceinline__ void ph5_merge(Ctx& C) {
    pg8::Gemm g{C.YAB, C.WM, M, D, D}; pg8::StaticOrder S; S.init(M, D, C.G, C.bid);
    pg8::EpiMerge E{C.GA, C.GB, C.H};
    pg8::gemm_phase<pg8::EpiMerge, pg8::StaticOrder, true, MIX_BF16 ? 1 : 0>(C.lds, g, S, E);
}
__device__ __forceinline__ void ph6_out(Ctx& C) {
    pg8::Gemm g{C.H, C.WO, M, D, D}; pg8::StaticOrder S; S.init(M, D, C.G, C.bid);
    pg8::EpiH16 E{C.Y1, D};
    pg8::gemm_phase<pg8::EpiH16, pg8::StaticOrder, true, MIX_BF16 ? 1 : 0>(C.lds, g, S, E);
}
__device__ __forceinline__ void ph8_up(Ctx& C) {
    pg8::Gemm g{(const f16*)((signed char*)(C.ws + WS_H2)), (const f16*)((signed char*)(C.ws + WS_WUPQ)), M + 256, NUP, D / 2}; pg8::StaticOrder S; S.init(M + 256, NUP, C.G, C.bid);
    pg8::EpiConv E{C.ws, C.conv_w, C.conv_b, (LAS float*)(C.lds + pg8::STAGE_BYTES), FFN_BF16};
    pg8::gemm_phase<pg8::EpiConv, pg8::StaticOrder, true, 2>(C.lds, g, S, E);
}
__device__ __forceinline__ void ph9_conv(Ctx& C) { p9_fixup(C); }
__device__ __forceinline__ void ph9b_quant(Ctx& C) { quant_rows_ff(C, C.ACT, M, (signed char*)(C.ws + WS_ACTQ), (float*)(C.ws + WS_SACT), FFN_BF16 != 0, true); }
__device__ __forceinline__ void ph10_down(Ctx& C) {
    pg8::Gemm g{(const f16*)(C.ws + WS_ACTQ), (const f16*)(C.ws + WS_WDNQ), M, D, DFF / 2}; pg8::StaticOrder S; S.init(M, D, C.G, C.bid);
    pg8::EpiH16Q E{C.Y2, D, (const float*)(C.ws + WS_SACT), (const float*)(C.ws + WS_SWDN)};
    pg8::gemm_phase<pg8::EpiH16Q, pg8::StaticOrder, true, 2>(C.lds, g, S, E);
}

constexpr int NPHASE = 12;
__global__ void __launch_bounds__(NTHREADS, 2) fwd_kernel(Args args) {
    extern __shared__ __attribute__((aligned(16))) unsigned char lds_raw[];
    Ctx C;
    C.lds = (LAS unsigned char*)lds_raw;
    C.tid = threadIdx.x; C.lane = C.tid & 63; C.wave = __builtin_amdgcn_readfirstlane(C.tid >> 6); C.G = gridDim.x; C.bid = blockIdx.x;
    C.x = args.in[0]; C.c = args.in[1]; C.w_mod = args.in[2]; C.b_mod = args.in[3]; C.g_norms = args.in[4]; C.w_in = args.in[5]; C.cmp_pos = args.in[6]; C.cmp_w1 = args.in[7];
    C.cmp_b1 = args.in[8]; C.cmp_w2 = args.in[9]; C.cmp_b2 = args.in[10]; C.rel_table = args.in[11]; C.ln_g = args.in[12]; C.ln_b = args.in[13]; C.sgu_w = args.in[14]; C.sgu_b = args.in[15];
    C.w_pn = args.in[16]; C.w_ps = args.in[17]; C.w_out = args.in[18]; C.w_up = args.in[19]; C.conv_w = args.in[20]; C.conv_b = args.in[21]; C.w_dn = args.in[22];
    C.out = args.out; C.ws = args.ws; unsigned char* ws = args.ws;
    C.mod = (float*)(ws + WS_MOD); C.posw1 = (float*)(ws + WS_POSW1); C.gates = (float*)(ws + WS_GATES); C.ysc = (float*)(ws + WS_YSC); C.AH = (float*)(ws + WS_AH); C.AT = (float*)(ws + WS_AT); C.Y1 = (f16*)(ws + WS_Z); C.Y2 = (f16*)(ws + WS_Y2); C.X1H = (f16*)(ws + WS_X1H);
    C.W2T = (f16*)(ws + WS_W2T); C.SGUW = (f16*)(ws + WS_SGUW); C.WG = (f16*)(ws + WS_WG); C.KC = (f16*)(ws + WS_KC); C.VCT = (f16*)(ws + WS_VCT); C.W1T = (f16*)(ws + WS_W1T);
    C.WUP = (f16*)(ws + WS_WUP); C.WDN = (f16*)(ws + WS_WDN); C.WIN = (f16*)(ws + WS_WIN); C.WVT = (f16*)(ws + WS_WVT); C.WM = (f16*)(ws + WS_WM); C.WO = (f16*)(ws + WS_WO);
    C.H = (f16*)(ws + WS_H); C.Q = (f16*)(ws + WS_Q); C.KV = (f16*)(ws + WS_KV); C.VT = (f16*)(ws + WS_VT); C.Z = (f16*)(ws + WS_Z); C.GA = (f16*)(ws + WS_GA); C.GB = (f16*)(ws + WS_GB);
    C.YAB = (f16*)(ws + WS_YAB); C.H2 = (f16*)(ws + WS_H2); C.ACT = (f16*)(ws + WS_ACT);

    volatile LAS unsigned* MISC = (volatile LAS unsigned*)(C.lds + MISC_OFF);
    for (int u = C.tid; u < (LDS_BYTES - MISC_OFF) / 4; u += NTHREADS) MISC[u] = 0u;
    __syncthreads();
    unsigned* barw = (unsigned*)(ws + WS_CTL) + CW_BAR;
    XcdBarrier bar; bar.bar = barw; bar.x = 0; bar.st = nullptr;
    if (MK_N_LAUNCHES == 1) bar = xcd_barrier_post(barw, MISC + 8);
    const int lo = args.ph_lo, hi = args.ph_hi;
#define IN(k) (lo <= (k) && (k) < hi)
#define DUP(k) ((((PROBE_DUP) >> (k)) & 1) != 0)
#define SEAM(k) do { if (IN(k) && IN((k) + 1)) xcd_barrier(bar); } while (0)

    if (IN(0)) { p0_prologue(C); if constexpr (DUP(0)) p0_prologue(C); }
    SEAM(0);
    if (IN(1)) { p1_norm(C); p1_quant_weights(C); if constexpr (DUP(1)) p1_norm(C); }
    SEAM(1);
    if (IN(2)) { ph2_proj(C); if constexpr (DUP(2)) ph2_proj(C); }
    SEAM(2);
    if (IN(3)) { ph3_mixers(C); if constexpr (DUP(3)) ph3_mixers(C); }
    SEAM(3);
    if (IN(4)) { p4_attention(C); if constexpr (DUP(4)) p4_attention(C); }
    SEAM(4);
    if (IN(5)) { ph5_merge(C); if constexpr (DUP(5)) ph5_merge(C); }
    SEAM(5);
    if (IN(6)) { ph6_out(C); if constexpr (DUP(6)) ph6_out(C); }
    SEAM(6);
    if (IN(7)) { p7_norm(C); }
    SEAM(7);
    if (IN(8)) { ph8_up(C); if constexpr (DUP(8)) ph8_up(C); }
    SEAM(8);
    if (IN(9)) { ph9_conv(C); if (MK_N_LAUNCHES == 1) xcd_barrier(bar); ph9b_quant(C); }
    SEAM(9);
    if (IN(10)) { ph10_down(C); if constexpr (DUP(10)) ph10_down(C); }
    SEAM(10);
    if (IN(11)) { p11_final(C); }
#undef IN
#undef DUP
#undef SEAM
}

extern "C" void kernel_launch(void* const* d_in, const int* in_sizes, int n_in, void* d_out, int out_size, void* d_ws, size_t ws_size, hipStream_t stream) {
    static int grid = 0;
    if (grid == 0) {
        if (n_in != 23 || in_sizes[0] != M * D || out_size != M * D || ws_size < WS_END) { fprintf(stderr, "kernel_launch: unexpected shapes (n_in %d, in0 %d, out %d, ws %zu); nothing launched\n", n_in, n_in > 0 ? in_sizes[0] : -1, out_size, ws_size); grid = -1; return; }
        int dev = 0, cus = 0, per_cu = 0;
        if (hipGetDevice(&dev) != hipSuccess || hipDeviceGetAttribute(&cus, hipDeviceAttributeMultiprocessorCount, dev) != hipSuccess) { grid = -1; return; }
        if (hipFuncSetAttribute((const void*)fwd_kernel, hipFuncAttributeMaxDynamicSharedMemorySize, LDS_BYTES) != hipSuccess) { fprintf(stderr, "kernel_launch: hipFuncSetAttribute failed\n"); grid = -1; return; }
        if (hipOccupancyMaxActiveBlocksPerMultiprocessor(&per_cu, (const void*)fwd_kernel, NTHREADS, LDS_BYTES) != hipSuccess || per_cu < 1) { fprintf(stderr, "kernel_launch: occupancy query reports %d\n", per_cu); }
        (void)hipGetLastError();
        grid = cus;
        if (grid > 256) grid = 256;
    }
    if (grid < 0) return;
    (void)hipMemsetAsync((char*)d_ws + WS_CTL, 0, CTL_BYTES, stream);
    Args a{};
    for (int i = 0; i < 23; ++i) a.in[i] = (const float*)d_in[i];
    a.out = (float*)d_out; a.ws = (unsigned char*)d_ws;
    if (MK_N_LAUNCHES == 1) { a.ph_lo = 0; a.ph_hi = NPHASE; hipLaunchKernelGGL(fwd_kernel, dim3(grid), dim3(NTHREADS), LDS_BYTES, stream, a); }
    else { for (int li = 0; li < NPHASE; ++li) { a.ph_lo = li; a.ph_hi = li + 1; hipLaunchKernelGGL(fwd_kernel, dim3(grid), dim3(NTHREADS), LDS_BYTES, stream, a); } }
}
```

```cpp
#include <hip/hip_runtime.h>
#include <cstdio>
#include <cstdint>

#ifndef MK_N_LAUNCHES
#define MK_N_LAUNCHES 1
#endif

#ifndef PROBE_DUP
#define ATT_TPROBE 0
#define BAR_TPROBE 0
#define PROBE_DUP 0
#endif
#define GAS __attribute__((address_space(1)))
#define LAS __attribute__((address_space(3)))
typedef _Float16 f16;
typedef _Float16 hx8 __attribute__((ext_vector_type(8)));
typedef _Float16 hx4 __attribute__((ext_vector_type(4)));
typedef _Float16 hx2 __attribute__((ext_vector_type(2)));
typedef float f32x4 __attribute__((ext_vector_type(4)));
typedef float f32x2 __attribute__((ext_vector_type(2)));
typedef unsigned u32x4 __attribute__((ext_vector_type(4)));
typedef unsigned u32x2 __attribute__((ext_vector_type(2)));
typedef int ix4 __attribute__((ext_vector_type(4)));

constexpr int NB = 2, T = 8192, D = 4096, M = NB * T;
constexpr int NG = 4, HD = 128;
constexpr int DFF = 11008, NUP = 2 * DFF;
constexpr int IN_W = 17456, NPROJ = 16384, NMOD = 6 * D;
constexpr float EPS = 1e-6f;
constexpr float LOG2E = 1.4426950408889634f;
constexpr float SC2 = 0.08838834764831845f * 1.4426950408889634f;

constexpr size_t MiB = 1ull << 20;
constexpr size_t WS_CTL = 0, CTL_BYTES = 1 * MiB;
constexpr size_t WS_MOD = 1 * MiB;
constexpr size_t WS_POSW1 = 1 * MiB + 256 * 1024;
constexpr size_t WS_W2T = 1 * MiB + 384 * 1024;
constexpr size_t WS_SGUW = 2 * MiB;
constexpr size_t WS_WG = 2 * MiB + 512 * 1024;
constexpr size_t WS_KC = 3 * MiB;
constexpr size_t WS_VCT = 4 * MiB;
constexpr size_t WS_GATES = 5 * MiB;
constexpr size_t WS_W1T = 8 * MiB;
constexpr size_t WS_WUP = 16 * MiB;
constexpr size_t WS_WDN = 188 * MiB;
constexpr size_t WS_WIN = 274 * MiB;
constexpr size_t WS_WVT = 402 * MiB;
constexpr size_t WS_WM = 410 * MiB;
constexpr size_t WS_WO = 442 * MiB;
constexpr size_t WS_H = 474 * MiB;
constexpr size_t WS_Q = 602 * MiB;
constexpr size_t WS_KV = 666 * MiB;
constexpr size_t WS_VT = 730 * MiB;
constexpr size_t WS_Z = 762 * MiB;
constexpr size_t WS_GA = 890 * MiB;
constexpr size_t WS_GB = 1018 * MiB;
constexpr size_t WS_YAB = 1146 * MiB;
constexpr size_t WS_H2 = 274 * MiB;
constexpr size_t WS_AH = 406 * MiB;
constexpr size_t WS_AT = 418 * MiB;
constexpr size_t WS_ACT = 1090 * MiB;
constexpr size_t WS_Y2 = 432 * MiB;
constexpr size_t WS_X1H = 602 * MiB;
constexpr size_t WS_YSC = 1274 * MiB;
constexpr size_t WS_SA = 12 * MiB;
constexpr size_t WS_SW = 12 * MiB + 256 * 1024;
constexpr size_t WS_SAH = 12 * MiB + 512 * 1024;
constexpr size_t WS_SWQ = 12 * MiB + 640 * 1024;
constexpr size_t WS_H1Q = 1274 * MiB;
constexpr size_t WS_WINQ = 1338 * MiB;
constexpr size_t WS_WVTQ = 1390 * MiB;
constexpr size_t WS_SACT = 12 * MiB + 784 * 1024;
constexpr size_t WS_SWDN = 12 * MiB + 848 * 1024;
constexpr size_t WS_ACTQ = 730 * MiB;
constexpr size_t WS_WDNQ = 1520 * MiB;
constexpr size_t WS_WUPQ = 1434 * MiB;
constexpr size_t WS_MRGQ = 602 * MiB;
constexpr size_t WS_WOQ = 300 * MiB;
constexpr size_t WS_SAM = 12 * MiB + 896 * 1024;
constexpr size_t WS_SWO = 12 * MiB + 960 * 1024;
constexpr size_t WS_END = 1563 * MiB;

constexpr int CW_BAR = 4096;

constexpr int LDS_BYTES = 147456;
constexpr int MISC_OFF = LDS_BYTES - 512;
constexpr int NWAVES = 8, NTHREADS = 512;

#define LDS_WAIT() asm volatile("s_waitcnt lgkmcnt(0)" ::: "memory")
#define VM_WAIT() asm volatile("s_waitcnt vmcnt(0)" ::: "memory")
__device__ __forceinline__ unsigned pkh(float lo, float hi) { hx2 p; p.x = (f16)lo; p.y = (f16)hi; return __builtin_bit_cast(unsigned, p); }
__device__ __forceinline__ unsigned pkb(float lo, float hi) { unsigned r; asm volatile("v_cvt_pk_bf16_f32 %0, %1, %2" : "=v"(r) : "v"(lo), "v"(hi)); return r; }
#ifndef FFN_BF16
#define FFN_BF16 1
#endif
__device__ __forceinline__ unsigned pk_ffn(float lo, float hi) { return FFN_BF16 ? pkb(lo, hi) : pkh(lo, hi); }
#ifndef MIX_BF16
#define P6_INT8 1
#define MIX_BF16 1
#endif
__device__ __forceinline__ unsigned pk_mix(float lo, float hi) { return MIX_BF16 ? pkb(lo, hi) : pkh(lo, hi); }
__device__ __forceinline__ float wave_max(float v) {
#pragma unroll
    for (int o = 1; o < 64; o <<= 1) v = fmaxf(v, __shfl_xor(v, o));
    return v;
}
__device__ __forceinline__ unsigned pk_i8(float a, float b, float c, float d) {
    a = fminf(fmaxf(a, -127.f), 127.f); b = fminf(fmaxf(b, -127.f), 127.f); c = fminf(fmaxf(c, -127.f), 127.f); d = fminf(fmaxf(d, -127.f), 127.f);
    const int ia = (int)__builtin_rintf(a), ib = (int)__builtin_rintf(b), ic = (int)__builtin_rintf(c), id = (int)__builtin_rintf(d);
    return (unsigned)(ia & 255) | ((unsigned)(ib & 255) << 8) | ((unsigned)(ic & 255) << 16) | ((unsigned)(id & 255) << 24);
}
__device__ __forceinline__ void fwht64(float (&t)[64]) {
#pragma unroll
    for (int h = 1; h < 64; h <<= 1)
#pragma unroll
        for (int i = 0; i < 64; ++i) if ((i & h) == 0) { const float a = t[i], b = t[i + h]; t[i] = a + b; t[i + h] = a - b; }
#pragma unroll
    for (int i = 0; i < 64; ++i) t[i] *= 0.125f;
}
__device__ __forceinline__ void fwht8(float (&t)[8]) {
#pragma unroll
    for (int h = 1; h < 8; h <<= 1)
#pragma unroll
        for (int i = 0; i < 8; ++i) if ((i & h) == 0) { const float a = t[i], b = t[i + h]; t[i] = a + b; t[i + h] = a - b; }
#pragma unroll
    for (int i = 0; i < 8; ++i) t[i] *= 0.35355339059f;
}
__device__ __forceinline__ float wave_sum(float v) {
#pragma unroll
    for (int o = 1; o < 64; o <<= 1) v += __shfl_xor(v, o);
    return v;
}
__device__ __forceinline__ float fsigmoid(float x) { return __builtin_amdgcn_rcpf(1.0f + __builtin_amdgcn_exp2f(-LOG2E * x)); }
__device__ __forceinline__ float fsilu(float x) { return x * fsigmoid(x); }
__device__ __forceinline__ float fgelu(float x) { const float u = x * (1.0f + 0.044715f * x * x); return x * __builtin_amdgcn_rcpf(1.0f + __builtin_amdgcn_exp2f(-2.302208198f * u)); }
template <int CTRL> __device__ __forceinline__ float dpp_f(float v) { return __builtin_bit_cast(float, __builtin_amdgcn_update_dpp(0, __builtin_bit_cast(int, v), CTRL, 0xF, 0xF, true)); }

namespace pg8 {
constexpr int BM = 256, BK = 64, HALF = 128, HTB = HALF * BK * 2, STAGE_BYTES = 8 * HTB, NXCD = 8, WGM = 8;
__host__ __device__ __forceinline__ int lds_byte(int r, int c) { const int st = (r >> 4) * 2 + (c >> 5), rr = r & 15, cc = c & 31, ob = rr * 64 + cc * 2; return st * 1024 + (ob ^ (((ob >> 9) & 1) << 5)); }
__host__ __device__ __forceinline__ void stage_rc(int b, int& R, int& C) { const int st = b / 1024, sb = b % 1024, swz = sb ^ (((sb >> 9) & 1) << 5); R = (st >> 1) * 16 + swz / 64; C = (st & 1) * 32 + (swz % 64) / 2; }
__host__ __device__ __forceinline__ int perm32(int rho) { const int n = rho >> 4, i = rho & 15; return 8 * (i >> 2) + 4 * n + (i & 3); }

struct Unit { int pm, pn; };
struct Gemm { const f16* A; const f16* Bt; int M, N, K; };

struct StaticOrder {
    int nM, nN, nwg, G, c;
    __host__ __device__ void init(int M_, int N_, int G_, int c_) { nM = M_ / BM; nN = N_ / BM; nwg = nM * nN; G = G_; c = c_; }
    __host__ __device__ bool next(int i, Unit& u) const {
        const long L = (long)i * G + c; if (L >= nwg) return false;
        int wgid = (int)L; { const int q = nwg / NXCD, r = nwg % NXCD, xcd = wgid % NXCD, off = wgid / NXCD; wgid = (xcd < r ? xcd * (q + 1) : r * (q + 1) + (xcd - r) * q) + off; }
        const int nig = WGM * nN, gid = wgid / nig, fm = gid * WGM, gsz = (nM - fm) < WGM ? (nM - fm) : WGM;
        u.pm = fm + ((wgid % nig) % gsz); u.pn = (wgid % nig) / gsz; return true;
    }
    __device__ __forceinline__ void a_ready(const Unit&) const {}
    __device__ __forceinline__ void done(const Unit&) const {}
};

__device__ __forceinline__ u32x4 pack8(const f32x4 v0, const f32x4 v1) { u32x4 w; w.x = pkh(v0[0], v0[1]); w.y = pkh(v0[2], v0[3]); w.z = pkh(v1[0], v1[1]); w.w = pkh(v1[2], v1[3]); return w; }

__device__ __forceinline__ unsigned opaque(unsigned v) { asm volatile("" : "+v"(v)); return v; }
struct EpiF32 {
    static constexpr bool PERM = false, AFTER_DRAIN = false, HAS_MID = false;
    float* C; int ldc;
    __device__ __forceinline__ void mid(f32x4 (&)[2][2][4][2], const Unit&, int, int, int, int) const {}
    __device__ __forceinline__ void operator()(const f32x4 (&acc)[2][2][4][2], const Unit& u, int wr, int wc, int fr, int fq) const {
        const unsigned off = opaque((unsigned)((u.pm * BM + wr * 64 + fr) * ldc + u.pn * BM + wc * 32 + 4 * fq) * 4u);
        char* base = (char*)C;
#pragma unroll
        for (int ai = 0; ai < 2; ++ai)
#pragma unroll
            for (int m = 0; m < 4; ++m) { const unsigned ro = off + (unsigned)((ai * HALF + m * 16) * ldc) * 4u;
#pragma unroll
                for (int bj = 0; bj < 2; ++bj)
#pragma unroll
                    for (int n = 0; n < 2; ++n) *(f32x4*)(base + ro + (bj * HALF + n * 16) * 4) = acc[ai][bj][m][n]; }
    }
};
struct EpiH16 {
    static constexpr bool PERM = true, AFTER_DRAIN = false, HAS_MID = false;
    f16* O; int ldc;
    __device__ __forceinline__ void mid(f32x4 (&)[2][2][4][2], const Unit&, int, int, int, int) const {}
    __device__ __forceinline__ void operator()(const f32x4 (&acc)[2][2][4][2], const Unit& u, int wr, int wc, int fr, int fq) const {
        const unsigned off = opaque((unsigned)((u.pm * BM + wr * 64 + fr) * ldc + u.pn * BM + wc * 32 + 8 * fq) * 2u);
        char* base = (char*)O;
#pragma unroll
        for (int ai = 0; ai < 2; ++ai)
#pragma unroll
            for (int m = 0; m < 4; ++m) { const unsigned ro = off + (unsigned)((ai * HALF + m * 16) * ldc) * 2u;
#pragma unroll
                for (int bj = 0; bj < 2; ++bj) *(u32x4*)(base + ro + bj * HALF * 2) = pack8(acc[ai][bj][m][0], acc[ai][bj][m][1]); }
    }
};
struct EpiProj {
    static constexpr bool PERM = true, AFTER_DRAIN = false, HAS_MID = false;
    f16 *Q, *KV, *Z, *GA, *GB; int pn0;
    __device__ __forceinline__ void mid(f32x4 (&)[2][2][4][2], const Unit&, int, int, int, int) const {}
    __device__ __forceinline__ void operator()(const f32x4 (&acc)[2][2][4][2], const Unit& u, int wr, int wc, int fr, int fq) const {
        const int pn = u.pn + pn0; char* base; int ldc, colt, act;
        if (pn < 8) { base = (char*)Q; ldc = 2048; colt = pn * 256; act = 0; }
        else if (pn < 16) { base = (char*)KV; ldc = 2048; colt = (pn - 8) * 256; act = 0; }
        else if (pn < 32) { base = (char*)Z; ldc = 4096; colt = (pn - 16) * 256; act = 1; }
        else if (pn < 48) { base = (char*)GA; ldc = 4096; colt = (pn - 32) * 256; act = 2; }
        else { base = (char*)GB; ldc = 4096; colt = (pn - 48) * 256; act = 2; }
        const unsigned off = opaque((unsigned)((u.pm * BM + wr * 64 + fr) * ldc + colt + wc * 32 + 8 * fq) * 2u);
#pragma unroll
        for (int ai = 0; ai < 2; ++ai)
#pragma unroll
            for (int m = 0; m < 4; ++m) { const unsigned ro = off + (unsigned)((ai * HALF + m * 16) * ldc) * 2u;
#pragma unroll
                for (int bj = 0; bj < 2; ++bj) { f32x4 v0 = acc[ai][bj][m][0], v1 = acc[ai][bj][m][1];
                    if (act == 1) {
#pragma unroll
                        for (int j = 0; j < 4; ++j) { v0[j] = fgelu(v0[j]); v1[j] = fgelu(v1[j]); } }
                    else if (act == 2) {
#pragma unroll
                        for (int j = 0; j < 4; ++j) { v0[j] = fsigmoid(v0[j]); v1[j] = fsigmoid(v1[j]); } }
                    *(u32x4*)(base + ro + bj * HALF * 2) = pack8(v0, v1); } }
    }
};
struct EpiProjQ {
    static constexpr bool PERM = true, AFTER_DRAIN = false, HAS_MID = false;
    unsigned char* ws; int pn0;
    __device__ __forceinline__ void mid(f32x4 (&)[2][2][4][2], const Unit&, int, int, int, int) const {}
    __device__ __forceinline__ void operator()(const f32x4 (&acc)[2][2][4][2], const Unit& u, int wr, int wc, int fr, int fq) const {
        const int pn = u.pn + pn0; char* base; int ldc, colt, act;
        if (pn < 16) { base = (char*)(ws + WS_KV); ldc = 2048; colt = (pn - 8) * 256; act = 0; }
        else if (pn < 32) { base = (char*)(ws + WS_Z); ldc = 4096; colt = (pn - 16) * 256; act = 1; }
        else if (pn < 48) { base = (char*)(ws + WS_GA); ldc = 4096; colt = (pn - 32) * 256; act = 2; }
        else { base = (char*)(ws + WS_GB); ldc = 4096; colt = (pn - 48) * 256; act = 2; }
        const float* const SA = (const float*)(ws + WS_SAH); const float* const SW = (const float*)(ws + WS_SWQ);
        const unsigned off = opaque((unsigned)((u.pm * BM + wr * 64 + fr) * ldc + colt + wc * 32 + 8 * fq) * 2u);
        const unsigned arow = opaque((unsigned)(u.pm * BM + wr * 64 + fr)), wrow = opaque((unsigned)((pn - 12) * 256 + wc * 32 + 8 * fq));
        f32x4 sw[2][2];
#pragma unroll
        for (int bj = 0; bj < 2; ++bj)
#pragma unroll
            for (int n = 0; n < 2; ++n) sw[bj][n] = *(const f32x4*)(SW + wrow + bj * HALF + 4 * n);
#pragma unroll
        for (int ai = 0; ai < 2; ++ai)
#pragma unroll
            for (int m = 0; m < 4; ++m) { const unsigned ro = off + (unsigned)((ai * HALF + m * 16) * ldc) * 2u; const float sa = SA[arow + ai * HALF + m * 16];
#pragma unroll
                for (int bj = 0; bj < 2; ++bj) { const ix4 i0 = __builtin_bit_cast(ix4, acc[ai][bj][m][0]), i1 = __builtin_bit_cast(ix4, acc[ai][bj][m][1]); f32x4 v0, v1;
#pragma unroll
                    for (int j = 0; j < 4; ++j) { v0[j] = (float)i0[j] * (sa * sw[bj][0][j]); v1[j] = (float)i1[j] * (sa * sw[bj][1][j]); }
                    if (act == 1) {
#pragma unroll
                        for (int j = 0; j < 4; ++j) { v0[j] = fgelu(v0[j]); v1[j] = fgelu(v1[j]); } }
                    else if (act == 2) {
#pragma unroll
                        for (int j = 0; j < 4; ++j) { v0[j] = fsigmoid(v0[j]); v1[j] = fsigmoid(v1[j]); } }
                    *(u32x4*)(base + ro + bj * HALF * 2) = pack8(v0, v1); } }
    }
};
struct EpiH16Q {
    static constexpr bool PERM = true, AFTER_DRAIN = false, HAS_MID = false;
    f16* O; int ldc; const float* SA; const float* SW;
    __device__ __forceinline__ void mid(f32x4 (&)[2][2][4][2], const Unit&, int, int, int, int) const {}
    __device__ __forceinline__ void operator()(const f32x4 (&acc)[2][2][4][2], const Unit& u, int wr, int wc, int fr, int fq) const {
        const unsigned off = opaque((unsigned)((u.pm * BM + wr * 64 + fr) * ldc + u.pn * BM + wc * 32 + 8 * fq) * 2u);
        const unsigned arow = opaque((unsigned)(u.pm * BM + wr * 64 + fr)), wrow = opaque((unsigned)(u.pn * BM + wc * 32 + 8 * fq));
        char* base = (char*)O;
        f32x4 sw[2][2];
#pragma unroll
        for (int bj = 0; bj < 2; ++bj)
#pragma unroll
            for (int n = 0; n < 2; ++n) sw[bj][n] = *(const f32x4*)(SW + wrow + bj * HALF + 4 * n);
#pragma unroll
        for (int ai = 0; ai < 2; ++ai)
#pragma unroll
            for (int m = 0; m < 4; ++m) { const unsigned ro = off + (unsigned)((ai * HALF + m * 16) * ldc) * 2u; const float sa = SA[arow + ai * HALF + m * 16];
#pragma unroll
                for (int bj = 0; bj < 2; ++bj) { const ix4 i0 = __builtin_bit_cast(ix4, acc[ai][bj][m][0]), i1 = __builtin_bit_cast(ix4, acc[ai][bj][m][1]); f32x4 v0, v1;
#pragma unroll
                    for (int j = 0; j < 4; ++j) { v0[j] = (float)i0[j] * (sa * sw[bj][0][j]); v1[j] = (float)i1[j] * (sa * sw[bj][1][j]); }
                    *(u32x4*)(base + ro + bj * HALF * 2) = pack8(v0, v1); } }
    }
};
struct EpiVTQ {
    static constexpr bool PERM = true, AFTER_DRAIN = false, HAS_MID = false;
    unsigned char* ws;
    __device__ __forceinline__ void mid(f32x4 (&)[2][2][4][2], const Unit&, int, int, int, int) const {}
    __device__ __forceinline__ void operator()(const f32x4 (&acc)[2][2][4][2], const Unit& u, int wr, int wc, int fr, int fq) const {
        const float* const SA = (const float*)(ws + WS_SAH); const float* const SW = (const float*)(ws + WS_SWQ) + 13312;
        const unsigned off = opaque((unsigned)((u.pm * BM + wr * 64 + fr) * M + u.pn * BM + wc * 32 + 8 * fq) * 2u);
        const unsigned wrow = opaque((unsigned)(u.pm * BM + wr * 64 + fr)), tcol = opaque((unsigned)(u.pn * BM + wc * 32 + 8 * fq));
        char* base = (char*)(ws + WS_VT);
        f32x4 sa[2][2];
#pragma unroll
        for (int bj = 0; bj < 2; ++bj)
#pragma unroll
            for (int n = 0; n < 2; ++n) sa[bj][n] = *(const f32x4*)(SA + tcol + bj * HALF + 4 * n);
#pragma unroll
        for (int ai = 0; ai < 2; ++ai)
#pragma unroll
            for (int m = 0; m < 4; ++m) { const unsigned ro = off + (unsigned)((ai * HALF + m * 16) * M) * 2u; const float sw = SW[wrow + ai * HALF + m * 16];
#pragma unroll
                for (int bj = 0; bj < 2; ++bj) { const ix4 i0 = __builtin_bit_cast(ix4, acc[ai][bj][m][0]), i1 = __builtin_bit_cast(ix4, acc[ai][bj][m][1]); f32x4 v0, v1;
#pragma unroll
                    for (int j = 0; j < 4; ++j) { v0[j] = (float)i0[j] * (sw * sa[bj][0][j]); v1[j] = (float)i1[j] * (sw * sa[bj][1][j]); }
                    *(u32x4*)(base + ro + bj * HALF * 2) = pack8(v0, v1); } }
    }
};
struct EpiMerge {
    static constexpr bool PERM = true, AFTER_DRAIN = false, HAS_MID = true;
    const f16 *GA, *GB; f16* O;
    __device__ __forceinline__ void mid(f32x4 (&acc)[2][2][4][2], const Unit& u, int wr, int wc, int fr, int fq) const {
        const unsigned off = opaque((unsigned)((u.pm * BM + wr * 64 + fr) * D + u.pn * BM + wc * 32 + 8 * fq) * 2u);
        const char* ga = (const char*)GA; const char* gb = (const char*)GB;
#pragma unroll
        for (int ai = 0; ai < 2; ++ai)
#pragma unroll
            for (int m = 0; m < 4; ++m) { const unsigned ro = off + (unsigned)((ai * HALF + m * 16) * D) * 2u;
#pragma unroll
                for (int bj = 0; bj < 2; ++bj) { const hx8 a = *(const hx8*)(ga + ro + bj * HALF * 2), b = *(const hx8*)(gb + ro + bj * HALF * 2);
#pragma unroll
                    for (int j = 0; j < 4; ++j) { acc[ai][bj][m][0][j] *= (float)a[j] * __builtin_amdgcn_rcpf((float)b[j]); acc[ai][bj][m][1][j] *= (float)a[4 + j] * __builtin_amdgcn_rcpf((float)b[4 + j]); } } }
    }
    __device__ __forceinline__ void operator()(const f32x4 (&acc)[2][2][4][2], const Unit& u, int wr, int wc, int fr, int fq) const {
        const unsigned off = opaque((unsigned)((u.pm * BM + wr * 64 + fr) * D + u.pn * BM + wc * 32 + 8 * fq) * 2u);
        const char* gb = (const char*)GB; char* ob = (char*)O;
#pragma unroll
        for (int ai = 0; ai < 2; ++ai)
#pragma unroll
            for (int m = 0; m < 4; ++m) { const unsigned ro = off + (unsigned)((ai * HALF + m * 16) * D) * 2u;
#pragma unroll
                for (int bj = 0; bj < 2; ++bj) { const hx8 b = *(const hx8*)(gb + ro + bj * HALF * 2); f32x4 v0 = acc[ai][bj][m][0], v1 = acc[ai][bj][m][1];
#pragma unroll
                    for (int j = 0; j < 4; ++j) { v0[j] *= (float)b[j]; v1[j] *= (float)b[4 + j]; }
                    u32x4 w; w.x = pk_mix(v0[0], v0[1]); w.y = pk_mix(v0[2], v0[3]); w.z = pk_mix(v1[0], v1[1]); w.w = pk_mix(v1[2], v1[3]);
                    *(u32x4*)(ob + ro + bj * HALF * 2) = w; } }
    }
};

typedef short sx8 __attribute__((ext_vector_type(8)));
template <int CTRL> __device__ __forceinline__ float dpp_mov(float old, float v) { return __builtin_bit_cast(float, __builtin_amdgcn_update_dpp(__builtin_bit_cast(int, old), __builtin_bit_cast(int, v), CTRL, 0xF, 0xF, false)); }
struct EpiConv {
    static constexpr bool PERM = true, AFTER_DRAIN = false, HAS_MID = false;
    unsigned char* ws; const float* cw; const float* cb; LAS float* X; int bf16out;
    __device__ __forceinline__ void mid(f32x4 (&)[2][2][4][2], const Unit&, int, int, int, int) const {}
    static __device__ __forceinline__ f32x4 deq(const f32x4 a, float s) { const ix4 iv = __builtin_bit_cast(ix4, a); return (f32x4){(float)iv[0] * s, (float)iv[1] * s, (float)iv[2] * s, (float)iv[3] * s}; }
    __device__ __forceinline__ void operator()(const f32x4 (&acc)[2][2][4][2], const Unit& u, int wr, int wc, int fr_, int fq_) const {
        const unsigned lane_o = opaque(threadIdx.x & 63u); const int fr = (int)(lane_o & 15u), fq = (int)(lane_o >> 4); (void)fr_; (void)fq_;
        f16* const ACT = (f16*)(ws + WS_ACT); float* const AH = (float*)(ws + WS_AH); float* const AT = (float*)(ws + WS_AT); const float* const SA = (const float*)(ws + WS_SA); const float* const SW = (const float*)(ws + WS_SW);
        const int chl = wc * 32 + 8 * fq;
        const unsigned ch0 = opaque((unsigned)(u.pn * 128 + chl)), wrow = opaque((unsigned)(u.pn * 256 + chl)), arow = opaque((unsigned)(u.pm * BM + wr * 64 + fr));
        float sa[2][4];
#pragma unroll
        for (int ai = 0; ai < 2; ++ai)
#pragma unroll
            for (int m = 0; m < 4; ++m) sa[ai][m] = SA[arow + ai * HALF + m * 16];
        LAS f32x4* const PB = (LAS f32x4*)(X + 2048);
        { const unsigned t = opaque(threadIdx.x);
          if (t < 352u) { const unsigned row = t >> 5, c4 = t & 31u; const float* sp;
              if (row < 2u) sp = cb + row * DFF + u.pn * 128; else if (row < 4u) sp = SW + u.pn * 256 + (row - 2u) * 128; else sp = cw + ((row - 4u) >> 1) * NUP + ((row - 4u) & 1u) * DFF + u.pn * 128;
              PB[t] = *(const f32x4*)(sp + 4 * c4); } }
        if (fr >= 14) {
#pragma unroll
            for (int ai = 0; ai < 2; ++ai)
#pragma unroll
                for (int bj = 0; bj < 2; ++bj)
#pragma unroll
                    for (int n = 0; n < 2; ++n) *(LAS f32x4*)(X + ((((2 * ai + wr) * 2 + (fr - 14)) * 2 + bj) * 128 + chl + 4 * n)) = deq(acc[ai][bj][3][n], sa[ai][3]);
        }
        asm volatile("s_waitcnt lgkmcnt(0)" ::: "memory"); __builtin_amdgcn_s_barrier(); asm volatile("" ::: "memory");
        if (u.pm == 64) {
            const unsigned hro = opaque((unsigned)((wr * 64 + fr) * 2));
#pragma unroll
            for (int bj = 0; bj < 2; ++bj)
#pragma unroll
                for (int n = 0; n < 2; ++n) { const f32x4 swv = *(const f32x4*)(SW + wrow + bj * 128 + 4 * n);
#pragma unroll
                    for (int m = 0; m < 4; ++m) *(f32x4*)(AH + (size_t)(hro + 32 * m + bj) * DFF + ch0 + 4 * n) = deq(acc[0][bj][m][n], sa[0][m]) * swv; }
            return;
        }
        const unsigned orow = opaque((unsigned)(u.pm * BM + wr * 64 + fr));
#pragma unroll
        for (int n = 0; n < 2; ++n) {
            f32x4 wv[3][2], bv[2];
#pragma unroll
            for (int bj = 0; bj < 2; ++bj) { const int pc = (chl >> 2) + n; bv[bj] = PB[bj * 32 + pc]; const f32x4 swv = PB[(2 + bj) * 32 + pc];
#pragma unroll
                for (int k = 0; k < 3; ++k) wv[k][bj] = PB[(4 + 2 * k + bj) * 32 + pc] * swv;
                if (wr == 0 && fr < 2) *(f32x4*)(AT + (size_t)((u.pm * 2 + fr) * 2 + bj) * DFF + ch0 + 4 * n) = deq(acc[0][bj][0][n], sa[0][0]) * swv; }
#pragma unroll
            for (int ai = 0; ai < 2; ++ai) {
                f32x4 E[2];
                const int blk = 2 * ai + wr - 1;
#pragma unroll
                for (int bj = 0; bj < 2; ++bj) { E[bj] = (f32x4){0.f, 0.f, 0.f, 0.f};
                    if (blk >= 0 && fr >= 14) E[bj] = *(const LAS f32x4*)(X + (((blk * 2 + (fr - 14)) * 2 + bj) * 128 + chl + 4 * n)); }
#pragma unroll
                for (int m = 0; m < 4; ++m) {
                    f32x4 cv[2];
#pragma unroll
                    for (int bj = 0; bj < 2; ++bj) { const f32x4 cur = deq(acc[ai][bj][m][n], sa[ai][m]); const f32x4 prv = (m == 0) ? E[bj] : deq(acc[ai][bj][m == 0 ? 0 : m - 1][n], sa[ai][m == 0 ? 0 : m - 1]);
#pragma unroll
                        for (int i = 0; i < 4; ++i) { const float p1 = dpp_mov<0x111>(dpp_mov<0x121>(0.f, prv[i]), cur[i]), p2 = dpp_mov<0x112>(dpp_mov<0x122>(0.f, prv[i]), cur[i]);
                            cv[bj][i] = bv[bj][i] + wv[0][bj][i] * p2 + wv[1][bj][i] * p1 + wv[2][bj][i] * cur[i]; } }
                    float res[4];
#pragma unroll
                    for (int e = 0; e < 4; ++e) res[e] = fsilu(cv[0][e]) * cv[1][e];
                    u32x2 ov;
                    if (bf16out) { ov.x = pkb(res[0], res[1]); ov.y = pkb(res[2], res[3]); }
                    else { ov.x = pkh(res[0], res[1]); ov.y = pkh(res[2], res[3]); }
                    *(u32x2*)(ACT + (size_t)(orow + ai * HALF + m * 16) * DFF + ch0 + 4 * n) = ov;
                }
            }
        }
    }
};

template <class Epi, class Sched, bool ALIGN_EPI = true, int DT = 0  >
__device__ __forceinline__ void gemm_phase(LAS unsigned char* lds, const Gemm g, const Sched& S, const Epi& E) {
    const int tid = threadIdx.x, wid = __builtin_amdgcn_readfirstlane(tid >> 6), lane = tid & 63, wr = wid >> 2, wc = wid & 3, fr = lane & 15, fq = lane >> 4;
    const int K = g.K, nt = K / BK;
    unsigned voffA[2], voffB[2];
#pragma unroll
    for (int i = 0; i < 2; ++i) { int R, C; stage_rc(tid * 16 + i * 8192, R, C); const int Rb = Epi::PERM ? ((R & ~31) + perm32(R & 31)) : R;
        voffA[i] = (unsigned)(R * K + C) * 2u; voffB[i] = (unsigned)(Rb * K + C) * 2u; }
    const size_t kstep = (size_t)(BK * 2);
    const size_t hstep = (size_t)HALF * K * 2;
    const size_t tstep = 2 * hstep;
    const unsigned ldsw = (unsigned)wid * 1024u;
    const int aoff = lds_byte(wr * 64 + fr, fq * 8), boff = lds_byte(wc * 32 + fr, fq * 8);
#define PG8_SA(b, h) (((b) * 2 + (h)) * HTB)
#define PG8_SB(b, h) ((4 + (b) * 2 + (h)) * HTB)
#define PG8_STAGE(bufoff, gbase, voff) do { _Pragma("unroll") for (int _i = 0; _i < 2; ++_i) \
        __builtin_amdgcn_global_load_lds((const unsigned*)((const char*)(gbase) + (voff)[_i]), (LAS unsigned*)(lds + (bufoff) + ldsw + _i * 8192), 16, 0, 0); } while (0)
#define PG8_LDA(dst, b, h) do { _Pragma("unroll") for (int m = 0; m < 4; ++m) _Pragma("unroll") for (int k = 0; k < 2; ++k) dst[m][k] = *(const LAS hx8*)(lds + PG8_SA(b, h) + aoff + m * 2048 + k * 1024); } while (0)
#define PG8_LDB(dst, b, h) do { _Pragma("unroll") for (int n = 0; n < 2; ++n) _Pragma("unroll") for (int k = 0; k < 2; ++k) dst[n][k] = *(const LAS hx8*)(lds + PG8_SB(b, h) + boff + n * 2048 + k * 1024); } while (0)
#define PG8_MMA(ai, bj, At, Bt) do { __builtin_amdgcn_s_setprio(1); _Pragma("unroll") for (int m = 0; m < 4; ++m) _Pragma("unroll") for (int n = 0; n < 2; ++n) _Pragma("unroll") for (int k = 0; k < 2; ++k) \
        { if constexpr (DT == 2) acc[ai][bj][m][n] = __builtin_bit_cast(f32x4, __builtin_amdgcn_mfma_i32_16x16x64_i8(__builtin_bit_cast(ix4, Bt[n][k]), __builtin_bit_cast(ix4, At[m][k]), __builtin_bit_cast(ix4, acc[ai][bj][m][n]), 0, 0, 0)); \
          else if constexpr (DT == 1) acc[ai][bj][m][n] = __builtin_amdgcn_mfma_f32_16x16x32_bf16(__builtin_bit_cast(sx8, Bt[n][k]), __builtin_bit_cast(sx8, At[m][k]), acc[ai][bj][m][n], 0, 0, 0); \
          else acc[ai][bj][m][n] = __builtin_amdgcn_mfma_f32_16x16x32_f16(Bt[n][k], At[m][k], acc[ai][bj][m][n], 0, 0, 0); } __builtin_amdgcn_s_setprio(0); } while (0)
#define PG8_WAIT_V(n) asm volatile("s_waitcnt vmcnt(" #n ")" ::: "memory")
#define PG8_WAIT_L(n) asm volatile("s_waitcnt lgkmcnt(" #n ")" ::: "memory")
#define PG8_BAR __builtin_amdgcn_s_barrier()
#define PG8_SCHED __builtin_amdgcn_sched_barrier(0)
    Unit cur, nxt; int ui = 0;
    if (!S.next(0, cur)) return;
    f32x4 acc[2][2][4][2];
#pragma unroll
    for (int a = 0; a < 2; ++a)
#pragma unroll
        for (int b = 0; b < 2; ++b)
#pragma unroll
            for (int m = 0; m < 4; ++m)
#pragma unroll
                for (int n = 0; n < 2; ++n) acc[a][b][m][n] = (f32x4){0.f, 0.f, 0.f, 0.f};
    hx8 At[4][2], B0[2][2], B1[2][2];
    const char* cA = (const char*)g.A + (size_t)cur.pm * tstep; const char* cB = (const char*)g.Bt + (size_t)cur.pn * tstep;
    S.a_ready(cur);
    PG8_STAGE(PG8_SB(0, 0), cB, voffB); PG8_STAGE(PG8_SB(0, 1), cB + hstep, voffB); PG8_STAGE(PG8_SA(0, 0), cA, voffA); PG8_STAGE(PG8_SA(0, 1), cA + hstep, voffA);
    if (wr == 1) PG8_BAR;
    PG8_WAIT_V(2); PG8_BAR;
    PG8_STAGE(PG8_SB(1, 0), cB + kstep, voffB); PG8_STAGE(PG8_SA(1, 0), cA + kstep, voffA); PG8_STAGE(PG8_SB(1, 1), cB + hstep + kstep, voffB);
    PG8_WAIT_V(6); PG8_BAR;
    for (;;) {
        const bool has_next = S.next(ui + 1, nxt);
        const char* nA = has_next ? (const char*)g.A + (size_t)nxt.pm * tstep : cA; const char* nB = has_next ? (const char*)g.Bt + (size_t)nxt.pn * tstep : cB;
        for (int t = 0; t < nt; t += 2) {
            const bool last = (t == nt - 2);
            const char* a1 = cA + (size_t)(t + 1) * kstep;
            const char* a2 = last ? nA : cA + (size_t)(t + 2) * kstep; const char* b2 = last ? nB : cB + (size_t)(t + 2) * kstep;
            const char* a3 = a2 + kstep; const char* b3 = b2 + kstep;
            if (last && has_next) S.a_ready(nxt);
            if constexpr (Epi::HAS_MID) { if (t == (nt >> 1)) E.mid(acc, cur, wr, wc, fr, fq); }
            PG8_LDB(B0, 0, 0); PG8_LDB(B1, 0, 1); PG8_SCHED; PG8_LDA(At, 0, 0); PG8_STAGE(PG8_SA(1, 1), a1 + hstep, voffA);
            PG8_WAIT_V(8); PG8_WAIT_L(0); PG8_BAR; PG8_MMA(0, 0, At, B0); PG8_MMA(0, 1, At, B1); PG8_BAR; PG8_SCHED;
            PG8_LDA(At, 0, 1); PG8_STAGE(PG8_SB(0, 0), b2, voffB); PG8_STAGE(PG8_SB(0, 1), b2 + hstep, voffB); PG8_STAGE(PG8_SA(0, 0), a2, voffA);
            PG8_WAIT_V(8); PG8_WAIT_L(0); PG8_BAR; PG8_MMA(1, 0, At, B0); PG8_MMA(1, 1, At, B1); PG8_BAR; PG8_SCHED;
            PG8_LDB(B0, 1, 0); PG8_LDB(B1, 1, 1); PG8_SCHED; PG8_LDA(At, 1, 0); PG8_STAGE(PG8_SA(0, 1), a2 + hstep, voffA);
            PG8_WAIT_V(8); PG8_WAIT_L(0); PG8_BAR; PG8_MMA(0, 0, At, B0); PG8_MMA(0, 1, At, B1); PG8_BAR; PG8_SCHED;
            PG8_LDA(At, 1, 1); PG8_STAGE(PG8_SB(1, 0), b3, voffB); PG8_STAGE(PG8_SB(1, 1), b3 + hstep, voffB); PG8_STAGE(PG8_SA(1, 0), a3, voffA);
            PG8_WAIT_V(8); PG8_WAIT_L(0); PG8_BAR; PG8_MMA(1, 0, At, B0); PG8_MMA(1, 1, At, B1); PG8_BAR; PG8_SCHED;
        }
        if constexpr (ALIGN_EPI) { if (wr == 0) PG8_BAR; }
        E(acc, cur, wr, wc, fr, fq); S.done(cur);
        if (!has_next) break;
#pragma unroll
        for (int a = 0; a < 2; ++a)
#pragma unroll
            for (int b = 0; b < 2; ++b)
#pragma unroll
                for (int m = 0; m < 4; ++m)
#pragma unroll
                    for (int n = 0; n < 2; ++n) acc[a][b][m][n] = (f32x4){0.f, 0.f, 0.f, 0.f};
        cur = nxt; cA = nA; cB = nB; ++ui;
        if constexpr (ALIGN_EPI) { if (wr == 1) PG8_BAR; }
    }
    PG8_WAIT_V(0);
    if constexpr (!ALIGN_EPI) { if (wr == 0) PG8_BAR; }
    PG8_BAR;
#undef PG8_SA
#undef PG8_SB
#undef PG8_STAGE
#undef PG8_LDA
#undef PG8_LDB
#undef PG8_MMA
#undef PG8_WAIT_V
#undef PG8_WAIT_L
#undef PG8_BAR
#undef PG8_SCHED
}
}

#define XB_TMO      128
#define XB_XCNT(j)  (256  + 64 * (j))
#define XB_XSUB(j)  (1280 + 64 * (j))
#define XB_XGEN(j)  (2304 + 64 * (j))
#define XB_TOP      3328
#define XB_TOPGEN   3392
#define XCD_BAR_WORDS 3456
#define XB_SPIN_CAP (1u << 18)
__device__ __forceinline__ unsigned xb_ld(unsigned* p)              { return __hip_atomic_load(p, __ATOMIC_RELAXED, __HIP_MEMORY_SCOPE_AGENT); }
__device__ __forceinline__ unsigned xb_add(unsigned* p, unsigned v) { return __hip_atomic_fetch_add(p, v, __ATOMIC_RELAXED, __HIP_MEMORY_SCOPE_AGENT); }
__device__ __forceinline__ unsigned xb_xcc_id() { return (unsigned)__builtin_amdgcn_s_getreg((3 << 11) | 20) & 0xFu; }
#define XB_SPIN(cond, bar) do { unsigned _sp = 0; while (cond) { __builtin_amdgcn_s_sleep(1); \
    if ((++_sp & 255u) == 0u) { if (xb_ld(&(bar)[XB_TMO])) break; if (_sp > XB_SPIN_CAP) { atomicAdd(&(bar)[XB_TMO], 1u); break; } } } } while (0)
struct XcdBarrier { unsigned* bar; unsigned x; volatile LAS unsigned* st; };
__device__ __forceinline__ XcdBarrier xcd_barrier_post(unsigned* bar, volatile LAS unsigned* st) {
    XcdBarrier b; b.bar = bar; b.x = xb_xcc_id(); b.st = st;
    if (threadIdx.x == 0) (void)xb_add(&bar[XB_XCNT(b.x)], 1u);
    return b;
}
__device__ __forceinline__ void xcd_barrier_complete(unsigned* bar, unsigned x, unsigned& nloc, unsigned& nx) {
    const unsigned G = gridDim.x * gridDim.y * gridDim.z;
    unsigned sum, cnt, mine, sp = 0u;
    for (;;) {
        sum = 0u; cnt = 0u; mine = 0u;
#pragma unroll
        for (unsigned j = 0; j < 16; ++j) { const unsigned c = xb_ld(&bar[XB_XCNT(j)]); sum += c; cnt += (c > 0u) ? 1u : 0u; mine = (j == x) ? c : mine; }
        if (sum == G) break;
        __builtin_amdgcn_s_sleep(1);
        if ((++sp & 255u) == 0u) { if (xb_ld(&bar[XB_TMO])) break; if (sp > XB_SPIN_CAP) { atomicAdd(&bar[XB_TMO], 1u); break; } }
    }
    nloc = mine > 0u ? mine : 1u; nx = cnt > 0u ? cnt : 1u;
}
__device__ __forceinline__ void xcd_barrier(const XcdBarrier& b) {
    asm volatile("s_waitcnt vmcnt(0)" ::: "memory");
    __syncthreads();
    if (threadIdx.x == 0) {
        unsigned* bar = b.bar;
        __builtin_amdgcn_s_waitcnt(0);
        unsigned nloc = b.st[0], nx = b.st[1];
        if (nloc == 0u) { xcd_barrier_complete(bar, b.x, nloc, nx); b.st[0] = nloc; b.st[1] = nx; }
        const unsigned old = xb_add(&bar[XB_XSUB(b.x)], 1u);
        const unsigned gen = old / nloc;
        if (old + 1u == (gen + 1u) * nloc) {
            __builtin_amdgcn_fence(__ATOMIC_RELEASE, "agent");
            asm volatile("s_waitcnt vmcnt(0)" ::: "memory");
            const unsigned og = xb_add(&bar[XB_TOP], 1u);
            const unsigned tg = og / nx;
            if (og + 1u == (tg + 1u) * nx) xb_add(&bar[XB_TOPGEN], 1u);
            else XB_SPIN(xb_ld(&bar[XB_TOPGEN]) == tg, bar);
            __builtin_amdgcn_fence(__ATOMIC_ACQUIRE, "agent");
            xb_add(&bar[XB_XGEN(b.x)], 1u);
            asm volatile("s_waitcnt vmcnt(0)" ::: "memory");
        } else {
            XB_SPIN(xb_ld(&bar[XB_XGEN(b.x)]) == gen, bar);
            __builtin_amdgcn_fence(__ATOMIC_ACQUIRE, "agent");
            asm volatile("s_waitcnt vmcnt(0)" ::: "memory");
        }
    }
    __syncthreads();
}

struct Args { const float* in[23]; float* out; unsigned char* ws; int ph_lo, ph_hi; };
struct Ctx {
    LAS unsigned char* lds;
    int tid, lane, wave, G, bid;
    const float *x, *c, *w_mod, *b_mod, *g_norms, *w_in, *cmp_pos, *cmp_w1, *cmp_b1, *cmp_w2, *cmp_b2, *rel_table, *ln_g, *ln_b, *sgu_w, *sgu_b,
                *w_pn, *w_ps, *w_out, *w_up, *conv_w, *conv_b, *w_dn;
    float* out; unsigned char* ws;
    float *mod, *posw1, *gates, *ysc, *AH, *AT; f16 *Y1, *Y2, *X1H, *W2T, *SGUW, *WG, *KC, *VCT, *W1T, *WUP, *WDN, *WIN, *WVT, *WM, *WO, *H, *Q, *KV, *VT, *Z, *GA, *GB, *YAB, *H2, *ACT;
};

__device__ __forceinline__ void p0_mod_item(Ctx& C, int item) {
    LAS float* sc = (LAS float*)C.lds;
    LAS float* red = (LAS float*)(C.lds + 32768);
    for (int i = C.tid; i < 2 * D; i += NTHREADS) sc[i] = fsilu(C.c[i]);
    __syncthreads();
    const int cq = C.tid & 31, kg = C.tid >> 5, n0 = item * 128 + 4 * cq;
    f32x4 a0 = {0.f, 0.f, 0.f, 0.f}, a1 = {0.f, 0.f, 0.f, 0.f};
    const float* wp = C.w_mod + (size_t)(kg * 256) * NMOD + n0;
#pragma unroll 8
    for (int i = 0; i < 256; ++i) { const f32x4 w = *(const f32x4*)(wp + (size_t)i * NMOD); const float s0 = sc[kg * 256 + i], s1 = sc[D + kg * 256 + i]; a0 += w * s0; a1 += w * s1; }
    *(LAS f32x4*)(red + (kg * 2 + 0) * 128 + 4 * cq) = a0; *(LAS f32x4*)(red + (kg * 2 + 1) * 128 + 4 * cq) = a1;
    __syncthreads();
    if (C.tid < 256) { const int b = C.tid >> 7, col = C.tid & 127; float s = 0.f;
#pragma unroll
        for (int k = 0; k < 16; ++k) s += red[(k * 2 + b) * 128 + col];
        C.mod[b * NMOD + item * 128 + col] = s + C.b_mod[item * 128 + col]; }
    __syncthreads();
}
__device__ __forceinline__ void p0_posw1_item(Ctx& C, int item) {
    LAS float* red = (LAS float*)C.lds;
    const int kk = item >> 2, j = (item & 3) * 64 + C.lane; float s = 0.f;
    const float* w = C.cmp_w1 + (size_t)kk * 4096 * 256 + j; const float* pp = C.cmp_pos + kk * 4096;
    for (int k = C.wave * 512; k < C.wave * 512 + 512; ++k) s += pp[k] * w[(size_t)k * 256];
    red[C.wave * 64 + C.lane] = s;
    __syncthreads();
    if (C.wave == 0) { float t = 0.f;
#pragma unroll
        for (int k = 0; k < 8; ++k) t += red[k * 64 + C.lane];
        C.posw1[kk * 256 + j] = t + C.cmp_b1[kk * 256 + j]; }
    __syncthreads();
}
__device__ __forceinline__ f16* win_row(Ctx& C, int n) {
    if (n < 3584) return C.WIN + (size_t)n * D;
    if (n < 4096) return C.WVT + (size_t)(n - 3584) * D;
    if (n < 4608) return C.WIN + (size_t)(n - 512) * D;
    if (n < 5120) return C.WVT + (size_t)(n - 4608 + 512) * D;
    if (n < 5168) return C.WG + (size_t)(n - 5120) * D;
    return C.WIN + (size_t)(n - 5168 + 4096) * D;
}
__device__ __forceinline__ void p0_transpose_item(Ctx& C, int mat, const float* src, int N, int kb, int nb, LAS float* scr) {
    const int lane = C.lane, k0 = kb * 64, n0 = nb * 64, r4 = lane >> 4, c4 = (lane & 15) * 4; const bool ok = n0 + c4 < N;
    const float* sp = src + (size_t)(k0 + r4) * N + (ok ? n0 + c4 : 0);
#pragma unroll
    for (int i = 0; i < 16; ++i) { const f32x4 v = ok ? *(const f32x4*)(sp + (size_t)(4 * i) * N) : (f32x4){0.f, 0.f, 0.f, 0.f};
        LAS float* d = scr + (4 * i + r4) * 65 + c4; d[0] = v.x; d[1] = v.y; d[2] = v.z; d[3] = v.w; }
    LDS_WAIT();
    const int c = lane & 7;
#pragma unroll
    for (int j = 0; j < 8; ++j) { const int nn = (lane >> 3) + 8 * j, ng = n0 + nn;
        if (ng < N) { const LAS float* s = scr + (8 * c) * 65 + nn;
            u32x4 o;
            if ((FFN_BF16 && (mat == 4 || mat == 5)) || (MIX_BF16 && (mat == 1 || mat == 2 || mat == 3))) { o.x = pkb(s[0], s[65]); o.y = pkb(s[2 * 65], s[3 * 65]); o.z = pkb(s[4 * 65], s[5 * 65]); o.w = pkb(s[6 * 65], s[7 * 65]); }
            else { o.x = pkh(s[0], s[65]); o.y = pkh(s[2 * 65], s[3 * 65]); o.z = pkh(s[4 * 65], s[5 * 65]); o.w = pkh(s[6 * 65], s[7 * 65]); }
            f16* rowp;
            if (mat == 0) rowp = win_row(C, ng);
            else if (mat == 1) rowp = C.WM + (size_t)ng * D;
            else if (mat == 2) rowp = C.WM + (size_t)ng * D + 2048;
            else if (mat == 3) rowp = C.WO + (size_t)ng * D;
            else if (mat == 4) { const int isup = ng >= DFF ? 1 : 0, cc = ng - isup * DFF; rowp = C.WUP + (size_t)((cc >> 7) * 256 + isup * 128 + (cc & 127)) * D; }
            else if (mat == 5) rowp = C.WDN + (size_t)ng * DFF;
            else if (mat == 6) rowp = C.W1T + (size_t)ng * D;
            else rowp = C.W1T + (size_t)(256 + ng) * D;
            *(u32x4*)(rowp + k0 + 8 * c) = o; } }
    LDS_WAIT();
}
__device__ __forceinline__ void p0_prologue(Ctx& C) {
    for (int it = C.bid; it < 200; it += C.G) { if (it < 192) p0_mod_item(C, it); else p0_posw1_item(C, it - 192); }
    const int gw = C.bid * NWAVES + C.wave, NGW = C.G * NWAVES;
    LAS float* scr = (LAS float*)(C.lds + C.wave * 16640);
    constexpr int I0 = 64 * 273, I1 = 32 * 64, I3 = 64 * 64, I4 = 64 * 344, I5 = 172 * 64, I6 = 64 * 4;
    constexpr int NIT = I0 + 2 * I1 + I3 + I4 + I5 + 2 * I6;
    for (int it = gw; it < NIT; it += NGW) {
        int r = it;
        if (r < I0) { p0_transpose_item(C, 0, C.w_in, IN_W, r / 273, r % 273, scr); continue; } r -= I0;
        if (r < I1) { p0_transpose_item(C, 1, C.w_pn, D, r / 64, r % 64, scr); continue; } r -= I1;
        if (r < I1) { p0_transpose_item(C, 2, C.w_ps, D, r / 64, r % 64, scr); continue; } r -= I1;
        if (r < I3) { p0_transpose_item(C, 3, C.w_out, D, r / 64, r % 64, scr); continue; } r -= I3;
        if (r < I4) { p0_transpose_item(C, 4, C.w_up, NUP, r / 344, r % 344, scr); continue; } r -= I4;
        if (r < I5) { p0_transpose_item(C, 5, C.w_dn, D, r / 64, r % 64, scr); continue; } r -= I5;
        if (r < I6) { p0_transpose_item(C, 6, C.cmp_w1, 256, r / 4, r % 4, scr); continue; } r -= I6;
        p0_transpose_item(C, 7, C.cmp_w1 + (size_t)4096 * 256, 256, r / 4, r % 4, scr);
    }
    const int gt = C.bid * NTHREADS + C.tid, NGT = C.G * NTHREADS;
    for (int i = gt; i < 16 * 128 * 128; i += NGT) { const int s = i & 127, t = (i >> 7) & 127; C.SGUW[i] = (f16)(s <= t ? C.sgu_w[i] : 0.f); }
    for (int i = gt; i < 2 * 128 * 256; i += NGT) { const int j = i & 255, d = (i >> 8) & 127, kk = i >> 15; C.W2T[i] = (f16)C.cmp_w2[(size_t)kk * 256 * 128 + j * 128 + d]; }
    for (int i = gt; i < 16 * D; i += NGT) C.WG[48 * D + i] = (f16)0.f;
    __syncthreads();
}

__device__ __forceinline__ void p1_norm(Ctx& C) {
    const int gw = C.bid * NWAVES + C.wave, NGW = C.G * NWAVES, lane = C.lane;
    LAS f32x4* const PV = (LAS f32x4*)C.lds;
    for (int i = C.tid; i < 2 * 1024; i += NTHREADS) { const int b = i >> 10, k = i & 1023;
        const f32x4 g0v = ((const f32x4*)(C.g_norms))[k], shv = ((const f32x4*)(C.mod + b * NMOD))[k], scv = ((const f32x4*)(C.mod + b * NMOD + D))[k];
        PV[(b * 2 + 0) * 1024 + k] = g0v * (scv + 1.0f); PV[(b * 2 + 1) * 1024 + k] = shv; }
    __syncthreads();
    for (int row = gw; row < M; row += NGW) {
        const int b = row >> 13; const f32x4* xr = (const f32x4*)(C.x + (size_t)row * D);
        f32x4 v[16]; float ss = 0.f;
#pragma unroll
        for (int j = 0; j < 16; ++j) { v[j] = xr[2 * (lane + 64 * (j >> 1)) + (j & 1)]; ss += (v[j].x * v[j].x + v[j].y * v[j].y) + (v[j].z * v[j].z + v[j].w * v[j].w); }
        const float rs = 1.0f / sqrtf(wave_sum(ss) * (1.0f / D) + EPS);
        const LAS f32x4* const B1 = PV + (b * 2 + 0) * 1024; const LAS f32x4* const B2 = PV + (b * 2 + 1) * 1024;
        u32x4* o = (u32x4*)(C.H + (size_t)row * D); u32x2* oq = (u32x2*)(C.ws + WS_H1Q + (size_t)row * D);
        float t[64];
#pragma unroll
        for (int j = 0; j < 16; ++j) { const int k = 2 * (lane + 64 * (j >> 1)) + (j & 1); v[j] = v[j] * rs * B1[k] + B2[k]; t[4 * j] = v[j].x; t[4 * j + 1] = v[j].y; t[4 * j + 2] = v[j].z; t[4 * j + 3] = v[j].w; }
#pragma unroll
        for (int jj = 0; jj < 8; ++jj) { u32x4 w; w.x = pkh(v[2 * jj].x, v[2 * jj].y); w.y = pkh(v[2 * jj].z, v[2 * jj].w); w.z = pkh(v[2 * jj + 1].x, v[2 * jj + 1].y); w.w = pkh(v[2 * jj + 1].z, v[2 * jj + 1].w); o[lane + 64 * jj] = w; }
        fwht64(t);
        float amax = 0.f;
#pragma unroll
        for (int i = 0; i < 64; ++i) amax = fmaxf(amax, fabsf(t[i]));
        amax = fmaxf(wave_max(amax), 1e-20f);
        const float qs = 127.0f / amax;
        if (lane == 0) ((float*)(C.ws + WS_SAH))[row] = amax * (1.0f / 127.0f);
#pragma unroll
        for (int jj = 0; jj < 8; ++jj) { u32x2 w; w.x = pk_i8(t[8 * jj] * qs, t[8 * jj + 1] * qs, t[8 * jj + 2] * qs, t[8 * jj + 3] * qs); w.y = pk_i8(t[8 * jj + 4] * qs, t[8 * jj + 5] * qs, t[8 * jj + 6] * qs, t[8 * jj + 7] * qs); oq[lane + 64 * jj] = w; }
    }
}
__device__ __forceinline__ void p1_quant_rows(Ctx& C, const f16* src, int nrows, signed char* dst, float* scale, bool bf, bool rot) {
    const int gw = C.bid * NWAVES + C.wave, NGW = C.G * NWAVES, lane = C.lane;
    for (int row = gw; row < nrows; row += NGW) {
        const u32x4* wr = (const u32x4*)(src + (size_t)row * D);
        float v[64]; float amax = 0.f;
#pragma unroll
        for (int j = 0; j < 8; ++j) { const u32x4 wv = wr[lane + 64 * j];
#pragma unroll
            for (int e = 0; e < 4; ++e) { const unsigned wd = wv[e]; float lo, hi;
                if (bf) { lo = __builtin_bit_cast(float, wd << 16); hi = __builtin_bit_cast(float, wd & 0xffff0000u); }
                else { const hx2 hv = __builtin_bit_cast(hx2, wd); lo = (float)hv.x; hi = (float)hv.y; }
                v[8 * j + 2 * e] = lo; v[8 * j + 2 * e + 1] = hi; } }
        if (rot) fwht64(v);
#pragma unroll
        for (int i = 0; i < 64; ++i) amax = fmaxf(amax, fabsf(v[i]));
        amax = fmaxf(wave_max(amax), 1e-30f);
        const float qs = 127.0f / amax;
        if (lane == 0) scale[row] = amax * (1.0f / 127.0f);
        u32x2* o = (u32x2*)(dst + (size_t)row * D);
#pragma unroll
        for (int j = 0; j < 8; ++j) { u32x2 w; w.x = pk_i8(v[8 * j] * qs, v[8 * j + 1] * qs, v[8 * j + 2] * qs, v[8 * j + 3] * qs); w.y = pk_i8(v[8 * j + 4] * qs, v[8 * j + 5] * qs, v[8 * j + 6] * qs, v[8 * j + 7] * qs); o[lane + 64 * j] = w; }
    }
}
__device__ __forceinline__ void rot128(float (&t)[8], int lane) {
#pragma unroll
    for (int h = 1; h < 8; h <<= 1)
#pragma unroll
        for (int i = 0; i < 8; ++i) if ((i & h) == 0) { const float a = t[i], b = t[i + h]; t[i] = a + b; t[i + h] = a - b; }
    const float s1 = (lane & 1) ? -1.f : 1.f, s2 = (lane & 2) ? -1.f : 1.f, s3 = (lane & 4) ? -1.f : 1.f, s4 = (lane & 8) ? -1.f : 1.f;
#pragma unroll
    for (int e = 0; e < 8; ++e) { float x = t[e];
        x = dpp_f<0xB1>(x) + s1 * x; x = dpp_f<0x4E>(x) + s2 * x; x = dpp_f<0x141>(x) + s3 * x; x = dpp_f<0x140>(x) + s4 * x;
        t[e] = x * 0.08838834764831845f; }
}
__device__ __forceinline__ void quant_rows_ff(Ctx& C, const f16* src, int nrows, signed char* dst, float* scale, bool bf, bool rms) {
    const int gw = C.bid * NWAVES + C.wave, NGW = C.G * NWAVES, lane = C.lane;
    for (int row = gw; row < nrows; row += NGW) {
        const u32x4* wr = (const u32x4*)(src + (size_t)row * DFF);
        float amax = 0.f;
        if (rms) {
            u32x4 wv[22];
#pragma unroll
            for (int i = 0; i < 22; ++i) { const int c = 64 * i + lane; wv[i] = c < DFF / 8 ? wr[c] : (u32x4){0u, 0u, 0u, 0u}; }
#pragma unroll
            for (int i = 0; i < 22; ++i)
#pragma unroll
                for (int e = 0; e < 4; ++e) { const unsigned wd = wv[i][e]; float lo, hi;
                    if (bf) { lo = __builtin_bit_cast(float, wd << 16); hi = __builtin_bit_cast(float, wd & 0xffff0000u); }
                    else { const hx2 hv = __builtin_bit_cast(hx2, wd); lo = (float)hv.x; hi = (float)hv.y; }
                    amax += lo * lo + hi * hi; }
            amax = fmaxf(5.0f * sqrtf(wave_sum(amax) * (1.0f / DFF)), 1e-30f);
            const float qs1 = 127.0f / amax;
            if (lane == 0) scale[row] = amax * (1.0f / 127.0f);
            u32x2* o1 = (u32x2*)(dst + (size_t)row * DFF);
#pragma unroll
            for (int i = 0; i < 22; ++i) { const int c = 64 * i + lane; const bool ok = c < DFF / 8; float t[8];
#pragma unroll
                for (int e = 0; e < 4; ++e) { const unsigned wd = wv[i][e];
                    if (bf) { t[2 * e] = __builtin_bit_cast(float, wd << 16); t[2 * e + 1] = __builtin_bit_cast(float, wd & 0xffff0000u); }
                    else { const hx2 hv = __builtin_bit_cast(hx2, wd); t[2 * e] = (float)hv.x; t[2 * e + 1] = (float)hv.y; } }
                rot128(t, lane);
                if (ok) { u32x2 w; w.x = pk_i8(t[0] * qs1, t[1] * qs1, t[2] * qs1, t[3] * qs1); w.y = pk_i8(t[4] * qs1, t[5] * qs1, t[6] * qs1, t[7] * qs1); o1[c] = w; } }
            continue;
        }
        if (rms) {
#pragma unroll 1
            for (int cb = 0; cb < DFF / 8; cb += 704) { u32x4 wv[11];
#pragma unroll
                for (int i = 0; i < 11; ++i) { const int c = cb + 64 * i + lane; wv[i] = c < DFF / 8 ? wr[c] : (u32x4){0u, 0u, 0u, 0u}; }
#pragma unroll
                for (int i = 0; i < 11; ++i)
#pragma unroll
                    for (int e = 0; e < 4; ++e) { const unsigned wd = wv[i][e]; float lo, hi;
                        if (bf) { lo = __builtin_bit_cast(float, wd << 16); hi = __builtin_bit_cast(float, wd & 0xffff0000u); }
                        else { const hx2 hv = __builtin_bit_cast(hx2, wd); lo = (float)hv.x; hi = (float)hv.y; }
                        amax += lo * lo + hi * hi; } }
        } else {
#pragma unroll 1
            for (int cb = 0; cb < DFF / 8; cb += 704) { u32x4 wv[11];
#pragma unroll
                for (int i = 0; i < 11; ++i) { const int c = cb + 64 * i + lane; wv[i] = c < DFF / 8 ? wr[c] : (u32x4){0u, 0u, 0u, 0u}; }
#pragma unroll
                for (int i = 0; i < 11; ++i) { float t[8];
#pragma unroll
                    for (int e = 0; e < 4; ++e) { const unsigned wd = wv[i][e];
                        if (bf) { t[2 * e] = __builtin_bit_cast(float, wd << 16); t[2 * e + 1] = __builtin_bit_cast(float, wd & 0xffff0000u); }
                        else { const hx2 hv = __builtin_bit_cast(hx2, wd); t[2 * e] = (float)hv.x; t[2 * e + 1] = (float)hv.y; } }
                    rot128(t, lane);
#pragma unroll
                    for (int e = 0; e < 8; ++e) amax = fmaxf(amax, fabsf(t[e])); } } }
        amax = rms ? fmaxf(5.0f * sqrtf(wave_sum(amax) * (1.0f / DFF)), 1e-30f) : fmaxf(wave_max(amax), 1e-30f);
        const float qs = 127.0f / amax;
        if (lane == 0) scale[row] = amax * (1.0f / 127.0f);
        u32x2* o = (u32x2*)(dst + (size_t)row * DFF);
#pragma unroll 1
        for (int cb = 0; cb < DFF / 8; cb += 704) { u32x4 wq[11];
#pragma unroll
            for (int i = 0; i < 11; ++i) { const int c = cb + 64 * i + lane; wq[i] = c < DFF / 8 ? wr[c] : (u32x4){0u, 0u, 0u, 0u}; }
#pragma unroll
            for (int i = 0; i < 11; ++i) { const int c = cb + 64 * i + lane; const bool ok = c < DFF / 8; float t[8];
#pragma unroll
                for (int e = 0; e < 4; ++e) { const unsigned wd = wq[i][e];
                    if (bf) { t[2 * e] = __builtin_bit_cast(float, wd << 16); t[2 * e + 1] = __builtin_bit_cast(float, wd & 0xffff0000u); }
                    else { const hx2 hv = __builtin_bit_cast(hx2, wd); t[2 * e] = (float)hv.x; t[2 * e + 1] = (float)hv.y; } }
                rot128(t, lane);
                if (ok) { u32x2 w; w.x = pk_i8(t[0] * qs, t[1] * qs, t[2] * qs, t[3] * qs); w.y = pk_i8(t[4] * qs, t[5] * qs, t[6] * qs, t[7] * qs); o[c] = w; } } }
    }
}
__device__ __forceinline__ void p1_quant_weights(Ctx& C) {
    quant_rows_ff(C, C.WDN, D, (signed char*)(C.ws + WS_WDNQ), (float*)(C.ws + WS_SWDN), FFN_BF16 != 0, false);
    p1_quant_rows(C, C.WIN + (size_t)3072 * D, 13312, (signed char*)(C.ws + WS_WINQ), (float*)(C.ws + WS_SWQ), false, true);
    p1_quant_rows(C, C.WVT, 1024, (signed char*)(C.ws + WS_WVTQ), (float*)(C.ws + WS_SWQ) + 13312, false, true);
    p1_quant_rows(C, C.WUP, NUP, (signed char*)(C.ws + WS_WUPQ), (float*)(C.ws + WS_SW), FFN_BF16 != 0, true);
}
__device__ __forceinline__ void p7_norm(Ctx& C) {
    const int gw = C.bid * NWAVES + C.wave, NGW = C.G * NWAVES, lane = C.lane;
    LAS f32x4* const PV = (LAS f32x4*)C.lds;
    for (int i = C.tid; i < 2 * 1024; i += NTHREADS) { const int b = i >> 10, k = i & 1023;
        const f32x4 g1v = ((const f32x4*)(C.g_norms + D))[k], g2v = ((const f32x4*)(C.g_norms + 2 * D))[k];
        const f32x4 gtv = ((const f32x4*)(C.mod + b * NMOD + 2 * D))[k], shv = ((const f32x4*)(C.mod + b * NMOD + 3 * D))[k], scv = ((const f32x4*)(C.mod + b * NMOD + 4 * D))[k];
        PV[(b * 3 + 0) * 1024 + k] = gtv * g1v; PV[(b * 3 + 1) * 1024 + k] = g2v * (scv + 1.0f); PV[(b * 3 + 2) * 1024 + k] = shv; }
    __syncthreads();
    for (int row = gw; row < M; row += NGW) {
        const int b = row >> 13; const hx8* yr = (const hx8*)(C.Y1 + (size_t)row * D); const f32x4* xr = (const f32x4*)(C.x + (size_t)row * D); u32x2* orow = (u32x2*)(C.X1H + (size_t)row * D);
        f32x4 v[16]; float ss = 0.f;
#pragma unroll
        for (int j = 0; j < 8; ++j) { const hx8 hv = yr[lane + 64 * j];
            v[2 * j] = (f32x4){(float)hv[0], (float)hv[1], (float)hv[2], (float)hv[3]}; v[2 * j + 1] = (f32x4){(float)hv[4], (float)hv[5], (float)hv[6], (float)hv[7]}; }
#pragma unroll
        for (int j = 0; j < 16; ++j) ss += (v[j].x * v[j].x + v[j].y * v[j].y) + (v[j].z * v[j].z + v[j].w * v[j].w);
        const float rs = 1.0f / sqrtf(wave_sum(ss) * (1.0f / D) + EPS);
        const LAS f32x4* const A1 = PV + (b * 3 + 0) * 1024; const LAS f32x4* const A2 = PV + (b * 3 + 1) * 1024; const LAS f32x4* const A3 = PV + (b * 3 + 2) * 1024;
        float s2 = 0.f;
#pragma unroll
        for (int j = 0; j < 16; ++j) { const int k = 2 * (lane + 64 * (j >> 1)) + (j & 1); v[j] = xr[k] + A1[k] * (v[j] * rs); { u32x2 xw; xw.x = pkh(v[j].x, v[j].y); xw.y = pkh(v[j].z, v[j].w); orow[k] = xw; } s2 += (v[j].x * v[j].x + v[j].y * v[j].y) + (v[j].z * v[j].z + v[j].w * v[j].w); }
        const float rs2 = 1.0f / sqrtf(wave_sum(s2) * (1.0f / D) + EPS);
        float amax = 0.f;
        { float t[64];
#pragma unroll
          for (int j = 0; j < 16; ++j) { const int k = 2 * (lane + 64 * (j >> 1)) + (j & 1); const f32x4 hv = v[j] * rs2 * A2[k] + A3[k]; t[4 * j] = hv.x; t[4 * j + 1] = hv.y; t[4 * j + 2] = hv.z; t[4 * j + 3] = hv.w; }
          fwht64(t);
#pragma unroll
          for (int j = 0; j < 16; ++j) { v[j] = (f32x4){t[4 * j], t[4 * j + 1], t[4 * j + 2], t[4 * j + 3]};
              amax = fmaxf(amax, fmaxf(fmaxf(fabsf(v[j].x), fabsf(v[j].y)), fmaxf(fabsf(v[j].z), fabsf(v[j].w)))); } }
        amax = fmaxf(wave_max(amax), 1e-20f);
        const float qs = 127.0f / amax;
        const bool halo = (row & 255) >= 254; const int hrow = M + 2 * (row >> 8) + (row & 1);
        if (lane == 0) { ((float*)(C.ws + WS_SA))[row] = amax * (1.0f / 127.0f); if (halo) ((float*)(C.ws + WS_SA))[hrow] = amax * (1.0f / 127.0f); }
        u32x2* o = (u32x2*)(((signed char*)(C.ws + WS_H2)) + (size_t)row * D); u32x2* oh = (u32x2*)(((signed char*)(C.ws + WS_H2)) + (size_t)hrow * D);
#pragma unroll
        for (int j = 0; j < 8; ++j) { u32x2 w; w.x = pk_i8(v[2 * j].x * qs, v[2 * j].y * qs, v[2 * j].z * qs, v[2 * j].w * qs); w.y = pk_i8(v[2 * j + 1].x * qs, v[2 * j + 1].y * qs, v[2 * j + 1].z * qs, v[2 * j + 1].w * qs);
            o[lane + 64 * j] = w; if (halo) oh[lane + 64 * j] = w; }
    }
}
__device__ __forceinline__ void p11_final(Ctx& C) {
    const int gw = C.bid * NWAVES + C.wave, NGW = C.G * NWAVES, lane = C.lane;
    LAS f32x4* const PV = (LAS f32x4*)C.lds;
    for (int i = C.tid; i < 2 * 1024; i += NTHREADS) { const int b = i >> 10, k = i & 1023; PV[i] = ((const f32x4*)(C.mod + b * NMOD + 5 * D))[k] * ((const f32x4*)(C.g_norms + 3 * D))[k]; }
    __syncthreads();
    for (int row = gw; row < M; row += NGW) {
        const int b = row >> 13; f32x4* orow = (f32x4*)(C.out + (size_t)row * D); const hx8* yr = (const hx8*)(C.Y2 + (size_t)row * D); const hx8* xr = (const hx8*)(C.X1H + (size_t)row * D);
        f32x4 v[16]; float ss = 0.f;
#pragma unroll
        for (int j = 0; j < 8; ++j) { const hx8 hv = yr[lane + 64 * j];
            v[2 * j] = (f32x4){(float)hv[0], (float)hv[1], (float)hv[2], (float)hv[3]}; v[2 * j + 1] = (f32x4){(float)hv[4], (float)hv[5], (float)hv[6], (float)hv[7]}; }
#pragma unroll
        for (int j = 0; j < 16; ++j) ss += (v[j].x * v[j].x + v[j].y * v[j].y) + (v[j].z * v[j].z + v[j].w * v[j].w);
        const float rs = 1.0f / sqrtf(wave_sum(ss) * (1.0f / D) + EPS);
        const LAS f32x4* const G3 = PV + b * 1024;
#pragma unroll
        for (int j = 0; j < 8; ++j) { const hx8 xv = xr[lane + 64 * j]; const int k = 2 * (lane + 64 * j);
            const f32x4 x0 = {(float)xv[0], (float)xv[1], (float)xv[2], (float)xv[3]}, x1 = {(float)xv[4], (float)xv[5], (float)xv[6], (float)xv[7]};
            orow[k] = x0 + G3[k] * (v[2 * j] * rs); orow[k + 1] = x1 + G3[k + 1] * (v[2 * j + 1] * rs); }
    }
}

__device__ __forceinline__ void p3_gates_item(Ctx& C, int item) {
    const int lane = C.lane, w = C.wave, qr = lane & 15, q = lane >> 4;
    const f16* ap = C.H + (size_t)(item * 64 + qr) * D + w * 512 + 8 * q;
    const f16* bp = C.WG + (size_t)qr * D + w * 512 + 8 * q;
    f32x4 acc[4][3];
#pragma unroll
    for (int mt = 0; mt < 4; ++mt)
#pragma unroll
        for (int nt = 0; nt < 3; ++nt) acc[mt][nt] = (f32x4){0.f, 0.f, 0.f, 0.f};
#pragma unroll 4
    for (int ks = 0; ks < 16; ++ks) { hx8 a[4], bfr[3];
#pragma unroll
        for (int mt = 0; mt < 4; ++mt) a[mt] = *(const hx8*)(ap + (size_t)mt * 16 * D + 32 * ks);
#pragma unroll
        for (int nt = 0; nt < 3; ++nt) bfr[nt] = *(const hx8*)(bp + (size_t)nt * 16 * D + 32 * ks);
#pragma unroll
        for (int mt = 0; mt < 4; ++mt)
#pragma unroll
            for (int nt = 0; nt < 3; ++nt) acc[mt][nt] = __builtin_amdgcn_mfma_f32_16x16x32_f16(a[mt], bfr[nt], acc[mt][nt], 0, 0, 0); }
    LAS f32x4* red = (LAS f32x4*)C.lds;
#pragma unroll
    for (int mt = 0; mt < 4; ++mt)
#pragma unroll
        for (int nt = 0; nt < 3; ++nt) red[(w * 12 + mt * 3 + nt) * 64 + lane] = acc[mt][nt];
    __syncthreads();
    for (int t = w; t < 12; t += NWAVES) { const int mt = t / 3, nt = t % 3; f32x4 s = red[t * 64 + lane];
#pragma unroll
        for (int k = 1; k < 8; ++k) s += red[(k * 12 + t) * 64 + lane];
#pragma unroll
        for (int i = 0; i < 4; ++i) C.gates[(size_t)(item * 64 + mt * 16 + 4 * q + i) * 48 + nt * 16 + qr] = fsigmoid(s[i]); }
    __syncthreads();
}
__device__ __forceinline__ void p3_compress_item(Ctx& C, int item) {
    const int lane = C.lane, w = C.wave, qr = lane & 15, q = lane >> 4, kk = item >> 7, R0 = (item & 127) * 32;
    LAS f16* hid = (LAS f16*)C.lds;
    LAS unsigned char* abuf = C.lds + 20480;
    const int srow = C.tid >> 4, sseg = C.tid & 15;
    const f16* sp;
    { const int R = R0 + srow, b = R >> 11, g = (R >> 9) & 3, n = R & 511, nc = n > 510 ? 510 : n; sp = C.KV + (size_t)(b * T + 16 * nc) * 2048 + kk * 512 + g * 128 + 8 * sseg; }
    const int sdst = (srow * 16 + (sseg ^ (srow & 15))) * 16;
    const f16* pb0 = C.W1T + (size_t)(kk * 256 + 32 * w + qr) * D + 8 * q; const f16* pb1 = pb0 + (size_t)16 * D;
    f32x4 acc[2][2] = {{{0.f, 0.f, 0.f, 0.f}, {0.f, 0.f, 0.f, 0.f}}, {{0.f, 0.f, 0.f, 0.f}, {0.f, 0.f, 0.f, 0.f}}};
    hx8 fb[2][8]; hx8 nxt = *(const hx8*)sp; sp += 2048;
#define CM_LOADB(buf) do { _Pragma("unroll") for (int k4 = 0; k4 < 4; ++k4) { fb[buf][2 * k4] = *(const hx8*)(pb0 + 32 * k4); fb[buf][2 * k4 + 1] = *(const hx8*)(pb1 + 32 * k4); } pb0 += 128; pb1 += 128; } while (0)
#define CM_STEP(c, buf) do { *(LAS hx8*)(abuf + ((c) & 1) * 8192 + sdst) = nxt; \
        if ((c) + 1 < 32) { nxt = *(const hx8*)sp; sp += 2048; CM_LOADB((buf) ^ 1); } \
        __syncthreads(); \
        hx8 af_[8]; _Pragma("unroll") for (int i_ = 0; i_ < 8; ++i_) { const int mt_ = i_ >> 2, k4_ = i_ & 3; af_[i_] = *(const LAS hx8*)(abuf + ((c) & 1) * 8192 + ((16 * mt_ + qr) * 16 + ((4 * k4_ + q) ^ qr)) * 16); } \
        _Pragma("unroll") for (int k4 = 0; k4 < 4; ++k4) { \
            acc[0][0] = __builtin_amdgcn_mfma_f32_16x16x32_f16(af_[k4], fb[buf][2 * k4], acc[0][0], 0, 0, 0); acc[0][1] = __builtin_amdgcn_mfma_f32_16x16x32_f16(af_[k4], fb[buf][2 * k4 + 1], acc[0][1], 0, 0, 0); \
            acc[1][0] = __builtin_amdgcn_mfma_f32_16x16x32_f16(af_[4 + k4], fb[buf][2 * k4], acc[1][0], 0, 0, 0); acc[1][1] = __builtin_amdgcn_mfma_f32_16x16x32_f16(af_[4 + k4], fb[buf][2 * k4 + 1], acc[1][1], 0, 0, 0); } } while (0)
    CM_LOADB(0);
#pragma unroll 1
    for (int c = 0; c < 32; c += 2) { CM_STEP(c, 0); CM_STEP(c + 1, 1); }
#undef CM_LOADB
#undef CM_STEP
    __syncthreads();
#pragma unroll
    for (int mt = 0; mt < 2; ++mt)
#pragma unroll
        for (int nt = 0; nt < 2; ++nt) { const int j = 32 * w + 16 * nt + qr; const float pb = C.posw1[kk * 256 + j];
#pragma unroll
            for (int i = 0; i < 4; ++i) hid[(16 * mt + 4 * q + i) * 264 + j] = (f16)fgelu(acc[mt][nt][i] + pb); }
    __syncthreads();
    const f16* wp = C.W2T + (size_t)(kk * 128 + 16 * w + qr) * 256 + 8 * q;
    f32x4 o2[2] = {{0.f, 0.f, 0.f, 0.f}, {0.f, 0.f, 0.f, 0.f}};
#pragma unroll
    for (int ks = 0; ks < 8; ++ks) { const hx8 wf = *(const hx8*)(wp + 32 * ks);
#pragma unroll
        for (int mt = 0; mt < 2; ++mt) { const hx8 hf = *(const LAS hx8*)(hid + (16 * mt + qr) * 264 + 32 * ks + 8 * q);
            if (kk == 0) o2[mt] = __builtin_amdgcn_mfma_f32_16x16x32_f16(wf, hf, o2[mt], 0, 0, 0);
            else o2[mt] = __builtin_amdgcn_mfma_f32_16x16x32_f16(hf, wf, o2[mt], 0, 0, 0); } }
    if (kk == 0) {
#pragma unroll
        for (int mt = 0; mt < 2; ++mt) { const int R = R0 + 16 * mt + qr, n = R & 511, d0 = 16 * w + 4 * q; const bool pad = n == 511;
            float v[4];
#pragma unroll
            for (int i = 0; i < 4; ++i) v[i] = pad ? 0.f : o2[mt][i] + C.cmp_b2[d0 + i];
            u32x2 o; o.x = pkh(v[0], v[1]); o.y = pkh(v[2], v[3]); *(u32x2*)(C.KC + (size_t)R * 128 + d0) = o; }
    } else {
#pragma unroll
        for (int mt = 0; mt < 2; ++mt) { const int Rb = R0 + 16 * mt + 4 * q, bg = Rb >> 9, n0 = Rb & 511, d = 16 * w + qr; const float bb = C.cmp_b2[128 + d];
            float v[4];
#pragma unroll
            for (int i = 0; i < 4; ++i) v[i] = (n0 + i == 511) ? 0.f : o2[mt][i] + bb;
            u32x2 o; o.x = pkh(v[0], v[1]); o.y = pkh(v[2], v[3]); *(u32x2*)(C.VCT + ((size_t)bg * 128 + d) * 512 + n0) = o; }
    }
    __syncthreads();
}
__device__ __forceinline__ void p3_sgu_item(Ctx& C, int item) {
    const int lane = C.lane, w = C.wave, tid = C.tid, qr = lane & 15, q = lane >> 4, r0 = (item >> 1) * 128, half = item & 1;
    LAS float* stats = (LAS float*)C.lds;
    LAS f16* vt = (LAS f16*)(C.lds + 1024);
#pragma unroll 4
    for (int tk = 0; tk < 16; ++tk) { const int s = 16 * w + tk; const f16* vp = C.Z + (size_t)(r0 + s) * D + 2048 + 8 * lane;
        float xv[32]; float sum = 0.f;
#pragma unroll
        for (int jj = 0; jj < 4; ++jj) { const hx8 h = *(const hx8*)(vp + 512 * jj);
#pragma unroll
            for (int e = 0; e < 8; ++e) { xv[8 * jj + e] = (float)h[e]; sum += xv[8 * jj + e]; } }
        const float mu = wave_sum(sum) * (1.0f / 2048.0f); float sq = 0.f;
#pragma unroll
        for (int e = 0; e < 32; ++e) { const float dv = xv[e] - mu; sq += dv * dv; }
        const float var = wave_sum(sq) * (1.0f / 2048.0f);
        if (lane == 0) { stats[2 * s] = mu; stats[2 * s + 1] = 1.0f / sqrtf(var + EPS); } }
    __syncthreads();
    hx8 hv[4];
    { const int s = tid >> 2, seg = tid & 3; const f16* vp = C.Z + (size_t)(r0 + s) * D + 2048 + (half * 8) * 128 + 32 * seg;
#pragma unroll
      for (int i = 0; i < 4; ++i) hv[i] = *(const hx8*)(vp + 8 * i); }
#pragma unroll 1
    for (int gi = 0; gi < 8; ++gi) { const int hh = half * 8 + gi;
        hx8 wf[4], hvn[4]; hx4 uu[8];
#pragma unroll
        for (int ks = 0; ks < 4; ++ks) wf[ks] = *(const hx8*)(C.SGUW + ((size_t)(hh * 128 + 16 * w + qr)) * 128 + 32 * ks + 8 * q);
        { const f16* up = C.Z + (size_t)(r0 + 16 * w + qr) * D + hh * 128 + 4 * q;
#pragma unroll
          for (int dt = 0; dt < 8; ++dt) uu[dt] = *(const hx4*)(up + 16 * dt); }
        { const int s = tid >> 2, seg = tid & 3; const f16* vp = C.Z + (size_t)(r0 + s) * D + 2048 + (gi < 7 ? hh + 1 : hh) * 128 + 32 * seg;
#pragma unroll
          for (int i = 0; i < 4; ++i) hvn[i] = *(const hx8*)(vp + 8 * i); }
        { const int s = tid >> 2, seg = tid & 3; const float mu = stats[2 * s], rstd = stats[2 * s + 1];
#pragma unroll
          for (int i = 0; i < 4; ++i) { const hx8 h = hv[i];
#pragma unroll
              for (int e = 0; e < 8; ++e) { const int d = 32 * seg + 8 * i + e; const float y = ((float)h[e] - mu) * rstd * C.ln_g[hh * 128 + d] + C.ln_b[hh * 128 + d]; vt[d * 136 + s] = (f16)y; } } }
        __syncthreads();
        f32x4 acc[8];
#pragma unroll
        for (int dt = 0; dt < 8; ++dt) { acc[dt] = (f32x4){0.f, 0.f, 0.f, 0.f};
#pragma unroll
            for (int ks = 0; ks < 4; ++ks) { const hx8 af = *(const LAS hx8*)(vt + (16 * dt + qr) * 136 + 32 * ks + 8 * q); acc[dt] = __builtin_amdgcn_mfma_f32_16x16x32_f16(af, wf[ks], acc[dt], 0, 0, 0); } }
        { const int tl = 16 * w + qr; const float bs = C.sgu_b[hh * 128 + tl];
          f16* yp = C.YAB + (size_t)(r0 + tl) * D + 2048 + hh * 128 + 4 * q;
#pragma unroll
          for (int dt = 0; dt < 8; ++dt) { const hx4 u = uu[dt];
              u32x2 o; o.x = pk_mix((float)u[0] * (acc[dt][0] + bs), (float)u[1] * (acc[dt][1] + bs)); o.y = pk_mix((float)u[2] * (acc[dt][2] + bs), (float)u[3] * (acc[dt][3] + bs));
              *(u32x2*)(yp + 16 * dt) = o; } }
        __syncthreads();
#pragma unroll
        for (int i = 0; i < 4; ++i) hv[i] = hvn[i];
    }
}

constexpr int ATT_LUT = 0, ATT_IMP = 8192, ATT_STG = 40960, STG_BYTES = 32768, STG_V = 16384;
static_assert(ATT_STG + 3 * STG_BYTES <= MISC_OFF, "attention LDS map");
__device__ __forceinline__ int rel_bucket_small(int n) {
    if (n < 16) return n;
    int b = 16;
    b += n >= 19; b += n >= 21; b += n >= 24; b += n >= 27; b += n >= 31; b += n >= 35; b += n >= 40; b += n >= 46; b += n >= 52; b += n >= 59; b += n >= 67; b += n >= 77; b += n >= 87; b += n >= 99; b += n >= 113;
    return b;
}
__device__ __forceinline__ void att_issue(Ctx& C, int s, int n_c, int n_s, int ks0g, int b, int g) {
    const int lane = (int)pg8::opaque((unsigned)C.lane), w = C.wave;
    const f16* kb; const f16* vb; int ldk, ldv, kb0;
    if (s < 2 * n_c) { kb0 = 64 * (s < n_c ? s : s - n_c); kb = C.KC + (size_t)(b * 4 + g) * 512 * 128; ldk = 128; vb = C.VCT + (size_t)(b * 4 + g) * 128 * 512; ldv = 512; }
    else if (s < 2 * n_c + n_s) { kb0 = 64 * (s - 2 * n_c); kb = C.KV + (size_t)b * T * 2048 + 1024 + g * 128; ldk = 2048; vb = C.VT + (size_t)(g * 128) * M + (size_t)b * T; ldv = M; }
    else { kb0 = ks0g + 64 * (s - 2 * n_c - n_s); kb = C.KV + (size_t)b * T * 2048 + 1536 + g * 128; ldk = 2048; vb = C.VT + (size_t)(512 + g * 128) * M + (size_t)b * T; ldv = M; }
    LAS unsigned char* buf = C.lds + ATT_STG + (s % 3) * STG_BYTES;
#pragma unroll
    for (int i = 0; i < 2; ++i) { const int R = 8 * w + 4 * i + (lane >> 4), m = R & 15, key = kb0 + 32 * (R >> 5) + (m >> 2) * 8 + (m & 3) + 4 * ((R >> 4) & 1), cidx = (lane & 15) ^ m;
        __builtin_amdgcn_global_load_lds((const unsigned*)(kb + (size_t)key * ldk + cidx * 8), (LAS unsigned*)(buf + (8 * w + 4 * i) * 256), 16, 0, 0); }
#pragma unroll
    for (int i = 0; i < 2; ++i) { const int dr = 16 * w + 8 * i + (lane >> 3), v = (lane & 7) ^ ((dr & 15) >> 1);
        __builtin_amdgcn_global_load_lds((const unsigned*)(vb + (size_t)dr * ldv + kb0 + 8 * v), (LAS unsigned*)(buf + STG_V + (16 * w + 8 * i) * 128), 16, 0, 0); }
}
#define SB() __builtin_amdgcn_sched_barrier(0)
#define ATT_QK2(TL) do { _Pragma("unroll") for (int scn_ = 0; scn_ < 2; ++scn_) { hx8 kf_[8]; \
        _Pragma("unroll") for (int i_ = 0; i_ < 8; ++i_) { const int kt_ = i_ >> 2, ks_ = i_ & 3; \
            kf_[i_] = *(const LAS hx8*)(bufp + scn_ * 8192 + kt_ * 4096 + qr * 256 + (((4 * ks_ + q) ^ qr) << 4)); } \
        __builtin_amdgcn_s_setprio(1); \
        _Pragma("unroll") for (int t_ = 0; t_ < 2; ++t_) { f32x4 a_ = {0.f, 0.f, 0.f, 0.f}; \
            _Pragma("unroll") for (int ks = 0; ks < 4; ++ks) a_ = __builtin_amdgcn_mfma_f32_16x16x32_f16(kf_[4 * t_ + ks], qf[TL][ks], a_, 0, 0, 0); sv[TL][2 * scn_ + t_] = a_; } \
        __builtin_amdgcn_s_setprio(0); } } while (0)
#define ATT_QK2B() do { hx8 kfa_[8], kfb_[8]; \
        _Pragma("unroll") for (int i_ = 0; i_ < 8; ++i_) { const int kt_ = i_ >> 2, ks_ = i_ & 3; \
            kfa_[i_] = *(const LAS hx8*)(bufp + kt_ * 4096 + qr * 256 + (((4 * ks_ + q) ^ qr) << 4)); } \
        _Pragma("unroll") for (int i_ = 0; i_ < 8; ++i_) { const int kt_ = i_ >> 2, ks_ = i_ & 3; \
            kfb_[i_] = *(const LAS hx8*)(bufp + 8192 + kt_ * 4096 + qr * 256 + (((4 * ks_ + q) ^ qr) << 4)); } \
        SB(); asm volatile("s_waitcnt lgkmcnt(8)" ::: "memory"); __builtin_amdgcn_s_setprio(1); \
        _Pragma("unroll") for (int t_ = 0; t_ < 2; ++t_) { f32x4 a0_ = {0.f, 0.f, 0.f, 0.f}, a1_ = {0.f, 0.f, 0.f, 0.f}; \
            _Pragma("unroll") for (int ks = 0; ks < 4; ++ks) { a0_ = __builtin_amdgcn_mfma_f32_16x16x32_f16(kfa_[4 * t_ + ks], qf[0][ks], a0_, 0, 0, 0); a1_ = __builtin_amdgcn_mfma_f32_16x16x32_f16(kfa_[4 * t_ + ks], qf[1][ks], a1_, 0, 0, 0); } \
            sv[0][t_] = a0_; sv[1][t_] = a1_; } \
        SB(); \
        _Pragma("unroll") for (int t_ = 0; t_ < 2; ++t_) { f32x4 a0_ = {0.f, 0.f, 0.f, 0.f}, a1_ = {0.f, 0.f, 0.f, 0.f}; \
            _Pragma("unroll") for (int ks = 0; ks < 4; ++ks) { a0_ = __builtin_amdgcn_mfma_f32_16x16x32_f16(kfb_[4 * t_ + ks], qf[0][ks], a0_, 0, 0, 0); a1_ = __builtin_amdgcn_mfma_f32_16x16x32_f16(kfb_[4 * t_ + ks], qf[1][ks], a1_, 0, 0, 0); } \
            sv[0][2 + t_] = a0_; sv[1][2 + t_] = a1_; } \
        __builtin_amdgcn_s_setprio(0); } while (0)
#define SVJ(tl, j) (sv[tl][(j) >> 2][(j) & 3])
#define ATT_PV2(SC) do { SB(); hx8 vfa_[8], vfb_[4]; \
    _Pragma("unroll") for (int dt_ = 0; dt_ < 8; ++dt_) vfa_[dt_] = *(const LAS hx8*)(bufp + STG_V + qr * 128 + (((q) ^ (qr >> 1)) << 4) + dt_ * 2048); \
    _Pragma("unroll") for (int dt_ = 0; dt_ < 4; ++dt_) vfb_[dt_] = *(const LAS hx8*)(bufp + STG_V + qr * 128 + (((4 + q) ^ (qr >> 1)) << 4) + dt_ * 2048); \
    SB(); asm volatile("s_waitcnt lgkmcnt(4)" ::: "memory"); \
    _Pragma("unroll") for (int tl_ = 0; tl_ < 2; ++tl_) { if (act[tl_]) { _Pragma("unroll") for (int dt = 0; dt < 8; ++dt) { f32x4 c_ = o[tl_][dt]; if (SC) c_ *= oal[tl_]; \
        o[tl_][dt] = __builtin_amdgcn_mfma_f32_16x16x32_f16(vfa_[dt], pf[tl_][0], c_, 0, 0, 0); } } } \
    SB(); \
    _Pragma("unroll") for (int dt_ = 0; dt_ < 4; ++dt_) vfa_[dt_] = *(const LAS hx8*)(bufp + STG_V + qr * 128 + (((4 + q) ^ (qr >> 1)) << 4) + (4 + dt_) * 2048); \
    _Pragma("unroll") for (int tl_ = 0; tl_ < 2; ++tl_) { if (act[tl_]) { _Pragma("unroll") for (int dt = 0; dt < 4; ++dt) \
        o[tl_][dt] = __builtin_amdgcn_mfma_f32_16x16x32_f16(vfb_[dt], pf[tl_][1], o[tl_][dt], 0, 0, 0); } } \
    SB(); \
    _Pragma("unroll") for (int tl_ = 0; tl_ < 2; ++tl_) { if (act[tl_]) { _Pragma("unroll") for (int dt = 0; dt < 4; ++dt) \
        o[tl_][4 + dt] = __builtin_amdgcn_mfma_f32_16x16x32_f16(vfa_[dt], pf[tl_][1], o[tl_][4 + dt], 0, 0, 0); } } \
    SB(); } while (0)
#define ATT_MAXUPD(TL, RESCALE_O) do { float al_ = 1.0f; if (__any(cm_ > m[TL] + 8.0f)) { cm_ = fmaxf(cm_, __shfl_xor(cm_, 16)); cm_ = fmaxf(cm_, __shfl_xor(cm_, 32)); \
    const float mn_ = fmaxf(m[TL], cm_); al_ = __builtin_amdgcn_exp2f(m[TL] - mn_); m[TL] = mn_; } l[TL] *= al_; if (RESCALE_O) oal[TL] = al_; } while (0)
#define ATT_PACKP(TL) do { _Pragma("unroll") for (int j = 0; j < 8; ++j) { pf[TL][0][j] = (f16)p[j]; pf[TL][1][j] = (f16)p[8 + j]; } } while (0)
#define ATT_SOFTMAX_FAR(TL, cb_, RESCALE_O) do { float mx_ = SVJ(TL, 0); _Pragma("unroll") for (int j = 1; j < 16; ++j) mx_ = fmaxf(mx_, SVJ(TL, j)); \
    float cm_ = mx_ * SC2 + (cb_); ATT_MAXUPD(TL, RESCALE_O); const float off_ = (cb_) - m[TL]; float ps_ = 0.f; \
    _Pragma("unroll") for (int j = 0; j < 16; ++j) { const float e_ = __builtin_amdgcn_exp2f(SVJ(TL, j) * SC2 + off_); ps_ += e_; pf[TL][j >> 3][j & 7] = (f16)e_; } l[TL] += ps_; } while (0)
#define ATT_SOFTMAX_NEAR(TL, RESCALE_O) do { float cm_ = sc[0]; _Pragma("unroll") for (int j = 1; j < 16; ++j) cm_ = fmaxf(cm_, sc[j]); \
    ATT_MAXUPD(TL, RESCALE_O); float ps_ = 0.f; \
    _Pragma("unroll") for (int j = 0; j < 16; ++j) { const float e_ = __builtin_amdgcn_exp2f(sc[j] - m[TL]); ps_ += e_; pf[TL][j >> 3][j & 7] = (f16)e_; } l[TL] += ps_; } while (0)
#define ATT_STAGE_BEGIN() do { TP_BEGIN(8); if (s + 1 < S) asm volatile("s_waitcnt vmcnt(4)" ::: "memory"); else asm volatile("s_waitcnt vmcnt(0)" ::: "memory"); \
    __builtin_amdgcn_s_barrier(); asm volatile("" ::: "memory"); TP_END(8); \
    if (s + 2 < S) att_issue(C, s + 2, n_c, n_s, ks0g, b, g); \
    bufp = C.lds + ATT_STG + (s % 3) * STG_BYTES; } while (0)
constexpr float NEGBIG = -3.0e38f;

#define TP_BEGIN(r) do { if (ATT_TPROBE == (r)) tp_t0 = (long long)wall_clock64(); } while (0)
#define TP_END(r) do { if (ATT_TPROBE == (r)) tp_acc += (long long)wall_clock64() - tp_t0; } while (0)
__device__ __forceinline__ void p4_attn_unit(Ctx& C, int u, long long& tp_acc) {
    long long tp_t0 = 0; TP_BEGIN(5); TP_BEGIN(6);
    const int lane = C.lane, w = C.wave, qr = lane & 15, q = lane >> 4, tok = qr >> 2, r = qr & 3;
    const int bg = u & 7, b = bg >> 2, g = bg & 3, tj = u >> 3, t0g = tj * 64, t0 = t0g + w * 8, h = g * 4 + r;
    const LAS float* lut = (const LAS float*)(C.lds + ATT_LUT) + h * 128;
    LAS float* imp = (LAS float*)(C.lds + ATT_IMP) + w * 1024;
    const LAS unsigned char* bufp = C.lds + ATT_STG;
    const int n_c = (tj >> 4) + 1, n_s = tj + 1, ks0g = (t0g - 511 < 0 ? 0 : t0g - 511) & ~63, n_w = ((t0g + 63 - ks0g) >> 6) + 1, S = 2 * n_c + n_s + n_w;
    hx8 qf[2][4];
#pragma unroll
    for (int tl = 0; tl < 2; ++tl) { const int t = t0 + 4 * tl + tok; const f16* qp = C.Q + (size_t)(b * T + t) * 2048 + h * 128 + 8 * q;
#pragma unroll
        for (int ks = 0; ks < 4; ++ks) qf[tl][ks] = *(const hx8*)(qp + 32 * ks); }
#define GATE(tl, i) (C.gates[(size_t)(b * T + t0 + 4 * (tl) + tok) * 48 + h * 3 + (i)])
#define YSP(tl) ((f32x4*)(C.ysc + (size_t)(b * T + t0 + 4 * (tl) + tok) * 2048 + h * 128 + 4 * q))
    const float b127 = lut[127];
    f32x4 o[2][8], sv[2][4]; hx8 pf[2][2]; float sc[16], p[16], m[2], l[2], oal[2] = {1.0f, 1.0f}; bool act[2];
#pragma unroll
    for (int tl = 0; tl < 2; ++tl)
#pragma unroll
        for (int dt = 0; dt < 8; ++dt) o[tl][dt] = (f32x4){0.f, 0.f, 0.f, 0.f};
    for (int i = lane; i < 1024; i += 64) imp[i] = 0.f;
    asm volatile("s_waitcnt vmcnt(0) lgkmcnt(0)" ::: "memory");
    __syncthreads();
    int s = 0;
    att_issue(C, 0, n_c, n_s, ks0g, b, g); att_issue(C, 1, n_c, n_s, ks0g, b, g);

    TP_END(6); TP_BEGIN(1);
    m[0] = m[1] = -1e30f; l[0] = l[1] = 0.f;
    for (int c = 0; c < n_c; ++c, ++s) {
        ATT_STAGE_BEGIN();
        const int kb0 = 64 * c;
        act[0] = kb0 <= ((t0 + 3 - 31) >> 4); act[1] = kb0 <= ((t0 + 7 - 31) >> 4);
        if (!act[1]) continue;
#pragma unroll
        for (int tl = 0; tl < 2; ++tl) { if (act[tl]) { const int tb = t0 + 4 * tl, t = tb + tok, nmax_t = (t - 31) >> 4;
            ATT_QK2(tl);
            if (kb0 + 63 <= ((tb - 31) >> 4) && tb - 16 * (kb0 + 63) - 31 >= 127) { ATT_SOFTMAX_FAR(tl, b127, false); }
            else {
#pragma unroll
                for (int j = 0; j < 16; ++j) { const int n = kb0 + 32 * (j >> 3) + 8 * q + (j & 7), dist = t - 16 * n - 31; sc[j] = lut[dist < 0 ? 0 : (dist > 127 ? 127 : dist)]; }
                SB();
#pragma unroll
                for (int j = 0; j < 16; ++j) { const int n = kb0 + 32 * (j >> 3) + 8 * q + (j & 7); const float sx = SVJ(tl, j) * SC2 + sc[j]; sc[j] = n <= nmax_t ? sx : NEGBIG; }
                ATT_SOFTMAX_NEAR(tl, false); } } }
    }
    float il[2];
#pragma unroll
    for (int tl = 0; tl < 2; ++tl) { l[tl] += __shfl_xor(l[tl], 16); l[tl] += __shfl_xor(l[tl], 32); il[tl] = l[tl] > 0.f ? 1.0f / l[tl] : 0.f; }
    float carry[2] = {0.f, 0.f};
    for (int c = 0; c < n_c; ++c, ++s) {
        ATT_STAGE_BEGIN();
        const int kb0 = 64 * c;
        act[0] = kb0 <= ((t0 + 3 - 31) >> 4); act[1] = kb0 <= ((t0 + 7 - 31) >> 4);
        if (!act[1]) continue;
#pragma unroll
        for (int tl = 0; tl < 2; ++tl) { if (act[tl]) { const int t = t0 + 4 * tl + tok, nmax_t = (t - 31) >> 4;
            ATT_QK2(tl);
#pragma unroll
            for (int j = 0; j < 16; ++j) { const int n = kb0 + 32 * (j >> 3) + 8 * q + (j & 7), dist = t - 16 * n - 31; p[j] = lut[dist < 0 ? 0 : (dist > 127 ? 127 : dist)]; }
            SB();
#pragma unroll
            for (int j = 0; j < 16; ++j) { const int n = kb0 + 32 * (j >> 3) + 8 * q + (j & 7); const float px = __builtin_amdgcn_exp2f(SVJ(tl, j) * SC2 + p[j] - m[tl]) * il[tl]; p[j] = n <= nmax_t ? px : 0.f; }
            ATT_PACKP(tl);
#pragma unroll
            for (int scn = 0; scn < 2; ++scn) { float ph[8];
#pragma unroll
                for (int j = 0; j < 8; ++j) { float v = p[8 * scn + j]; v += dpp_f<0xB1>(v); v += dpp_f<0x4E>(v); ph[j] = v; }
                const float t7 = __shfl(ph[7], (lane + 48) & 63);
                const float left = q == 0 ? carry[tl] : t7; carry[tl] = t7;
                if (r == 0) { f32x2 iv; iv.x = left + 2.0f * (ph[0] + ph[1] + ph[2]) + ph[3]; iv.y = ph[3] + 2.0f * (ph[4] + ph[5] + ph[6]) + ph[7];
                    *(LAS f32x2*)(imp + (4 * tl + tok) * 128 + ((kb0 + 32 * scn) >> 2) + 2 * q) = iv; } } } }
        ATT_PV2(false);
    }
#pragma unroll
    for (int tl = 0; tl < 2; ++tl) { f32x4* ysp = YSP(tl); const float gc = GATE(tl, 0);
#pragma unroll
        for (int dt = 0; dt < 8; ++dt) { ysp[4 * dt] = o[tl][dt] * gc; o[tl][dt] = (f32x4){0.f, 0.f, 0.f, 0.f}; } }
    LDS_WAIT();
    TP_END(1); TP_BEGIN(2);
    unsigned long long my_lo[2] = {0ull, 0ull}, my_hi[2] = {0ull, 0ull}, U_lo[2] = {0ull, 0ull}, U_hi[2] = {0ull, 0ull};
#pragma unroll
    for (int tk = 0; tk < 8; ++tk) { const int tt = t0 + tk, cur = tt >> 6; unsigned long long lo, hi;
        if (cur < 16) { lo = (1ull << (cur + 1)) - 1ull; hi = 0ull; }
        else {
            const LAS float* P = imp + tk * 128;
            const int j0 = lane, j1 = lane + 64;
            const bool c0 = j0 >= 1 && j0 <= cur - 2, c1 = j1 <= cur - 2;
            const int k0 = c0 ? __float_as_int(P[j0]) : -1, k1 = c1 ? __float_as_int(P[j1]) : -1;
            int Tk = 0;
#pragma unroll 1
            for (int bit = 30; bit >= 0; --bit) { const int cand = Tk | (1 << bit); const int cnt = __popcll(__ballot(k0 >= cand)) + __popcll(__ballot(k1 >= cand)); if (cnt >= 13) { Tk = cand; if (cnt == 13) break; } }
            const unsigned long long e0 = __ballot(k0 == Tk), e1 = __ballot(k1 == Tk);
            const int need = 13 - (__popcll(__ballot(k0 > Tk)) + __popcll(__ballot(k1 > Tk)));
            const int r0 = (int)__builtin_amdgcn_mbcnt_hi((unsigned)(e0 >> 32), __builtin_amdgcn_mbcnt_lo((unsigned)e0, 0u));
            const int r1 = __popcll(e0) + (int)__builtin_amdgcn_mbcnt_hi((unsigned)(e1 >> 32), __builtin_amdgcn_mbcnt_lo((unsigned)e1, 0u));
            const bool sel0 = k0 > Tk || (k0 == Tk && r0 < need) || j0 == 0 || j0 == cur || j0 == cur - 1, sel1 = k1 > Tk || (k1 == Tk && r1 < need) || j1 == cur || j1 == cur - 1;
            lo = __ballot(sel0); hi = __ballot(sel1);
        }
        U_lo[tk >> 2] |= lo; U_hi[tk >> 2] |= hi; if (tok == (tk & 3)) { my_lo[tk >> 2] = lo; my_hi[tk >> 2] = hi; } }
    TP_END(2); TP_BEGIN(3);
    m[0] = m[1] = -1e30f; l[0] = l[1] = 0.f;
    for (int jb = 0; jb < n_s; ++jb, ++s) {
        ATT_STAGE_BEGIN();
        bool mine[2];
#pragma unroll
        for (int tl = 0; tl < 2; ++tl) { act[tl] = jb < 64 ? ((U_lo[tl] >> jb) & 1ull) : ((U_hi[tl] >> (jb - 64)) & 1ull); mine[tl] = jb < 64 ? ((my_lo[tl] >> jb) & 1ull) : ((my_hi[tl] >> (jb - 64)) & 1ull); }
        if (!act[0] && !act[1]) continue;
        const int kb0 = 64 * jb;
        if (act[0] && act[1] && t0 - (kb0 + 63) >= 127) {
            ATT_QK2B();
            { const float cb = mine[0] ? b127 : NEGBIG; ATT_SOFTMAX_FAR(0, cb, true); }
            { const float cb = mine[1] ? b127 : NEGBIG; ATT_SOFTMAX_FAR(1, cb, true); }
        } else
#pragma unroll
        for (int tl = 0; tl < 2; ++tl) { if (act[tl]) { const int tb = t0 + 4 * tl, t = tb + tok;
            ATT_QK2(tl);
            if (tb - (kb0 + 63) >= 127) { const float cb = mine[tl] ? b127 : NEGBIG; ATT_SOFTMAX_FAR(tl, cb, true); }
            else { const int bd = t - kb0 - 8 * q;
#pragma unroll
                for (int j = 0; j < 16; ++j) { const int dist = bd - 32 * (j >> 3) - (j & 7); sc[j] = lut[dist < 0 ? 0 : (dist > 127 ? 127 : dist)]; }
                SB();
#pragma unroll
                for (int j = 0; j < 16; ++j) { const int dist = bd - 32 * (j >> 3) - (j & 7); const float sx = SVJ(tl, j) * SC2 + sc[j]; sc[j] = (mine[tl] && dist >= 0) ? sx : NEGBIG; }
                ATT_SOFTMAX_NEAR(tl, true); } } }
        ATT_PV2(true);
    }
#pragma unroll
    for (int tl = 0; tl < 2; ++tl) { l[tl] += __shfl_xor(l[tl], 16); l[tl] += __shfl_xor(l[tl], 32); const float gl = l[tl] > 0.f ? GATE(tl, 1) / l[tl] : 0.f; f32x4* ysp = YSP(tl);
#pragma unroll
        for (int dt = 0; dt < 8; ++dt) { ysp[4 * dt] = ysp[4 * dt] + o[tl][dt] * gl; o[tl][dt] = (f32x4){0.f, 0.f, 0.f, 0.f}; } }
    TP_END(3); TP_BEGIN(4);
    m[0] = m[1] = -1e30f; l[0] = l[1] = 0.f;
    for (int k = 0; k < n_w; ++k, ++s) {
        ATT_STAGE_BEGIN();
        const int kb0 = ks0g + 64 * k;
#pragma unroll
        for (int tl = 0; tl < 2; ++tl) { const int tb = t0 + 4 * tl; act[tl] = !(kb0 > tb + 3 || kb0 + 63 < tb - 511); }
        if (!act[0] && !act[1]) continue;
        if (act[0] && act[1] && t0 - (kb0 + 63) >= 127 && t0 + 7 - kb0 <= 511) {
            ATT_QK2B();
            ATT_SOFTMAX_FAR(0, b127, true); ATT_SOFTMAX_FAR(1, b127, true);
        } else
#pragma unroll
        for (int tl = 0; tl < 2; ++tl) { if (act[tl]) { const int tb = t0 + 4 * tl, t = tb + tok;
            ATT_QK2(tl);
            if (tb - (kb0 + 63) >= 127 && tb + 3 - kb0 <= 511) { ATT_SOFTMAX_FAR(tl, b127, true); }
            else { const int bd = t - kb0 - 8 * q;
#pragma unroll
                for (int j = 0; j < 16; ++j) { const int dist = bd - 32 * (j >> 3) - (j & 7); sc[j] = lut[dist < 0 ? 0 : (dist > 127 ? 127 : dist)]; }
                SB();
#pragma unroll
                for (int j = 0; j < 16; ++j) { const int dist = bd - 32 * (j >> 3) - (j & 7); const float sx = SVJ(tl, j) * SC2 + sc[j]; sc[j] = (dist >= 0 && dist < 512) ? sx : NEGBIG; }
                ATT_SOFTMAX_NEAR(tl, true); } } }
        ATT_PV2(true);
    }
#pragma unroll
    for (int tl = 0; tl < 2; ++tl) { l[tl] += __shfl_xor(l[tl], 16); l[tl] += __shfl_xor(l[tl], 32); const float gl = l[tl] > 0.f ? GATE(tl, 2) / l[tl] : 0.f; const f32x4* ysp = YSP(tl);
        f16* yp = C.YAB + (size_t)(b * T + t0 + 4 * tl + tok) * D + h * 128 + 4 * q;
#pragma unroll
        for (int dt = 0; dt < 8; ++dt) { const f32x4 yv = ysp[4 * dt] + o[tl][dt] * gl; u32x2 ov; ov.x = pk_mix(yv[0], yv[1]); ov.y = pk_mix(yv[2], yv[3]); *(u32x2*)(yp + 16 * dt) = ov; } }
    TP_END(4); TP_END(5);
}
#undef GATE
#undef YSP
__device__ __forceinline__ void p4_attention(Ctx& C) {
    LAS float* lut = (LAS float*)(C.lds + ATT_LUT);
    for (int i = C.tid; i < 16 * 128; i += NTHREADS) { const int hh = i >> 7, n = i & 127; lut[i] = C.rel_table[rel_bucket_small(n) * 16 + hh] * LOG2E; }
    __syncthreads();
    long long tp_acc = 0;
    for (int i = C.bid; i < 1024; i += C.G) { const int idx = i >> 3, k = idx >> 5, x = idx & 31, tj = (k & 1) ? 32 * k + 31 - x : idx; p4_attn_unit(C, (tj << 3) | (i & 7), tp_acc); }
    if (ATT_TPROBE != 0) { const long long t0 = (long long)wall_clock64(); while ((long long)wall_clock64() - t0 < tp_acc) __builtin_amdgcn_s_sleep(8); }
    __syncthreads();
}

__device__ __forceinline__ void p9_fixup(Ctx& C) {
    const int gt = C.bid * NTHREADS + C.tid, NGT = C.G * NTHREADS;
    for (int it = gt; it < 64 * (DFF / 8); it += NGT) {
        const int pm = it / (DFF / 8), c0 = (it % (DFF / 8)) * 8; const bool first = ((pm * 256) & (T - 1)) == 0;
        float res[2][8];
#pragma unroll
        for (int h4 = 0; h4 < 2; ++h4) {
            f32x4 cvv[2][2];
#pragma unroll
            for (int bj = 0; bj < 2; ++bj) { const int cc = c0 + 4 * h4;
                const f32x4 w0 = *(const f32x4*)(C.conv_w + 0 * NUP + bj * DFF + cc), w1 = *(const f32x4*)(C.conv_w + 1 * NUP + bj * DFF + cc), w2 = *(const f32x4*)(C.conv_w + 2 * NUP + bj * DFF + cc), bb = *(const f32x4*)(C.conv_b + bj * DFF + cc);
                const f32x4 a0 = *(const f32x4*)(C.AT + (size_t)((pm * 2 + 0) * 2 + bj) * DFF + cc), a1 = *(const f32x4*)(C.AT + (size_t)((pm * 2 + 1) * 2 + bj) * DFF + cc);
                f32x4 hm2 = {0.f, 0.f, 0.f, 0.f}, hm1 = {0.f, 0.f, 0.f, 0.f};
                if (!first) { hm2 = *(const f32x4*)(C.AH + (size_t)((2 * (pm - 1) + 0) * 2 + bj) * DFF + cc); hm1 = *(const f32x4*)(C.AH + (size_t)((2 * (pm - 1) + 1) * 2 + bj) * DFF + cc); }
                cvv[0][bj] = bb + w0 * hm2 + w1 * hm1 + w2 * a0; cvv[1][bj] = bb + w0 * hm1 + w1 * a0 + w2 * a1; }
#pragma unroll
            for (int j = 0; j < 2; ++j)
#pragma unroll
                for (int i = 0; i < 4; ++i) res[j][4 * h4 + i] = fsilu(cvv[j][0][i]) * cvv[j][1][i]; }
#pragma unroll
        for (int j = 0; j < 2; ++j) { u32x4 ov; ov.x = pk_ffn(res[j][0], res[j][1]); ov.y = pk_ffn(res[j][2], res[j][3]); ov.z = pk_ffn(res[j][4], res[j][5]); ov.w = pk_ffn(res[j][6], res[j][7]);
            *(u32x4*)(C.ACT + (size_t)(pm * 256 + j) * DFF + c0) = ov; }
    }
}

__device__ __forceinline__ void ph2_proj(Ctx& C) {
    { pg8::Gemm g{C.H, C.WIN, M, 3072, D}; pg8::StaticOrder S; S.init(M, 3072, C.G, C.bid);
      pg8::EpiProj E{C.Q, C.KV, C.Z, C.GA, C.GB, 0};
      pg8::gemm_phase<pg8::EpiProj, pg8::StaticOrder>(C.lds, g, S, E); }
    { pg8::Gemm g{(const f16*)(C.ws + WS_H1Q), (const f16*)(C.ws + WS_WINQ), M, 13312, D / 2}; pg8::StaticOrder S; S.init(M, 13312, C.G, C.bid);
      pg8::EpiProjQ E{C.ws, 12};
      pg8::gemm_phase<pg8::EpiProjQ, pg8::StaticOrder, true, 2>(C.lds, g, S, E); }
    { pg8::Gemm g{(const f16*)(C.ws + WS_WVTQ), (const f16*)(C.ws + WS_H1Q), 1024, M, D / 2}; pg8::StaticOrder S; S.init(1024, M, C.G, C.bid);
      pg8::EpiVTQ E{C.ws};
      pg8::gemm_phase<pg8::EpiVTQ, pg8::StaticOrder, true, 2>(C.lds, g, S, E); }
}
__device__ __forceinline__ void ph3_mixers(Ctx& C) {
    for (int it = C.bid; it < 256; it += C.G) p3_gates_item(C, it);
    if constexpr (((PROBE_DUP) >> 12) & 1) { for (int it = C.bid; it < 256; it += C.G) p3_gates_item(C, it); }
    for (int it = C.bid; it < 256; it += C.G) p3_compress_item(C, it);
    if constexpr (((PROBE_DUP) >> 13) & 1) { for (int it = C.bid; it < 256; it += C.G) p3_compress_item(C, it); }
    for (int it = C.bid; it < 256; it += C.G) p3_sgu_item(C, it);
    if constexpr (((PROBE_DUP) >> 14) & 1) { for (int it = C.bid; it < 256; it += C.G) p3_sgu_item(C, it); }
}
__device__ __forceinline__ void ph5_merge(Ctx& C) {
    pg8::Gemm g{C.YAB, C.WM, M, D, D}; pg8::StaticOrder S; S.init(M, D, C.G, C.bid);
    pg8::EpiMerge E{C.GA, C.GB, C.H};
    pg8::gemm_phase<pg8::EpiMerge, pg8::StaticOrder, true, MIX_BF16 ? 1 : 0>(C.lds, g, S, E);
}
__device__ __forceinline__ void ph5w_quant(Ctx& C) { p1_quant_rows(C, C.WO, D, (signed char*)(C.ws + WS_WOQ), (float*)(C.ws + WS_SWO), MIX_BF16 != 0, true); }
__device__ __forceinline__ void ph5b_quant(Ctx& C) { p1_quant_rows(C, C.H, M, (signed char*)(C.ws + WS_MRGQ), (float*)(C.ws + WS_SAM), MIX_BF16 != 0, true); }
__device__ __forceinline__ void ph6_out(Ctx& C) {
    pg8::StaticOrder S; S.init(M, D, C.G, C.bid);
    if constexpr (P6_INT8) {
        pg8::Gemm g{(const f16*)(C.ws + WS_MRGQ), (const f16*)(C.ws + WS_WOQ), M, D, D / 2};
        pg8::EpiH16Q E{C.Y1, D, (const float*)(C.ws + WS_SAM), (const float*)(C.ws + WS_SWO)};
        pg8::gemm_phase<pg8::EpiH16Q, pg8::StaticOrder, true, 2>(C.lds, g, S, E);
    } else {
        pg8::Gemm g{C.H, C.WO, M, D, D};
        pg8::EpiH16 E{C.Y1, D};
        pg8::gemm_phase<pg8::EpiH16, pg8::StaticOrder, true, MIX_BF16 ? 1 : 0>(C.lds, g, S, E);
    }
}
__device__ __forceinline__ void ph8_up(Ctx& C) {
    pg8::Gemm g{(const f16*)((signed char*)(C.ws + WS_H2)), (const f16*)((signed char*)(C.ws + WS_WUPQ)), M + 256, NUP, D / 2}; pg8::StaticOrder S; S.init(M + 256, NUP, C.G, C.bid);
    pg8::EpiConv E{C.ws, C.conv_w, C.conv_b, (LAS float*)(C.lds + pg8::STAGE_BYTES), FFN_BF16};
    pg8::gemm_phase<pg8::EpiConv, pg8::StaticOrder, true, 2>(C.lds, g, S, E);
}
__device__ __forceinline__ void ph9_conv(Ctx& C) { p9_fixup(C); }
__device__ __forceinline__ void ph9b_quant(Ctx& C) { quant_rows_ff(C, C.ACT, M, (signed char*)(C.ws + WS_ACTQ), (float*)(C.ws + WS_SACT), FFN_BF16 != 0, true); }
__device__ __forceinline__ void ph10_down(Ctx& C) {
    pg8::Gemm g{(const f16*)(C.ws + WS_ACTQ), (const f16*)(C.ws + WS_WDNQ), M, D, DFF / 2}; pg8::StaticOrder S; S.init(M, D, C.G, C.bid);
    pg8::EpiH16Q E{C.Y2, D, (const float*)(C.ws + WS_SACT), (const float*)(C.ws + WS_SWDN)};
    pg8::gemm_phase<pg8::EpiH16Q, pg8::StaticOrder, true, 2>(C.lds, g, S, E);
}

constexpr int NPHASE = 12;
__global__ void __launch_bounds__(NTHREADS, 2) fwd_kernel(Args args) {
    extern __shared__ __attribute__((aligned(16))) unsigned char lds_raw[];
    Ctx C;
    C.lds = (LAS unsigned char*)lds_raw;
    C.tid = threadIdx.x; C.lane = C.tid & 63; C.wave = __builtin_amdgcn_readfirstlane(C.tid >> 6); C.G = gridDim.x; C.bid = blockIdx.x;
    C.x = args.in[0]; C.c = args.in[1]; C.w_mod = args.in[2]; C.b_mod = args.in[3]; C.g_norms = args.in[4]; C.w_in = args.in[5]; C.cmp_pos = args.in[6]; C.cmp_w1 = args.in[7];
    C.cmp_b1 = args.in[8]; C.cmp_w2 = args.in[9]; C.cmp_b2 = args.in[10]; C.rel_table = args.in[11]; C.ln_g = args.in[12]; C.ln_b = args.in[13]; C.sgu_w = args.in[14]; C.sgu_b = args.in[15];
    C.w_pn = args.in[16]; C.w_ps = args.in[17]; C.w_out = args.in[18]; C.w_up = args.in[19]; C.conv_w = args.in[20]; C.conv_b = args.in[21]; C.w_dn = args.in[22];
    C.out = args.out; C.ws = args.ws; unsigned char* ws = args.ws;
    C.mod = (float*)(ws + WS_MOD); C.posw1 = (float*)(ws + WS_POSW1); C.gates = (float*)(ws + WS_GATES); C.ysc = (float*)(ws + WS_YSC); C.AH = (float*)(ws + WS_AH); C.AT = (float*)(ws + WS_AT); C.Y1 = (f16*)(ws + WS_Z); C.Y2 = (f16*)(ws + WS_Y2); C.X1H = (f16*)(ws + WS_X1H);
    C.W2T = (f16*)(ws + WS_W2T); C.SGUW = (f16*)(ws + WS_SGUW); C.WG = (f16*)(ws + WS_WG); C.KC = (f16*)(ws + WS_KC); C.VCT = (f16*)(ws + WS_VCT); C.W1T = (f16*)(ws + WS_W1T);
    C.WUP = (f16*)(ws + WS_WUP); C.WDN = (f16*)(ws + WS_WDN); C.WIN = (f16*)(ws + WS_WIN); C.WVT = (f16*)(ws + WS_WVT); C.WM = (f16*)(ws + WS_WM); C.WO = (f16*)(ws + WS_WO);
    C.H = (f16*)(ws + WS_H); C.Q = (f16*)(ws + WS_Q); C.KV = (f16*)(ws + WS_KV); C.VT = (f16*)(ws + WS_VT); C.Z = (f16*)(ws + WS_Z); C.GA = (f16*)(ws + WS_GA); C.GB = (f16*)(ws + WS_GB);
    C.YAB = (f16*)(ws + WS_YAB); C.H2 = (f16*)(ws + WS_H2); C.ACT = (f16*)(ws + WS_ACT);

    volatile LAS unsigned* MISC = (volatile LAS unsigned*)(C.lds + MISC_OFF);
    for (int u = C.tid; u < (LDS_BYTES - MISC_OFF) / 4; u += NTHREADS) MISC[u] = 0u;
    __syncthreads();
    unsigned* barw = (unsigned*)(ws + WS_CTL) + CW_BAR;
    XcdBarrier bar; bar.bar = barw; bar.x = 0; bar.st = nullptr;
    if (MK_N_LAUNCHES == 1) bar = xcd_barrier_post(barw, MISC + 8);
    const int lo = args.ph_lo, hi = args.ph_hi;
#define IN(k) (lo <= (k) && (k) < hi)
#define DUP(k) ((((PROBE_DUP) >> (k)) & 1) != 0)
#define SEAM(k) do { if (IN(k) && IN((k) + 1)) { if (BAR_TPROBE == 100 || BAR_TPROBE == (k) + 1) { const long long t0_ = (long long)wall_clock64(); xcd_barrier(bar); ktp += (long long)wall_clock64() - t0_; } else xcd_barrier(bar); } } while (0)
    long long ktp = 0;

    if (IN(0)) { p0_prologue(C); if constexpr (DUP(0)) p0_prologue(C); }
    SEAM(0);
    if (IN(1)) { p1_norm(C); p1_quant_weights(C); if constexpr (DUP(1)) p1_norm(C); }
    SEAM(1);
    if (IN(2)) { ph2_proj(C); if constexpr (DUP(2)) ph2_proj(C); }
    SEAM(2);
    if (IN(3)) { ph3_mixers(C); if constexpr (DUP(3)) ph3_mixers(C); }
    SEAM(3);
    if (IN(4)) { p4_attention(C); if constexpr (DUP(4)) p4_attention(C); }
    SEAM(4);
    if (IN(5)) { ph5_merge(C); if constexpr (DUP(5)) ph5_merge(C); if (P6_INT8) { ph5w_quant(C); if (MK_N_LAUNCHES == 1) xcd_barrier(bar); ph5b_quant(C); } }
    SEAM(5);
    if (IN(6)) { ph6_out(C); if constexpr (DUP(6)) ph6_out(C); }
    SEAM(6);
    if (IN(7)) { p7_norm(C); }
    SEAM(7);
    if (IN(8)) { ph8_up(C); if constexpr (DUP(8)) ph8_up(C); }
    SEAM(8);
    if (IN(9)) { ph9_conv(C); if (MK_N_LAUNCHES == 1) xcd_barrier(bar); ph9b_quant(C); }
    SEAM(9);
    if (IN(10)) { ph10_down(C); if constexpr (DUP(10)) ph10_down(C); }
    SEAM(10);
    if (IN(11)) { p11_final(C); }
    if (BAR_TPROBE != 0) { const long long t0_ = (long long)wall_clock64(); while ((long long)wall_clock64() - t0_ < ktp) __builtin_amdgcn_s_sleep(8); }
#undef IN
#undef DUP
#undef SEAM
}

extern "C" void kernel_launch(void* const* d_in, const int* in_sizes, int n_in, void* d_out, int out_size, void* d_ws, size_t ws_size, hipStream_t stream) {
    static int grid = 0;
    if (grid == 0) {
        if (n_in != 23 || in_sizes[0] != M * D || out_size != M * D || ws_size < WS_END) { fprintf(stderr, "kernel_launch: unexpected shapes (n_in %d, in0 %d, out %d, ws %zu); nothing launched\n", n_in, n_in > 0 ? in_sizes[0] : -1, out_size, ws_size); grid = -1; return; }
        int dev = 0, cus = 0, per_cu = 0;
        if (hipGetDevice(&dev) != hipSuccess || hipDeviceGetAttribute(&cus, hipDeviceAttributeMultiprocessorCount, dev) != hipSuccess) { grid = -1; return; }
        if (hipFuncSetAttribute((const void*)fwd_kernel, hipFuncAttributeMaxDynamicSharedMemorySize, LDS_BYTES) != hipSuccess) { fprintf(stderr, "kernel_launch: hipFuncSetAttribute failed\n"); grid = -1; return; }
        if (hipOccupancyMaxActiveBlocksPerMultiprocessor(&per_cu, (const void*)fwd_kernel, NTHREADS, LDS_BYTES) != hipSuccess || per_cu < 1) { fprintf(stderr, "kernel_launch: occupancy query reports %d\n", per_cu); }
        (void)hipGetLastError();
        grid = cus;
        if (grid > 256) grid = 256;
    }
    if (grid < 0) return;
    (void)hipMemsetAsync((char*)d_ws + WS_CTL, 0, CTL_BYTES, stream);
    Args a{};
    for (int i = 0; i < 23; ++i) a.in[i] = (const float*)d_in[i];
    a.out = (float*)d_out; a.ws = (unsigned char*)d_ws;
    if (MK_N_LAUNCHES == 1) { a.ph_lo = 0; a.ph_hi = NPHASE; hipLaunchKernelGGL(fwd_kernel, dim3(grid), dim3(NTHREADS), LDS_BYTES, stream, a); }
    else { for (int li = 0; li < NPHASE; ++li) { a.ph_lo = li; a.ph_hi = li + 1; hipLaunchKernelGGL(fwd_kernel, dim3(grid), dim3(NTHREADS), LDS_BYTES, stream, a); } }
}
```

```cpp
#include <hip/hip_runtime.h>
#include <cstdio>
#include <cstdint>

#ifndef MK_N_LAUNCHES
#define MK_N_LAUNCHES 1
#endif

#ifndef PROBE_DUP
#define ATT_TPROBE 0
#define BAR_TPROBE 0
#define PROBE_DUP 0
#endif
#define GAS __attribute__((address_space(1)))
#define LAS __attribute__((address_space(3)))
typedef _Float16 f16;
typedef _Float16 hx8 __attribute__((ext_vector_type(8)));
typedef _Float16 hx4 __attribute__((ext_vector_type(4)));
typedef _Float16 hx2 __attribute__((ext_vector_type(2)));
typedef float f32x4 __attribute__((ext_vector_type(4)));
typedef float f32x2 __attribute__((ext_vector_type(2)));
typedef unsigned u32x4 __attribute__((ext_vector_type(4)));
typedef unsigned u32x2 __attribute__((ext_vector_type(2)));
typedef int ix4 __attribute__((ext_vector_type(4)));

constexpr int NB = 2, T = 8192, D = 4096, M = NB * T;
constexpr int NG = 4, HD = 128;
constexpr int DFF = 11008, NUP = 2 * DFF;
constexpr int IN_W = 17456, NPROJ = 16384, NMOD = 6 * D;
constexpr float EPS = 1e-6f;
constexpr float LOG2E = 1.4426950408889634f;
constexpr float SC2 = 0.08838834764831845f * 1.4426950408889634f;

constexpr size_t MiB = 1ull << 20;
constexpr size_t WS_CTL = 0, CTL_BYTES = 1 * MiB;
constexpr size_t WS_MOD = 1 * MiB;
constexpr size_t WS_POSW1 = 1 * MiB + 256 * 1024;
constexpr size_t WS_W2T = 1 * MiB + 384 * 1024;
constexpr size_t WS_SGUW = 2 * MiB;
constexpr size_t WS_WG = 2 * MiB + 512 * 1024;
constexpr size_t WS_KC = 3 * MiB;
constexpr size_t WS_VCT = 4 * MiB;
constexpr size_t WS_GATES = 5 * MiB;
constexpr size_t WS_W1T = 8 * MiB;
constexpr size_t WS_WUP = 16 * MiB;
constexpr size_t WS_WDN = 188 * MiB;
constexpr size_t WS_WIN = 274 * MiB;
constexpr size_t WS_WVT = 402 * MiB;
constexpr size_t WS_WM = 410 * MiB;
constexpr size_t WS_WO = 442 * MiB;
constexpr size_t WS_H = 474 * MiB;
constexpr size_t WS_Q = 602 * MiB;
constexpr size_t WS_KV = 666 * MiB;
constexpr size_t WS_VT = 730 * MiB;
constexpr size_t WS_Z = 762 * MiB;
constexpr size_t WS_GA = 890 * MiB;
constexpr size_t WS_GB = 1018 * MiB;
constexpr size_t WS_YAB = 1146 * MiB;
constexpr size_t WS_H2 = 274 * MiB;
constexpr size_t WS_AH = 406 * MiB;
constexpr size_t WS_AT = 418 * MiB;
constexpr size_t WS_ACT = 1090 * MiB;
constexpr size_t WS_Y2 = 432 * MiB;
constexpr size_t WS_X1H = 602 * MiB;
constexpr size_t WS_YSC = 1274 * MiB;
constexpr size_t WS_SA = 12 * MiB;
constexpr size_t WS_SW = 12 * MiB + 256 * 1024;
constexpr size_t WS_SAH = 12 * MiB + 512 * 1024;
constexpr size_t WS_SWQ = 12 * MiB + 640 * 1024;
constexpr size_t WS_H1Q = 1274 * MiB;
constexpr size_t WS_WINQ = 1338 * MiB;
constexpr size_t WS_WVTQ = 1390 * MiB;
constexpr size_t WS_SACT = 12 * MiB + 784 * 1024;
constexpr size_t WS_SWDN = 12 * MiB + 848 * 1024;
constexpr size_t WS_ACTQ = 730 * MiB;
constexpr size_t WS_WDNQ = 1520 * MiB;
constexpr size_t WS_WUPQ = 1434 * MiB;
constexpr size_t WS_MRGQ = 602 * MiB;
constexpr size_t WS_WOQ = 300 * MiB;
constexpr size_t WS_SAM = 12 * MiB + 896 * 1024;
constexpr size_t WS_SWO = 12 * MiB + 960 * 1024;
constexpr size_t WS_END = 1563 * MiB;

constexpr int CW_BAR = 4096;

constexpr int LDS_BYTES = 147456;
constexpr int MISC_OFF = LDS_BYTES - 512;
constexpr int NWAVES = 8, NTHREADS = 512;

#define LDS_WAIT() asm volatile("s_waitcnt lgkmcnt(0)" ::: "memory")
#define VM_WAIT() asm volatile("s_waitcnt vmcnt(0)" ::: "memory")
__device__ __forceinline__ unsigned pkh(float lo, float hi) { hx2 p; p.x = (f16)lo; p.y = (f16)hi; return __builtin_bit_cast(unsigned, p); }
__device__ __forceinline__ unsigned pkb(float lo, float hi) { unsigned r; asm volatile("v_cvt_pk_bf16_f32 %0, %1, %2" : "=v"(r) : "v"(lo), "v"(hi)); return r; }
#ifndef FFN_BF16
#define FFN_BF16 1
#endif
__device__ __forceinline__ unsigned pk_ffn(float lo, float hi) { return FFN_BF16 ? pkb(lo, hi) : pkh(lo, hi); }
#ifndef MIX_BF16
#define P6_INT8 1
#define MIX_BF16 1
#endif
__device__ __forceinline__ unsigned pk_mix(float lo, float hi) { return MIX_BF16 ? pkb(lo, hi) : pkh(lo, hi); }
__device__ __forceinline__ float wave_max(float v) {
#pragma unroll
    for (int o = 1; o < 64; o <<= 1) v = fmaxf(v, __shfl_xor(v, o));
    return v;
}
__device__ __forceinline__ unsigned pk_i8(float a, float b, float c, float d) {
    const float M_ = 12582912.0f;
    const unsigned ua = __builtin_bit_cast(unsigned, __builtin_amdgcn_fmed3f(a, -127.f, 127.f) + M_), ub = __builtin_bit_cast(unsigned, __builtin_amdgcn_fmed3f(b, -127.f, 127.f) + M_);
    const unsigned uc = __builtin_bit_cast(unsigned, __builtin_amdgcn_fmed3f(c, -127.f, 127.f) + M_), ud = __builtin_bit_cast(unsigned, __builtin_amdgcn_fmed3f(d, -127.f, 127.f) + M_);
    const unsigned lo = __builtin_amdgcn_perm(ub, ua, 0x0c0c0400u), hi = __builtin_amdgcn_perm(ud, uc, 0x04000c0cu);
    return lo | hi;
}
__device__ __forceinline__ unsigned pk_i8s(float a, float b, float c, float d, float qs) {
    const float M_ = 12582912.0f, L_ = 12582912.0f - 127.0f, H_ = 12582912.0f + 127.0f;
    const unsigned ua = __builtin_bit_cast(unsigned, __builtin_amdgcn_fmed3f(__builtin_fmaf(a, qs, M_), L_, H_)), ub = __builtin_bit_cast(unsigned, __builtin_amdgcn_fmed3f(__builtin_fmaf(b, qs, M_), L_, H_));
    const unsigned uc = __builtin_bit_cast(unsigned, __builtin_amdgcn_fmed3f(__builtin_fmaf(c, qs, M_), L_, H_)), ud = __builtin_bit_cast(unsigned, __builtin_amdgcn_fmed3f(__builtin_fmaf(d, qs, M_), L_, H_));
    return __builtin_amdgcn_perm(ub, ua, 0x0c0c0400u) | __builtin_amdgcn_perm(ud, uc, 0x04000c0cu);
}
__device__ __forceinline__ void fwht64(float (&t)[64]) {
#pragma unroll
    for (int h = 1; h < 64; h <<= 1)
#pragma unroll
        for (int i = 0; i < 64; ++i) if ((i & h) == 0) { const float a = t[i], b = t[i + h]; t[i] = a + b; t[i + h] = a - b; }
}
__device__ __forceinline__ void fwht8(float (&t)[8]) {
#pragma unroll
    for (int h = 1; h < 8; h <<= 1)
#pragma unroll
        for (int i = 0; i < 8; ++i) if ((i & h) == 0) { const float a = t[i], b = t[i + h]; t[i] = a + b; t[i + h] = a - b; }
#pragma unroll
    for (int i = 0; i < 8; ++i) t[i] *= 0.35355339059f;
}
__device__ __forceinline__ float wave_sum(float v) {
#pragma unroll
    for (int o = 1; o < 64; o <<= 1) v += __shfl_xor(v, o);
    return v;
}
__device__ __forceinline__ float fsigmoid(float x) { return __builtin_amdgcn_rcpf(1.0f + __builtin_amdgcn_exp2f(-LOG2E * x)); }
__device__ __forceinline__ float fsilu(float x) { return x * fsigmoid(x); }
__device__ __forceinline__ float fgelu(float x) { const float u = x * (1.0f + 0.044715f * x * x); return x * __builtin_amdgcn_rcpf(1.0f + __builtin_amdgcn_exp2f(-2.302208198f * u)); }
template <int CTRL> __device__ __forceinline__ float dpp_f(float v) { return __builtin_bit_cast(float, __builtin_amdgcn_update_dpp(0, __builtin_bit_cast(int, v), CTRL, 0xF, 0xF, true)); }

namespace pg8 {
constexpr int BM = 256, BK = 64, HALF = 128, HTB = HALF * BK * 2, STAGE_BYTES = 8 * HTB, NXCD = 8, WGM = 8;
__host__ __device__ __forceinline__ int lds_byte(int r, int c) { const int st = (r >> 4) * 2 + (c >> 5), rr = r & 15, cc = c & 31, ob = rr * 64 + cc * 2; return st * 1024 + (ob ^ (((ob >> 9) & 1) << 5)); }
__host__ __device__ __forceinline__ void stage_rc(int b, int& R, int& C) { const int st = b / 1024, sb = b % 1024, swz = sb ^ (((sb >> 9) & 1) << 5); R = (st >> 1) * 16 + swz / 64; C = (st & 1) * 32 + (swz % 64) / 2; }
__host__ __device__ __forceinline__ int perm32(int rho) { const int n = rho >> 4, i = rho & 15; return 8 * (i >> 2) + 4 * n + (i & 3); }

struct Unit { int pm, pn; };
struct Gemm { const f16* A; const f16* Bt; int M, N, K; };

struct StaticOrder {
    int nM, nN, nwg, G, c;
    __host__ __device__ void init(int M_, int N_, int G_, int c_) { nM = M_ / BM; nN = N_ / BM; nwg = nM * nN; G = G_; c = c_; }
    __host__ __device__ bool next(int i, Unit& u) const {
        const long L = (long)i * G + c; if (L >= nwg) return false;
        int wgid = (int)L; { const int q = nwg / NXCD, r = nwg % NXCD, xcd = wgid % NXCD, off = wgid / NXCD; wgid = (xcd < r ? xcd * (q + 1) : r * (q + 1) + (xcd - r) * q) + off; }
        const int nig = WGM * nN, gid = wgid / nig, fm = gid * WGM, gsz = (nM - fm) < WGM ? (nM - fm) : WGM;
        u.pm = fm + ((wgid % nig) % gsz); u.pn = (wgid % nig) / gsz; return true;
    }
    __device__ __forceinline__ void a_ready(const Unit&) const {}
    __device__ __forceinline__ void done(const Unit&) const {}
};

__device__ __forceinline__ u32x4 pack8(const f32x4 v0, const f32x4 v1) { u32x4 w; w.x = pkh(v0[0], v0[1]); w.y = pkh(v0[2], v0[3]); w.z = pkh(v1[0], v1[1]); w.w = pkh(v1[2], v1[3]); return w; }

__device__ __forceinline__ unsigned opaque(unsigned v) { asm volatile("" : "+v"(v)); return v; }
struct EpiF32 {
    static constexpr bool PERM = false, AFTER_DRAIN = false, HAS_MID = false;
    float* C; int ldc;
    __device__ __forceinline__ void mid(f32x4 (&)[2][2][4][2], const Unit&, int, int, int, int) const {}
    __device__ __forceinline__ void operator()(const f32x4 (&acc)[2][2][4][2], const Unit& u, int wr, int wc, int fr, int fq) const {
        const unsigned off = opaque((unsigned)((u.pm * BM + wr * 64 + fr) * ldc + u.pn * BM + wc * 32 + 4 * fq) * 4u);
        char* base = (char*)C;
#pragma unroll
        for (int ai = 0; ai < 2; ++ai)
#pragma unroll
            for (int m = 0; m < 4; ++m) { const unsigned ro = off + (unsigned)((ai * HALF + m * 16) * ldc) * 4u;
#pragma unroll
                for (int bj = 0; bj < 2; ++bj)
#pragma unroll
                    for (int n = 0; n < 2; ++n) *(f32x4*)(base + ro + (bj * HALF + n * 16) * 4) = acc[ai][bj][m][n]; }
    }
};
struct EpiH16 {
    static constexpr bool PERM = true, AFTER_DRAIN = false, HAS_MID = false;
    f16* O; int ldc;
    __device__ __forceinline__ void mid(f32x4 (&)[2][2][4][2], const Unit&, int, int, int, int) const {}
    __device__ __forceinline__ void operator()(const f32x4 (&acc)[2][2][4][2], const Unit& u, int wr, int wc, int fr, int fq) const {
        const unsigned off = opaque((unsigned)((u.pm * BM + wr * 64 + fr) * ldc + u.pn * BM + wc * 32 + 8 * fq) * 2u);
        char* base = (char*)O;
#pragma unroll
        for (int ai = 0; ai < 2; ++ai)
#pragma unroll
            for (int m = 0; m < 4; ++m) { const unsigned ro = off + (unsigned)((ai * HALF + m * 16) * ldc) * 2u;
#pragma unroll
                for (int bj = 0; bj < 2; ++bj) *(u32x4*)(base + ro + bj * HALF * 2) = pack8(acc[ai][bj][m][0], acc[ai][bj][m][1]); }
    }
};
struct EpiProj {
    static constexpr bool PERM = true, AFTER_DRAIN = false, HAS_MID = false;
    f16 *Q, *KV, *Z, *GA, *GB; int pn0;
    __device__ __forceinline__ void mid(f32x4 (&)[2][2][4][2], const Unit&, int, int, int, int) const {}
    __device__ __forceinline__ void operator()(const f32x4 (&acc)[2][2][4][2], const Unit& u, int wr, int wc, int fr, int fq) const {
        const int pn = u.pn + pn0; char* base; int ldc, colt, act;
        if (pn < 8) { base = (char*)Q; ldc = 2048; colt = pn * 256; act = 0; }
        else if (pn < 16) { base = (char*)KV; ldc = 2048; colt = (pn - 8) * 256; act = 0; }
        else if (pn < 32) { base = (char*)Z; ldc = 4096; colt = (pn - 16) * 256; act = 1; }
        else if (pn < 48) { base = (char*)GA; ldc = 4096; colt = (pn - 32) * 256; act = 2; }
        else { base = (char*)GB; ldc = 4096; colt = (pn - 48) * 256; act = 2; }
        const unsigned off = opaque((unsigned)((u.pm * BM + wr * 64 + fr) * ldc + colt + wc * 32 + 8 * fq) * 2u);
#pragma unroll
        for (int ai = 0; ai < 2; ++ai)
#pragma unroll
            for (int m = 0; m < 4; ++m) { const unsigned ro = off + (unsigned)((ai * HALF + m * 16) * ldc) * 2u;
#pragma unroll
                for (int bj = 0; bj < 2; ++bj) { f32x4 v0 = acc[ai][bj][m][0], v1 = acc[ai][bj][m][1];
                    if (act == 1) {
#pragma unroll
                        for (int j = 0; j < 4; ++j) { v0[j] = fgelu(v0[j]); v1[j] = fgelu(v1[j]); } }
                    else if (act == 2) {
#pragma unroll
                        for (int j = 0; j < 4; ++j) { v0[j] = fsigmoid(v0[j]); v1[j] = fsigmoid(v1[j]); } }
                    *(u32x4*)(base + ro + bj * HALF * 2) = pack8(v0, v1); } }
    }
};
struct EpiProjQ {
    static constexpr bool PERM = true, AFTER_DRAIN = false, HAS_MID = false;
    unsigned char* ws; int pn0;
    __device__ __forceinline__ void mid(f32x4 (&)[2][2][4][2], const Unit&, int, int, int, int) const {}
    __device__ __forceinline__ void operator()(const f32x4 (&acc)[2][2][4][2], const Unit& u, int wr, int wc, int fr, int fq) const {
        const int pn = u.pn + pn0; char* base; int ldc, colt, act;
        if (pn < 16) { base = (char*)(ws + WS_KV); ldc = 2048; colt = (pn - 8) * 256; act = 0; }
        else if (pn < 32) { base = (char*)(ws + WS_Z); ldc = 4096; colt = (pn - 16) * 256; act = 1; }
        else if (pn < 48) { base = (char*)(ws + WS_GA); ldc = 4096; colt = (pn - 32) * 256; act = 2; }
        else { base = (char*)(ws + WS_GB); ldc = 4096; colt = (pn - 48) * 256; act = 2; }
        const float* const SA = (const float*)(ws + WS_SAH); const float* const SW = (const float*)(ws + WS_SWQ);
        const unsigned off = opaque((unsigned)((u.pm * BM + wr * 64 + fr) * ldc + colt + wc * 32 + 8 * fq) * 2u);
        const unsigned arow = opaque((unsigned)(u.pm * BM + wr * 64 + fr)), wrow = opaque((unsigned)((pn - 12) * 256 + wc * 32 + 8 * fq));
        f32x4 sw[2][2];
#pragma unroll
        for (int bj = 0; bj < 2; ++bj)
#pragma unroll
            for (int n = 0; n < 2; ++n) sw[bj][n] = *(const f32x4*)(SW + wrow + bj * HALF + 4 * n);
#pragma unroll
        for (int ai = 0; ai < 2; ++ai)
#pragma unroll
            for (int m = 0; m < 4; ++m) { const unsigned ro = off + (unsigned)((ai * HALF + m * 16) * ldc) * 2u; const float sa = SA[arow + ai * HALF + m * 16];
#pragma unroll
                for (int bj = 0; bj < 2; ++bj) { const ix4 i0 = __builtin_bit_cast(ix4, acc[ai][bj][m][0]), i1 = __builtin_bit_cast(ix4, acc[ai][bj][m][1]); f32x4 v0, v1;
#pragma unroll
                    for (int j = 0; j < 4; ++j) { v0[j] = (float)i0[j] * (sa * sw[bj][0][j]); v1[j] = (float)i1[j] * (sa * sw[bj][1][j]); }
                    if (act == 1) {
#pragma unroll
                        for (int j = 0; j < 4; ++j) { v0[j] = fgelu(v0[j]); v1[j] = fgelu(v1[j]); } }
                    else if (act == 2) {
#pragma unroll
                        for (int j = 0; j < 4; ++j) { v0[j] = fsigmoid(v0[j]); v1[j] = fsigmoid(v1[j]); } }
                    *(u32x4*)(base + ro + bj * HALF * 2) = pack8(v0, v1); } }
    }
};
struct EpiH16Q {
    static constexpr bool PERM = true, AFTER_DRAIN = false, HAS_MID = false;
    f16* O; int ldc; const float* SA; const float* SW;
    __device__ __forceinline__ void mid(f32x4 (&)[2][2][4][2], const Unit&, int, int, int, int) const {}
    __device__ __forceinline__ void operator()(const f32x4 (&acc)[2][2][4][2], const Unit& u, int wr, int wc, int fr, int fq) const {
        const unsigned off = opaque((unsigned)((u.pm * BM + wr * 64 + fr) * ldc + u.pn * BM + wc * 32 + 8 * fq) * 2u);
        const unsigned arow = opaque((unsigned)(u.pm * BM + wr * 64 + fr)), wrow = opaque((unsigned)(u.pn * BM + wc * 32 + 8 * fq));
        char* base = (char*)O;
        f32x4 sw[2][2];
#pragma unroll
        for (int bj = 0; bj < 2; ++bj)
#pragma unroll
            for (int n = 0; n < 2; ++n) sw[bj][n] = *(const f32x4*)(SW + wrow + bj * HALF + 4 * n);
#pragma unroll
        for (int ai = 0; ai < 2; ++ai)
#pragma unroll
            for (int m = 0; m < 4; ++m) { const unsigned ro = off + (unsigned)((ai * HALF + m * 16) * ldc) * 2u; const float sa = SA[arow + ai * HALF + m * 16];
#pragma unroll
                for (int bj = 0; bj < 2; ++bj) { const ix4 i0 = __builtin_bit_cast(ix4, acc[ai][bj][m][0]), i1 = __builtin_bit_cast(ix4, acc[ai][bj][m][1]); f32x4 v0, v1;
#pragma unroll
                    for (int j = 0; j < 4; ++j) { v0[j] = (float)i0[j] * (sa * sw[bj][0][j]); v1[j] = (float)i1[j] * (sa * sw[bj][1][j]); }
                    *(u32x4*)(base + ro + bj * HALF * 2) = pack8(v0, v1); } }
    }
};
struct EpiVTQ {
    static constexpr bool PERM = true, AFTER_DRAIN = false, HAS_MID = false;
    unsigned char* ws;
    __device__ __forceinline__ void mid(f32x4 (&)[2][2][4][2], const Unit&, int, int, int, int) const {}
    __device__ __forceinline__ void operator()(const f32x4 (&acc)[2][2][4][2], const Unit& u, int wr, int wc, int fr, int fq) const {
        const float* const SA = (const float*)(ws + WS_SAH); const float* const SW = (const float*)(ws + WS_SWQ) + 13312;
        const unsigned off = opaque((unsigned)((u.pm * BM + wr * 64 + fr) * M + u.pn * BM + wc * 32 + 8 * fq) * 2u);
        const unsigned wrow = opaque((unsigned)(u.pm * BM + wr * 64 + fr)), tcol = opaque((unsigned)(u.pn * BM + wc * 32 + 8 * fq));
        char* base = (char*)(ws + WS_VT);
        f32x4 sa[2][2];
#pragma unroll
        for (int bj = 0; bj < 2; ++bj)
#pragma unroll
            for (int n = 0; n < 2; ++n) sa[bj][n] = *(const f32x4*)(SA + tcol + bj * HALF + 4 * n);
#pragma unroll
        for (int ai = 0; ai < 2; ++ai)
#pragma unroll
            for (int m = 0; m < 4; ++m) { const unsigned ro = off + (unsigned)((ai * HALF + m * 16) * M) * 2u; const float sw = SW[wrow + ai * HALF + m * 16];
#pragma unroll
                for (int bj = 0; bj < 2; ++bj) { const ix4 i0 = __builtin_bit_cast(ix4, acc[ai][bj][m][0]), i1 = __builtin_bit_cast(ix4, acc[ai][bj][m][1]); f32x4 v0, v1;
#pragma unroll
                    for (int j = 0; j < 4; ++j) { v0[j] = (float)i0[j] * (sw * sa[bj][0][j]); v1[j] = (float)i1[j] * (sw * sa[bj][1][j]); }
                    *(u32x4*)(base + ro + bj * HALF * 2) = pack8(v0, v1); } }
    }
};
struct EpiMerge {
    static constexpr bool PERM = true, AFTER_DRAIN = false, HAS_MID = true;
    const f16 *GA, *GB; f16* O;
    __device__ __forceinline__ void mid(f32x4 (&acc)[2][2][4][2], const Unit& u, int wr, int wc, int fr, int fq) const {
        const unsigned off = opaque((unsigned)((u.pm * BM + wr * 64 + fr) * D + u.pn * BM + wc * 32 + 8 * fq) * 2u);
        const char* ga = (const char*)GA; const char* gb = (const char*)GB;
#pragma unroll
        for (int ai = 0; ai < 2; ++ai)
#pragma unroll
            for (int m = 0; m < 4; ++m) { const unsigned ro = off + (unsigned)((ai * HALF + m * 16) * D) * 2u;
#pragma unroll
                for (int bj = 0; bj < 2; ++bj) { const hx8 a = *(const hx8*)(ga + ro + bj * HALF * 2), b = *(const hx8*)(gb + ro + bj * HALF * 2);
#pragma unroll
                    for (int j = 0; j < 4; ++j) { acc[ai][bj][m][0][j] *= (float)a[j] * __builtin_amdgcn_rcpf((float)b[j]); acc[ai][bj][m][1][j] *= (float)a[4 + j] * __builtin_amdgcn_rcpf((float)b[4 + j]); } } }
    }
    __device__ __forceinline__ void operator()(const f32x4 (&acc)[2][2][4][2], const Unit& u, int wr, int wc, int fr, int fq) const {
        const unsigned off = opaque((unsigned)((u.pm * BM + wr * 64 + fr) * D + u.pn * BM + wc * 32 + 8 * fq) * 2u);
        const char* gb = (const char*)GB; char* ob = (char*)O;
#pragma unroll
        for (int ai = 0; ai < 2; ++ai)
#pragma unroll
            for (int m = 0; m < 4; ++m) { const unsigned ro = off + (unsigned)((ai * HALF + m * 16) * D) * 2u;
#pragma unroll
                for (int bj = 0; bj < 2; ++bj) { const hx8 b = *(const hx8*)(gb + ro + bj * HALF * 2); f32x4 v0 = acc[ai][bj][m][0], v1 = acc[ai][bj][m][1];
#pragma unroll
                    for (int j = 0; j < 4; ++j) { v0[j] *= (float)b[j]; v1[j] *= (float)b[4 + j]; }
                    u32x4 w; w.x = pk_mix(v0[0], v0[1]); w.y = pk_mix(v0[2], v0[3]); w.z = pk_mix(v1[0], v1[1]); w.w = pk_mix(v1[2], v1[3]);
                    *(u32x4*)(ob + ro + bj * HALF * 2) = w; } }
    }
};

typedef short sx8 __attribute__((ext_vector_type(8)));
template <int CTRL> __device__ __forceinline__ float dpp_mov(float old, float v) { return __builtin_bit_cast(float, __builtin_amdgcn_update_dpp(__builtin_bit_cast(int, old), __builtin_bit_cast(int, v), CTRL, 0xF, 0xF, false)); }
struct EpiConv {
    static constexpr bool PERM = true, AFTER_DRAIN = false, HAS_MID = false;
    unsigned char* ws; const float* cw; const float* cb; LAS float* X; int bf16out;
    __device__ __forceinline__ void mid(f32x4 (&)[2][2][4][2], const Unit&, int, int, int, int) const {}
    static __device__ __forceinline__ f32x4 deq(const f32x4 a, float s) { const ix4 iv = __builtin_bit_cast(ix4, a); return (f32x4){(float)iv[0] * s, (float)iv[1] * s, (float)iv[2] * s, (float)iv[3] * s}; }
    __device__ __forceinline__ void operator()(const f32x4 (&acc)[2][2][4][2], const Unit& u, int wr, int wc, int fr_, int fq_) const {
        const unsigned lane_o = opaque(threadIdx.x & 63u); const int fr = (int)(lane_o & 15u), fq = (int)(lane_o >> 4); (void)fr_; (void)fq_;
        f16* const ACT = (f16*)(ws + WS_ACT); float* const AH = (float*)(ws + WS_AH); float* const AT = (float*)(ws + WS_AT); const float* const SA = (const float*)(ws + WS_SA); const float* const SW = (const float*)(ws + WS_SW);
        const int chl = wc * 32 + 8 * fq;
        const unsigned ch0 = opaque((unsigned)(u.pn * 128 + chl)), wrow = opaque((unsigned)(u.pn * 256 + chl)), arow = opaque((unsigned)(u.pm * BM + wr * 64 + fr));
        float sa[2][4];
#pragma unroll
        for (int ai = 0; ai < 2; ++ai)
#pragma unroll
            for (int m = 0; m < 4; ++m) sa[ai][m] = SA[arow + ai * HALF + m * 16];
        LAS f32x4* const PB = (LAS f32x4*)(X + 2048);
        { const unsigned t = opaque(threadIdx.x);
          if (t < 352u) { const unsigned row = t >> 5, c4 = t & 31u; const float* sp;
              if (row < 2u) sp = cb + row * DFF + u.pn * 128; else if (row < 4u) sp = SW + u.pn * 256 + (row - 2u) * 128; else sp = cw + ((row - 4u) >> 1) * NUP + ((row - 4u) & 1u) * DFF + u.pn * 128;
              PB[t] = *(const f32x4*)(sp + 4 * c4); } }
        if (fr >= 14) {
#pragma unroll
            for (int ai = 0; ai < 2; ++ai)
#pragma unroll
                for (int bj = 0; bj < 2; ++bj)
#pragma unroll
                    for (int n = 0; n < 2; ++n) *(LAS f32x4*)(X + ((((2 * ai + wr) * 2 + (fr - 14)) * 2 + bj) * 128 + chl + 4 * n)) = deq(acc[ai][bj][3][n], sa[ai][3]);
        }
        asm volatile("s_waitcnt lgkmcnt(0)" ::: "memory"); __builtin_amdgcn_s_barrier(); asm volatile("" ::: "memory");
        if (u.pm == 64) {
            const unsigned hro = opaque((unsigned)((wr * 64 + fr) * 2));
#pragma unroll
            for (int bj = 0; bj < 2; ++bj)
#pragma unroll
                for (int n = 0; n < 2; ++n) { const f32x4 swv = *(const f32x4*)(SW + wrow + bj * 128 + 4 * n);
#pragma unroll
                    for (int m = 0; m < 4; ++m) *(f32x4*)(AH + (size_t)(hro + 32 * m + bj) * DFF + ch0 + 4 * n) = deq(acc[0][bj][m][n], sa[0][m]) * swv; }
            return;
        }
        const unsigned orow = opaque((unsigned)(u.pm * BM + wr * 64 + fr));
#pragma unroll
        for (int n = 0; n < 2; ++n) {
            f32x4 wv[3][2], bv[2];
#pragma unroll
            for (int bj = 0; bj < 2; ++bj) { const int pc = (chl >> 2) + n; bv[bj] = PB[bj * 32 + pc]; const f32x4 swv = PB[(2 + bj) * 32 + pc];
#pragma unroll
                for (int k = 0; k < 3; ++k) wv[k][bj] = PB[(4 + 2 * k + bj) * 32 + pc] * swv;
                if (wr == 0 && fr < 2) *(f32x4*)(AT + (size_t)((u.pm * 2 + fr) * 2 + bj) * DFF + ch0 + 4 * n) = deq(acc[0][bj][0][n], sa[0][0]) * swv; }
#pragma unroll
            for (int ai = 0; ai < 2; ++ai) {
                f32x4 E[2];
                const int blk = 2 * ai + wr - 1;
#pragma unroll
                for (int bj = 0; bj < 2; ++bj) { E[bj] = (f32x4){0.f, 0.f, 0.f, 0.f};
                    if (blk >= 0 && fr >= 14) E[bj] = *(const LAS f32x4*)(X + (((blk * 2 + (fr - 14)) * 2 + bj) * 128 + chl + 4 * n)); }
#pragma unroll
                for (int m = 0; m < 4; ++m) {
                    f32x4 cv[2];
#pragma unroll
                    for (int bj = 0; bj < 2; ++bj) { const f32x4 cur = deq(acc[ai][bj][m][n], sa[ai][m]); const f32x4 prv = (m == 0) ? E[bj] : deq(acc[ai][bj][m == 0 ? 0 : m - 1][n], sa[ai][m == 0 ? 0 : m - 1]);
#pragma unroll
                        for (int i = 0; i < 4; ++i) { const float p1 = dpp_mov<0x111>(dpp_mov<0x121>(0.f, prv[i]), cur[i]), p2 = dpp_mov<0x112>(dpp_mov<0x122>(0.f, prv[i]), cur[i]);
                            cv[bj][i] = bv[bj][i] + wv[0][bj][i] * p2 + wv[1][bj][i] * p1 + wv[2][bj][i] * cur[i]; } }
                    float res[4];
#pragma unroll
                    for (int e = 0; e < 4; ++e) res[e] = fsilu(cv[0][e]) * cv[1][e];
                    u32x2 ov;
                    if (bf16out) { ov.x = pkb(res[0], res[1]); ov.y = pkb(res[2], res[3]); }
                    else { ov.x = pkh(res[0], res[1]); ov.y = pkh(res[2], res[3]); }
                    *(u32x2*)(ACT + (size_t)(orow + ai * HALF + m * 16) * DFF + ch0 + 4 * n) = ov;
                }
            }
        }
    }
};

template <class Epi, class Sched, bool ALIGN_EPI = true, int DT = 0  >
__device__ __forceinline__ void gemm_phase(LAS unsigned char* lds, const Gemm g, const Sched& S, const Epi& E) {
    const int tid = threadIdx.x, wid = __builtin_amdgcn_readfirstlane(tid >> 6), lane = tid & 63, wr = wid >> 2, wc = wid & 3, fr = lane & 15, fq = lane >> 4;
    const int K = g.K, nt = K / BK;
    unsigned voffA[2], voffB[2];
#pragma unroll
    for (int i = 0; i < 2; ++i) { int R, C; stage_rc(tid * 16 + i * 8192, R, C); const int Rb = Epi::PERM ? ((R & ~31) + perm32(R & 31)) : R;
        voffA[i] = (unsigned)(R * K + C) * 2u; voffB[i] = (unsigned)(Rb * K + C) * 2u; }
    const size_t kstep = (size_t)(BK * 2);
    const size_t hstep = (size_t)HALF * K * 2;
    const size_t tstep = 2 * hstep;
    const unsigned ldsw = (unsigned)wid * 1024u;
    const int aoff = lds_byte(wr * 64 + fr, fq * 8), boff = lds_byte(wc * 32 + fr, fq * 8);
#define PG8_SA(b, h) (((b) * 2 + (h)) * HTB)
#define PG8_SB(b, h) ((4 + (b) * 2 + (h)) * HTB)
#define PG8_STAGE(bufoff, gbase, voff) do { _Pragma("unroll") for (int _i = 0; _i < 2; ++_i) \
        __builtin_amdgcn_global_load_lds((const unsigned*)((const char*)(gbase) + (voff)[_i]), (LAS unsigned*)(lds + (bufoff) + ldsw + _i * 8192), 16, 0, 0); } while (0)
#define PG8_LDA(dst, b, h) do { _Pragma("unroll") for (int m = 0; m < 4; ++m) _Pragma("unroll") for (int k = 0; k < 2; ++k) dst[m][k] = *(const LAS hx8*)(lds + PG8_SA(b, h) + aoff + m * 2048 + k * 1024); } while (0)
#define PG8_LDB(dst, b, h) do { _Pragma("unroll") for (int n = 0; n < 2; ++n) _Pragma("unroll") for (int k = 0; k < 2; ++k) dst[n][k] = *(const LAS hx8*)(lds + PG8_SB(b, h) + boff + n * 2048 + k * 1024); } while (0)
#define PG8_MMA(ai, bj, At, Bt) do { __builtin_amdgcn_s_setprio(1); _Pragma("unroll") for (int m = 0; m < 4; ++m) _Pragma("unroll") for (int n = 0; n < 2; ++n) _Pragma("unroll") for (int k = 0; k < 2; ++k) \
        { if constexpr (DT == 2) acc[ai][bj][m][n] = __builtin_bit_cast(f32x4, __builtin_amdgcn_mfma_i32_16x16x64_i8(__builtin_bit_cast(ix4, Bt[n][k]), __builtin_bit_cast(ix4, At[m][k]), __builtin_bit_cast(ix4, acc[ai][bj][m][n]), 0, 0, 0)); \
          else if constexpr (DT == 1) acc[ai][bj][m][n] = __builtin_amdgcn_mfma_f32_16x16x32_bf16(__builtin_bit_cast(sx8, Bt[n][k]), __builtin_bit_cast(sx8, At[m][k]), acc[ai][bj][m][n], 0, 0, 0); \
          else acc[ai][bj][m][n] = __builtin_amdgcn_mfma_f32_16x16x32_f16(Bt[n][k], At[m][k], acc[ai][bj][m][n], 0, 0, 0); } __builtin_amdgcn_s_setprio(0); } while (0)
#define PG8_WAIT_V(n) asm volatile("s_waitcnt vmcnt(" #n ")" ::: "memory")
#define PG8_WAIT_L(n) asm volatile("s_waitcnt lgkmcnt(" #n ")" ::: "memory")
#define PG8_BAR __builtin_amdgcn_s_barrier()
#define PG8_SCHED __builtin_amdgcn_sched_barrier(0)
    Unit cur, nxt; int ui = 0;
    if (!S.next(0, cur)) return;
    f32x4 acc[2][2][4][2];
#pragma unroll
    for (int a = 0; a < 2; ++a)
#pragma unroll
        for (int b = 0; b < 2; ++b)
#pragma unroll
            for (int m = 0; m < 4; ++m)
#pragma unroll
                for (int n = 0; n < 2; ++n) acc[a][b][m][n] = (f32x4){0.f, 0.f, 0.f, 0.f};
    hx8 At[4][2], B0[2][2], B1[2][2];
    const char* cA = (const char*)g.A + (size_t)cur.pm * tstep; const char* cB = (const char*)g.Bt + (size_t)cur.pn * tstep;
    S.a_ready(cur);
    PG8_STAGE(PG8_SB(0, 0), cB, voffB); PG8_STAGE(PG8_SB(0, 1), cB + hstep, voffB); PG8_STAGE(PG8_SA(0, 0), cA, voffA); PG8_STAGE(PG8_SA(0, 1), cA + hstep, voffA);
    if (wr == 1) PG8_BAR;
    PG8_WAIT_V(2); PG8_BAR;
    PG8_STAGE(PG8_SB(1, 0), cB + kstep, voffB); PG8_STAGE(PG8_SA(1, 0), cA + kstep, voffA); PG8_STAGE(PG8_SB(1, 1), cB + hstep + kstep, voffB);
    PG8_WAIT_V(6); PG8_BAR;
    for (;;) {
        const bool has_next = S.next(ui + 1, nxt);
        const char* nA = has_next ? (const char*)g.A + (size_t)nxt.pm * tstep : cA; const char* nB = has_next ? (const char*)g.Bt + (size_t)nxt.pn * tstep : cB;
        for (int t = 0; t < nt; t += 2) {
            const bool last = (t == nt - 2);
            const char* a1 = cA + (size_t)(t + 1) * kstep;
            const char* a2 = last ? nA : cA + (size_t)(t + 2) * kstep; const char* b2 = last ? nB : cB + (size_t)(t + 2) * kstep;
            const char* a3 = a2 + kstep; const char* b3 = b2 + kstep;
            if (last && has_next) S.a_ready(nxt);
            if constexpr (Epi::HAS_MID) { if (t == (nt >> 1)) E.mid(acc, cur, wr, wc, fr, fq); }
            PG8_LDB(B0, 0, 0); PG8_LDB(B1, 0, 1); PG8_SCHED; PG8_LDA(At, 0, 0); PG8_STAGE(PG8_SA(1, 1), a1 + hstep, voffA);
            PG8_WAIT_V(8); PG8_WAIT_L(0); PG8_BAR; PG8_MMA(0, 0, At, B0); PG8_MMA(0, 1, At, B1); PG8_BAR; PG8_SCHED;
            PG8_LDA(At, 0, 1); PG8_STAGE(PG8_SB(0, 0), b2, voffB); PG8_STAGE(PG8_SB(0, 1), b2 + hstep, voffB); PG8_STAGE(PG8_SA(0, 0), a2, voffA);
            PG8_WAIT_V(8); PG8_WAIT_L(0); PG8_BAR; PG8_MMA(1, 0, At, B0); PG8_MMA(1, 1, At, B1); PG8_BAR; PG8_SCHED;
            PG8_LDB(B0, 1, 0); PG8_LDB(B1, 1, 1); PG8_SCHED; PG8_LDA(At, 1, 0); PG8_STAGE(PG8_SA(0, 1), a2 + hstep, voffA);
            PG8_WAIT_V(8); PG8_WAIT_L(0); PG8_BAR; PG8_MMA(0, 0, At, B0); PG8_MMA(0, 1, At, B1); PG8_BAR; PG8_SCHED;
            PG8_LDA(At, 1, 1); PG8_STAGE(PG8_SB(1, 0), b3, voffB); PG8_STAGE(PG8_SB(1, 1), b3 + hstep, voffB); PG8_STAGE(PG8_SA(1, 0), a3, voffA);
            PG8_WAIT_V(8); PG8_WAIT_L(0); PG8_BAR; PG8_MMA(1, 0, At, B0); PG8_MMA(1, 1, At, B1); PG8_BAR; PG8_SCHED;
        }
        if constexpr (ALIGN_EPI) { if (wr == 0) PG8_BAR; }
        E(acc, cur, wr, wc, fr, fq); S.done(cur);
        if (!has_next) break;
#pragma unroll
        for (int a = 0; a < 2; ++a)
#pragma unroll
            for (int b = 0; b < 2; ++b)
#pragma unroll
                for (int m = 0; m < 4; ++m)
#pragma unroll
                    for (int n = 0; n < 2; ++n) acc[a][b][m][n] = (f32x4){0.f, 0.f, 0.f, 0.f};
        cur = nxt; cA = nA; cB = nB; ++ui;
        if constexpr (ALIGN_EPI) { if (wr == 1) PG8_BAR; }
    }
    PG8_WAIT_V(0);
    if constexpr (!ALIGN_EPI) { if (wr == 0) PG8_BAR; }
    PG8_BAR;
#undef PG8_SA
#undef PG8_SB
#undef PG8_STAGE
#undef PG8_LDA
#undef PG8_LDB
#undef PG8_MMA
#undef PG8_WAIT_V
#undef PG8_WAIT_L
#undef PG8_BAR
#undef PG8_SCHED
}
}

#define XB_TMO      128
#define XB_XCNT(j)  (256  + 64 * (j))
#define XB_XSUB(j)  (1280 + 64 * (j))
#define XB_XGEN(j)  (2304 + 64 * (j))
#define XB_TOP      3328
#define XB_TOPGEN   3392
#define XCD_BAR_WORDS 3456
#define XB_SPIN_CAP (1u << 18)
__device__ __forceinline__ unsigned xb_ld(unsigned* p)              { return __hip_atomic_load(p, __ATOMIC_RELAXED, __HIP_MEMORY_SCOPE_AGENT); }
__device__ __forceinline__ unsigned xb_add(unsigned* p, unsigned v) { return __hip_atomic_fetch_add(p, v, __ATOMIC_RELAXED, __HIP_MEMORY_SCOPE_AGENT); }
__device__ __forceinline__ unsigned xb_xcc_id() { return (unsigned)__builtin_amdgcn_s_getreg((3 << 11) | 20) & 0xFu; }
#define XB_SPIN(cond, bar) do { unsigned _sp = 0; while (cond) { __builtin_amdgcn_s_sleep(1); \
    if ((++_sp & 255u) == 0u) { if (xb_ld(&(bar)[XB_TMO])) break; if (_sp > XB_SPIN_CAP) { atomicAdd(&(bar)[XB_TMO], 1u); break; } } } } while (0)
struct XcdBarrier { unsigned* bar; unsigned x; volatile LAS unsigned* st; };
__device__ __forceinline__ XcdBarrier xcd_barrier_post(unsigned* bar, volatile LAS unsigned* st) {
    XcdBarrier b; b.bar = bar; b.x = xb_xcc_id(); b.st = st;
    if (threadIdx.x == 0) (void)xb_add(&bar[XB_XCNT(b.x)], 1u);
    return b;
}
__device__ __forceinline__ void xcd_barrier_complete(unsigned* bar, unsigned x, unsigned& nloc, unsigned& nx) {
    const unsigned G = gridDim.x * gridDim.y * gridDim.z;
    unsigned sum, cnt, mine, sp = 0u;
    for (;;) {
        sum = 0u; cnt = 0u; mine = 0u;
#pragma unroll
        for (unsigned j = 0; j < 16; ++j) { const unsigned c = xb_ld(&bar[XB_XCNT(j)]); sum += c; cnt += (c > 0u) ? 1u : 0u; mine = (j == x) ? c : mine; }
        if (sum == G) break;
        __builtin_amdgcn_s_sleep(1);
        if ((++sp & 255u) == 0u) { if (xb_ld(&bar[XB_TMO])) break; if (sp > XB_SPIN_CAP) { atomicAdd(&bar[XB_TMO], 1u); break; } }
    }
    nloc = mine > 0u ? mine : 1u; nx = cnt > 0u ? cnt : 1u;
}
__device__ __forceinline__ void xcd_barrier(const XcdBarrier& b) {
    asm volatile("s_waitcnt vmcnt(0)" ::: "memory");
    __syncthreads();
    if (threadIdx.x == 0) {
        unsigned* bar = b.bar;
        __builtin_amdgcn_s_waitcnt(0);
        unsigned nloc = b.st[0], nx = b.st[1];
        if (nloc == 0u) { xcd_barrier_complete(bar, b.x, nloc, nx); b.st[0] = nloc; b.st[1] = nx; }
        const unsigned old = xb_add(&bar[XB_XSUB(b.x)], 1u);
        const unsigned gen = old / nloc;
        if (old + 1u == (gen + 1u) * nloc) {
            __builtin_amdgcn_fence(__ATOMIC_RELEASE, "agent");
            asm volatile("s_waitcnt vmcnt(0)" ::: "memory");
            const unsigned og = xb_add(&bar[XB_TOP], 1u);
            const unsigned tg = og / nx;
            if (og + 1u == (tg + 1u) * nx) xb_add(&bar[XB_TOPGEN], 1u);
            else XB_SPIN(xb_ld(&bar[XB_TOPGEN]) == tg, bar);
            __builtin_amdgcn_fence(__ATOMIC_ACQUIRE, "agent");
            xb_add(&bar[XB_XGEN(b.x)], 1u);
            asm volatile("s_waitcnt vmcnt(0)" ::: "memory");
        } else {
            XB_SPIN(xb_ld(&bar[XB_XGEN(b.x)]) == gen, bar);
            __builtin_amdgcn_fence(__ATOMIC_ACQUIRE, "agent");
            asm volatile("s_waitcnt vmcnt(0)" ::: "memory");
        }
    }
    __syncthreads();
}

struct Args { const float* in[23]; float* out; unsigned char* ws; int ph_lo, ph_hi; };
struct Ctx {
    LAS unsigned char* lds;
    int tid, lane, wave, G, bid;
    const float *x, *c, *w_mod, *b_mod, *g_norms, *w_in, *cmp_pos, *cmp_w1, *cmp_b1, *cmp_w2, *cmp_b2, *rel_table, *ln_g, *ln_b, *sgu_w, *sgu_b,
                *w_pn, *w_ps, *w_out, *w_up, *conv_w, *conv_b, *w_dn;
    float* out; unsigned char* ws;
    float *mod, *posw1, *gates, *ysc, *AH, *AT; f16 *Y1, *Y2, *X1H, *W2T, *SGUW, *WG, *KC, *VCT, *W1T, *WUP, *WDN, *WIN, *WVT, *WM, *WO, *H, *Q, *KV, *VT, *Z, *GA, *GB, *YAB, *H2, *ACT;
};

__device__ __forceinline__ void p0_mod_item(Ctx& C, int item) {
    LAS float* sc = (LAS float*)C.lds;
    LAS float* red = (LAS float*)(C.lds + 32768);
    for (int i = C.tid; i < 2 * D; i += NTHREADS) sc[i] = fsilu(C.c[i]);
    __syncthreads();
    const int cq = C.tid & 31, kg = C.tid >> 5, n0 = item * 128 + 4 * cq;
    f32x4 a0 = {0.f, 0.f, 0.f, 0.f}, a1 = {0.f, 0.f, 0.f, 0.f};
    const float* wp = C.w_mod + (size_t)(kg * 256) * NMOD + n0;
#pragma unroll 8
    for (int i = 0; i < 256; ++i) { const f32x4 w = *(const f32x4*)(wp + (size_t)i * NMOD); const float s0 = sc[kg * 256 + i], s1 = sc[D + kg * 256 + i]; a0 += w * s0; a1 += w * s1; }
    *(LAS f32x4*)(red + (kg * 2 + 0) * 128 + 4 * cq) = a0; *(LAS f32x4*)(red + (kg * 2 + 1) * 128 + 4 * cq) = a1;
    __syncthreads();
    if (C.tid < 256) { const int b = C.tid >> 7, col = C.tid & 127; float s = 0.f;
#pragma unroll
        for (int k = 0; k < 16; ++k) s += red[(k * 2 + b) * 128 + col];
        C.mod[b * NMOD + item * 128 + col] = s + C.b_mod[item * 128 + col]; }
    __syncthreads();
}
__device__ __forceinline__ void p0_posw1_item(Ctx& C, int item) {
    LAS float* red = (LAS float*)C.lds;
    const int kk = item >> 2, j = (item & 3) * 64 + C.lane; float s = 0.f;
    const float* w = C.cmp_w1 + (size_t)kk * 4096 * 256 + j; const float* pp = C.cmp_pos + kk * 4096;
    for (int k = C.wave * 512; k < C.wave * 512 + 512; ++k) s += pp[k] * w[(size_t)k * 256];
    red[C.wave * 64 + C.lane] = s;
    __syncthreads();
    if (C.wave == 0) { float t = 0.f;
#pragma unroll
        for (int k = 0; k < 8; ++k) t += red[k * 64 + C.lane];
        C.posw1[kk * 256 + j] = t + C.cmp_b1[kk * 256 + j]; }
    __syncthreads();
}
__device__ __forceinline__ f16* win_row(Ctx& C, int n) {
    if (n < 3584) return C.WIN + (size_t)n * D;
    if (n < 4096) return C.WVT + (size_t)(n - 3584) * D;
    if (n < 4608) return C.WIN + (size_t)(n - 512) * D;
    if (n < 5120) return C.WVT + (size_t)(n - 4608 + 512) * D;
    if (n < 5168) return C.WG + (size_t)(n - 5120) * D;
    return C.WIN + (size_t)(n - 5168 + 4096) * D;
}
__device__ __forceinline__ void p0_transpose_item(Ctx& C, int mat, const float* src, int N, int kb, int nb, LAS float* scr) {
    const int lane = C.lane, k0 = kb * 64, n0 = nb * 64, r4 = lane >> 4, c4 = (lane & 15) * 4; const bool ok = n0 + c4 < N;
    const float* sp = src + (size_t)(k0 + r4) * N + (ok ? n0 + c4 : 0);
#pragma unroll
    for (int i = 0; i < 16; ++i) { const f32x4 v = ok ? *(const f32x4*)(sp + (size_t)(4 * i) * N) : (f32x4){0.f, 0.f, 0.f, 0.f};
        LAS float* d = scr + (4 * i + r4) * 65 + c4; d[0] = v.x; d[1] = v.y; d[2] = v.z; d[3] = v.w; }
    LDS_WAIT();
    const int c = lane & 7;
#pragma unroll
    for (int j = 0; j < 8; ++j) { const int nn = (lane >> 3) + 8 * j, ng = n0 + nn;
        if (ng < N) { const LAS float* s = scr + (8 * c) * 65 + nn;
            u32x4 o;
            if ((FFN_BF16 && (mat == 4 || mat == 5)) || (MIX_BF16 && (mat == 1 || mat == 2 || mat == 3))) { o.x = pkb(s[0], s[65]); o.y = pkb(s[2 * 65], s[3 * 65]); o.z = pkb(s[4 * 65], s[5 * 65]); o.w = pkb(s[6 * 65], s[7 * 65]); }
            else { o.x = pkh(s[0], s[65]); o.y = pkh(s[2 * 65], s[3 * 65]); o.z = pkh(s[4 * 65], s[5 * 65]); o.w = pkh(s[6 * 65], s[7 * 65]); }
            f16* rowp;
            if (mat == 0) rowp = win_row(C, ng);
            else if (mat == 1) rowp = C.WM + (size_t)ng * D;
            else if (mat == 2) rowp = C.WM + (size_t)ng * D + 2048;
            else if (mat == 3) rowp = C.WO + (size_t)ng * D;
            else if (mat == 4) { const int isup = ng >= DFF ? 1 : 0, cc = ng - isup * DFF; rowp = C.WUP + (size_t)((cc >> 7) * 256 + isup * 128 + (cc & 127)) * D; }
            else if (mat == 5) rowp = C.WDN + (size_t)ng * DFF;
            else if (mat == 6) rowp = C.W1T + (size_t)ng * D;
            else rowp = C.W1T + (size_t)(256 + ng) * D;
            *(u32x4*)(rowp + k0 + 8 * c) = o; } }
    LDS_WAIT();
}
__device__ __forceinline__ void p0_prologue(Ctx& C) {
    for (int it = C.bid; it < 200; it += C.G) { if (it < 192) p0_mod_item(C, it); else p0_posw1_item(C, it - 192); }
    const int gw = C.bid * NWAVES + C.wave, NGW = C.G * NWAVES;
    LAS float* scr = (LAS float*)(C.lds + C.wave * 16640);
    constexpr int I0 = 64 * 273, I1 = 32 * 64, I3 = 64 * 64, I4 = 64 * 344, I5 = 172 * 64, I6 = 64 * 4;
    constexpr int NIT = I0 + 2 * I1 + I3 + I4 + I5 + 2 * I6;
    for (int it = gw; it < NIT; it += NGW) {
        int r = it;
        if (r < I0) { p0_transpose_item(C, 0, C.w_in, IN_W, r / 273, r % 273, scr); continue; } r -= I0;
        if (r < I1) { p0_transpose_item(C, 1, C.w_pn, D, r / 64, r % 64, scr); continue; } r -= I1;
        if (r < I1) { p0_transpose_item(C, 2, C.w_ps, D, r / 64, r % 64, scr); continue; } r -= I1;
        if (r < I3) { p0_transpose_item(C, 3, C.w_out, D, r / 64, r % 64, scr); continue; } r -= I3;
        if (r < I4) { p0_transpose_item(C, 4, C.w_up, NUP, r / 344, r % 344, scr); continue; } r -= I4;
        if (r < I5) { p0_transpose_item(C, 5, C.w_dn, D, r / 64, r % 64, scr); continue; } r -= I5;
        if (r < I6) { p0_transpose_item(C, 6, C.cmp_w1, 256, r / 4, r % 4, scr); continue; } r -= I6;
        p0_transpose_item(C, 7, C.cmp_w1 + (size_t)4096 * 256, 256, r / 4, r % 4, scr);
    }
    const int gt = C.bid * NTHREADS + C.tid, NGT = C.G * NTHREADS;
    for (int i = gt; i < 16 * 128 * 128; i += NGT) { const int s = i & 127, t = (i >> 7) & 127; C.SGUW[i] = (f16)(s <= t ? C.sgu_w[i] : 0.f); }
    for (int i = gt; i < 2 * 128 * 256; i += NGT) { const int j = i & 255, d = (i >> 8) & 127, kk = i >> 15; C.W2T[i] = (f16)C.cmp_w2[(size_t)kk * 256 * 128 + j * 128 + d]; }
    for (int i = gt; i < 16 * D; i += NGT) C.WG[48 * D + i] = (f16)0.f;
    __syncthreads();
}

__device__ __forceinline__ void p1_norm(Ctx& C) {
    const int gw = C.bid * NWAVES + C.wave, NGW = C.G * NWAVES, lane = C.lane;
    LAS f32x4* const PV = (LAS f32x4*)C.lds;
    for (int i = C.tid; i < 2 * 1024; i += NTHREADS) { const int b = i >> 10, k = i & 1023;
        const f32x4 g0v = ((const f32x4*)(C.g_norms))[k], shv = ((const f32x4*)(C.mod + b * NMOD))[k], scv = ((const f32x4*)(C.mod + b * NMOD + D))[k];
        PV[(b * 2 + 0) * 1024 + k] = g0v * (scv + 1.0f); PV[(b * 2 + 1) * 1024 + k] = shv; }
    __syncthreads();
    for (int row = gw; row < M; row += NGW) {
        const int b = row >> 13; const f32x4* xr = (const f32x4*)(C.x + (size_t)row * D);
        f32x4 v[16]; float ss = 0.f;
#pragma unroll
        for (int j = 0; j < 16; ++j) { v[j] = xr[2 * (lane + 64 * (j >> 1)) + (j & 1)]; ss += (v[j].x * v[j].x + v[j].y * v[j].y) + (v[j].z * v[j].z + v[j].w * v[j].w); }
        const float rs = 1.0f / sqrtf(wave_sum(ss) * (1.0f / D) + EPS);
        const LAS f32x4* const B1 = PV + (b * 2 + 0) * 1024; const LAS f32x4* const B2 = PV + (b * 2 + 1) * 1024;
        u32x4* o = (u32x4*)(C.H + (size_t)row * D); u32x2* oq = (u32x2*)(C.ws + WS_H1Q + (size_t)row * D);
        float t[64];
#pragma unroll
        for (int j = 0; j < 16; ++j) { const int k = 2 * (lane + 64 * (j >> 1)) + (j & 1); v[j] = v[j] * rs * B1[k] + B2[k]; t[4 * j] = v[j].x; t[4 * j + 1] = v[j].y; t[4 * j + 2] = v[j].z; t[4 * j + 3] = v[j].w; }
#pragma unroll
        for (int jj = 0; jj < 8; ++jj) { u32x4 w; w.x = pkh(v[2 * jj].x, v[2 * jj].y); w.y = pkh(v[2 * jj].z, v[2 * jj].w); w.z = pkh(v[2 * jj + 1].x, v[2 * jj + 1].y); w.w = pkh(v[2 * jj + 1].z, v[2 * jj + 1].w); o[lane + 64 * jj] = w; }
        fwht64(t);
        float amax = 0.f;
#pragma unroll
        for (int i = 0; i < 64; ++i) amax = fmaxf(amax, fabsf(t[i]));
        amax = fmaxf(wave_max(amax), 1e-20f);
        const float qs = 127.0f / amax;
        if (lane == 0) ((float*)(C.ws + WS_SAH))[row] = amax * (0.125f / 127.0f);
#pragma unroll
        for (int jj = 0; jj < 8; ++jj) { u32x2 w; w.x = pk_i8s(t[8 * jj], t[8 * jj + 1], t[8 * jj + 2], t[8 * jj + 3], qs); w.y = pk_i8s(t[8 * jj + 4], t[8 * jj + 5], t[8 * jj + 6], t[8 * jj + 7], qs); oq[lane + 64 * jj] = w; }
    }
}
__device__ __forceinline__ void p1_quant_rows(Ctx& C, const f16* src, int nrows, signed char* dst, float* scale, bool bf, bool rot) {
    const int gw = C.bid * NWAVES + C.wave, NGW = C.G * NWAVES, lane = C.lane;
    for (int row = gw; row < nrows; row += NGW) {
        const u32x4* wr = (const u32x4*)(src + (size_t)row * D);
        float v[64]; float amax = 0.f;
#pragma unroll
        for (int j = 0; j < 8; ++j) { const u32x4 wv = wr[lane + 64 * j];
#pragma unroll
            for (int e = 0; e < 4; ++e) { const unsigned wd = wv[e]; float lo, hi;
                if (bf) { lo = __builtin_bit_cast(float, wd << 16); hi = __builtin_bit_cast(float, wd & 0xffff0000u); }
                else { const hx2 hv = __builtin_bit_cast(hx2, wd); lo = (float)hv.x; hi = (float)hv.y; }
                v[8 * j + 2 * e] = lo; v[8 * j + 2 * e + 1] = hi; } }
        if (rot) fwht64(v);
#pragma unroll
        for (int i = 0; i < 64; ++i) amax = fmaxf(amax, fabsf(v[i]));
        amax = fmaxf(wave_max(amax), 1e-30f);
        const float qs = 127.0f / amax;
        if (lane == 0) scale[row] = amax * ((rot ? 0.125f : 1.0f) / 127.0f);
        u32x2* o = (u32x2*)(dst + (size_t)row * D);
#pragma unroll
        for (int j = 0; j < 8; ++j) { u32x2 w; w.x = pk_i8s(v[8 * j], v[8 * j + 1], v[8 * j + 2], v[8 * j + 3], qs); w.y = pk_i8s(v[8 * j + 4], v[8 * j + 5], v[8 * j + 6], v[8 * j + 7], qs); o[lane + 64 * j] = w; }
    }
}
__device__ __forceinline__ void rot128(float (&t)[8], int lane) {
#pragma unroll
    for (int h = 1; h < 8; h <<= 1)
#pragma unroll
        for (int i = 0; i < 8; ++i) if ((i & h) == 0) { const float a = t[i], b = t[i + h]; t[i] = a + b; t[i + h] = a - b; }
    const float s1 = (lane & 1) ? -1.f : 1.f, s2 = (lane & 2) ? -1.f : 1.f, s3 = (lane & 4) ? -1.f : 1.f, s4 = (lane & 8) ? -1.f : 1.f;
#pragma unroll
    for (int e = 0; e < 8; ++e) { float x = t[e];
        x = dpp_f<0xB1>(x) + s1 * x; x = dpp_f<0x4E>(x) + s2 * x; x = dpp_f<0x141>(x) + s3 * x; x = dpp_f<0x140>(x) + s4 * x;
        t[e] = x; }
}
__device__ __forceinline__ void quant_rows_ff(Ctx& C, const f16* src, int nrows, signed char* dst, float* scale, bool bf, bool rms) {
    const int gw = C.bid * NWAVES + C.wave, NGW = C.G * NWAVES, lane = C.lane;
    for (int row = gw; row < nrows; row += NGW) {
        const u32x4* wr = (const u32x4*)(src + (size_t)row * DFF);
        float amax = 0.f;
        if (rms) {
            u32x4 wv[22];
#pragma unroll
            for (int i = 0; i < 22; ++i) { const int c = 64 * i + lane; wv[i] = c < DFF / 8 ? wr[c] : (u32x4){0u, 0u, 0u, 0u}; }
#pragma unroll
            for (int i = 0; i < 22; ++i)
#pragma unroll
                for (int e = 0; e < 4; ++e) { const unsigned wd = wv[i][e]; float lo, hi;
                    if (bf) { lo = __builtin_bit_cast(float, wd << 16); hi = __builtin_bit_cast(float, wd & 0xffff0000u); }
                    else { const hx2 hv = __builtin_bit_cast(hx2, wd); lo = (float)hv.x; hi = (float)hv.y; }
                    amax += lo * lo + hi * hi; }
            amax = fmaxf(5.0f * sqrtf(wave_sum(amax) * (1.0f / DFF)), 1e-30f);
            const float qs1 = (127.0f * 0.08838834764831845f) / amax;
            if (lane == 0) scale[row] = amax * (1.0f / 127.0f);
            u32x2* o1 = (u32x2*)(dst + (size_t)row * DFF);
#pragma unroll
            for (int i = 0; i < 22; ++i) { const int c = 64 * i + lane; const bool ok = c < DFF / 8; float t[8];
#pragma unroll
                for (int e = 0; e < 4; ++e) { const unsigned wd = wv[i][e];
                    if (bf) { t[2 * e] = __builtin_bit_cast(float, wd << 16); t[2 * e + 1] = __builtin_bit_cast(float, wd & 0xffff0000u); }
                    else { const hx2 hv = __builtin_bit_cast(hx2, wd); t[2 * e] = (float)hv.x; t[2 * e + 1] = (float)hv.y; } }
                rot128(t, lane);
                if (ok) { u32x2 w; w.x = pk_i8s(t[0], t[1], t[2], t[3], qs1); w.y = pk_i8s(t[4], t[5], t[6], t[7], qs1); o1[c] = w; } }
            continue;
        }
        if (rms) {
#pragma unroll 1
            for (int cb = 0; cb < DFF / 8; cb += 704) { u32x4 wv[11];
#pragma unroll
                for (int i = 0; i < 11; ++i) { const int c = cb + 64 * i + lane; wv[i] = c < DFF / 8 ? wr[c] : (u32x4){0u, 0u, 0u, 0u}; }
#pragma unroll
                for (int i = 0; i < 11; ++i)
#pragma unroll
                    for (int e = 0; e < 4; ++e) { const unsigned wd = wv[i][e]; float lo, hi;
                        if (bf) { lo = __builtin_bit_cast(float, wd << 16); hi = __builtin_bit_cast(float, wd & 0xffff0000u); }
                        else { const hx2 hv = __builtin_bit_cast(hx2, wd); lo = (float)hv.x; hi = (float)hv.y; }
                        amax += lo * lo + hi * hi; } }
        } else {
#pragma unroll 1
            for (int cb = 0; cb < DFF / 8; cb += 704) { u32x4 wv[11];
#pragma unroll
                for (int i = 0; i < 11; ++i) { const int c = cb + 64 * i + lane; wv[i] = c < DFF / 8 ? wr[c] : (u32x4){0u, 0u, 0u, 0u}; }
#pragma unroll
                for (int i = 0; i < 11; ++i) { float t[8];
#pragma unroll
                    for (int e = 0; e < 4; ++e) { const unsigned wd = wv[i][e];
                        if (bf) { t[2 * e] = __builtin_bit_cast(float, wd << 16); t[2 * e + 1] = __builtin_bit_cast(float, wd & 0xffff0000u); }
                        else { const hx2 hv = __builtin_bit_cast(hx2, wd); t[2 * e] = (float)hv.x; t[2 * e + 1] = (float)hv.y; } }
                    rot128(t, lane);
#pragma unroll
                    for (int e = 0; e < 8; ++e) amax = fmaxf(amax, fabsf(t[e])); } } }
        amax = rms ? fmaxf(5.0f * sqrtf(wave_sum(amax) * (1.0f / DFF)), 1e-30f) : fmaxf(wave_max(amax), 1e-30f);
        const float qs = (rms ? 127.0f * 0.08838834764831845f : 127.0f) / amax;
        if (lane == 0) scale[row] = amax * ((rms ? 1.0f : 0.08838834764831845f) / 127.0f);
        u32x2* o = (u32x2*)(dst + (size_t)row * DFF);
#pragma unroll 1
        for (int cb = 0; cb < DFF / 8; cb += 704) { u32x4 wq[11];
#pragma unroll
            for (int i = 0; i < 11; ++i) { const int c = cb + 64 * i + lane; wq[i] = c < DFF / 8 ? wr[c] : (u32x4){0u, 0u, 0u, 0u}; }
#pragma unroll
            for (int i = 0; i < 11; ++i) { const int c = cb + 64 * i + lane; const bool ok = c < DFF / 8; float t[8];
#pragma unroll
                for (int e = 0; e < 4; ++e) { const unsigned wd = wq[i][e];
                    if (bf) { t[2 * e] = __builtin_bit_cast(float, wd << 16); t[2 * e + 1] = __builtin_bit_cast(float, wd & 0xffff0000u); }
                    else { const hx2 hv = __builtin_bit_cast(hx2, wd); t[2 * e] = (float)hv.x; t[2 * e + 1] = (float)hv.y; } }
                rot128(t, lane);
                if (ok) { u32x2 w; w.x = pk_i8s(t[0], t[1], t[2], t[3], qs); w.y = pk_i8s(t[4], t[5], t[6], t[7], qs); o[c] = w; } } }
    }
}
__device__ __forceinline__ void p1_quant_weights(Ctx& C) {
    quant_rows_ff(C, C.WDN, D, (signed char*)(C.ws + WS_WDNQ), (float*)(C.ws + WS_SWDN), FFN_BF16 != 0, false);
    p1_quant_rows(C, C.WIN + (size_t)3072 * D, 13312, (signed char*)(C.ws + WS_WINQ), (float*)(C.ws + WS_SWQ), false, true);
    p1_quant_rows(C, C.WVT, 1024, (signed char*)(C.ws + WS_WVTQ), (float*)(C.ws + WS_SWQ) + 13312, false, true);
    p1_quant_rows(C, C.WUP, NUP, (signed char*)(C.ws + WS_WUPQ), (float*)(C.ws + WS_SW), FFN_BF16 != 0, true);
}
__device__ __forceinline__ void p7_norm(Ctx& C) {
    const int gw = C.bid * NWAVES + C.wave, NGW = C.G * NWAVES, lane = C.lane;
    LAS f32x4* const PV = (LAS f32x4*)C.lds;
    for (int i = C.tid; i < 2 * 1024; i += NTHREADS) { const int b = i >> 10, k = i & 1023;
        const f32x4 g1v = ((const f32x4*)(C.g_norms + D))[k], g2v = ((const f32x4*)(C.g_norms + 2 * D))[k];
        const f32x4 gtv = ((const f32x4*)(C.mod + b * NMOD + 2 * D))[k], shv = ((const f32x4*)(C.mod + b * NMOD + 3 * D))[k], scv = ((const f32x4*)(C.mod + b * NMOD + 4 * D))[k];
        PV[(b * 3 + 0) * 1024 + k] = gtv * g1v; PV[(b * 3 + 1) * 1024 + k] = g2v * (scv + 1.0f); PV[(b * 3 + 2) * 1024 + k] = shv; }
    __syncthreads();
    for (int row = gw; row < M; row += NGW) {
        const int b = row >> 13; const hx8* yr = (const hx8*)(C.Y1 + (size_t)row * D); const f32x4* xr = (const f32x4*)(C.x + (size_t)row * D); u32x2* orow = (u32x2*)(C.X1H + (size_t)row * D);
        f32x4 v[16]; float ss = 0.f;
#pragma unroll
        for (int j = 0; j < 8; ++j) { const hx8 hv = yr[lane + 64 * j];
            v[2 * j] = (f32x4){(float)hv[0], (float)hv[1], (float)hv[2], (float)hv[3]}; v[2 * j + 1] = (f32x4){(float)hv[4], (float)hv[5], (float)hv[6], (float)hv[7]}; }
#pragma unroll
        for (int j = 0; j < 16; ++j) ss += (v[j].x * v[j].x + v[j].y * v[j].y) + (v[j].z * v[j].z + v[j].w * v[j].w);
        const float rs = 1.0f / sqrtf(wave_sum(ss) * (1.0f / D) + EPS);
        const LAS f32x4* const A1 = PV + (b * 3 + 0) * 1024; const LAS f32x4* const A2 = PV + (b * 3 + 1) * 1024; const LAS f32x4* const A3 = PV + (b * 3 + 2) * 1024;
        float s2 = 0.f;
#pragma unroll
        for (int j = 0; j < 16; ++j) { const int k = 2 * (lane + 64 * (j >> 1)) + (j & 1); v[j] = xr[k] + A1[k] * (v[j] * rs); { u32x2 xw; xw.x = pkh(v[j].x, v[j].y); xw.y = pkh(v[j].z, v[j].w); orow[k] = xw; } s2 += (v[j].x * v[j].x + v[j].y * v[j].y) + (v[j].z * v[j].z + v[j].w * v[j].w); }
        const float rs2 = 1.0f / sqrtf(wave_sum(s2) * (1.0f / D) + EPS);
        float amax = 0.f;
        { float t[64];
#pragma unroll
          for (int j = 0; j < 16; ++j) { const int k = 2 * (lane + 64 * (j >> 1)) + (j & 1); const f32x4 hv = v[j] * rs2 * A2[k] + A3[k]; t[4 * j] = hv.x; t[4 * j + 1] = hv.y; t[4 * j + 2] = hv.z; t[4 * j + 3] = hv.w; }
          fwht64(t);
#pragma unroll
          for (int j = 0; j < 16; ++j) { v[j] = (f32x4){t[4 * j], t[4 * j + 1], t[4 * j + 2], t[4 * j + 3]};
              amax = fmaxf(amax, fmaxf(fmaxf(fabsf(v[j].x), fabsf(v[j].y)), fmaxf(fabsf(v[j].z), fabsf(v[j].w)))); } }
        amax = fmaxf(wave_max(amax), 1e-20f);
        const float qs = 127.0f / amax;
        const bool halo = (row & 255) >= 254; const int hrow = M + 2 * (row >> 8) + (row & 1);
        if (lane == 0) { ((float*)(C.ws + WS_SA))[row] = amax * (0.125f / 127.0f); if (halo) ((float*)(C.ws + WS_SA))[hrow] = amax * (0.125f / 127.0f); }
        u32x2* o = (u32x2*)(((signed char*)(C.ws + WS_H2)) + (size_t)row * D); u32x2* oh = (u32x2*)(((signed char*)(C.ws + WS_H2)) + (size_t)hrow * D);
#pragma unroll
        for (int j = 0; j < 8; ++j) { u32x2 w; w.x = pk_i8s(v[2 * j].x, v[2 * j].y, v[2 * j].z, v[2 * j].w, qs); w.y = pk_i8s(v[2 * j + 1].x, v[2 * j + 1].y, v[2 * j + 1].z, v[2 * j + 1].w, qs);
            o[lane + 64 * j] = w; if (halo) oh[lane + 64 * j] = w; }
    }
}
__device__ __forceinline__ void p11_final(Ctx& C) {
    const int gw = C.bid * NWAVES + C.wave, NGW = C.G * NWAVES, lane = C.lane;
    LAS f32x4* const PV = (LAS f32x4*)C.lds;
    for (int i = C.tid; i < 2 * 1024; i += NTHREADS) { const int b = i >> 10, k = i & 1023; PV[i] = ((const f32x4*)(C.mod + b * NMOD + 5 * D))[k] * ((const f32x4*)(C.g_norms + 3 * D))[k]; }
    __syncthreads();
    for (int row = gw; row < M; row += NGW) {
        const int b = row >> 13; f32x4* orow = (f32x4*)(C.out + (size_t)row * D); const hx8* yr = (const hx8*)(C.Y2 + (size_t)row * D); const hx8* xr = (const hx8*)(C.X1H + (size_t)row * D);
        f32x4 v[16]; float ss = 0.f;
#pragma unroll
        for (int j = 0; j < 8; ++j) { const hx8 hv = yr[lane + 64 * j];
            v[2 * j] = (f32x4){(float)hv[0], (float)hv[1], (float)hv[2], (float)hv[3]}; v[2 * j + 1] = (f32x4){(float)hv[4], (float)hv[5], (float)hv[6], (float)hv[7]}; }
#pragma unroll
        for (int j = 0; j < 16; ++j) ss += (v[j].x * v[j].x + v[j].y * v[j].y) + (v[j].z * v[j].z + v[j].w * v[j].w);
        const float rs = 1.0f / sqrtf(wave_sum(ss) * (1.0f / D) + EPS);
        const LAS f32x4* const G3 = PV + b * 1024;
#pragma unroll
        for (int j = 0; j < 8; ++j) { const hx8 xv = xr[lane + 64 * j]; const int k = 2 * (lane + 64 * j);
            const f32x4 x0 = {(float)xv[0], (float)xv[1], (float)xv[2], (float)xv[3]}, x1 = {(float)xv[4], (float)xv[5], (float)xv[6], (float)xv[7]};
            orow[k] = x0 + G3[k] * (v[2 * j] * rs); orow[k + 1] = x1 + G3[k + 1] * (v[2 * j + 1] * rs); }
    }
}

__device__ __forceinline__ void p3_gates_item(Ctx& C, int item) {
    const int lane = C.lane, w = C.wave, qr = lane & 15, q = lane >> 4;
    const f16* ap = C.H + (size_t)(item * 64 + qr) * D + w * 512 + 8 * q;
    const f16* bp = C.WG + (size_t)qr * D + w * 512 + 8 * q;
    f32x4 acc[4][3];
#pragma unroll
    for (int mt = 0; mt < 4; ++mt)
#pragma unroll
        for (int nt = 0; nt < 3; ++nt) acc[mt][nt] = (f32x4){0.f, 0.f, 0.f, 0.f};
#pragma unroll 4
    for (int ks = 0; ks < 16; ++ks) { hx8 a[4], bfr[3];
#pragma unroll
        for (int mt = 0; mt < 4; ++mt) a[mt] = *(const hx8*)(ap + (size_t)mt * 16 * D + 32 * ks);
#pragma unroll
        for (int nt = 0; nt < 3; ++nt) bfr[nt] = *(const hx8*)(bp + (size_t)nt * 16 * D + 32 * ks);
#pragma unroll
        for (int mt = 0; mt < 4; ++mt)
#pragma unroll
            for (int nt = 0; nt < 3; ++nt) acc[mt][nt] = __builtin_amdgcn_mfma_f32_16x16x32_f16(a[mt], bfr[nt], acc[mt][nt], 0, 0, 0); }
    LAS f32x4* red = (LAS f32x4*)C.lds;
#pragma unroll
    for (int mt = 0; mt < 4; ++mt)
#pragma unroll
        for (int nt = 0; nt < 3; ++nt) red[(w * 12 + mt * 3 + nt) * 64 + lane] = acc[mt][nt];
    __syncthreads();
    for (int t = w; t < 12; t += NWAVES) { const int mt = t / 3, nt = t % 3; f32x4 s = red[t * 64 + lane];
#pragma unroll
        for (int k = 1; k < 8; ++k) s += red[(k * 12 + t) * 64 + lane];
#pragma unroll
        for (int i = 0; i < 4; ++i) C.gates[(size_t)(item * 64 + mt * 16 + 4 * q + i) * 48 + nt * 16 + qr] = fsigmoid(s[i]); }
    __syncthreads();
}
__device__ __forceinline__ void p3_compress_item(Ctx& C, int item) {
    const int lane = C.lane, w = C.wave, qr = lane & 15, q = lane >> 4, kk = item >> 7, R0 = (item & 127) * 32;
    LAS f16* hid = (LAS f16*)C.lds;
    LAS unsigned char* abuf = C.lds + 20480;
    const int srow = C.tid >> 4, sseg = C.tid & 15;
    const f16* sp;
    { const int R = R0 + srow, b = R >> 11, g = (R >> 9) & 3, n = R & 511, nc = n > 510 ? 510 : n; sp = C.KV + (size_t)(b * T + 16 * nc) * 2048 + kk * 512 + g * 128 + 8 * sseg; }
    const int sdst = (srow * 16 + (sseg ^ (srow & 15))) * 16;
    const f16* pb0 = C.W1T + (size_t)(kk * 256 + 32 * w + qr) * D + 8 * q; const f16* pb1 = pb0 + (size_t)16 * D;
    f32x4 acc[2][2] = {{{0.f, 0.f, 0.f, 0.f}, {0.f, 0.f, 0.f, 0.f}}, {{0.f, 0.f, 0.f, 0.f}, {0.f, 0.f, 0.f, 0.f}}};
    hx8 fb[2][8]; hx8 nxt = *(const hx8*)sp; sp += 2048;
#define CM_LOADB(buf) do { _Pragma("unroll") for (int k4 = 0; k4 < 4; ++k4) { fb[buf][2 * k4] = *(const hx8*)(pb0 + 32 * k4); fb[buf][2 * k4 + 1] = *(const hx8*)(pb1 + 32 * k4); } pb0 += 128; pb1 += 128; } while (0)
#define CM_STEP(c, buf) do { *(LAS hx8*)(abuf + ((c) & 1) * 8192 + sdst) = nxt; \
        if ((c) + 1 < 32) { nxt = *(const hx8*)sp; sp += 2048; CM_LOADB((buf) ^ 1); } \
        __syncthreads(); \
        hx8 af_[8]; _Pragma("unroll") for (int i_ = 0; i_ < 8; ++i_) { const int mt_ = i_ >> 2, k4_ = i_ & 3; af_[i_] = *(const LAS hx8*)(abuf + ((c) & 1) * 8192 + ((16 * mt_ + qr) * 16 + ((4 * k4_ + q) ^ qr)) * 16); } \
        _Pragma("unroll") for (int k4 = 0; k4 < 4; ++k4) { \
            acc[0][0] = __builtin_amdgcn_mfma_f32_16x16x32_f16(af_[k4], fb[buf][2 * k4], acc[0][0], 0, 0, 0); acc[0][1] = __builtin_amdgcn_mfma_f32_16x16x32_f16(af_[k4], fb[buf][2 * k4 + 1], acc[0][1], 0, 0, 0); \
            acc[1][0] = __builtin_amdgcn_mfma_f32_16x16x32_f16(af_[4 + k4], fb[buf][2 * k4], acc[1][0], 0, 0, 0); acc[1][1] = __builtin_amdgcn_mfma_f32_16x16x32_f16(af_[4 + k4], fb[buf][2 * k4 + 1], acc[1][1], 0, 0, 0); } } while (0)
    CM_LOADB(0);
#pragma unroll 1
    for (int c = 0; c < 32; c += 2) { CM_STEP(c, 0); CM_STEP(c + 1, 1); }
#undef CM_LOADB
#undef CM_STEP
    __syncthreads();
#pragma unroll
    for (int mt = 0; mt < 2; ++mt)
#pragma unroll
        for (int nt = 0; nt < 2; ++nt) { const int j = 32 * w + 16 * nt + qr; const float pb = C.posw1[kk * 256 + j];
#pragma unroll
            for (int i = 0; i < 4; ++i) hid[(16 * mt + 4 * q + i) * 264 + j] = (f16)fgelu(acc[mt][nt][i] + pb); }
    __syncthreads();
    const f16* wp = C.W2T + (size_t)(kk * 128 + 16 * w + qr) * 256 + 8 * q;
    f32x4 o2[2] = {{0.f, 0.f, 0.f, 0.f}, {0.f, 0.f, 0.f, 0.f}};
#pragma unroll
    for (int ks = 0; ks < 8; ++ks) { const hx8 wf = *(const hx8*)(wp + 32 * ks);
#pragma unroll
        for (int mt = 0; mt < 2; ++mt) { const hx8 hf = *(const LAS hx8*)(hid + (16 * mt + qr) * 264 + 32 * ks + 8 * q);
            if (kk == 0) o2[mt] = __builtin_amdgcn_mfma_f32_16x16x32_f16(wf, hf, o2[mt], 0, 0, 0);
            else o2[mt] = __builtin_amdgcn_mfma_f32_16x16x32_f16(hf, wf, o2[mt], 0, 0, 0); } }
    if (kk == 0) {
#pragma unroll
        for (int mt = 0; mt < 2; ++mt) { const int R = R0 + 16 * mt + qr, n = R & 511, d0 = 16 * w + 4 * q; const bool pad = n == 511;
            float v[4];
#pragma unroll
            for (int i = 0; i < 4; ++i) v[i] = pad ? 0.f : o2[mt][i] + C.cmp_b2[d0 + i];
            u32x2 o; o.x = pkh(v[0], v[1]); o.y = pkh(v[2], v[3]); *(u32x2*)(C.KC + (size_t)R * 128 + d0) = o; }
    } else {
#pragma unroll
        for (int mt = 0; mt < 2; ++mt) { const int Rb = R0 + 16 * mt + 4 * q, bg = Rb >> 9, n0 = Rb & 511, d = 16 * w + qr; const float bb = C.cmp_b2[128 + d];
            float v[4];
#pragma unroll
            for (int i = 0; i < 4; ++i) v[i] = (n0 + i == 511) ? 0.f : o2[mt][i] + bb;
            u32x2 o; o.x = pkh(v[0], v[1]); o.y = pkh(v[2], v[3]); *(u32x2*)(C.VCT + ((size_t)bg * 128 + d) * 512 + n0) = o; }
    }
    __syncthreads();
}
__device__ __forceinline__ void p3_sgu_item(Ctx& C, int item) {
    const int lane = C.lane, w = C.wave, tid = C.tid, qr = lane & 15, q = lane >> 4, r0 = (item >> 1) * 128, half = item & 1;
    LAS float* stats = (LAS float*)C.lds;
    LAS f16* vt = (LAS f16*)(C.lds + 1024);
#pragma unroll 4
    for (int tk = 0; tk < 16; ++tk) { const int s = 16 * w + tk; const f16* vp = C.Z + (size_t)(r0 + s) * D + 2048 + 8 * lane;
        float xv[32]; float sum = 0.f;
#pragma unroll
        for (int jj = 0; jj < 4; ++jj) { const hx8 h = *(const hx8*)(vp + 512 * jj);
#pragma unroll
            for (int e = 0; e < 8; ++e) { xv[8 * jj + e] = (float)h[e]; sum += xv[8 * jj + e]; } }
        const float mu = wave_sum(sum) * (1.0f / 2048.0f); float sq = 0.f;
#pragma unroll
        for (int e = 0; e < 32; ++e) { const float dv = xv[e] - mu; sq += dv * dv; }
        const float var = wave_sum(sq) * (1.0f / 2048.0f);
        if (lane == 0) { stats[2 * s] = mu; stats[2 * s + 1] = 1.0f / sqrtf(var + EPS); } }
    __syncthreads();
    hx8 hv[4];
    { const int s = tid >> 2, seg = tid & 3; const f16* vp = C.Z + (size_t)(r0 + s) * D + 2048 + (half * 8) * 128 + 32 * seg;
#pragma unroll
      for (int i = 0; i < 4; ++i) hv[i] = *(const hx8*)(vp + 8 * i); }
#pragma unroll 1
    for (int gi = 0; gi < 8; ++gi) { const int hh = half * 8 + gi;
        hx8 wf[4], hvn[4]; hx4 uu[8];
#pragma unroll
        for (int ks = 0; ks < 4; ++ks) wf[ks] = *(const hx8*)(C.SGUW + ((size_t)(hh * 128 + 16 * w + qr)) * 128 + 32 * ks + 8 * q);
        { const f16* up = C.Z + (size_t)(r0 + 16 * w + qr) * D + hh * 128 + 4 * q;
#pragma unroll
          for (int dt = 0; dt < 8; ++dt) uu[dt] = *(const hx4*)(up + 16 * dt); }
        { const int s = tid >> 2, seg = tid & 3; const f16* vp = C.Z + (size_t)(r0 + s) * D + 2048 + (gi < 7 ? hh + 1 : hh) * 128 + 32 * seg;
#pragma unroll
          for (int i = 0; i < 4; ++i) hvn[i] = *(const hx8*)(vp + 8 * i); }
        { const int s = tid >> 2, seg = tid & 3; const float mu = stats[2 * s], rstd = stats[2 * s + 1];
#pragma unroll
          for (int i = 0; i < 4; ++i) { const hx8 h = hv[i];
#pragma unroll
              for (int e = 0; e < 8; ++e) { const int d = 32 * seg + 8 * i + e; const float y = ((float)h[e] - mu) * rstd * C.ln_g[hh * 128 + d] + C.ln_b[hh * 128 + d]; vt[d * 136 + s] = (f16)y; } } }
        __syncthreads();
        f32x4 acc[8];
#pragma unroll
        for (int dt = 0; dt < 8; ++dt) { acc[dt] = (f32x4){0.f, 0.f, 0.f, 0.f};
#pragma unroll
            for (int ks = 0; ks < 4; ++ks) { const hx8 af = *(const LAS hx8*)(vt + (16 * dt + qr) * 136 + 32 * ks + 8 * q); acc[dt] = __builtin_amdgcn_mfma_f32_16x16x32_f16(af, wf[ks], acc[dt], 0, 0, 0); } }
        { const int tl = 16 * w + qr; const float bs = C.sgu_b[hh * 128 + tl];
          f16* yp = C.YAB + (size_t)(r0 + tl) * D + 2048 + hh * 128 + 4 * q;
#pragma unroll
          for (int dt = 0; dt < 8; ++dt) { const hx4 u = uu[dt];
              u32x2 o; o.x = pk_mix((float)u[0] * (acc[dt][0] + bs), (float)u[1] * (acc[dt][1] + bs)); o.y = pk_mix((float)u[2] * (acc[dt][2] + bs), (float)u[3] * (acc[dt][3] + bs));
              *(u32x2*)(yp + 16 * dt) = o; } }
        __syncthreads();
#pragma unroll
        for (int i = 0; i < 4; ++i) hv[i] = hvn[i];
    }
}

constexpr int ATT_LUT = 0, ATT_IMP = 8192, ATT_STG = 40960, STG_BYTES = 32768, STG_V = 16384;
static_assert(ATT_STG + 3 * STG_BYTES <= MISC_OFF, "attention LDS map");
__device__ __forceinline__ int rel_bucket_small(int n) {
    if (n < 16) return n;
    int b = 16;
    b += n >= 19; b += n >= 21; b += n >= 24; b += n >= 27; b += n >= 31; b += n >= 35; b += n >= 40; b += n >= 46; b += n >= 52; b += n >= 59; b += n >= 67; b += n >= 77; b += n >= 87; b += n >= 99; b += n >= 113;
    return b;
}
__device__ __forceinline__ void att_issue(Ctx& C, int s, int n_c, int n_s, int ks0g, int b, int g) {
    const int lane = (int)pg8::opaque((unsigned)C.lane), w = C.wave;
    const f16* kb; const f16* vb; int ldk, ldv, kb0;
    if (s < 2 * n_c) { kb0 = 64 * (s < n_c ? s : s - n_c); kb = C.KC + (size_t)(b * 4 + g) * 512 * 128; ldk = 128; vb = C.VCT + (size_t)(b * 4 + g) * 128 * 512; ldv = 512; }
    else if (s < 2 * n_c + n_s) { kb0 = 64 * (s - 2 * n_c); kb = C.KV + (size_t)b * T * 2048 + 1024 + g * 128; ldk = 2048; vb = C.VT + (size_t)(g * 128) * M + (size_t)b * T; ldv = M; }
    else { kb0 = ks0g + 64 * (s - 2 * n_c - n_s); kb = C.KV + (size_t)b * T * 2048 + 1536 + g * 128; ldk = 2048; vb = C.VT + (size_t)(512 + g * 128) * M + (size_t)b * T; ldv = M; }
    LAS unsigned char* buf = C.lds + ATT_STG + (s % 3) * STG_BYTES;
#pragma unroll
    for (int i = 0; i < 2; ++i) { const int R = 8 * w + 4 * i + (lane >> 4), m = R & 15, key = kb0 + 32 * (R >> 5) + (m >> 2) * 8 + (m & 3) + 4 * ((R >> 4) & 1), cidx = (lane & 15) ^ m;
        __builtin_amdgcn_global_load_lds((const unsigned*)(kb + (size_t)key * ldk + cidx * 8), (LAS unsigned*)(buf + (8 * w + 4 * i) * 256), 16, 0, 0); }
#pragma unroll
    for (int i = 0; i < 2; ++i) { const int dr = 16 * w + 8 * i + (lane >> 3), v = (lane & 7) ^ ((dr & 15) >> 1);
        __builtin_amdgcn_global_load_lds((const unsigned*)(vb + (size_t)dr * ldv + kb0 + 8 * v), (LAS unsigned*)(buf + STG_V + (16 * w + 8 * i) * 128), 16, 0, 0); }
}
#define SB() __builtin_amdgcn_sched_barrier(0)
#define ATT_QK2(TL) do { _Pragma("unroll") for (int scn_ = 0; scn_ < 2; ++scn_) { hx8 kf_[8]; \
        _Pragma("unroll") for (int i_ = 0; i_ < 8; ++i_) { const int kt_ = i_ >> 2, ks_ = i_ & 3; \
            kf_[i_] = *(const LAS hx8*)(bufp + scn_ * 8192 + kt_ * 4096 + qr * 256 + (((4 * ks_ + q) ^ qr) << 4)); } \
        __builtin_amdgcn_s_setprio(1); \
        _Pragma("unroll") for (int t_ = 0; t_ < 2; ++t_) { f32x4 a_ = {0.f, 0.f, 0.f, 0.f}; \
            _Pragma("unroll") for (int ks = 0; ks < 4; ++ks) a_ = __builtin_amdgcn_mfma_f32_16x16x32_f16(kf_[4 * t_ + ks], qf[TL][ks], a_, 0, 0, 0); sv[TL][2 * scn_ + t_] = a_; } \
        __builtin_amdgcn_s_setprio(0); } } while (0)
#define ATT_QK2B() do { hx8 kfa_[8], kfb_[8]; \
        _Pragma("unroll") for (int i_ = 0; i_ < 8; ++i_) { const int kt_ = i_ >> 2, ks_ = i_ & 3; \
            kfa_[i_] = *(const LAS hx8*)(bufp + kt_ * 4096 + qr * 256 + (((4 * ks_ + q) ^ qr) << 4)); } \
        _Pragma("unroll") for (int i_ = 0; i_ < 8; ++i_) { const int kt_ = i_ >> 2, ks_ = i_ & 3; \
            kfb_[i_] = *(const LAS hx8*)(bufp + 8192 + kt_ * 4096 + qr * 256 + (((4 * ks_ + q) ^ qr) << 4)); } \
        SB(); asm volatile("s_waitcnt lgkmcnt(8)" ::: "memory"); __builtin_amdgcn_s_setprio(1); \
        _Pragma("unroll") for (int t_ = 0; t_ < 2; ++t_) { f32x4 a0_ = {0.f, 0.f, 0.f, 0.f}, a1_ = {0.f, 0.f, 0.f, 0.f}; \
            _Pragma("unroll") for (int ks = 0; ks < 4; ++ks) { a0_ = __builtin_amdgcn_mfma_f32_16x16x32_f16(kfa_[4 * t_ + ks], qf[0][ks], a0_, 0, 0, 0); a1_ = __builtin_amdgcn_mfma_f32_16x16x32_f16(kfa_[4 * t_ + ks], qf[1][ks], a1_, 0, 0, 0); } \
            sv[0][t_] = a0_; sv[1][t_] = a1_; } \
        SB(); \
        _Pragma("unroll") for (int t_ = 0; t_ < 2; ++t_) { f32x4 a0_ = {0.f, 0.f, 0.f, 0.f}, a1_ = {0.f, 0.f, 0.f, 0.f}; \
            _Pragma("unroll") for (int ks = 0; ks < 4; ++ks) { a0_ = __builtin_amdgcn_mfma_f32_16x16x32_f16(kfb_[4 * t_ + ks], qf[0][ks], a0_, 0, 0, 0); a1_ = __builtin_amdgcn_mfma_f32_16x16x32_f16(kfb_[4 * t_ + ks], qf[1][ks], a1_, 0, 0, 0); } \
            sv[0][2 + t_] = a0_; sv[1][2 + t_] = a1_; } \
        __builtin_amdgcn_s_setprio(0); } while (0)
#define SVJ(tl, j) (sv[tl][(j) >> 2][(j) & 3])
#define ATT_PV2(SC) do { SB(); hx8 vfa_[8], vfb_[4]; \
    _Pragma("unroll") for (int dt_ = 0; dt_ < 8; ++dt_) vfa_[dt_] = *(const LAS hx8*)(bufp + STG_V + qr * 128 + (((q) ^ (qr >> 1)) << 4) + dt_ * 2048); \
    _Pragma("unroll") for (int dt_ = 0; dt_ < 4; ++dt_) vfb_[dt_] = *(const LAS hx8*)(bufp + STG_V + qr * 128 + (((4 + q) ^ (qr >> 1)) << 4) + dt_ * 2048); \
    SB(); asm volatile("s_waitcnt lgkmcnt(4)" ::: "memory"); \
    _Pragma("unroll") for (int tl_ = 0; tl_ < 2; ++tl_) { if (act[tl_]) { _Pragma("unroll") for (int dt = 0; dt < 8; ++dt) { f32x4 c_ = o[tl_][dt]; if (SC) c_ *= oal[tl_]; \
        o[tl_][dt] = __builtin_amdgcn_mfma_f32_16x16x32_f16(vfa_[dt], pf[tl_][0], c_, 0, 0, 0); } } } \
    SB(); \
    _Pragma("unroll") for (int dt_ = 0; dt_ < 4; ++dt_) vfa_[dt_] = *(const LAS hx8*)(bufp + STG_V + qr * 128 + (((4 + q) ^ (qr >> 1)) << 4) + (4 + dt_) * 2048); \
    _Pragma("unroll") for (int tl_ = 0; tl_ < 2; ++tl_) { if (act[tl_]) { _Pragma("unroll") for (int dt = 0; dt < 4; ++dt) \
        o[tl_][dt] = __builtin_amdgcn_mfma_f32_16x16x32_f16(vfb_[dt], pf[tl_][1], o[tl_][dt], 0, 0, 0); } } \
    SB(); \
    _Pragma("unroll") for (int tl_ = 0; tl_ < 2; ++tl_) { if (act[tl_]) { _Pragma("unroll") for (int dt = 0; dt < 4; ++dt) \
        o[tl_][4 + dt] = __builtin_amdgcn_mfma_f32_16x16x32_f16(vfa_[dt], pf[tl_][1], o[tl_][4 + dt], 0, 0, 0); } } \
    SB(); } while (0)
#define ATT_MAXUPD(TL, RESCALE_O) do { float al_ = 1.0f; if (__any(cm_ > m[TL] + 8.0f)) { cm_ = fmaxf(cm_, __shfl_xor(cm_, 16)); cm_ = fmaxf(cm_, __shfl_xor(cm_, 32)); \
    const float mn_ = fmaxf(m[TL], cm_); al_ = __builtin_amdgcn_exp2f(m[TL] - mn_); m[TL] = mn_; } l[TL] *= al_; if (RESCALE_O) oal[TL] = al_; } while (0)
#define ATT_PACKP(TL) do { _Pragma("unroll") for (int j = 0; j < 8; ++j) { pf[TL][0][j] = (f16)p[j]; pf[TL][1][j] = (f16)p[8 + j]; } } while (0)
#define ATT_SOFTMAX_FAR(TL, cb_, RESCALE_O) do { float mx_ = SVJ(TL, 0); _Pragma("unroll") for (int j = 1; j < 16; ++j) mx_ = fmaxf(mx_, SVJ(TL, j)); \
    float cm_ = mx_ * SC2 + (cb_); ATT_MAXUPD(TL, RESCALE_O); const float off_ = (cb_) - m[TL]; float ps_ = 0.f; \
    _Pragma("unroll") for (int j = 0; j < 16; ++j) { const float e_ = __builtin_amdgcn_exp2f(SVJ(TL, j) * SC2 + off_); ps_ += e_; pf[TL][j >> 3][j & 7] = (f16)e_; } l[TL] += ps_; } while (0)
#define ATT_SOFTMAX_NEAR(TL, RESCALE_O) do { float cm_ = sc[0]; _Pragma("unroll") for (int j = 1; j < 16; ++j) cm_ = fmaxf(cm_, sc[j]); \
    ATT_MAXUPD(TL, RESCALE_O); float ps_ = 0.f; \
    _Pragma("unroll") for (int j = 0; j < 16; ++j) { const float e_ = __builtin_amdgcn_exp2f(sc[j] - m[TL]); ps_ += e_; pf[TL][j >> 3][j & 7] = (f16)e_; } l[TL] += ps_; } while (0)
#define ATT_STAGE_BEGIN() do { TP_BEGIN(8); if (s + 1 < S) asm volatile("s_waitcnt vmcnt(4)" ::: "memory"); else asm volatile("s_waitcnt vmcnt(0)" ::: "memory"); \
    __builtin_amdgcn_s_barrier(); asm volatile("" ::: "memory"); TP_END(8); \
    if (s + 2 < S) att_issue(C, s + 2, n_c, n_s, ks0g, b, g); \
    bufp = C.lds + ATT_STG + (s % 3) * STG_BYTES; } while (0)
constexpr float NEGBIG = -3.0e38f;

#define TP_BEGIN(r) do { if (ATT_TPROBE == (r)) tp_t0 = (long long)wall_clock64(); } while (0)
#define TP_END(r) do { if (ATT_TPROBE == (r)) tp_acc += (long long)wall_clock64() - tp_t0; } while (0)
__device__ __forceinline__ void p4_attn_unit(Ctx& C, int u, long long& tp_acc) {
    long long tp_t0 = 0; TP_BEGIN(5); TP_BEGIN(6);
    const int lane = C.lane, w = C.wave, qr = lane & 15, q = lane >> 4, tok = qr >> 2, r = qr & 3;
    const int bg = u & 7, b = bg >> 2, g = bg & 3, tj = u >> 3, t0g = tj * 64, t0 = t0g + w * 8, h = g * 4 + r;
    const LAS float* lut = (const LAS float*)(C.lds + ATT_LUT) + h * 128;
    LAS float* imp = (LAS float*)(C.lds + ATT_IMP) + w * 1024;
    const LAS unsigned char* bufp = C.lds + ATT_STG;
    const int n_c = (tj >> 4) + 1, n_s = tj + 1, ks0g = (t0g - 511 < 0 ? 0 : t0g - 511) & ~63, n_w = ((t0g + 63 - ks0g) >> 6) + 1, S = 2 * n_c + n_s + n_w;
    hx8 qf[2][4];
#pragma unroll
    for (int tl = 0; tl < 2; ++tl) { const int t = t0 + 4 * tl + tok; const f16* qp = C.Q + (size_t)(b * T + t) * 2048 + h * 128 + 8 * q;
#pragma unroll
        for (int ks = 0; ks < 4; ++ks) qf[tl][ks] = *(const hx8*)(qp + 32 * ks); }
#define GATE(tl, i) (C.gates[(size_t)(b * T + t0 + 4 * (tl) + tok) * 48 + h * 3 + (i)])
#define YSP(tl) ((f32x4*)(C.ysc + (size_t)(b * T + t0 + 4 * (tl) + tok) * 2048 + h * 128 + 4 * q))
    const float b127 = lut[127];
    f32x4 o[2][8], sv[2][4]; hx8 pf[2][2]; float sc[16], p[16], m[2], l[2], oal[2] = {1.0f, 1.0f}; bool act[2];
#pragma unroll
    for (int tl = 0; tl < 2; ++tl)
#pragma unroll
        for (int dt = 0; dt < 8; ++dt) o[tl][dt] = (f32x4){0.f, 0.f, 0.f, 0.f};
    for (int i = lane; i < 1024; i += 64) imp[i] = 0.f;
    asm volatile("s_waitcnt vmcnt(0) lgkmcnt(0)" ::: "memory");
    __syncthreads();
    int s = 0;
    att_issue(C, 0, n_c, n_s, ks0g, b, g); att_issue(C, 1, n_c, n_s, ks0g, b, g);

    TP_END(6); TP_BEGIN(1);
    m[0] = m[1] = -1e30f; l[0] = l[1] = 0.f;
    for (int c = 0; c < n_c; ++c, ++s) {
        ATT_STAGE_BEGIN();
        const int kb0 = 64 * c;
        act[0] = kb0 <= ((t0 + 3 - 31) >> 4); act[1] = kb0 <= ((t0 + 7 - 31) >> 4);
        if (!act[1]) continue;
#pragma unroll
        for (int tl = 0; tl < 2; ++tl) { if (act[tl]) { const int tb = t0 + 4 * tl, t = tb + tok, nmax_t = (t - 31) >> 4;
            ATT_QK2(tl);
            if (kb0 + 63 <= ((tb - 31) >> 4) && tb - 16 * (kb0 + 63) - 31 >= 127) { ATT_SOFTMAX_FAR(tl, b127, false); }
            else {
#pragma unroll
                for (int j = 0; j < 16; ++j) { const int n = kb0 + 32 * (j >> 3) + 8 * q + (j & 7), dist = t - 16 * n - 31; sc[j] = lut[dist < 0 ? 0 : (dist > 127 ? 127 : dist)]; }
                SB();
#pragma unroll
                for (int j = 0; j < 16; ++j) { const int n = kb0 + 32 * (j >> 3) + 8 * q + (j & 7); const float sx = SVJ(tl, j) * SC2 + sc[j]; sc[j] = n <= nmax_t ? sx : NEGBIG; }
                ATT_SOFTMAX_NEAR(tl, false); } } }
    }
    float il[2];
#pragma unroll
    for (int tl = 0; tl < 2; ++tl) { l[tl] += __shfl_xor(l[tl], 16); l[tl] += __shfl_xor(l[tl], 32); il[tl] = l[tl] > 0.f ? 1.0f / l[tl] : 0.f; }
    float carry[2] = {0.f, 0.f};
    for (int c = 0; c < n_c; ++c, ++s) {
        ATT_STAGE_BEGIN();
        const int kb0 = 64 * c;
        act[0] = kb0 <= ((t0 + 3 - 31) >> 4); act[1] = kb0 <= ((t0 + 7 - 31) >> 4);
        if (!act[1]) continue;
#pragma unroll
        for (int tl = 0; tl < 2; ++tl) { if (act[tl]) { const int t = t0 + 4 * tl + tok, nmax_t = (t - 31) >> 4;
            ATT_QK2(tl);
#pragma unroll
            for (int j = 0; j < 16; ++j) { const int n = kb0 + 32 * (j >> 3) + 8 * q + (j & 7), dist = t - 16 * n - 31; p[j] = lut[dist < 0 ? 0 : (dist > 127 ? 127 : dist)]; }
            SB();
#pragma unroll
            for (int j = 0; j < 16; ++j) { const int n = kb0 + 32 * (j >> 3) + 8 * q + (j & 7); const float px = __builtin_amdgcn_exp2f(SVJ(tl, j) * SC2 + p[j] - m[tl]) * il[tl]; p[j] = n <= nmax_t ? px : 0.f; }
            ATT_PACKP(tl);
#pragma unroll
            for (int scn = 0; scn < 2; ++scn) { float ph[8];
#pragma unroll
                for (int j = 0; j < 8; ++j) { float v = p[8 * scn + j]; v += dpp_f<0xB1>(v); v += dpp_f<0x4E>(v); ph[j] = v; }
                const float t7 = __shfl(ph[7], (lane + 48) & 63);
                const float left = q == 0 ? carry[tl] : t7; carry[tl] = t7;
                if (r == 0) { f32x2 iv; iv.x = left + 2.0f * (ph[0] + ph[1] + ph[2]) + ph[3]; iv.y = ph[3] + 2.0f * (ph[4] + ph[5] + ph[6]) + ph[7];
                    *(LAS f32x2*)(imp + (4 * tl + tok) * 128 + ((kb0 + 32 * scn) >> 2) + 2 * q) = iv; } } } }
        ATT_PV2(false);
    }
#pragma unroll
    for (int tl = 0; tl < 2; ++tl) { f32x4* ysp = YSP(tl); const float gc = GATE(tl, 0);
#pragma unroll
        for (int dt = 0; dt < 8; ++dt) { ysp[4 * dt] = o[tl][dt] * gc; o[tl][dt] = (f32x4){0.f, 0.f, 0.f, 0.f}; } }
    LDS_WAIT();
    TP_END(1); TP_BEGIN(2);
    unsigned long long my_lo[2] = {0ull, 0ull}, my_hi[2] = {0ull, 0ull}, U_lo[2] = {0ull, 0ull}, U_hi[2] = {0ull, 0ull};
#pragma unroll
    for (int tk = 0; tk < 8; ++tk) { const int tt = t0 + tk, cur = tt >> 6; unsigned long long lo, hi;
        if (cur < 16) { lo = (1ull << (cur + 1)) - 1ull; hi = 0ull; }
        else {
            const LAS float* P = imp + tk * 128;
            const int j0 = lane, j1 = lane + 64;
            const bool c0 = j0 >= 1 && j0 <= cur - 2, c1 = j1 <= cur - 2;
            const int k0 = c0 ? __float_as_int(P[j0]) : -1, k1 = c1 ? __float_as_int(P[j1]) : -1;
            int Tk = 0;
#pragma unroll 1
            for (int bit = 30; bit >= 0; --bit) { const int cand = Tk | (1 << bit); const int cnt = __popcll(__ballot(k0 >= cand)) + __popcll(__ballot(k1 >= cand)); if (cnt >= 13) { Tk = cand; if (cnt == 13) break; } }
            const unsigned long long e0 = __ballot(k0 == Tk), e1 = __ballot(k1 == Tk);
            const int need = 13 - (__popcll(__ballot(k0 > Tk)) + __popcll(__ballot(k1 > Tk)));
            const int r0 = (int)__builtin_amdgcn_mbcnt_hi((unsigned)(e0 >> 32), __builtin_amdgcn_mbcnt_lo((unsigned)e0, 0u));
            const int r1 = __popcll(e0) + (int)__builtin_amdgcn_mbcnt_hi((unsigned)(e1 >> 32), __builtin_amdgcn_mbcnt_lo((unsigned)e1, 0u));
            const bool sel0 = k0 > Tk || (k0 == Tk && r0 < need) || j0 == 0 || j0 == cur || j0 == cur - 1, sel1 = k1 > Tk || (k1 == Tk && r1 < need) || j1 == cur || j1 == cur - 1;
            lo = __ballot(sel0); hi = __ballot(sel1);
        }
        U_lo[tk >> 2] |= lo; U_hi[tk >> 2] |= hi; if (tok == (tk & 3)) { my_lo[tk >> 2] = lo; my_hi[tk >> 2] = hi; } }
    TP_END(2); TP_BEGIN(3);
    m[0] = m[1] = -1e30f; l[0] = l[1] = 0.f;
    for (int jb = 0; jb < n_s; ++jb, ++s) {
        ATT_STAGE_BEGIN();
        bool mine[2];
#pragma unroll
        for (int tl = 0; tl < 2; ++tl) { act[tl] = jb < 64 ? ((U_lo[tl] >> jb) & 1ull) : ((U_hi[tl] >> (jb - 64)) & 1ull); mine[tl] = jb < 64 ? ((my_lo[tl] >> jb) & 1ull) : ((my_hi[tl] >> (jb - 64)) & 1ull); }
        if (!act[0] && !act[1]) continue;
        const int kb0 = 64 * jb;
        if (act[0] && act[1] && t0 - (kb0 + 63) >= 127) {
            ATT_QK2B();
            { const float cb = mine[0] ? b127 : NEGBIG; ATT_SOFTMAX_FAR(0, cb, true); }
            { const float cb = mine[1] ? b127 : NEGBIG; ATT_SOFTMAX_FAR(1, cb, true); }
        } else
#pragma unroll
        for (int tl = 0; tl < 2; ++tl) { if (act[tl]) { const int tb = t0 + 4 * tl, t = tb + tok;
            ATT_QK2(tl);
            if (tb - (kb0 + 63) >= 127) { const float cb = mine[tl] ? b127 : NEGBIG; ATT_SOFTMAX_FAR(tl, cb, true); }
            else { const int bd = t - kb0 - 8 * q;
#pragma unroll
                for (int j = 0; j < 16; ++j) { const int dist = bd - 32 * (j >> 3) - (j & 7); sc[j] = lut[dist < 0 ? 0 : (dist > 127 ? 127 : dist)]; }
                SB();
#pragma unroll
                for (int j = 0; j < 16; ++j) { const int dist = bd - 32 * (j >> 3) - (j & 7); const float sx = SVJ(tl, j) * SC2 + sc[j]; sc[j] = (mine[tl] && dist >= 0) ? sx : NEGBIG; }
                ATT_SOFTMAX_NEAR(tl, true); } } }
        ATT_PV2(true);
    }
#pragma unroll
    for (int tl = 0; tl < 2; ++tl) { l[tl] += __shfl_xor(l[tl], 16); l[tl] += __shfl_xor(l[tl], 32); const float gl = l[tl] > 0.f ? GATE(tl, 1) / l[tl] : 0.f; f32x4* ysp = YSP(tl);
#pragma unroll
        for (int dt = 0; dt < 8; ++dt) { ysp[4 * dt] = ysp[4 * dt] + o[tl][dt] * gl; o[tl][dt] = (f32x4){0.f, 0.f, 0.f, 0.f}; } }
    TP_END(3); TP_BEGIN(4);
    m[0] = m[1] = -1e30f; l[0] = l[1] = 0.f;
    for (int k = 0; k < n_w; ++k, ++s) {
        ATT_STAGE_BEGIN();
        const int kb0 = ks0g + 64 * k;
#pragma unroll
        for (int tl = 0; tl < 2; ++tl) { const int tb = t0 + 4 * tl; act[tl] = !(kb0 > tb + 3 || kb0 + 63 < tb - 511); }
        if (!act[0] && !act[1]) continue;
        if (act[0] && act[1] && t0 - (kb0 + 63) >= 127 && t0 + 7 - kb0 <= 511) {
            ATT_QK2B();
            ATT_SOFTMAX_FAR(0, b127, true); ATT_SOFTMAX_FAR(1, b127, true);
        } else
#pragma unroll
        for (int tl = 0; tl < 2; ++tl) { if (act[tl]) { const int tb = t0 + 4 * tl, t = tb + tok;
            ATT_QK2(tl);
            if (tb - (kb0 + 63) >= 127 && tb + 3 - kb0 <= 511) { ATT_SOFTMAX_FAR(tl, b127, true); }
            else { const int bd = t - kb0 - 8 * q;
#pragma unroll
                for (int j = 0; j < 16; ++j) { const int dist = bd - 32 * (j >> 3) - (j & 7); sc[j] = lut[dist < 0 ? 0 : (dist > 127 ? 127 : dist)]; }
                SB();
#pragma unroll
                for (int j = 0; j < 16; ++j) { const int dist = bd - 32 * (j >> 3) - (j & 7); const float sx = SVJ(tl, j) * SC2 + sc[j]; sc[j] = (dist >= 0 && dist < 512) ? sx : NEGBIG; }
                ATT_SOFTMAX_NEAR(tl, true); } } }
        ATT_PV2(true);
    }
#pragma unroll
    for (int tl = 0; tl < 2; ++tl) { l[tl] += __shfl_xor(l[tl], 16); l[tl] += __shfl_xor(l[tl], 32); const float gl = l[tl] > 0.f ? GATE(tl, 2) / l[tl] : 0.f; const f32x4* ysp = YSP(tl);
        f16* yp = C.YAB + (size_t)(b * T + t0 + 4 * tl + tok) * D + h * 128 + 4 * q;
#pragma unroll
        for (int dt = 0; dt < 8; ++dt) { const f32x4 yv = ysp[4 * dt] + o[tl][dt] * gl; u32x2 ov; ov.x = pk_mix(yv[0], yv[1]); ov.y = pk_mix(yv[2], yv[3]); *(u32x2*)(yp + 16 * dt) = ov; } }
    TP_END(4); TP_END(5);
}
#undef GATE
#undef YSP
__device__ __forceinline__ void p4_attention(Ctx& C) {
    LAS float* lut = (LAS float*)(C.lds + ATT_LUT);
    for (int i = C.tid; i < 16 * 128; i += NTHREADS) { const int hh = i >> 7, n = i & 127; lut[i] = C.rel_table[rel_bucket_small(n) * 16 + hh] * LOG2E; }
    __syncthreads();
    long long tp_acc = 0;
    for (int i = C.bid; i < 1024; i += C.G) { const int idx = i >> 3, k = idx >> 5, x = idx & 31, tj = (k & 1) ? 32 * k + 31 - x : idx; p4_attn_unit(C, (tj << 3) | (i & 7), tp_acc); }
    if (ATT_TPROBE != 0) { const long long t0 = (long long)wall_clock64(); while ((long long)wall_clock64() - t0 < tp_acc) __builtin_amdgcn_s_sleep(8); }
    __syncthreads();
}

__device__ __forceinline__ void p9_fixup(Ctx& C) {
    const int gt = C.bid * NTHREADS + C.tid, NGT = C.G * NTHREADS;
    for (int it = gt; it < 64 * (DFF / 8); it += NGT) {
        const int pm = it / (DFF / 8), c0 = (it % (DFF / 8)) * 8; const bool first = ((pm * 256) & (T - 1)) == 0;
        float res[2][8];
#pragma unroll
        for (int h4 = 0; h4 < 2; ++h4) {
            f32x4 cvv[2][2];
#pragma unroll
            for (int bj = 0; bj < 2; ++bj) { const int cc = c0 + 4 * h4;
                const f32x4 w0 = *(const f32x4*)(C.conv_w + 0 * NUP + bj * DFF + cc), w1 = *(const f32x4*)(C.conv_w + 1 * NUP + bj * DFF + cc), w2 = *(const f32x4*)(C.conv_w + 2 * NUP + bj * DFF + cc), bb = *(const f32x4*)(C.conv_b + bj * DFF + cc);
                const f32x4 a0 = *(const f32x4*)(C.AT + (size_t)((pm * 2 + 0) * 2 + bj) * DFF + cc), a1 = *(const f32x4*)(C.AT + (size_t)((pm * 2 + 1) * 2 + bj) * DFF + cc);
                f32x4 hm2 = {0.f, 0.f, 0.f, 0.f}, hm1 = {0.f, 0.f, 0.f, 0.f};
                if (!first) { hm2 = *(const f32x4*)(C.AH + (size_t)((2 * (pm - 1) + 0) * 2 + bj) * DFF + cc); hm1 = *(const f32x4*)(C.AH + (size_t)((2 * (pm - 1) + 1) * 2 + bj) * DFF + cc); }
                cvv[0][bj] = bb + w0 * hm2 + w1 * hm1 + w2 * a0; cvv[1][bj] = bb + w0 * hm1 + w1 * a0 + w2 * a1; }
#pragma unroll
            for (int j = 0; j < 2; ++j)
#pragma unroll
                for (int i = 0; i < 4; ++i) res[j][4 * h4 + i] = fsilu(cvv[j][0][i]) * cvv[j][1][i]; }
#pragma unroll
        for (int j = 0; j < 2; ++j) { u32x4 ov; ov.x = pk_ffn(res[j][0], res[j][1]); ov.y = pk_ffn(res[j][2], res[j][3]); ov.z = pk_ffn(res[j][4], res[j][5]); ov.w = pk_ffn(res[j][6], res[j][7]);
            *(u32x4*)(C.ACT + (size_t)(pm * 256 + j) * DFF + c0) = ov; }
    }
}

__device__ __forceinline__ void ph2_proj(Ctx& C) {
    { pg8::Gemm g{C.H, C.WIN, M, 3072, D}; pg8::StaticOrder S; S.init(M, 3072, C.G, C.bid);
      pg8::EpiProj E{C.Q, C.KV, C.Z, C.GA, C.GB, 0};
      pg8::gemm_phase<pg8::EpiProj, pg8::StaticOrder>(C.lds, g, S, E); }
    { pg8::Gemm g{(const f16*)(C.ws + WS_H1Q), (const f16*)(C.ws + WS_WINQ), M, 13312, D / 2}; pg8::StaticOrder S; S.init(M, 13312, C.G, C.bid);
      pg8::EpiProjQ E{C.ws, 12};
      pg8::gemm_phase<pg8::EpiProjQ, pg8::StaticOrder, true, 2>(C.lds, g, S, E); }
    { pg8::Gemm g{(const f16*)(C.ws + WS_WVTQ), (const f16*)(C.ws + WS_H1Q), 1024, M, D / 2}; pg8::StaticOrder S; S.init(1024, M, C.G, C.bid);
      pg8::EpiVTQ E{C.ws};
      pg8::gemm_phase<pg8::EpiVTQ, pg8::StaticOrder, true, 2>(C.lds, g, S, E); }
}
__device__ __forceinline__ void ph3_mixers(Ctx& C) {
    for (int it = C.bid; it < 256; it += C.G) p3_gates_item(C, it);
    if constexpr (((PROBE_DUP) >> 12) & 1) { for (int it = C.bid; it < 256; it += C.G) p3_gates_item(C, it); }
    for (int it = C.bid; it < 256; it += C.G) p3_compress_item(C, it);
    if constexpr (((PROBE_DUP) >> 13) & 1) { for (int it = C.bid; it < 256; it += C.G) p3_compress_item(C, it); }
    for (int it = C.bid; it < 256; it += C.G) p3_sgu_item(C, it);
    if constexpr (((PROBE_DUP) >> 14) & 1) { for (int it = C.bid; it < 256; it += C.G) p3_sgu_item(C, it); }
}
__device__ __forceinline__ void ph5_merge(Ctx& C) {
    pg8::Gemm g{C.YAB, C.WM, M, D, D}; pg8::StaticOrder S; S.init(M, D, C.G, C.bid);
    pg8::EpiMerge E{C.GA, C.GB, C.H};
    pg8::gemm_phase<pg8::EpiMerge, pg8::StaticOrder, true, MIX_BF16 ? 1 : 0>(C.lds, g, S, E);
}
__device__ __forceinline__ void ph5w_quant(Ctx& C) { p1_quant_rows(C, C.WO, D, (signed char*)(C.ws + WS_WOQ), (float*)(C.ws + WS_SWO), MIX_BF16 != 0, true); }
__device__ __forceinline__ void ph5b_quant(Ctx& C) { p1_quant_rows(C, C.H, M, (signed char*)(C.ws + WS_MRGQ), (float*)(C.ws + WS_SAM), MIX_BF16 != 0, true); }
__device__ __forceinline__ void ph6_out(Ctx& C) {
    pg8::StaticOrder S; S.init(M, D, C.G, C.bid);
    if constexpr (P6_INT8) {
        pg8::Gemm g{(const f16*)(C.ws + WS_MRGQ), (const f16*)(C.ws + WS_WOQ), M, D, D / 2};
        pg8::EpiH16Q E{C.Y1, D, (const float*)(C.ws + WS_SAM), (const float*)(C.ws + WS_SWO)};
        pg8::gemm_phase<pg8::EpiH16Q, pg8::StaticOrder, true, 2>(C.lds, g, S, E);
    } else {
        pg8::Gemm g{C.H, C.WO, M, D, D};
        pg8::EpiH16 E{C.Y1, D};
        pg8::gemm_phase<pg8::EpiH16, pg8::StaticOrder, true, MIX_BF16 ? 1 : 0>(C.lds, g, S, E);
    }
}
__device__ __forceinline__ void ph8_up(Ctx& C) {
    pg8::Gemm g{(const f16*)((signed char*)(C.ws + WS_H2)), (const f16*)((signed char*)(C.ws + WS_WUPQ)), M + 256, NUP, D / 2}; pg8::StaticOrder S; S.init(M + 256, NUP, C.G, C.bid);
    pg8::EpiConv E{C.ws, C.conv_w, C.conv_b, (LAS float*)(C.lds + pg8::STAGE_BYTES), FFN_BF16};
    pg8::gemm_phase<pg8::EpiConv, pg8::StaticOrder, true, 2>(C.lds, g, S, E);
}
__device__ __forceinline__ void ph9_conv(Ctx& C) { p9_fixup(C); }
__device__ __forceinline__ void ph9b_quant(Ctx& C) { quant_rows_ff(C, C.ACT, M, (signed char*)(C.ws + WS_ACTQ), (float*)(C.ws + WS_SACT), FFN_BF16 != 0, true); }
__device__ __forceinline__ void ph10_down(Ctx& C) {
    pg8::Gemm g{(const f16*)(C.ws + WS_ACTQ), (const f16*)(C.ws + WS_WDNQ), M, D, DFF / 2}; pg8::StaticOrder S; S.init(M, D, C.G, C.bid);
    pg8::EpiH16Q E{C.Y2, D, (const float*)(C.ws + WS_SACT), (const float*)(C.ws + WS_SWDN)};
    pg8::gemm_phase<pg8::EpiH16Q, pg8::StaticOrder, true, 2>(C.lds, g, S, E);
}

constexpr int NPHASE = 12;
__global__ void __launch_bounds__(NTHREADS, 2) fwd_kernel(Args args) {
    extern __shared__ __attribute__((aligned(16))) unsigned char lds_raw[];
    Ctx C;
    C.lds = (LAS unsigned char*)lds_raw;
    C.tid = threadIdx.x; C.lane = C.tid & 63; C.wave = __builtin_amdgcn_readfirstlane(C.tid >> 6); C.G = gridDim.x; C.bid = blockIdx.x;
    C.x = args.in[0]; C.c = args.in[1]; C.w_mod = args.in[2]; C.b_mod = args.in[3]; C.g_norms = args.in[4]; C.w_in = args.in[5]; C.cmp_pos = args.in[6]; C.cmp_w1 = args.in[7];
    C.cmp_b1 = args.in[8]; C.cmp_w2 = args.in[9]; C.cmp_b2 = args.in[10]; C.rel_table = args.in[11]; C.ln_g = args.in[12]; C.ln_b = args.in[13]; C.sgu_w = args.in[14]; C.sgu_b = args.in[15];
    C.w_pn = args.in[16]; C.w_ps = args.in[17]; C.w_out = args.in[18]; C.w_up = args.in[19]; C.conv_w = args.in[20]; C.conv_b = args.in[21]; C.w_dn = args.in[22];
    C.out = args.out; C.ws = args.ws; unsigned char* ws = args.ws;
    C.mod = (float*)(ws + WS_MOD); C.posw1 = (float*)(ws + WS_POSW1); C.gates = (float*)(ws + WS_GATES); C.ysc = (float*)(ws + WS_YSC); C.AH = (float*)(ws + WS_AH); C.AT = (float*)(ws + WS_AT); C.Y1 = (f16*)(ws + WS_Z); C.Y2 = (f16*)(ws + WS_Y2); C.X1H = (f16*)(ws + WS_X1H);
    C.W2T = (f16*)(ws + WS_W2T); C.SGUW = (f16*)(ws + WS_SGUW); C.WG = (f16*)(ws + WS_WG); C.KC = (f16*)(ws + WS_KC); C.VCT = (f16*)(ws + WS_VCT); C.W1T = (f16*)(ws + WS_W1T);
    C.WUP = (f16*)(ws + WS_WUP); C.WDN = (f16*)(ws + WS_WDN); C.WIN = (f16*)(ws + WS_WIN); C.WVT = (f16*)(ws + WS_WVT); C.WM = (f16*)(ws + WS_WM); C.WO = (f16*)(ws + WS_WO);
    C.H = (f16*)(ws + WS_H); C.Q = (f16*)(ws + WS_Q); C.KV = (f16*)(ws + WS_KV); C.VT = (f16*)(ws + WS_VT); C.Z = (f16*)(ws + WS_Z); C.GA = (f16*)(ws + WS_GA); C.GB = (f16*)(ws + WS_GB);
    C.YAB = (f16*)(ws + WS_YAB); C.H2 = (f16*)(ws + WS_H2); C.ACT = (f16*)(ws + WS_ACT);

    volatile LAS unsigned* MISC = (volatile LAS unsigned*)(C.lds + MISC_OFF);
    for (int u = C.tid; u < (LDS_BYTES - MISC_OFF) / 4; u += NTHREADS) MISC[u] = 0u;
    __syncthreads();
    unsigned* barw = (unsigned*)(ws + WS_CTL) + CW_BAR;
    XcdBarrier bar; bar.bar = barw; bar.x = 0; bar.st = nullptr;
    if (MK_N_LAUNCHES == 1) bar = xcd_barrier_post(barw, MISC + 8);
    const int lo = args.ph_lo, hi = args.ph_hi;
#define IN(k) (lo <= (k) && (k) < hi)
#define DUP(k) ((((PROBE_DUP) >> (k)) & 1) != 0)
#define SEAM(k) do { if (IN(k) && IN((k) + 1)) { if (BAR_TPROBE == 100 || BAR_TPROBE == (k) + 1) { const long long t0_ = (long long)wall_clock64(); xcd_barrier(bar); ktp += (long long)wall_clock64() - t0_; } else xcd_barrier(bar); } } while (0)
    long long ktp = 0;

    if (IN(0)) { p0_prologue(C); if constexpr (DUP(0)) p0_prologue(C); }
    SEAM(0);
    if (IN(1)) { p1_norm(C); p1_quant_weights(C); if constexpr (DUP(1)) p1_norm(C); }
    SEAM(1);
    if (IN(2)) { ph2_proj(C); if constexpr (DUP(2)) ph2_proj(C); }
    SEAM(2);
    if (IN(3)) { ph3_mixers(C); if constexpr (DUP(3)) ph3_mixers(C); }
    SEAM(3);
    if (IN(4)) { p4_attention(C); if constexpr (DUP(4)) p4_attention(C); }
    SEAM(4);
    if (IN(5)) { ph5_merge(C); if constexpr (DUP(5)) ph5_merge(C); if (P6_INT8) { ph5w_quant(C); if (MK_N_LAUNCHES == 1) xcd_barrier(bar); ph5b_quant(C); } }
    SEAM(5);
    if (IN(6)) { ph6_out(C); if constexpr (DUP(6)) ph6_out(C); }
    SEAM(6);
    if (IN(7)) { p7_norm(C); }
    SEAM(7);
    if (IN(8)) { ph8_up(C); if constexpr (DUP(8)) ph8_up(C); }
    SEAM(8);
    if (IN(9)) { ph9_conv(C); if (MK_N_LAUNCHES == 1) xcd_barrier(bar); ph9b_quant(C); }
    SEAM(9);
    if (IN(10)) { ph10_down(C); if constexpr (DUP(10)) ph10_down(C); }
    SEAM(10);
    if (IN(11)) { p11_final(C); }
    if (BAR_TPROBE != 0) { const long long t0_ = (long long)wall_clock64(); while ((long long)wall_clock64() - t0_ < ktp) __builtin_amdgcn_s_sleep(8); }
#undef IN
#undef DUP
#undef SEAM
}

extern "C" void kernel_launch(void* const* d_in, const int* in_sizes, int n_in, void* d_out, int out_size, void* d_ws, size_t ws_size, hipStream_t stream) {
    static int grid = 0;
    if (grid == 0) {
        if (n_in != 23 || in_sizes[0] != M * D || out_size != M * D || ws_size < WS_END) { fprintf(stderr, "kernel_launch: unexpected shapes (n_in %d, in0 %d, out %d, ws %zu); nothing launched\n", n_in, n_in > 0 ? in_sizes[0] : -1, out_size, ws_size); grid = -1; return; }
        int dev = 0, cus = 0, per_cu = 0;
        if (hipGetDevice(&dev) != hipSuccess || hipDeviceGetAttribute(&cus, hipDeviceAttributeMultiprocessorCount, dev) != hipSuccess) { grid = -1; return; }
        if (hipFuncSetAttribute((const void*)fwd_kernel, hipFuncAttributeMaxDynamicSharedMemorySize, LDS_BYTES) != hipSuccess) { fprintf(stderr, "kernel_launch: hipFuncSetAttribute failed\n"); grid = -1; return; }
        if (hipOccupancyMaxActiveBlocksPerMultiprocessor(&per_cu, (const void*)fwd_kernel, NTHREADS, LDS_BYTES) != hipSuccess || per_cu < 1) { fprintf(stderr, "kernel_launch: occupancy query reports %d\n", per_cu); }
        (void)hipGetLastError();
        grid = cus;
        if (grid > 256) grid = 256;
    }
    if (grid < 0) return;
    (void)hipMemsetAsync((char*)d_ws + WS_CTL, 0, CTL_BYTES, stream);
    Args a{};
    for (int i = 0; i < 23; ++i) a.in[i] = (const float*)d_in[i];
    a.out = (float*)d_out; a.ws = (unsigned char*)d_ws;
    if (MK_N_LAUNCHES == 1) { a.ph_lo = 0; a.ph_hi = NPHASE; hipLaunchKernelGGL(fwd_kernel, dim3(grid), dim3(NTHREADS), LDS_BYTES, stream, a); }
    else { for (int li = 0; li < NPHASE; ++li) { a.ph_lo = li; a.ph_hi = li + 1; hipLaunchKernelGGL(fwd_kernel, dim3(grid), dim3(NTHREADS), LDS_BYTES, stream, a); } }
}
```
